# Optimizing an MI355X kernel written in HIP

```python
import jax, jax.numpy as jnp
from jax import lax
import numpy as np

D_MODEL = 2048
BATCH = 2
SEQ = 4096
DEPTH = 1
DEC_BATCH = 32
DEC_SEQ = 64
PAST_LEN = 1024

CHUNK = 64
HEAD_DIM = 64
N_HEADS = D_MODEL // HEAD_DIM
D_RWKV = N_HEADS * HEAD_DIM
D_CONV = D_MODEL
CONV_W = 3
LORA_W = 96
LORA_A = 96
LORA_G = 256
D_FF = 5632
RMS_EPS = 1e-6
GN_EPS = 64e-5
N_A = 3 * D_RWKV + LORA_W + LORA_A + LORA_G
N_IN = N_A + 3 * D_CONV + 2 * D_MODEL

kernel_name = 'rwkv7_shortconv_gated_hybrid_stream'


def rms_norm(x, g):
    xf = x.astype(jnp.float32)
    y = xf * lax.rsqrt(jnp.mean(xf * xf, axis=-1, keepdims=True) + RMS_EPS)
    return (y * g.astype(jnp.float32)).astype(x.dtype)


def swiglu(x, w_gate, w_up, w_down):
    return (jax.nn.silu(x @ w_gate) * (x @ w_up)) @ w_down


def wkv7_scan(r, w, k, v, kk, kka, s0):
    def step(s, xs):
        r_t, w_t, k_t, v_t, kk_t, kka_t = xs
        sa = jnp.einsum('bhvk,bhk->bhv', s, kk_t)
        s = s * w_t[:, :, None, :] - sa[..., None] * kka_t[:, :, None, :] + v_t[..., None] * k_t[:, :, None, :]
        return s, jnp.einsum('bhvk,bhk->bhv', s, r_t)
    xs = tuple(jnp.moveaxis(z, 1, 0) for z in (r, w, k, v, kk, kka))
    s, ys = lax.scan(step, s0, xs)
    return jnp.moveaxis(ys, 0, 1), s


def hybrid_layer(x, shift_prev, conv_prev, wkv_prev,
                 ffn1_norm, ffn1_gate, ffn1_up, ffn1_down,
                 mix_norm, w_in, mu_shift, w0, w_lora_up, a0, a_lora_up, g_lora_up,
                 k_k, k_a, r_k, ln_x_g, ln_x_b, conv_w, w_out,
                 ffn2_norm, ffn2_gate, ffn2_up, ffn2_down):
    b, t, _ = x.shape
    f32 = jnp.float32
    x = x + 0.5 * swiglu(rms_norm(x, ffn1_norm), ffn1_gate, ffn1_up, ffn1_down)

    h = rms_norm(x, mix_norm)
    p = h @ w_in
    pa = p[..., :N_A]
    pc = p[..., N_A:N_A + 3 * D_CONV]
    pg = p[..., N_A + 3 * D_CONV:]
    pa_first = (shift_prev @ w_in[:, :N_A])[:, None, :]
    pa_prev = jnp.concatenate([pa_first, pa[:, :-1]], axis=1)
    pa = pa + mu_shift * (pa_prev - pa)
    r, k, v, wl, al, gl = jnp.split(pa, [D_RWKV, 2 * D_RWKV, 3 * D_RWKV,
                                         3 * D_RWKV + LORA_W, 3 * D_RWKV + LORA_W + LORA_A], axis=-1)

    heads = lambda z: z.astype(f32).reshape(b, t, N_HEADS, HEAD_DIM)
    w_log = -jax.nn.softplus(-(w0.astype(f32) + jnp.tanh(wl.astype(f32)) @ w_lora_up.astype(f32))) - 0.5
    decay = jnp.exp(-jnp.exp(w_log))
    a = jax.nn.sigmoid(a0.astype(f32) + al.astype(f32) @ a_lora_up.astype(f32))
    g = jax.nn.sigmoid(gl.astype(f32)) @ g_lora_up.astype(f32)
    kk = heads(k * k_k)
    kk = kk / jnp.maximum(jnp.sqrt(jnp.sum(kk * kk, axis=-1, keepdims=True)), 1e-12)
    k_mod = k.astype(f32) * (1.0 + (a - 1.0) * k_a.astype(f32))
    rh, kh, vh, ah = heads(r), heads(k_mod), heads(v), heads(a)
    o, wkv_new = wkv7_scan(rh, heads(decay), kh, vh, kk, kk * ah, wkv_prev.astype(f32))
    mu = jnp.mean(o, axis=-1, keepdims=True)
    var = jnp.mean(jnp.square(o - mu), axis=-1, keepdims=True)
    o = ((o - mu) * lax.rsqrt(var + GN_EPS)).reshape(b, t, D_RWKV) * ln_x_g.astype(f32) + ln_x_b.astype(f32)
    bonus = (jnp.sum(rh * kh * r_k.astype(f32), axis=-1, keepdims=True) * vh).reshape(b, t, D_RWKV)
    y_a = ((o + bonus) * g).astype(x.dtype)

    gate_b, gate_c, xc = jnp.split(pc, [D_CONV, 2 * D_CONV], axis=-1)
    u = gate_c * xc
    full = jnp.concatenate([conv_prev.astype(u.dtype), u], axis=1)
    conv = conv_w[0] * full[:, 0:t]
    for j in range(1, CONV_W):
        conv = conv + conv_w[j] * full[:, j:j + t]
    y_b = gate_b * conv
    conv_new = full[:, t:]

    ga, gb = jnp.split(pg, [D_MODEL], axis=-1)
    merged = jax.nn.sigmoid(ga) * y_a + jax.nn.sigmoid(gb) * y_b
    x = x + merged @ w_out

    x = x + 0.5 * swiglu(rms_norm(x, ffn2_norm), ffn2_gate, ffn2_up, ffn2_down)
    return x, h[:, -1], conv_new, wkv_new.astype(wkv_prev.dtype)


def setup_inputs(seed: int = 0) -> dict:
    key = jax.random.key(seed)
    ks = jax.random.split(key, 32)
    f32 = jnp.float32
    L = DEPTH
    nrm = lambda k, shape, scale: jax.random.normal(k, shape, f32) * scale
    return {
        'x_prompt': nrm(ks[0], (BATCH, SEQ, D_MODEL), 1.0),
        'x_sample': nrm(ks[1], (DEC_BATCH, DEC_SEQ, D_MODEL), 1.0),
        'state_shift': nrm(ks[2], (L, DEC_BATCH, D_MODEL), 1.0),
        'state_conv': nrm(ks[3], (L, DEC_BATCH, CONV_W - 1, D_CONV), 1.0),
        'state_wkv': nrm(ks[4], (L, DEC_BATCH, N_HEADS, HEAD_DIM, HEAD_DIM), 0.5),
        'ffn1_norm': 1.0 + nrm(ks[5], (L, D_MODEL), 0.01),
        'ffn1_gate': nrm(ks[6], (L, D_MODEL, D_FF), D_MODEL ** -0.5),
        'ffn1_up': nrm(ks[7], (L, D_MODEL, D_FF), D_MODEL ** -0.5),
        'ffn1_down': nrm(ks[8], (L, D_FF, D_MODEL), D_FF ** -0.5),
        'mix_norm': 1.0 + nrm(ks[9], (L, D_MODEL), 0.01),
        'w_in': nrm(ks[10], (L, D_MODEL, N_IN), D_MODEL ** -0.5),
        'mu_shift': jax.random.uniform(ks[11], (L, N_A), f32),
        'w0': jax.random.uniform(ks[12], (L, D_RWKV), f32, -5.0, 0.0),
        'w_lora_up': nrm(ks[13], (L, LORA_W, D_RWKV), LORA_W ** -0.5),
        'a0': nrm(ks[14], (L, D_RWKV), 0.1),
        'a_lora_up': nrm(ks[15], (L, LORA_A, D_RWKV), LORA_A ** -0.5),
        'g_lora_up': nrm(ks[16], (L, LORA_G, D_RWKV), LORA_G ** -0.5),
        'k_k': 0.85 + nrm(ks[17], (L, D_RWKV), 0.05),
        'k_a': 1.0 + nrm(ks[18], (L, D_RWKV), 0.05),
        'r_k': nrm(ks[19], (L, N_HEADS, HEAD_DIM), 0.1),
        'ln_x_g': 1.0 + nrm(ks[20], (L, D_RWKV), 0.01),
        'ln_x_b': nrm(ks[21], (L, D_RWKV), 0.01),
        'conv_w': nrm(ks[22], (L, CONV_W, D_CONV), CONV_W ** -0.5),
        'w_out': nrm(ks[23], (L, D_MODEL, D_MODEL), D_MODEL ** -0.5),
        'ffn2_norm': 1.0 + nrm(ks[24], (L, D_MODEL), 0.01),
        'ffn2_gate': nrm(ks[25], (L, D_MODEL, D_FF), D_MODEL ** -0.5),
        'ffn2_up': nrm(ks[26], (L, D_MODEL, D_FF), D_MODEL ** -0.5),
        'ffn2_down': nrm(ks[27], (L, D_FF, D_MODEL), D_FF ** -0.5),
        'final_norm': 1.0 + nrm(ks[28], (D_MODEL,), 0.01),
    }


def reference(x_prompt, x_sample, state_shift, state_conv, state_wkv,
              ffn1_norm, ffn1_gate, ffn1_up, ffn1_down,
              mix_norm, w_in, mu_shift, w0, w_lora_up, a0, a_lora_up, g_lora_up,
              k_k, k_a, r_k, ln_x_g, ln_x_b, conv_w, w_out,
              ffn2_norm, ffn2_gate, ffn2_up, ffn2_down, final_norm):
    hp, hs = x_prompt, x_sample
    sh_p, cv_p, wk_p, sh_s, cv_s, wk_s = [], [], [], [], [], []
    for l in range(DEPTH):
        lw = tuple(w[l] for w in (ffn1_norm, ffn1_gate, ffn1_up, ffn1_down,
                                  mix_norm, w_in, mu_shift, w0, w_lora_up, a0, a_lora_up, g_lora_up,
                                  k_k, k_a, r_k, ln_x_g, ln_x_b, conv_w, w_out,
                                  ffn2_norm, ffn2_gate, ffn2_up, ffn2_down))
        zs = jnp.zeros((BATCH, D_MODEL), x_prompt.dtype)
        zc = jnp.zeros((BATCH, CONV_W - 1, D_CONV), x_prompt.dtype)
        zw = jnp.zeros((BATCH, N_HEADS, HEAD_DIM, HEAD_DIM), state_wkv.dtype)
        hp, s1, c1, w1 = hybrid_layer(hp, zs, zc, zw, *lw)
        hs, s2, c2, w2 = hybrid_layer(hs, state_shift[l], state_conv[l], state_wkv[l], *lw)
        sh_p.append(s1); cv_p.append(c1); wk_p.append(w1)
        sh_s.append(s2); cv_s.append(c2); wk_s.append(w2)
    y_prompt = rms_norm(hp, final_norm)
    y_sample = rms_norm(hs, final_norm)
    return (y_prompt, y_sample,
            jnp.stack(sh_p), jnp.stack(cv_p), jnp.stack(wk_p),
            jnp.stack(sh_s), jnp.stack(cv_s), jnp.stack(wk_s))
```

```cpp
#include <hip/hip_runtime.h>
#include <cstdio>

#define LAS __attribute__((address_space(3)))
typedef _Float16 h16;
typedef _Float16 h16x2 __attribute__((ext_vector_type(2)));
typedef _Float16 h16x4 __attribute__((ext_vector_type(4)));
typedef _Float16 h16x8 __attribute__((ext_vector_type(8)));
typedef float f32x4 __attribute__((ext_vector_type(4)));
typedef unsigned u32x4 __attribute__((ext_vector_type(4)));
typedef unsigned u32x2 __attribute__((ext_vector_type(2)));

constexpr int D = 2048, FF = 5632, NA = 6592, NIN = 16832;
constexpr int MP = 8192, MS = 2048, MT = MP + MS;
constexpr int MA = MT + 256;
constexpr int PP = 16896;
constexpr int PFW = 6656;
constexpr int C_GB = 6656, C_GC = 8704, C_XC = 10752, C_GA = 12800, C_GG = 14848;
constexpr int LK = 512;
constexpr int NCHUNK = MT / 64;
constexpr size_t O_Y = 0, O_SHP = 20971520, O_CVP = 20975616, O_WKP = 20983808, O_SHS = 21245952, O_CVS = 21311488, O_WKS = 21442560, O_END = 25636864;
constexpr size_t WS_CTL = 0;
constexpr size_t WS_W1GU = 1u << 20;
constexpr size_t WS_W1D = WS_W1GU + (size_t)2 * FF * D * 2;
constexpr size_t WS_WIN = WS_W1D + (size_t)D * FF * 2;
constexpr size_t WS_WOUT = WS_WIN + (size_t)PP * D * 2;
constexpr size_t WS_A16 = WS_WOUT + (size_t)D * D * 2;
constexpr size_t WS_P16 = WS_A16 + (size_t)MA * D * 2;
constexpr size_t WS_END = WS_P16 + (size_t)MT * PP * 2;
constexpr size_t WS_EAG = WS_W1GU;
constexpr size_t WS_HM = WS_P16;
constexpr size_t WS_W2GU = WS_P16 + (size_t)MT * FF * 2;
constexpr size_t WS_W2D = WS_W2GU + (size_t)2 * FF * D * 2;
static_assert((size_t)MT * 6144 * 2 <= WS_WOUT - WS_W1GU, "EAG overlay");
static_assert(WS_W2D + (size_t)D * FF * 2 <= WS_END, "W2 overlay");
constexpr size_t OB_WL = O_WKS * 4;
constexpr size_t OB_PF = OB_WL + (size_t)6144 * LK * 2;
constexpr size_t OB_SIDE = OB_PF + (size_t)256 * PFW * 2;
static_assert(OB_SIDE + (size_t)NCHUNK * PFW * 2 <= O_END * 4, "d_out scratch");

constexpr int NWAVES = 8, NTHR = 512;
constexpr int LDS_BYTES = 147456;

__device__ __forceinline__ unsigned pk2h(float a, float b) { h16x2 v = {(h16)a, (h16)b}; return __builtin_bit_cast(unsigned, v); }
__device__ __forceinline__ float wave_sum(float v) {
#pragma unroll
    for (int o = 1; o < 64; o <<= 1) v += __shfl_xor(v, o);
    return v;
}
__device__ __forceinline__ float sigmoidf_(float x) { return 1.0f / (1.0f + __expf(-x)); }

namespace pg8 {
constexpr int BM = 256, BK = 64, HALF = 128, HTB = HALF * BK * 2, STAGE_BYTES = 8 * HTB, NXCD = 8, WGM = 8;
__host__ __device__ __forceinline__ int lds_byte(int r, int c) { const int st = (r >> 4) * 2 + (c >> 5), rr = r & 15, cc = c & 31, ob = rr * 64 + cc * 2; return st * 1024 + (ob ^ (((ob >> 9) & 1) << 5)); }
__host__ __device__ __forceinline__ void stage_rc(int b, int& R, int& C) { const int st = b / 1024, sb = b % 1024, swz = sb ^ (((sb >> 9) & 1) << 5); R = (st >> 1) * 16 + swz / 64; C = (st & 1) * 32 + (swz % 64) / 2; }
__host__ __device__ __forceinline__ int perm32(int rho) { const int n = rho >> 4, i = rho & 15; return 8 * (i >> 2) + 4 * n + (i & 3); }
struct Unit { int pm, pn; };
struct Gemm { const h16* A; const h16* Bt; int M, N, K; };
struct Order {
    int nM, nN, nwg, G, c, extra;
    __device__ void init(int M, int N, int G_, int c_, int extra_) { nM = M / BM; nN = N / BM; nwg = nM * nN; G = G_; c = c_; extra = extra_; }
    __device__ bool next(int i, Unit& u) const {
        const long L = (long)i * G + c; if (L >= nwg + extra) return false;
        if (L >= nwg) { u.pm = nM; u.pn = (int)(L - nwg); return true; }
        int wgid = (int)L; { const int q = nwg / NXCD, r = nwg % NXCD, xcd = wgid % NXCD, off = wgid / NXCD; wgid = (xcd < r ? xcd * (q + 1) : r * (q + 1) + (xcd - r) * q) + off; }
        const int nig = WGM * nN, gid = wgid / nig, fm = gid * WGM, gsz = (nM - fm) < WGM ? (nM - fm) : WGM;
        u.pm = fm + ((wgid % nig) % gsz); u.pn = (wgid % nig) / gsz; return true;
    }
};

template <class Epi>
__device__ __forceinline__ void gemm_phase(LAS unsigned char* lds, const Gemm g, const Order& S, const Epi& E) {
    const int tid = threadIdx.x, wid = __builtin_amdgcn_readfirstlane(tid >> 6), lane = tid & 63, wr = wid >> 2, wc = wid & 3, fr = lane & 15, fq = lane >> 4;
    const int K = g.K, nt = K / BK;
    unsigned voffA[2], voffB[2];
#pragma unroll
    for (int i = 0; i < 2; ++i) { int R, C; stage_rc(tid * 16 + i * 8192, R, C); const int Rb = Epi::PERM ? ((R & ~31) + perm32(R & 31)) : R;
        voffA[i] = (unsigned)(R * K + C) * 2u; voffB[i] = (unsigned)(Rb * K + C) * 2u; }
    const size_t kstep = (size_t)(BK * 2);
    const size_t hstep = (size_t)HALF * K * 2;
    const size_t tstep = 2 * hstep;
    const unsigned ldsw = (unsigned)wid * 1024u;
    const int aoff = lds_byte(wr * 64 + fr, fq * 8), boff = lds_byte(wc * 32 + fr, fq * 8);
#define PG8_SA(b, h) (((b) * 2 + (h)) * HTB)
#define PG8_SB(b, h) ((4 + (b) * 2 + (h)) * HTB)
#define PG8_STAGE(bufoff, gbase, voff) do { _Pragma("unroll") for (int _i = 0; _i < 2; ++_i) \
        __builtin_amdgcn_global_load_lds((const unsigned*)((const char*)(gbase) + (voff)[_i]), (LAS unsigned*)(lds + (bufoff) + ldsw + _i * 8192), 16, 0, 0); } while (0)
#define PG8_LDA(dst, b, h) do { _Pragma("unroll") for (int m = 0; m < 4; ++m) _Pragma("unroll") for (int k = 0; k < 2; ++k) dst[m][k] = *(const LAS h16x8*)(lds + PG8_SA(b, h) + aoff + m * 2048 + k * 1024); } while (0)
#define PG8_LDB(dst, b, h) do { _Pragma("unroll") for (int n = 0; n < 2; ++n) _Pragma("unroll") for (int k = 0; k < 2; ++k) dst[n][k] = *(const LAS h16x8*)(lds + PG8_SB(b, h) + boff + n * 2048 + k * 1024); } while (0)
#define PG8_MMA(ai, bj, At, Bt) do { __builtin_amdgcn_s_setprio(1); _Pragma("unroll") for (int m = 0; m < 4; ++m) _Pragma("unroll") for (int n = 0; n < 2; ++n) _Pragma("unroll") for (int k = 0; k < 2; ++k) \
        acc[ai][bj][m][n] = __builtin_amdgcn_mfma_f32_16x16x32_f16(Bt[n][k], At[m][k], acc[ai][bj][m][n], 0, 0, 0); __builtin_amdgcn_s_setprio(0); } while (0)
#define PG8_WAIT_V(n) asm volatile("s_waitcnt vmcnt(" #n ")" ::: "memory")
#define PG8_WAIT_L(n) asm volatile("s_waitcnt lgkmcnt(" #n ")" ::: "memory")
#define PG8_BAR __builtin_amdgcn_s_barrier()
#define PG8_SCHED __builtin_amdgcn_sched_barrier(0)
    Unit cur, nxt; int ui = 0;
    if (!S.next(0, cur)) return;
    f32x4 acc[2][2][4][2];
#pragma unroll
    for (int a = 0; a < 2; ++a)
#pragma unroll
        for (int b = 0; b < 2; ++b)
#pragma unroll
            for (int m = 0; m < 4; ++m)
#pragma unroll
                for (int n = 0; n < 2; ++n) acc[a][b][m][n] = (f32x4){0.f, 0.f, 0.f, 0.f};
    h16x8 At[4][2], B0[2][2], B1[2][2];
    const char* cA = (const char*)g.A + (size_t)cur.pm * tstep; const char* cB = (const char*)g.Bt + (size_t)cur.pn * tstep;
    PG8_STAGE(PG8_SB(0, 0), cB, voffB); PG8_STAGE(PG8_SA(0, 0), cA, voffA); PG8_STAGE(PG8_SB(0, 1), cB + hstep, voffB); PG8_STAGE(PG8_SA(0, 1), cA + hstep, voffA);
    if (wr == 1) PG8_BAR;
    PG8_WAIT_V(4); PG8_BAR;
    PG8_STAGE(PG8_SB(1, 0), cB + kstep, voffB); PG8_STAGE(PG8_SA(1, 0), cA + kstep, voffA); PG8_STAGE(PG8_SB(1, 1), cB + hstep + kstep, voffB);
    PG8_WAIT_V(6); PG8_BAR;
    for (;;) {
        const bool has_next = S.next(ui + 1, nxt);
        const char* nA = has_next ? (const char*)g.A + (size_t)nxt.pm * tstep : cA; const char* nB = has_next ? (const char*)g.Bt + (size_t)nxt.pn * tstep : cB;
        for (int t = 0; t < nt; t += 2) {
            const bool last = (t == nt - 2);
            const char* a1 = cA + (size_t)(t + 1) * kstep;
            const char* a2 = last ? nA : cA + (size_t)(t + 2) * kstep; const char* b2 = last ? nB : cB + (size_t)(t + 2) * kstep;
            const char* a3 = a2 + kstep; const char* b3 = b2 + kstep;
            PG8_LDB(B0, 0, 0); PG8_SCHED; PG8_LDA(At, 0, 0); PG8_STAGE(PG8_SA(1, 1), a1 + hstep, voffA);
            PG8_WAIT_L(8); PG8_BAR; PG8_WAIT_L(0); PG8_MMA(0, 0, At, B0); PG8_BAR; PG8_SCHED;
            PG8_LDB(B1, 0, 1); PG8_STAGE(PG8_SB(0, 0), b2, voffB);
            PG8_BAR; PG8_WAIT_L(0); PG8_MMA(0, 1, At, B1); PG8_BAR;
            PG8_LDA(At, 0, 1); PG8_STAGE(PG8_SA(0, 0), a2, voffA);
            PG8_BAR; PG8_WAIT_L(0); PG8_MMA(1, 0, At, B0); PG8_BAR; PG8_SCHED;
            PG8_STAGE(PG8_SB(0, 1), b2 + hstep, voffB);
            PG8_WAIT_V(6); PG8_BAR; PG8_MMA(1, 1, At, B1); PG8_BAR;
            PG8_LDB(B0, 1, 0); PG8_SCHED; PG8_LDA(At, 1, 0); PG8_STAGE(PG8_SA(0, 1), a2 + hstep, voffA);
            PG8_WAIT_L(8); PG8_BAR; PG8_WAIT_L(0); PG8_MMA(0, 0, At, B0); PG8_BAR; PG8_SCHED;
            PG8_LDB(B1, 1, 1); PG8_STAGE(PG8_SB(1, 0), b3, voffB);
            PG8_BAR; PG8_WAIT_L(0); PG8_MMA(0, 1, At, B1); PG8_BAR;
            PG8_LDA(At, 1, 1); PG8_STAGE(PG8_SA(1, 0), a3, voffA);
            PG8_BAR; PG8_WAIT_L(0); PG8_MMA(1, 0, At, B0); PG8_BAR; PG8_SCHED;
            PG8_STAGE(PG8_SB(1, 1), b3 + hstep, voffB);
            PG8_WAIT_V(6); PG8_BAR; PG8_MMA(1, 1, At, B1); PG8_BAR;
        }
        E(acc, cur, wr, wc, fr, fq);
        if (!has_next) break;
#pragma unroll
        for (int a = 0; a < 2; ++a)
#pragma unroll
            for (int b = 0; b < 2; ++b)
#pragma unroll
                for (int m = 0; m < 4; ++m)
#pragma unroll
                    for (int n = 0; n < 2; ++n) acc[a][b][m][n] = (f32x4){0.f, 0.f, 0.f, 0.f};
        cur = nxt; cA = nA; cB = nB; ++ui;
    }
    PG8_WAIT_V(0);
    if (wr == 0) PG8_BAR;
    PG8_BAR;
#undef PG8_SA
#undef PG8_SB
#undef PG8_STAGE
#undef PG8_LDA
#undef PG8_LDB
#undef PG8_MMA
#undef PG8_WAIT_V
#undef PG8_WAIT_L
#undef PG8_BAR
#undef PG8_SCHED
}

struct EpiSwiGLU {
    static constexpr bool PERM = false;
    h16* O; int ldo;
    __device__ __forceinline__ void operator()(const f32x4 (&acc)[2][2][4][2], const Unit& u, int wr, int wc, int fr, int fq) const {
        const int row0 = u.pm * BM + wr * 64 + fr;
#pragma unroll
        for (int ai = 0; ai < 2; ++ai)
#pragma unroll
            for (int m = 0; m < 4; ++m) { h16* rowp = O + (size_t)(row0 + ai * HALF + m * 16) * ldo;
#pragma unroll
                for (int bj = 0; bj < 2; ++bj) { const int oc = (u.pn * BM + bj * HALF + wc * 32) / 2 + 4 * fq;
                    const f32x4 gt = acc[ai][bj][m][0], up = acc[ai][bj][m][1]; float o[4];
#pragma unroll
                    for (int j = 0; j < 4; ++j) o[j] = gt[j] * sigmoidf_(gt[j]) * up[j];
                    u32x2 w; w.x = pk2h(o[0], o[1]); w.y = pk2h(o[2], o[3]);
                    *(u32x2*)(rowp + oc) = w; } }
    }
};
struct EpiRes {
    static constexpr bool PERM = false;
    const float* r0; const float* r1; float* out; float scale; int pad;
    __device__ __forceinline__ void operator()(const f32x4 (&acc)[2][2][4][2], const Unit& u, int wr, int wc, int fr, int fq) const {
        const int row0 = u.pm * BM + wr * 64 + fr, col0 = u.pn * BM + wc * 32 + 4 * fq;
        const float* rb = (u.pm * BM < MP) ? r0 : r1 - (size_t)MP * D;
#pragma unroll
        for (int ai = 0; ai < 2; ++ai)
#pragma unroll
            for (int m = 0; m < 4; ++m) { const size_t off = (size_t)(row0 + ai * HALF + m * 16) * D + col0;
#pragma unroll
                for (int bj = 0; bj < 2; ++bj)
#pragma unroll
                    for (int n = 0; n < 2; ++n) { const f32x4 rv = *(const f32x4*)(rb + off + bj * HALF + n * 16);
                        *(f32x4*)(out + off + bj * HALF + n * 16) = rv + scale * acc[ai][bj][m][n]; } }
    }
};
struct EpiP16 {
    static constexpr bool PERM = true;
    h16* P; h16* PF; h16* SIDE;
    __device__ __forceinline__ void operator()(const f32x4 (&acc)[2][2][4][2], const Unit& u, int wr, int wc, int fr, int fq) const {
        const int row0 = u.pm * BM + wr * 64 + fr;
#pragma unroll
        for (int ai = 0; ai < 2; ++ai)
#pragma unroll
            for (int m = 0; m < 4; ++m) { const int row = row0 + ai * HALF + m * 16;
#pragma unroll
                for (int bj = 0; bj < 2; ++bj) { const int col = u.pn * BM + bj * HALF + wc * 32 + 8 * fq;
                    const f32x4 v0 = acc[ai][bj][m][0], v1 = acc[ai][bj][m][1];
                    u32x4 w; w.x = pk2h(v0[0], v0[1]); w.y = pk2h(v0[2], v0[3]); w.z = pk2h(v1[0], v1[1]); w.w = pk2h(v1[2], v1[3]);
                    if (u.pm < MT / BM) { *(u32x4*)(P + (size_t)row * PP + col) = w;
                        if ((row & 63) == 63 && col < PFW) *(u32x4*)(SIDE + (size_t)(row >> 6) * PFW + col) = w; }
                    else *(u32x4*)(PF + (size_t)(row - MT) * PFW + col) = w; } }
    }
};
struct EpiEAG {
    static constexpr bool PERM = true;
    h16* O; const float* w0; const float* a0;
    __device__ __forceinline__ void operator()(const f32x4 (&acc)[2][2][4][2], const Unit& u, int wr, int wc, int fr, int fq) const {
        const int row0 = u.pm * BM + wr * 64 + fr; const int typ = u.pn >> 3;
#pragma unroll
        for (int bj = 0; bj < 2; ++bj) { const int col = u.pn * BM + bj * HALF + wc * 32 + 8 * fq;
            f32x4 b0 = (f32x4){0.f, 0.f, 0.f, 0.f}, b1 = b0;
            if (typ == 0) { b0 = *(const f32x4*)(w0 + col); b1 = *(const f32x4*)(w0 + col + 4); }
            if (typ == 1) { b0 = *(const f32x4*)(a0 + col - D); b1 = *(const f32x4*)(a0 + col - D + 4); }
#pragma unroll
            for (int ai = 0; ai < 2; ++ai)
#pragma unroll
                for (int m = 0; m < 4; ++m) { const int row = row0 + ai * HALF + m * 16;
                    f32x4 v0 = acc[ai][bj][m][0] + b0, v1 = acc[ai][bj][m][1] + b1;
                    if (typ < 2) { const float sc = typ == 0 ? 0.60653065971f : 1.0f;
#pragma unroll
                        for (int j = 0; j < 4; ++j) { v0[j] = sigmoidf_(v0[j]) * sc; v1[j] = sigmoidf_(v1[j]) * sc; } }
                    u32x4 w; w.x = pk2h(v0[0], v0[1]); w.y = pk2h(v0[2], v0[3]); w.z = pk2h(v1[0], v1[1]); w.w = pk2h(v1[2], v1[3]);
                    *(u32x4*)(O + (size_t)row * 6144 + col) = w; } }
    }
};
}

struct Args { const float* in[29]; float* out; unsigned char* ws; int ph_lo, ph_hi; };

__device__ __forceinline__ void cvt_item(int mode, const float* s0, const float* s1, int Nsrc, int K, h16* WT, LAS float* scr, int item, int nblk, int lane) {
    const int kb = item / nblk, nb = item % nblk, k0 = 64 * kb, n0 = 32 * nb;
    const int nn = lane & 31; const float* src = s0; int col = n0 + nn; bool zero = false;
    if (mode == 1) { src = (nn < 16) ? s0 : s1; col = (n0 >> 1) + (nn & 15); }
    if (mode == 2) { if (n0 >= NA && n0 < PFW) zero = true; else if (n0 >= PFW) col -= 64; }
#pragma unroll 8
    for (int i = 0; i < 32; ++i) { const int kk = 2 * i + (lane >> 5); scr[kk * 33 + nn] = zero ? 0.f : src[(size_t)(k0 + kk) * Nsrc + col]; }
    asm volatile("s_waitcnt lgkmcnt(0)" ::: "memory");
    const int c = lane & 7;
#pragma unroll
    for (int j = 0; j < 4; ++j) { const int n = (lane >> 3) + 8 * j; const LAS float* s = scr + (8 * c) * 33 + n;
        u32x4 o; o.x = pk2h(s[0 * 33], s[1 * 33]); o.y = pk2h(s[2 * 33], s[3 * 33]); o.z = pk2h(s[4 * 33], s[5 * 33]); o.w = pk2h(s[6 * 33], s[7 * 33]);
        *(u32x4*)(WT + (size_t)(n0 + n) * K + k0 + 8 * c) = o; }
    asm volatile("s_waitcnt lgkmcnt(0)" ::: "memory");
}
__device__ __forceinline__ void cvt_lora_item(const float* wl, const float* al, const float* gl, h16* WT, int item, int lane) {
    const int n = item, typ = n >> 11, col = n & 2047; unsigned w[4];
#pragma unroll
    for (int j = 0; j < 4; ++j) { float v[2];
#pragma unroll
        for (int e = 0; e < 2; ++e) { const int k = lane * 8 + j * 2 + e; float x = 0.f;
            if (typ == 0 && k < 96) x = wl[(size_t)k * D + col];
            if (typ == 1 && k >= 96 && k < 192) x = al[(size_t)(k - 96) * D + col];
            if (typ == 2 && k >= 192 && k < 448) x = gl[(size_t)(k - 192) * D + col];
            v[e] = x; }
        w[j] = pk2h(v[0], v[1]); }
    *(u32x4*)(WT + (size_t)n * LK + lane * 8) = (u32x4){w[0], w[1], w[2], w[3]};
}

__device__ __forceinline__ void rms_row_f16(const float* xrow, const float* g, h16* orow, float* f32row, int lane) {
    const f32x4* xr = (const f32x4*)xrow + lane; const f32x4* gr = (const f32x4*)g + lane;
    f32x4 v[8]; float s = 0.f;
#pragma unroll
    for (int j = 0; j < 8; ++j) { v[j] = xr[64 * j]; s += (v[j].x * v[j].x + v[j].y * v[j].y) + (v[j].z * v[j].z + v[j].w * v[j].w); }
    const float rs = rsqrtf(wave_sum(s) * (1.f / D) + 1e-6f);
#pragma unroll
    for (int j = 0; j < 8; ++j) { const f32x4 gg = gr[64 * j]; const f32x4 o = v[j] * rs * gg;
        if (orow) { u32x2 w; w.x = pk2h(o.x, o.y); w.y = pk2h(o.z, o.w); *((u32x2*)orow + lane + 64 * j) = w; }
        if (f32row) *((f32x4*)f32row + lane + 64 * j) = o; }
}

enum { PH_CVT1 = 0, PH_FFN1_GU, PH_FFN1_D, PH_RMS_MIX, PH_WIN, PH_SHIFT, PH_LORA, PH_SCAN, PH_MERGE, PH_WOUT, PH_RMS2, PH_FFN2_GU, PH_FFN2_D, PH_FINAL, PH_N };

__global__ void __launch_bounds__(NTHR, 2) fwd_kernel(Args a) {
    extern __shared__ __attribute__((aligned(16))) unsigned char lds_raw[];
    LAS unsigned char* lds = (LAS unsigned char*)lds_raw;
    const int tid = threadIdx.x, lane = tid & 63, wave = __builtin_amdgcn_readfirstlane(tid >> 6);
    const int G = gridDim.x, bx = blockIdx.x;
    const int gw = bx * NWAVES + wave, NGW = G * NWAVES;
    unsigned char* ws = a.ws; unsigned char* ob = (unsigned char*)a.out;
    h16* W1GU = (h16*)(ws + WS_W1GU); h16* W1D = (h16*)(ws + WS_W1D); h16* WIN = (h16*)(ws + WS_WIN); h16* WOUT = (h16*)(ws + WS_WOUT);
    h16* A16 = (h16*)(ws + WS_A16); h16* P16 = (h16*)(ws + WS_P16); h16* EAG = (h16*)(ws + WS_EAG); h16* HM = (h16*)(ws + WS_HM);
    h16* W2GU = (h16*)(ws + WS_W2GU); h16* W2D = (h16*)(ws + WS_W2D);
    h16* WL = (h16*)(ob + OB_WL); h16* PF = (h16*)(ob + OB_PF); h16* SIDE = (h16*)(ob + OB_SIDE);
    float* Y = a.out + O_Y;
    const int lo = a.ph_lo, hi = a.ph_hi;
#define IN(k) (lo <= (k) && (k) < hi)

    if (IN(PH_CVT1)) {
        LAS float* scr = (LAS float*)(lds + wave * 16384);
        constexpr int I1 = (D / 64) * (2 * FF / 32), I2 = (FF / 64) * (D / 32), I3 = (D / 64) * (PP / 32), I4 = (D / 64) * (D / 32);
        for (int it = gw; it < I1 + I2 + I3 + I4; it += NGW) {
            int r = it;
            if (r < I1) { cvt_item(1, a.in[6], a.in[7], FF, D, W1GU, scr, r, 2 * FF / 32, lane); continue; } r -= I1;
            if (r < I2) { cvt_item(0, a.in[8], nullptr, D, FF, W1D, scr, r, D / 32, lane); continue; } r -= I2;
            if (r < I3) { cvt_item(2, a.in[10], nullptr, NIN, D, WIN, scr, r, PP / 32, lane); continue; } r -= I3;
            cvt_item(0, a.in[23], nullptr, D, D, WOUT, scr, r, D / 32, lane);
        }
        for (int it = gw; it < 6144; it += NGW) cvt_lora_item(a.in[13], a.in[15], a.in[16], WL, it, lane);
        for (int r = gw; r < 256; r += NGW) { h16* orow = A16 + (size_t)(MT + r) * D;
#pragma unroll
            for (int j = 0; j < 8; ++j) { u32x2 w = (u32x2){0u, 0u};
                if (r < 32) { const f32x4 v = *((const f32x4*)(a.in[2] + (size_t)r * D) + lane + 64 * j); w.x = pk2h(v.x, v.y); w.y = pk2h(v.z, v.w); }
                *((u32x2*)orow + lane + 64 * j) = w; } }
        for (int m = gw; m < MT; m += NGW) { const float* xr = m < MP ? a.in[0] + (size_t)m * D : a.in[1] + (size_t)(m - MP) * D; rms_row_f16(xr, a.in[5], A16 + (size_t)m * D, nullptr, lane); }
    }
    if (IN(PH_FFN1_GU)) { pg8::Gemm g{A16, W1GU, MT, 2 * FF, D}; pg8::Order S; S.init(MT, 2 * FF, G, bx, 0); pg8::EpiSwiGLU E{HM, FF}; pg8::gemm_phase(lds, g, S, E); }
    if (IN(PH_FFN1_D)) { pg8::Gemm g{HM, W1D, MT, D, FF}; pg8::Order S; S.init(MT, D, G, bx, 0); pg8::EpiRes E{a.in[0], a.in[1], Y, 0.5f, 0}; pg8::gemm_phase(lds, g, S, E); }
    if (IN(PH_RMS_MIX)) {
        for (int m = gw; m < MT; m += NGW) { float* so = nullptr;
            if (m < MP) { if ((m & 4095) == 4095) so = a.out + O_SHP + (size_t)(m >> 12) * D; } else { if (((m - MP) & 63) == 63) so = a.out + O_SHS + (size_t)((m - MP) >> 6) * D; }
            rms_row_f16(Y + (size_t)m * D, a.in[9], A16 + (size_t)m * D, so, lane); }
    }
    if (IN(PH_WIN)) { pg8::Gemm g{A16, WIN, MT, PP, D}; pg8::Order S; S.init(MT, PP, G, bx, PFW / 256); pg8::EpiP16 E{P16, PF, SIDE}; pg8::gemm_phase(lds, g, S, E); }
    if (IN(PH_SHIFT)) {
        h16* AIN = A16; const float* mu = a.in[11];
        for (int c = bx; c < NCHUNK; c += G) {
            const bool seq_start = (c < 128) ? ((c & 63) == 0) : true;
            for (int o8 = tid; o8 < 840; o8 += NTHR) {
                const int c0 = o8 * 8; const size_t rowb = (size_t)c * 64;
                if (o8 >= 824) {
                    if (o8 < 832) { for (int t = 0; t < 64; ++t) *(u32x4*)(AIN + (rowb + t) * LK + 448 + (o8 - 824) * 8) = (u32x4){0u, 0u, 0u, 0u}; }
                    continue; }
                float prev[8], mu8[8];
                { const f32x4 m0 = *(const f32x4*)(mu + c0), m1 = *(const f32x4*)(mu + c0 + 4);
                  mu8[0] = m0.x; mu8[1] = m0.y; mu8[2] = m0.z; mu8[3] = m0.w; mu8[4] = m1.x; mu8[5] = m1.y; mu8[6] = m1.z; mu8[7] = m1.w; }
                if (seq_start && c < 128) {
#pragma unroll
                    for (int j = 0; j < 8; ++j) prev[j] = 0.f;
                } else { const h16* pp = seq_start ? PF + (size_t)(c - 128) * PFW + c0 : SIDE + (size_t)(c - 1) * PFW + c0; const h16x8 pv = *(const h16x8*)pp;
#pragma unroll
                    for (int j = 0; j < 8; ++j) prev[j] = (float)pv[j]; }
                for (int t = 0; t < 64; ++t) {
                    h16* pr = P16 + (rowb + t) * PP + c0; const h16x8 cv = *(const h16x8*)pr; float s[8];
#pragma unroll
                    for (int j = 0; j < 8; ++j) { const float cu = (float)cv[j]; s[j] = cu + mu8[j] * (prev[j] - cu); prev[j] = cu; }
                    if (c0 < 6144) { *(u32x4*)pr = (u32x4){pk2h(s[0], s[1]), pk2h(s[2], s[3]), pk2h(s[4], s[5]), pk2h(s[6], s[7])}; }
                    else { const int idx = c0 - 6144;
                        if (idx < 96) {
#pragma unroll
                            for (int j = 0; j < 8; ++j) s[j] = tanhf(s[j]);
                        } else if (idx >= 192) {
#pragma unroll
                            for (int j = 0; j < 8; ++j) s[j] = sigmoidf_(s[j]);
                        }
                        *(u32x4*)(AIN + (rowb + t) * LK + idx) = (u32x4){pk2h(s[0], s[1]), pk2h(s[2], s[3]), pk2h(s[4], s[5]), pk2h(s[6], s[7])}; }
                }
            }
        }
    }
    if (IN(PH_LORA)) { pg8::Gemm g{A16, WL, MT, 6144, LK}; pg8::Order S; S.init(MT, 6144, G, bx, 0); pg8::EpiEAG E{EAG, a.in[12], a.in[14]}; pg8::gemm_phase(lds, g, S, E); }
    if (IN(PH_SCAN)) {
        int item = -1;
        if (wave == 0) { if (bx < 64) item = bx; } else { const int idx = bx * 7 + (wave - 1); if (idx < 1024) item = 64 + idx; }
        if (item >= 0) {
            LAS float* sh = (LAS float*)(lds + wave * 2048);
            int row0, T, h; const float* s0 = nullptr; float* sout;
            if (item < 64) { const int b = item >> 5; h = item & 31; row0 = b * 4096; T = 4096; sout = a.out + O_WKP + (size_t)(b * 32 + h) * 4096; }
            else { const int b = (item - 64) >> 5; h = (item - 64) & 31; row0 = MP + b * 64; T = 64; s0 = a.in[4] + (size_t)(b * 32 + h) * 4096; sout = a.out + O_WKS + (size_t)(b * 32 + h) * 4096; }
            const int hj = h * 64 + lane;
            float S[64];
#pragma unroll
            for (int k4 = 0; k4 < 16; ++k4) { f32x4 v = (f32x4){0.f, 0.f, 0.f, 0.f}; if (s0) v = *(const f32x4*)(s0 + lane * 64 + k4 * 4); S[k4 * 4] = v.x; S[k4 * 4 + 1] = v.y; S[k4 * 4 + 2] = v.z; S[k4 * 4 + 3] = v.w; }
            const float kkc = a.in[17][hj], kac = a.in[18][hj], rkc = a.in[19][hj], lg = a.in[20][hj], lb = a.in[21][hj];
            for (int t = 0; t < T; ++t) {
                const size_t m = (size_t)(row0 + t);
                const float r = (float)P16[m * PP + hj], k = (float)P16[m * PP + D + hj], v = (float)P16[m * PP + 2 * D + hj];
                const float e = (float)EAG[m * 6144 + hj], av = (float)EAG[m * 6144 + D + hj], gv = (float)EAG[m * 6144 + 2 * D + hj];
                const float w = __expf(-e);
                const float kkr = k * kkc; const float ss = wave_sum(kkr * kkr); const float kk = kkr / fmaxf(sqrtf(ss), 1e-12f);
                const float kmod = k * (1.f + (av - 1.f) * kac), kka = kk * av;
                asm volatile("s_waitcnt lgkmcnt(0)" ::: "memory");
                sh[lane] = kk; sh[64 + lane] = w; sh[128 + lane] = kka; sh[192 + lane] = kmod; sh[256 + lane] = r;
                asm volatile("s_waitcnt lgkmcnt(0)" ::: "memory");
                float sa0 = 0.f, sa1 = 0.f, sa2 = 0.f, sa3 = 0.f;
#pragma unroll
                for (int k4 = 0; k4 < 16; ++k4) { const f32x4 q = *(const LAS f32x4*)(sh + k4 * 4); sa0 += S[k4 * 4] * q.x; sa1 += S[k4 * 4 + 1] * q.y; sa2 += S[k4 * 4 + 2] * q.z; sa3 += S[k4 * 4 + 3] * q.w; }
                const float sa = (sa0 + sa1) + (sa2 + sa3);
                float o0 = 0.f, o1 = 0.f, o2 = 0.f, o3 = 0.f;
#pragma unroll
                for (int k4 = 0; k4 < 16; ++k4) {
                    const f32x4 qw = *(const LAS f32x4*)(sh + 64 + k4 * 4), qa = *(const LAS f32x4*)(sh + 128 + k4 * 4), qk = *(const LAS f32x4*)(sh + 192 + k4 * 4), qr = *(const LAS f32x4*)(sh + 256 + k4 * 4);
                    S[k4 * 4] = S[k4 * 4] * qw.x + (v * qk.x - sa * qa.x); S[k4 * 4 + 1] = S[k4 * 4 + 1] * qw.y + (v * qk.y - sa * qa.y);
                    S[k4 * 4 + 2] = S[k4 * 4 + 2] * qw.z + (v * qk.z - sa * qa.z); S[k4 * 4 + 3] = S[k4 * 4 + 3] * qw.w + (v * qk.w - sa * qa.w);
                    o0 += S[k4 * 4] * qr.x; o1 += S[k4 * 4 + 1] * qr.y; o2 += S[k4 * 4 + 2] * qr.z; o3 += S[k4 * 4 + 3] * qr.w; }
                const float o = (o0 + o1) + (o2 + o3);
                const float mean = wave_sum(o) * (1.f / 64.f); const float dlt = o - mean; const float var = wave_sum(dlt * dlt) * (1.f / 64.f);
                const float on = dlt * rsqrtf(var + 64e-5f) * lg + lb;
                const float rk = wave_sum(r * kmod * rkc);
                const float ya = (on + rk * v) * gv;
                P16[m * PP + hj] = (h16)ya;
            }
#pragma unroll
            for (int k4 = 0; k4 < 16; ++k4) *(f32x4*)(sout + lane * 64 + k4 * 4) = (f32x4){S[k4 * 4], S[k4 * 4 + 1], S[k4 * 4 + 2], S[k4 * 4 + 3]};
        }
    }
    if (IN(PH_MERGE)) {
        const float* cw = a.in[22];
        for (int c = bx; c < NCHUNK; c += G) {
            const int half = tid >> 8, o8 = tid & 255, c0 = o8 * 8; const size_t rowb = (size_t)c * 64 + half * 32;
            const bool seq_start = ((c < 128) ? ((c & 63) == 0) : true) && half == 0;
            float u1[8], u2[8], w0[8], w1[8], w2[8];
#pragma unroll
            for (int j = 0; j < 8; ++j) { w0[j] = cw[c0 + j]; w1[j] = cw[D + c0 + j]; w2[j] = cw[2 * D + c0 + j]; }
            if (seq_start) {
                if (c < 128) {
#pragma unroll
                    for (int j = 0; j < 8; ++j) { u1[j] = 0.f; u2[j] = 0.f; }
                } else { const float* sc = a.in[3] + (size_t)(c - 128) * 2 * D + c0;
#pragma unroll
                    for (int j = 0; j < 8; ++j) { u2[j] = sc[j]; u1[j] = sc[D + j]; } }
            } else {
                const h16x8 g2 = *(const h16x8*)(P16 + (rowb - 2) * PP + C_GC + c0), x2 = *(const h16x8*)(P16 + (rowb - 2) * PP + C_XC + c0);
                const h16x8 g1 = *(const h16x8*)(P16 + (rowb - 1) * PP + C_GC + c0), x1 = *(const h16x8*)(P16 + (rowb - 1) * PP + C_XC + c0);
#pragma unroll
                for (int j = 0; j < 8; ++j) { u2[j] = (float)g2[j] * (float)x2[j]; u1[j] = (float)g1[j] * (float)x1[j]; }
            }
            const bool seq_end = ((c < 128) ? ((c & 63) == 63) : true) && half == 1;
            float* cvout = (c < 128) ? a.out + O_CVP + (size_t)(c >> 6) * 2 * D : a.out + O_CVS + (size_t)(c - 128) * 2 * D;
            for (int t = 0; t < 32; ++t) {
                const h16* pr = P16 + (rowb + t) * PP;
                const h16x8 ya = *(const h16x8*)(pr + c0), gb = *(const h16x8*)(pr + C_GB + c0), gc = *(const h16x8*)(pr + C_GC + c0), xc = *(const h16x8*)(pr + C_XC + c0),
                            ga = *(const h16x8*)(pr + C_GA + c0), gg = *(const h16x8*)(pr + C_GG + c0);
                float mg[8];
#pragma unroll
                for (int j = 0; j < 8; ++j) { const float u0 = (float)gc[j] * (float)xc[j]; const float cv = w0[j] * u2[j] + w1[j] * u1[j] + w2[j] * u0;
                    mg[j] = sigmoidf_((float)ga[j]) * (float)ya[j] + sigmoidf_((float)gg[j]) * ((float)gb[j] * cv); u2[j] = u1[j]; u1[j] = u0; }
                *(u32x4*)(A16 + (rowb + t) * D + c0) = (u32x4){pk2h(mg[0], mg[1]), pk2h(mg[2], mg[3]), pk2h(mg[4], mg[5]), pk2h(mg[6], mg[7])};
                if (seq_end && t >= 30) { float* q = cvout + (size_t)(t - 30) * D + c0; *(f32x4*)q = (f32x4){u1[0], u1[1], u1[2], u1[3]}; *(f32x4*)(q + 4) = (f32x4){u1[4], u1[5], u1[6], u1[7]}; }
            }
        }
    }
    if (IN(PH_WOUT)) {
        { pg8::Gemm g{A16, WOUT, MT, D, D}; pg8::Order S; S.init(MT, D, G, bx, 0); pg8::EpiRes E{Y, Y + (size_t)MP * D, Y, 1.0f, 0}; pg8::gemm_phase(lds, g, S, E); }
        LAS float* scr = (LAS float*)(lds + wave * 16384);
        constexpr int I1 = (D / 64) * (2 * FF / 32), I2 = (FF / 64) * (D / 32);
        for (int it = gw; it < I1 + I2; it += NGW) {
            if (it < I1) cvt_item(1, a.in[25], a.in[26], FF, D, W2GU, scr, it, 2 * FF / 32, lane);
            else cvt_item(0, a.in[27], nullptr, D, FF, W2D, scr, it - I1, D / 32, lane);
        }
    }
    if (IN(PH_RMS2)) { for (int m = gw; m < MT; m += NGW) rms_row_f16(Y + (size_t)m * D, a.in[24], A16 + (size_t)m * D, nullptr, lane); }
    if (IN(PH_FFN2_GU)) { pg8::Gemm g{A16, W2GU, MT, 2 * FF, D}; pg8::Order S; S.init(MT, 2 * FF, G, bx, 0); pg8::EpiSwiGLU E{HM, FF}; pg8::gemm_phase(lds, g, S, E); }
    if (IN(PH_FFN2_D)) { pg8::Gemm g{HM, W2D, MT, D, FF}; pg8::Order S; S.init(MT, D, G, bx, 0); pg8::EpiRes E{Y, Y + (size_t)MP * D, Y, 0.5f, 0}; pg8::gemm_phase(lds, g, S, E); }
    if (IN(PH_FINAL)) { for (int m = gw; m < MT; m += NGW) rms_row_f16(Y + (size_t)m * D, a.in[28], nullptr, Y + (size_t)m * D, lane); }
#undef IN
}

extern "C" void kernel_launch(void* const* d_in, const int* in_sizes, int n_in, void* d_out, int out_size, void* d_ws, size_t ws_size, hipStream_t stream) {
    static int grid = 0;
    if (grid == 0) {
        if (n_in != 29 || (size_t)out_size != O_END || ws_size < WS_END) { fprintf(stderr, "kernel_launch: unexpected shapes (n_in %d out %d ws %zu need %zu)\n", n_in, out_size, ws_size, (size_t)WS_END); grid = -1; return; }
        int dev = 0, cus = 0;
        if (hipGetDevice(&dev) != hipSuccess || hipDeviceGetAttribute(&cus, hipDeviceAttributeMultiprocessorCount, dev) != hipSuccess) { grid = -1; return; }
        if (hipFuncSetAttribute((const void*)fwd_kernel, hipFuncAttributeMaxDynamicSharedMemorySize, LDS_BYTES) != hipSuccess) { grid = -1; return; }
        grid = cus;
    }
    if (grid < 0) return;
    Args a{};
    for (int i = 0; i < 29; ++i) a.in[i] = (const float*)d_in[i];
    a.out = (float*)d_out; a.ws = (unsigned char*)d_ws;
    for (int ph = 0; ph < PH_N; ++ph) { a.ph_lo = ph; a.ph_hi = ph + 1; hipLaunchKernelGGL(fwd_kernel, dim3(grid), dim3(NTHR), LDS_BYTES, stream, a); }
}
```

```cpp
#include <hip/hip_runtime.h>
#include <hip/hip_cooperative_groups.h>
#include <cstdio>
namespace cg = cooperative_groups;

#define LAS __attribute__((address_space(3)))
typedef _Float16 h16;
typedef _Float16 h16x2 __attribute__((ext_vector_type(2)));
typedef _Float16 h16x4 __attribute__((ext_vector_type(4)));
typedef _Float16 h16x8 __attribute__((ext_vector_type(8)));
typedef float f32x4 __attribute__((ext_vector_type(4)));
typedef unsigned u32x4 __attribute__((ext_vector_type(4)));
typedef unsigned u32x2 __attribute__((ext_vector_type(2)));

constexpr int D = 2048, FF = 5632, NA = 6592, NIN = 16832;
constexpr int MP = 8192, MS = 2048, MT = MP + MS;
constexpr int MA = MT + 256;
constexpr int PP = 16896;
constexpr int PFW = 6656;
constexpr int C_GB = 6656, C_GC = 8704, C_XC = 10752, C_GA = 12800, C_GG = 14848;
constexpr int LK = 512;
constexpr int NCHUNK = MT / 64;
constexpr size_t O_Y = 0, O_SHP = 20971520, O_CVP = 20975616, O_WKP = 20983808, O_SHS = 21245952, O_CVS = 21311488, O_WKS = 21442560, O_END = 25636864;
constexpr size_t WS_CTL = 0;
constexpr size_t WS_W1GU = 1u << 20;
constexpr size_t WS_W1D = WS_W1GU + (size_t)2 * FF * D * 2;
constexpr size_t WS_WIN = WS_W1D + (size_t)D * FF * 2;
constexpr size_t WS_WOUT = WS_WIN + (size_t)PP * D * 2;
constexpr size_t WS_A16 = WS_WOUT + (size_t)D * D * 2;
constexpr size_t WS_P16 = WS_A16 + (size_t)MA * D * 2;
constexpr size_t WS_END = WS_P16 + (size_t)MT * PP * 2;
constexpr size_t WS_EAG = WS_W1GU;
constexpr size_t WS_HM = WS_P16;
constexpr size_t WS_W2GU = WS_P16 + (size_t)MT * FF * 2;
constexpr size_t WS_W2D = WS_W2GU + (size_t)2 * FF * D * 2;
static_assert((size_t)MT * 6144 * 2 <= WS_WOUT - WS_W1GU, "EAG overlay");
static_assert(WS_W2D + (size_t)D * FF * 2 <= WS_END, "W2 overlay");
constexpr size_t OB_WL = O_WKS * 4;
constexpr size_t OB_PF = OB_WL + (size_t)6144 * LK * 2;
constexpr size_t OB_SIDE = OB_PF + (size_t)256 * PFW * 2;
static_assert(OB_SIDE + (size_t)NCHUNK * PFW * 2 <= O_END * 4, "d_out scratch");

constexpr int NWAVES = 8, NTHR = 512;
constexpr int LDS_BYTES = 147456;

__device__ __forceinline__ unsigned pk2h(float a, float b) { h16x2 v = {(h16)a, (h16)b}; return __builtin_bit_cast(unsigned, v); }
__device__ __forceinline__ float wave_sum(float v) {
#pragma unroll
    for (int o = 1; o < 64; o <<= 1) v += __shfl_xor(v, o);
    return v;
}
__device__ __forceinline__ float sigmoidf_(float x) { return 1.0f / (1.0f + __expf(-x)); }

namespace pg8 {
constexpr int BM = 256, BK = 64, HALF = 128, HTB = HALF * BK * 2, STAGE_BYTES = 8 * HTB, NXCD = 8, WGM = 8;
__host__ __device__ __forceinline__ int lds_byte(int r, int c) { const int st = (r >> 4) * 2 + (c >> 5), rr = r & 15, cc = c & 31, ob = rr * 64 + cc * 2; return st * 1024 + (ob ^ (((ob >> 9) & 1) << 5)); }
__host__ __device__ __forceinline__ void stage_rc(int b, int& R, int& C) { const int st = b / 1024, sb = b % 1024, swz = sb ^ (((sb >> 9) & 1) << 5); R = (st >> 1) * 16 + swz / 64; C = (st & 1) * 32 + (swz % 64) / 2; }
__host__ __device__ __forceinline__ int perm32(int rho) { const int n = rho >> 4, i = rho & 15; return 8 * (i >> 2) + 4 * n + (i & 3); }
struct Unit { int pm, pn; };
struct Gemm { const h16* A; const h16* Bt; int M, N, K; };
struct Order {
    int nM, nN, nwg, G, c, extra;
    __device__ void init(int M, int N, int G_, int c_, int extra_) { nM = M / BM; nN = N / BM; nwg = nM * nN; G = G_; c = c_; extra = extra_; }
    __device__ bool next(int i, Unit& u) const {
        const long L = (long)i * G + c; if (L >= nwg + extra) return false;
        if (L >= nwg) { u.pm = nM; u.pn = (int)(L - nwg); return true; }
        int wgid = (int)L; { const int q = nwg / NXCD, r = nwg % NXCD, xcd = wgid % NXCD, off = wgid / NXCD; wgid = (xcd < r ? xcd * (q + 1) : r * (q + 1) + (xcd - r) * q) + off; }
        const int nig = WGM * nN, gid = wgid / nig, fm = gid * WGM, gsz = (nM - fm) < WGM ? (nM - fm) : WGM;
        u.pm = fm + ((wgid % nig) % gsz); u.pn = (wgid % nig) / gsz; return true;
    }
};

template <class Epi>
__device__ __forceinline__ void gemm_phase(LAS unsigned char* lds, const Gemm g, const Order& S, const Epi& E) {
    const int tid = threadIdx.x, wid = __builtin_amdgcn_readfirstlane(tid >> 6), lane = tid & 63, wr = wid >> 2, wc = wid & 3, fr = lane & 15, fq = lane >> 4;
    const int K = g.K, nt = K / BK;
    unsigned voffA[2], voffB[2];
#pragma unroll
    for (int i = 0; i < 2; ++i) { int R, C; stage_rc(tid * 16 + i * 8192, R, C); const int Rb = Epi::PERM ? ((R & ~31) + perm32(R & 31)) : R;
        voffA[i] = (unsigned)(R * K + C) * 2u; voffB[i] = (unsigned)(Rb * K + C) * 2u; }
    const size_t kstep = (size_t)(BK * 2);
    const size_t hstep = (size_t)HALF * K * 2;
    const size_t tstep = 2 * hstep;
    const unsigned ldsw = (unsigned)wid * 1024u;
    const int aoff = lds_byte(wr * 64 + fr, fq * 8), boff = lds_byte(wc * 32 + fr, fq * 8);
#define PG8_SA(b, h) (((b) * 2 + (h)) * HTB)
#define PG8_SB(b, h) ((4 + (b) * 2 + (h)) * HTB)
#define PG8_STAGE(bufoff, gbase, voff) do { _Pragma("unroll") for (int _i = 0; _i < 2; ++_i) \
        __builtin_amdgcn_global_load_lds((const unsigned*)((const char*)(gbase) + (voff)[_i]), (LAS unsigned*)(lds + (bufoff) + ldsw + _i * 8192), 16, 0, 0); } while (0)
#define PG8_LDA(dst, b, h) do { _Pragma("unroll") for (int m = 0; m < 4; ++m) _Pragma("unroll") for (int k = 0; k < 2; ++k) dst[m][k] = *(const LAS h16x8*)(lds + PG8_SA(b, h) + aoff + m * 2048 + k * 1024); } while (0)
#define PG8_LDB(dst, b, h) do { _Pragma("unroll") for (int n = 0; n < 2; ++n) _Pragma("unroll") for (int k = 0; k < 2; ++k) dst[n][k] = *(const LAS h16x8*)(lds + PG8_SB(b, h) + boff + n * 2048 + k * 1024); } while (0)
#define PG8_MMA(ai, bj, At, Bt) do { __builtin_amdgcn_s_setprio(1); _Pragma("unroll") for (int m = 0; m < 4; ++m) _Pragma("unroll") for (int n = 0; n < 2; ++n) _Pragma("unroll") for (int k = 0; k < 2; ++k) \
        acc[ai][bj][m][n] = __builtin_amdgcn_mfma_f32_16x16x32_f16(Bt[n][k], At[m][k], acc[ai][bj][m][n], 0, 0, 0); __builtin_amdgcn_s_setprio(0); } while (0)
#define PG8_WAIT_V(n) asm volatile("s_waitcnt vmcnt(" #n ")" ::: "memory")
#define PG8_WAIT_L(n) asm volatile("s_waitcnt lgkmcnt(" #n ")" ::: "memory")
#define PG8_BAR __builtin_amdgcn_s_barrier()
#define PG8_SCHED __builtin_amdgcn_sched_barrier(0)
    Unit cur, nxt; int ui = 0;
    if (!S.next(0, cur)) return;
    f32x4 acc[2][2][4][2];
#pragma unroll
    for (int a = 0; a < 2; ++a)
#pragma unroll
        for (int b = 0; b < 2; ++b)
#pragma unroll
            for (int m = 0; m < 4; ++m)
#pragma unroll
                for (int n = 0; n < 2; ++n) acc[a][b][m][n] = (f32x4){0.f, 0.f, 0.f, 0.f};
    h16x8 At[4][2], B0[2][2], B1[2][2];
    const char* cA = (const char*)g.A + (size_t)cur.pm * tstep; const char* cB = (const char*)g.Bt + (size_t)cur.pn * tstep;
    PG8_STAGE(PG8_SB(0, 0), cB, voffB); PG8_STAGE(PG8_SA(0, 0), cA, voffA); PG8_STAGE(PG8_SB(0, 1), cB + hstep, voffB); PG8_STAGE(PG8_SA(0, 1), cA + hstep, voffA);
    if (wr == 1) PG8_BAR;
    PG8_WAIT_V(4); PG8_BAR;
    PG8_STAGE(PG8_SB(1, 0), cB + kstep, voffB); PG8_STAGE(PG8_SA(1, 0), cA + kstep, voffA); PG8_STAGE(PG8_SB(1, 1), cB + hstep + kstep, voffB);
    PG8_WAIT_V(6); PG8_BAR;
    for (;;) {
        const bool has_next = S.next(ui + 1, nxt);
        const char* nA = has_next ? (const char*)g.A + (size_t)nxt.pm * tstep : cA; const char* nB = has_next ? (const char*)g.Bt + (size_t)nxt.pn * tstep : cB;
        for (int t = 0; t < nt; t += 2) {
            const bool last = (t == nt - 2);
            const char* a1 = cA + (size_t)(t + 1) * kstep;
            const char* a2 = last ? nA : cA + (size_t)(t + 2) * kstep; const char* b2 = last ? nB : cB + (size_t)(t + 2) * kstep;
            const char* a3 = a2 + kstep; const char* b3 = b2 + kstep;
            PG8_LDB(B0, 0, 0); PG8_SCHED; PG8_LDA(At, 0, 0); PG8_STAGE(PG8_SA(1, 1), a1 + hstep, voffA);
            PG8_WAIT_L(8); PG8_BAR; PG8_WAIT_L(0); PG8_MMA(0, 0, At, B0); PG8_BAR; PG8_SCHED;
            PG8_LDB(B1, 0, 1); PG8_STAGE(PG8_SB(0, 0), b2, voffB);
            PG8_BAR; PG8_WAIT_L(0); PG8_MMA(0, 1, At, B1); PG8_BAR;
            PG8_LDA(At, 0, 1); PG8_STAGE(PG8_SA(0, 0), a2, voffA);
            PG8_BAR; PG8_WAIT_L(0); PG8_MMA(1, 0, At, B0); PG8_BAR; PG8_SCHED;
            PG8_STAGE(PG8_SB(0, 1), b2 + hstep, voffB);
            PG8_WAIT_V(6); PG8_BAR; PG8_MMA(1, 1, At, B1); PG8_BAR;
            PG8_LDB(B0, 1, 0); PG8_SCHED; PG8_LDA(At, 1, 0); PG8_STAGE(PG8_SA(0, 1), a2 + hstep, voffA);
            PG8_WAIT_L(8); PG8_BAR; PG8_WAIT_L(0); PG8_MMA(0, 0, At, B0); PG8_BAR; PG8_SCHED;
            PG8_LDB(B1, 1, 1); PG8_STAGE(PG8_SB(1, 0), b3, voffB);
            PG8_BAR; PG8_WAIT_L(0); PG8_MMA(0, 1, At, B1); PG8_BAR;
            PG8_LDA(At, 1, 1); PG8_STAGE(PG8_SA(1, 0), a3, voffA);
            PG8_BAR; PG8_WAIT_L(0); PG8_MMA(1, 0, At, B0); PG8_BAR; PG8_SCHED;
            PG8_STAGE(PG8_SB(1, 1), b3 + hstep, voffB);
            PG8_WAIT_V(6); PG8_BAR; PG8_MMA(1, 1, At, B1); PG8_BAR;
        }
        E(acc, cur, wr, wc, fr, fq);
        if (!has_next) break;
#pragma unroll
        for (int a = 0; a < 2; ++a)
#pragma unroll
            for (int b = 0; b < 2; ++b)
#pragma unroll
                for (int m = 0; m < 4; ++m)
#pragma unroll
                    for (int n = 0; n < 2; ++n) acc[a][b][m][n] = (f32x4){0.f, 0.f, 0.f, 0.f};
        cur = nxt; cA = nA; cB = nB; ++ui;
    }
    PG8_WAIT_V(0);
    if (wr == 0) PG8_BAR;
    PG8_BAR;
#undef PG8_SA
#undef PG8_SB
#undef PG8_STAGE
#undef PG8_LDA
#undef PG8_LDB
#undef PG8_MMA
#undef PG8_WAIT_V
#undef PG8_WAIT_L
#undef PG8_BAR
#undef PG8_SCHED
}

struct EpiSwiGLU {
    static constexpr bool PERM = false;
    h16* O; int ldo;
    __device__ __forceinline__ void operator()(const f32x4 (&acc)[2][2][4][2], const Unit& u, int wr, int wc, int fr, int fq) const {
        const int row0 = u.pm * BM + wr * 64 + fr;
#pragma unroll
        for (int ai = 0; ai < 2; ++ai)
#pragma unroll
            for (int m = 0; m < 4; ++m) { h16* rowp = O + (size_t)(row0 + ai * HALF + m * 16) * ldo;
#pragma unroll
                for (int bj = 0; bj < 2; ++bj) { const int oc = (u.pn * BM + bj * HALF + wc * 32) / 2 + 4 * fq;
                    const f32x4 gt = acc[ai][bj][m][0], up = acc[ai][bj][m][1]; float o[4];
#pragma unroll
                    for (int j = 0; j < 4; ++j) o[j] = gt[j] * sigmoidf_(gt[j]) * up[j];
                    u32x2 w; w.x = pk2h(o[0], o[1]); w.y = pk2h(o[2], o[3]);
                    *(u32x2*)(rowp + oc) = w; } }
    }
};
struct EpiRes {
    static constexpr bool PERM = false;
    const float* r0; const float* r1; float* out; float scale; int pad;
    __device__ __forceinline__ void operator()(const f32x4 (&acc)[2][2][4][2], const Unit& u, int wr, int wc, int fr, int fq) const {
        const int row0 = u.pm * BM + wr * 64 + fr, col0 = u.pn * BM + wc * 32 + 4 * fq;
        const float* rb = (u.pm * BM < MP) ? r0 : r1 - (size_t)MP * D;
#pragma unroll
        for (int ai = 0; ai < 2; ++ai)
#pragma unroll
            for (int m = 0; m < 4; ++m) { const size_t off = (size_t)(row0 + ai * HALF + m * 16) * D + col0;
#pragma unroll
                for (int bj = 0; bj < 2; ++bj)
#pragma unroll
                    for (int n = 0; n < 2; ++n) { const f32x4 rv = *(const f32x4*)(rb + off + bj * HALF + n * 16);
                        *(f32x4*)(out + off + bj * HALF + n * 16) = rv + scale * acc[ai][bj][m][n]; } }
    }
};
struct EpiP16 {
    static constexpr bool PERM = true;
    h16* P; h16* PF; h16* SIDE;
    __device__ __forceinline__ void operator()(const f32x4 (&acc)[2][2][4][2], const Unit& u, int wr, int wc, int fr, int fq) const {
        const int row0 = u.pm * BM + wr * 64 + fr;
#pragma unroll
        for (int ai = 0; ai < 2; ++ai)
#pragma unroll
            for (int m = 0; m < 4; ++m) { const int row = row0 + ai * HALF + m * 16;
#pragma unroll
                for (int bj = 0; bj < 2; ++bj) { const int col = u.pn * BM + bj * HALF + wc * 32 + 8 * fq;
                    const f32x4 v0 = acc[ai][bj][m][0], v1 = acc[ai][bj][m][1];
                    u32x4 w; w.x = pk2h(v0[0], v0[1]); w.y = pk2h(v0[2], v0[3]); w.z = pk2h(v1[0], v1[1]); w.w = pk2h(v1[2], v1[3]);
                    if (u.pm < MT / BM) { *(u32x4*)(P + (size_t)row * PP + col) = w;
                        if ((row & 63) == 63 && col < PFW) *(u32x4*)(SIDE + (size_t)(row >> 6) * PFW + col) = w; }
                    else *(u32x4*)(PF + (size_t)(row - MT) * PFW + col) = w; } }
    }
};
struct EpiEAG {
    static constexpr bool PERM = true;
    h16* O; const float* w0; const float* a0;
    __device__ __forceinline__ void operator()(const f32x4 (&acc)[2][2][4][2], const Unit& u, int wr, int wc, int fr, int fq) const {
        const int row0 = u.pm * BM + wr * 64 + fr; const int typ = u.pn >> 3;
#pragma unroll
        for (int bj = 0; bj < 2; ++bj) { const int col = u.pn * BM + bj * HALF + wc * 32 + 8 * fq;
            f32x4 b0 = (f32x4){0.f, 0.f, 0.f, 0.f}, b1 = b0;
            if (typ == 0) { b0 = *(const f32x4*)(w0 + col); b1 = *(const f32x4*)(w0 + col + 4); }
            if (typ == 1) { b0 = *(const f32x4*)(a0 + col - D); b1 = *(const f32x4*)(a0 + col - D + 4); }
#pragma unroll
            for (int ai = 0; ai < 2; ++ai)
#pragma unroll
                for (int m = 0; m < 4; ++m) { const int row = row0 + ai * HALF + m * 16;
                    f32x4 v0 = acc[ai][bj][m][0] + b0, v1 = acc[ai][bj][m][1] + b1;
                    if (typ < 2) { const float sc = typ == 0 ? 0.60653065971f : 1.0f;
#pragma unroll
                        for (int j = 0; j < 4; ++j) { v0[j] = sigmoidf_(v0[j]) * sc; v1[j] = sigmoidf_(v1[j]) * sc; } }
                    u32x4 w; w.x = pk2h(v0[0], v0[1]); w.y = pk2h(v0[2], v0[3]); w.z = pk2h(v1[0], v1[1]); w.w = pk2h(v1[2], v1[3]);
                    *(u32x4*)(O + (size_t)row * 6144 + col) = w; } }
    }
};
}

struct Args { const float* in[29]; float* out; unsigned char* ws; int ph_lo, ph_hi; };

__device__ __forceinline__ void cvt_item(int mode, const float* s0, const float* s1, int Nsrc, int K, h16* WT, LAS float* scr, int item, int nblk, int lane) {
    const int kb = item / nblk, nb = item % nblk, k0 = 64 * kb, n0 = 32 * nb;
    const int nn = lane & 31; const float* src = s0; int col = n0 + nn; bool zero = false;
    if (mode == 1) { src = (nn < 16) ? s0 : s1; col = (n0 >> 1) + (nn & 15); }
    if (mode == 2) { if (n0 >= NA && n0 < PFW) zero = true; else if (n0 >= PFW) col -= 64; }
#pragma unroll 8
    for (int i = 0; i < 32; ++i) { const int kk = 2 * i + (lane >> 5); scr[kk * 33 + nn] = zero ? 0.f : src[(size_t)(k0 + kk) * Nsrc + col]; }
    asm volatile("s_waitcnt lgkmcnt(0)" ::: "memory");
    const int c = lane & 7;
#pragma unroll
    for (int j = 0; j < 4; ++j) { const int n = (lane >> 3) + 8 * j; const LAS float* s = scr + (8 * c) * 33 + n;
        u32x4 o; o.x = pk2h(s[0 * 33], s[1 * 33]); o.y = pk2h(s[2 * 33], s[3 * 33]); o.z = pk2h(s[4 * 33], s[5 * 33]); o.w = pk2h(s[6 * 33], s[7 * 33]);
        *(u32x4*)(WT + (size_t)(n0 + n) * K + k0 + 8 * c) = o; }
    asm volatile("s_waitcnt lgkmcnt(0)" ::: "memory");
}
__device__ __forceinline__ void cvt_lora_item(const float* wl, const float* al, const float* gl, h16* WT, int item, int lane) {
    const int n = item, typ = n >> 11, col = n & 2047; unsigned w[4];
#pragma unroll
    for (int j = 0; j < 4; ++j) { float v[2];
#pragma unroll
        for (int e = 0; e < 2; ++e) { const int k = lane * 8 + j * 2 + e; float x = 0.f;
            if (typ == 0 && k < 96) x = wl[(size_t)k * D + col];
            if (typ == 1 && k >= 96 && k < 192) x = al[(size_t)(k - 96) * D + col];
            if (typ == 2 && k >= 192 && k < 448) x = gl[(size_t)(k - 192) * D + col];
            v[e] = x; }
        w[j] = pk2h(v[0], v[1]); }
    *(u32x4*)(WT + (size_t)n * LK + lane * 8) = (u32x4){w[0], w[1], w[2], w[3]};
}

__device__ __forceinline__ void rms_row_f16(const float* xrow, const float* g, h16* orow, float* f32row, int lane) {
    const f32x4* xr = (const f32x4*)xrow + lane; const f32x4* gr = (const f32x4*)g + lane;
    f32x4 v[8]; float s = 0.f;
#pragma unroll
    for (int j = 0; j < 8; ++j) { v[j] = xr[64 * j]; s += (v[j].x * v[j].x + v[j].y * v[j].y) + (v[j].z * v[j].z + v[j].w * v[j].w); }
    const float rs = rsqrtf(wave_sum(s) * (1.f / D) + 1e-6f);
#pragma unroll
    for (int j = 0; j < 8; ++j) { const f32x4 gg = gr[64 * j]; const f32x4 o = v[j] * rs * gg;
        if (orow) { u32x2 w; w.x = pk2h(o.x, o.y); w.y = pk2h(o.z, o.w); *((u32x2*)orow + lane + 64 * j) = w; }
        if (f32row) *((f32x4*)f32row + lane + 64 * j) = o; }
}

enum { PH_CVT1 = 0, PH_FFN1_GU, PH_FFN1_D, PH_RMS_MIX, PH_WIN, PH_SHIFT, PH_LORA, PH_SCAN, PH_MERGE, PH_WOUT, PH_RMS2, PH_FFN2_GU, PH_FFN2_D, PH_FINAL, PH_N };

__global__ void __launch_bounds__(NTHR, 2) fwd_kernel(Args a) {
    extern __shared__ __attribute__((aligned(16))) unsigned char lds_raw[];
    LAS unsigned char* lds = (LAS unsigned char*)lds_raw;
    const int tid = threadIdx.x, lane = tid & 63, wave = __builtin_amdgcn_readfirstlane(tid >> 6);
    const int G = gridDim.x, bx = blockIdx.x;
    const int gw = bx * NWAVES + wave, NGW = G * NWAVES;
    unsigned char* ws = a.ws; unsigned char* ob = (unsigned char*)a.out;
    h16* W1GU = (h16*)(ws + WS_W1GU); h16* W1D = (h16*)(ws + WS_W1D); h16* WIN = (h16*)(ws + WS_WIN); h16* WOUT = (h16*)(ws + WS_WOUT);
    h16* A16 = (h16*)(ws + WS_A16); h16* P16 = (h16*)(ws + WS_P16); h16* EAG = (h16*)(ws + WS_EAG); h16* HM = (h16*)(ws + WS_HM);
    h16* W2GU = (h16*)(ws + WS_W2GU); h16* W2D = (h16*)(ws + WS_W2D);
    h16* WL = (h16*)(ob + OB_WL); h16* PF = (h16*)(ob + OB_PF); h16* SIDE = (h16*)(ob + OB_SIDE);
    float* Y = a.out + O_Y;
    const int lo = a.ph_lo, hi = a.ph_hi;
#define IN(k) (lo <= (k) && (k) < hi)
    cg::grid_group grid = cg::this_grid();
#define SEAM(k) do { if (IN(k) && IN((k) + 1)) grid.sync(); } while (0)

    if (IN(PH_CVT1)) {
        LAS float* scr = (LAS float*)(lds + wave * 16384);
        constexpr int I1 = (D / 64) * (2 * FF / 32), I2 = (FF / 64) * (D / 32), I3 = (D / 64) * (PP / 32), I4 = (D / 64) * (D / 32);
        for (int it = gw; it < I1 + I2 + I3 + I4; it += NGW) {
            int r = it;
            if (r < I1) { cvt_item(1, a.in[6], a.in[7], FF, D, W1GU, scr, r, 2 * FF / 32, lane); continue; } r -= I1;
            if (r < I2) { cvt_item(0, a.in[8], nullptr, D, FF, W1D, scr, r, D / 32, lane); continue; } r -= I2;
            if (r < I3) { cvt_item(2, a.in[10], nullptr, NIN, D, WIN, scr, r, PP / 32, lane); continue; } r -= I3;
            cvt_item(0, a.in[23], nullptr, D, D, WOUT, scr, r, D / 32, lane);
        }
        for (int it = gw; it < 6144; it += NGW) cvt_lora_item(a.in[13], a.in[15], a.in[16], WL, it, lane);
        for (int r = gw; r < 256; r += NGW) { h16* orow = A16 + (size_t)(MT + r) * D;
#pragma unroll
            for (int j = 0; j < 8; ++j) { u32x2 w = (u32x2){0u, 0u};
                if (r < 32) { const f32x4 v = *((const f32x4*)(a.in[2] + (size_t)r * D) + lane + 64 * j); w.x = pk2h(v.x, v.y); w.y = pk2h(v.z, v.w); }
                *((u32x2*)orow + lane + 64 * j) = w; } }
        for (int m = gw; m < MT; m += NGW) { const float* xr = m < MP ? a.in[0] + (size_t)m * D : a.in[1] + (size_t)(m - MP) * D; rms_row_f16(xr, a.in[5], A16 + (size_t)m * D, nullptr, lane); }
    }
    SEAM(PH_CVT1);
    if (IN(PH_FFN1_GU)) { pg8::Gemm g{A16, W1GU, MT, 2 * FF, D}; pg8::Order S; S.init(MT, 2 * FF, G, bx, 0); pg8::EpiSwiGLU E{HM, FF}; pg8::gemm_phase(lds, g, S, E); }
    SEAM(PH_FFN1_GU);
    if (IN(PH_FFN1_D)) { pg8::Gemm g{HM, W1D, MT, D, FF}; pg8::Order S; S.init(MT, D, G, bx, 0); pg8::EpiRes E{a.in[0], a.in[1], Y, 0.5f, 0}; pg8::gemm_phase(lds, g, S, E); }
    SEAM(PH_FFN1_D);
    if (IN(PH_RMS_MIX)) {
        for (int m = gw; m < MT; m += NGW) { float* so = nullptr;
            if (m < MP) { if ((m & 4095) == 4095) so = a.out + O_SHP + (size_t)(m >> 12) * D; } else { if (((m - MP) & 63) == 63) so = a.out + O_SHS + (size_t)((m - MP) >> 6) * D; }
            rms_row_f16(Y + (size_t)m * D, a.in[9], A16 + (size_t)m * D, so, lane); }
    }
    SEAM(PH_RMS_MIX);
    if (IN(PH_WIN)) { pg8::Gemm g{A16, WIN, MT, PP, D}; pg8::Order S; S.init(MT, PP, G, bx, PFW / 256); pg8::EpiP16 E{P16, PF, SIDE}; pg8::gemm_phase(lds, g, S, E); }
    SEAM(PH_WIN);
    if (IN(PH_SHIFT)) {
        h16* AIN = A16; const float* mu = a.in[11];
        for (int c = bx; c < NCHUNK; c += G) {
            const bool seq_start = (c < 128) ? ((c & 63) == 0) : true;
            for (int o8 = tid; o8 < 840; o8 += NTHR) {
                const int c0 = o8 * 8; const size_t rowb = (size_t)c * 64;
                if (o8 >= 824) {
                    if (o8 < 832) { for (int t = 0; t < 64; ++t) *(u32x4*)(AIN + (rowb + t) * LK + 448 + (o8 - 824) * 8) = (u32x4){0u, 0u, 0u, 0u}; }
                    continue; }
                float prev[8], mu8[8];
                { const f32x4 m0 = *(const f32x4*)(mu + c0), m1 = *(const f32x4*)(mu + c0 + 4);
                  mu8[0] = m0.x; mu8[1] = m0.y; mu8[2] = m0.z; mu8[3] = m0.w; mu8[4] = m1.x; mu8[5] = m1.y; mu8[6] = m1.z; mu8[7] = m1.w; }
                if (seq_start && c < 128) {
#pragma unroll
                    for (int j = 0; j < 8; ++j) prev[j] = 0.f;
                } else { const h16* pp = seq_start ? PF + (size_t)(c - 128) * PFW + c0 : SIDE + (size_t)(c - 1) * PFW + c0; const h16x8 pv = *(const h16x8*)pp;
#pragma unroll
                    for (int j = 0; j < 8; ++j) prev[j] = (float)pv[j]; }
                for (int t = 0; t < 64; ++t) {
                    h16* pr = P16 + (rowb + t) * PP + c0; const h16x8 cv = *(const h16x8*)pr; float s[8];
#pragma unroll
                    for (int j = 0; j < 8; ++j) { const float cu = (float)cv[j]; s[j] = cu + mu8[j] * (prev[j] - cu); prev[j] = cu; }
                    if (c0 < 6144) { *(u32x4*)pr = (u32x4){pk2h(s[0], s[1]), pk2h(s[2], s[3]), pk2h(s[4], s[5]), pk2h(s[6], s[7])}; }
                    else { const int idx = c0 - 6144;
                        if (idx < 96) {
#pragma unroll
                            for (int j = 0; j < 8; ++j) s[j] = tanhf(s[j]);
                        } else if (idx >= 192) {
#pragma unroll
                            for (int j = 0; j < 8; ++j) s[j] = sigmoidf_(s[j]);
                        }
                        *(u32x4*)(AIN + (rowb + t) * LK + idx) = (u32x4){pk2h(s[0], s[1]), pk2h(s[2], s[3]), pk2h(s[4], s[5]), pk2h(s[6], s[7])}; }
                }
            }
        }
    }
    SEAM(PH_SHIFT);
    if (IN(PH_LORA)) { pg8::Gemm g{A16, WL, MT, 6144, LK}; pg8::Order S; S.init(MT, 6144, G, bx, 0); pg8::EpiEAG E{EAG, a.in[12], a.in[14]}; pg8::gemm_phase(lds, g, S, E); }
    SEAM(PH_LORA);
    if (IN(PH_SCAN)) {
        int item = -1;
        if (wave == 0) { if (bx < 64) item = bx; } else { const int idx = bx * 7 + (wave - 1); if (idx < 1024) item = 64 + idx; }
        if (item >= 0) {
            LAS float* sh = (LAS float*)(lds + wave * 2048);
            int row0, T, h; const float* s0 = nullptr; float* sout;
            if (item < 64) { const int b = item >> 5; h = item & 31; row0 = b * 4096; T = 4096; sout = a.out + O_WKP + (size_t)(b * 32 + h) * 4096; }
            else { const int b = (item - 64) >> 5; h = (item - 64) & 31; row0 = MP + b * 64; T = 64; s0 = a.in[4] + (size_t)(b * 32 + h) * 4096; sout = a.out + O_WKS + (size_t)(b * 32 + h) * 4096; }
            const int hj = h * 64 + lane;
            float S[64];
#pragma unroll
            for (int k4 = 0; k4 < 16; ++k4) { f32x4 v = (f32x4){0.f, 0.f, 0.f, 0.f}; if (s0) v = *(const f32x4*)(s0 + lane * 64 + k4 * 4); S[k4 * 4] = v.x; S[k4 * 4 + 1] = v.y; S[k4 * 4 + 2] = v.z; S[k4 * 4 + 3] = v.w; }
            const float kkc = a.in[17][hj], kac = a.in[18][hj], rkc = a.in[19][hj], lg = a.in[20][hj], lb = a.in[21][hj];
            for (int t = 0; t < T; ++t) {
                const size_t m = (size_t)(row0 + t);
                const float r = (float)P16[m * PP + hj], k = (float)P16[m * PP + D + hj], v = (float)P16[m * PP + 2 * D + hj];
                const float e = (float)EAG[m * 6144 + hj], av = (float)EAG[m * 6144 + D + hj], gv = (float)EAG[m * 6144 + 2 * D + hj];
                const float w = __expf(-e);
                const float kkr = k * kkc; const float ss = wave_sum(kkr * kkr); const float kk = kkr / fmaxf(sqrtf(ss), 1e-12f);
                const float kmod = k * (1.f + (av - 1.f) * kac), kka = kk * av;
                asm volatile("s_waitcnt lgkmcnt(0)" ::: "memory");
                sh[lane] = kk; sh[64 + lane] = w; sh[128 + lane] = kka; sh[192 + lane] = kmod; sh[256 + lane] = r;
                asm volatile("s_waitcnt lgkmcnt(0)" ::: "memory");
                float sa0 = 0.f, sa1 = 0.f, sa2 = 0.f, sa3 = 0.f;
#pragma unroll
                for (int k4 = 0; k4 < 16; ++k4) { const f32x4 q = *(const LAS f32x4*)(sh + k4 * 4); sa0 += S[k4 * 4] * q.x; sa1 += S[k4 * 4 + 1] * q.y; sa2 += S[k4 * 4 + 2] * q.z; sa3 += S[k4 * 4 + 3] * q.w; }
                const float sa = (sa0 + sa1) + (sa2 + sa3);
                float o0 = 0.f, o1 = 0.f, o2 = 0.f, o3 = 0.f;
#pragma unroll
                for (int k4 = 0; k4 < 16; ++k4) {
                    const f32x4 qw = *(const LAS f32x4*)(sh + 64 + k4 * 4), qa = *(const LAS f32x4*)(sh + 128 + k4 * 4), qk = *(const LAS f32x4*)(sh + 192 + k4 * 4), qr = *(const LAS f32x4*)(sh + 256 + k4 * 4);
                    S[k4 * 4] = S[k4 * 4] * qw.x + (v * qk.x - sa * qa.x); S[k4 * 4 + 1] = S[k4 * 4 + 1] * qw.y + (v * qk.y - sa * qa.y);
                    S[k4 * 4 + 2] = S[k4 * 4 + 2] * qw.z + (v * qk.z - sa * qa.z); S[k4 * 4 + 3] = S[k4 * 4 + 3] * qw.w + (v * qk.w - sa * qa.w);
                    o0 += S[k4 * 4] * qr.x; o1 += S[k4 * 4 + 1] * qr.y; o2 += S[k4 * 4 + 2] * qr.z; o3 += S[k4 * 4 + 3] * qr.w; }
                const float o = (o0 + o1) + (o2 + o3);
                const float mean = wave_sum(o) * (1.f / 64.f); const float dlt = o - mean; const float var = wave_sum(dlt * dlt) * (1.f / 64.f);
                const float on = dlt * rsqrtf(var + 64e-5f) * lg + lb;
                const float rk = wave_sum(r * kmod * rkc);
                const float ya = (on + rk * v) * gv;
                P16[m * PP + hj] = (h16)ya;
            }
#pragma unroll
            for (int k4 = 0; k4 < 16; ++k4) *(f32x4*)(sout + lane * 64 + k4 * 4) = (f32x4){S[k4 * 4], S[k4 * 4 + 1], S[k4 * 4 + 2], S[k4 * 4 + 3]};
        }
    }
    SEAM(PH_SCAN);
    if (IN(PH_MERGE)) {
        const float* cw = a.in[22];
        for (int c = bx; c < NCHUNK; c += G) {
            const int half = tid >> 8, o8 = tid & 255, c0 = o8 * 8; const size_t rowb = (size_t)c * 64 + half * 32;
            const bool seq_start = ((c < 128) ? ((c & 63) == 0) : true) && half == 0;
            float u1[8], u2[8], w0[8], w1[8], w2[8];
#pragma unroll
            for (int j = 0; j < 8; ++j) { w0[j] = cw[c0 + j]; w1[j] = cw[D + c0 + j]; w2[j] = cw[2 * D + c0 + j]; }
            if (seq_start) {
                if (c < 128) {
#pragma unroll
                    for (int j = 0; j < 8; ++j) { u1[j] = 0.f; u2[j] = 0.f; }
                } else { const float* sc = a.in[3] + (size_t)(c - 128) * 2 * D + c0;
#pragma unroll
                    for (int j = 0; j < 8; ++j) { u2[j] = sc[j]; u1[j] = sc[D + j]; } }
            } else {
                const h16x8 g2 = *(const h16x8*)(P16 + (rowb - 2) * PP + C_GC + c0), x2 = *(const h16x8*)(P16 + (rowb - 2) * PP + C_XC + c0);
                const h16x8 g1 = *(const h16x8*)(P16 + (rowb - 1) * PP + C_GC + c0), x1 = *(const h16x8*)(P16 + (rowb - 1) * PP + C_XC + c0);
#pragma unroll
                for (int j = 0; j < 8; ++j) { u2[j] = (float)g2[j] * (float)x2[j]; u1[j] = (float)g1[j] * (float)x1[j]; }
            }
            const bool seq_end = ((c < 128) ? ((c & 63) == 63) : true) && half == 1;
            float* cvout = (c < 128) ? a.out + O_CVP + (size_t)(c >> 6) * 2 * D : a.out + O_CVS + (size_t)(c - 128) * 2 * D;
            for (int t = 0; t < 32; ++t) {
                const h16* pr = P16 + (rowb + t) * PP;
                const h16x8 ya = *(const h16x8*)(pr + c0), gb = *(const h16x8*)(pr + C_GB + c0), gc = *(const h16x8*)(pr + C_GC + c0), xc = *(const h16x8*)(pr + C_XC + c0),
                            ga = *(const h16x8*)(pr + C_GA + c0), gg = *(const h16x8*)(pr + C_GG + c0);
                float mg[8];
#pragma unroll
                for (int j = 0; j < 8; ++j) { const float u0 = (float)gc[j] * (float)xc[j]; const float cv = w0[j] * u2[j] + w1[j] * u1[j] + w2[j] * u0;
                    mg[j] = sigmoidf_((float)ga[j]) * (float)ya[j] + sigmoidf_((float)gg[j]) * ((float)gb[j] * cv); u2[j] = u1[j]; u1[j] = u0; }
                *(u32x4*)(A16 + (rowb + t) * D + c0) = (u32x4){pk2h(mg[0], mg[1]), pk2h(mg[2], mg[3]), pk2h(mg[4], mg[5]), pk2h(mg[6], mg[7])};
                if (seq_end && t >= 30) { float* q = cvout + (size_t)(t - 30) * D + c0; *(f32x4*)q = (f32x4){u1[0], u1[1], u1[2], u1[3]}; *(f32x4*)(q + 4) = (f32x4){u1[4], u1[5], u1[6], u1[7]}; }
            }
        }
    }
    SEAM(PH_MERGE);
    if (IN(PH_WOUT)) {
        { pg8::Gemm g{A16, WOUT, MT, D, D}; pg8::Order S; S.init(MT, D, G, bx, 0); pg8::EpiRes E{Y, Y + (size_t)MP * D, Y, 1.0f, 0}; pg8::gemm_phase(lds, g, S, E); }
        LAS float* scr = (LAS float*)(lds + wave * 16384);
        constexpr int I1 = (D / 64) * (2 * FF / 32), I2 = (FF / 64) * (D / 32);
        for (int it = gw; it < I1 + I2; it += NGW) {
            if (it < I1) cvt_item(1, a.in[25], a.in[26], FF, D, W2GU, scr, it, 2 * FF / 32, lane);
            else cvt_item(0, a.in[27], nullptr, D, FF, W2D, scr, it - I1, D / 32, lane);
        }
    }
    SEAM(PH_WOUT);
    if (IN(PH_RMS2)) { for (int m = gw; m < MT; m += NGW) rms_row_f16(Y + (size_t)m * D, a.in[24], A16 + (size_t)m * D, nullptr, lane); }
    SEAM(PH_RMS2);
    if (IN(PH_FFN2_GU)) { pg8::Gemm g{A16, W2GU, MT, 2 * FF, D}; pg8::Order S; S.init(MT, 2 * FF, G, bx, 0); pg8::EpiSwiGLU E{HM, FF}; pg8::gemm_phase(lds, g, S, E); }
    SEAM(PH_FFN2_GU);
    if (IN(PH_FFN2_D)) { pg8::Gemm g{HM, W2D, MT, D, FF}; pg8::Order S; S.init(MT, D, G, bx, 0); pg8::EpiRes E{Y, Y + (size_t)MP * D, Y, 0.5f, 0}; pg8::gemm_phase(lds, g, S, E); }
    SEAM(PH_FFN2_D);
    if (IN(PH_FINAL)) { for (int m = gw; m < MT; m += NGW) rms_row_f16(Y + (size_t)m * D, a.in[28], nullptr, Y + (size_t)m * D, lane); }
#undef IN
#undef SEAM
}

extern "C" void kernel_launch(void* const* d_in, const int* in_sizes, int n_in, void* d_out, int out_size, void* d_ws, size_t ws_size, hipStream_t stream) {
    static int grid = 0;
    if (grid == 0) {
        if (n_in != 29 || (size_t)out_size != O_END || ws_size < WS_END) { fprintf(stderr, "kernel_launch: unexpected shapes (n_in %d out %d ws %zu need %zu)\n", n_in, out_size, ws_size, (size_t)WS_END); grid = -1; return; }
        int dev = 0, cus = 0, per_cu = 0;
        if (hipGetDevice(&dev) != hipSuccess || hipDeviceGetAttribute(&cus, hipDeviceAttributeMultiprocessorCount, dev) != hipSuccess) { grid = -1; return; }
        if (hipFuncSetAttribute((const void*)fwd_kernel, hipFuncAttributeMaxDynamicSharedMemorySize, LDS_BYTES) != hipSuccess) { grid = -1; return; }
        if (hipOccupancyMaxActiveBlocksPerMultiprocessor(&per_cu, (const void*)fwd_kernel, NTHR, LDS_BYTES) != hipSuccess || per_cu < 1) { fprintf(stderr, "kernel_launch: occupancy query failed (%d)\n", per_cu); grid = -1; return; }
        grid = cus;
    }
    if (grid < 0) return;
    Args a{};
    for (int i = 0; i < 29; ++i) a.in[i] = (const float*)d_in[i];
    a.out = (float*)d_out; a.ws = (unsigned char*)d_ws; a.ph_lo = 0; a.ph_hi = PH_N;
    void* kargs[] = {&a};
    hipError_t e = hipLaunchCooperativeKernel((const void*)fwd_kernel, dim3(grid), dim3(NTHR), kargs, LDS_BYTES, stream);
    if (e != hipSuccess) fprintf(stderr, "kernel_launch: cooperative launch failed: %s (grid %d)\n", hipGetErrorString(e), grid);
}
```

```cpp
#include <hip/hip_runtime.h>
#include <hip/hip_cooperative_groups.h>
#include <cstdio>
namespace cg = cooperative_groups;

#define LAS __attribute__((address_space(3)))
typedef _Float16 h16;
typedef _Float16 h16x2 __attribute__((ext_vector_type(2)));
typedef _Float16 h16x4 __attribute__((ext_vector_type(4)));
typedef _Float16 h16x8 __attribute__((ext_vector_type(8)));
typedef float f32x4 __attribute__((ext_vector_type(4)));
typedef unsigned u32x4 __attribute__((ext_vector_type(4)));
typedef unsigned u32x2 __attribute__((ext_vector_type(2)));

constexpr int D = 2048, FF = 5632, NA = 6592, NIN = 16832;
constexpr int MP = 8192, MS = 2048, MT = MP + MS;
constexpr int MA = MT + 256;
constexpr int PP = 16896;
constexpr int PFW = 6656;
constexpr int C_GB = 6656, C_GC = 8704, C_XC = 10752, C_GA = 12800, C_GG = 14848;
constexpr int LK = 512;
constexpr int NCHUNK = MT / 64;
constexpr size_t O_Y = 0, O_SHP = 20971520, O_CVP = 20975616, O_WKP = 20983808, O_SHS = 21245952, O_CVS = 21311488, O_WKS = 21442560, O_END = 25636864;
constexpr size_t WS_CTL = 0;
constexpr size_t WS_W1GU = 1u << 20;
constexpr size_t WS_W1D = WS_W1GU + (size_t)2 * FF * D * 2;
constexpr size_t WS_WIN = WS_W1D + (size_t)D * FF * 2;
constexpr size_t WS_WOUT = WS_WIN + (size_t)PP * D * 2;
constexpr size_t WS_A16 = WS_WOUT + (size_t)D * D * 2;
constexpr size_t WS_P16 = WS_A16 + (size_t)MA * D * 2;
constexpr size_t WS_PF = WS_P16 + (size_t)MT * PP * 2;
constexpr size_t WS_END = WS_PF + (size_t)256 * PFW * 2;
constexpr size_t WS_EAG = WS_W1GU;
constexpr size_t WS_HM = WS_P16;
constexpr size_t WS_W2GU = WS_P16 + (size_t)MT * FF * 2;
constexpr size_t WS_W2D = WS_W2GU + (size_t)2 * FF * D * 2;
static_assert((size_t)MT * 6144 * 2 <= WS_WOUT - WS_W1GU, "EAG overlay");
static_assert(WS_W2D + (size_t)D * FF * 2 <= WS_PF, "W2 overlay");
constexpr size_t OB_WL = O_WKS * 4;
static_assert(OB_WL + (size_t)6144 * LK * 2 <= O_END * 4, "d_out scratch");

constexpr size_t WS_RK = WS_EAG + (size_t)MT * 6144 * 2;
static_assert(WS_RK + (size_t)MT * 32 * 4 <= WS_WOUT, "RK");
constexpr int SC_SLOT = 6 * 64, SC_BUF = 16 * SC_SLOT;
constexpr int NWAVES = 8, NTHR = 512;
constexpr int LDS_BYTES = 147456;

__device__ __forceinline__ unsigned pk2h(float a, float b) { h16x2 v = {(h16)a, (h16)b}; return __builtin_bit_cast(unsigned, v); }
__device__ __forceinline__ float wave_sum(float v) {
#pragma unroll
    for (int o = 1; o < 64; o <<= 1) v += __shfl_xor(v, o);
    return v;
}
template <int CTRL> __device__ __forceinline__ float dpp_f(float x) { return __builtin_bit_cast(float, __builtin_amdgcn_update_dpp(0, __builtin_bit_cast(int, x), CTRL, 0xF, 0xF, false)); }
__device__ __forceinline__ float row_allreduce8(float x) { x += dpp_f<0xB1>(x); x += dpp_f<0x4E>(x); x += dpp_f<0x141>(x); return x; }
__device__ __forceinline__ float row_allreduce16(float x) { x = row_allreduce8(x); x += dpp_f<0x140>(x); return x; }
__device__ __forceinline__ float rl_f(float x, int l) { return __builtin_bit_cast(float, __builtin_amdgcn_readlane(__builtin_bit_cast(int, x), l)); }
__device__ __forceinline__ float wave_sum_dpp(float x) { x = row_allreduce16(x); return (rl_f(x, 0) + rl_f(x, 16)) + (rl_f(x, 32) + rl_f(x, 48)); }
__device__ __forceinline__ float sigmoidf_(float x) { return 1.0f / (1.0f + __expf(-x)); }

namespace pg8 {
constexpr int BM = 256, BK = 64, HALF = 128, HTB = HALF * BK * 2, STAGE_BYTES = 8 * HTB, NXCD = 8, WGM = 8;
__host__ __device__ __forceinline__ int lds_byte(int r, int c) { const int st = (r >> 4) * 2 + (c >> 5), rr = r & 15, cc = c & 31, ob = rr * 64 + cc * 2; return st * 1024 + (ob ^ (((ob >> 9) & 1) << 5)); }
__host__ __device__ __forceinline__ void stage_rc(int b, int& R, int& C) { const int st = b / 1024, sb = b % 1024, swz = sb ^ (((sb >> 9) & 1) << 5); R = (st >> 1) * 16 + swz / 64; C = (st & 1) * 32 + (swz % 64) / 2; }
__host__ __device__ __forceinline__ int perm32(int rho) { const int n = rho >> 4, i = rho & 15; return 8 * (i >> 2) + 4 * n + (i & 3); }
struct Unit { int pm, pn; };
struct Gemm { const h16* A; const h16* Bt; int M, N, K; };
struct Order {
    int nM, nN, nwg, G, c, extra;
    __device__ void init(int M, int N, int G_, int c_, int extra_) { nM = M / BM; nN = N / BM; nwg = nM * nN; G = G_; c = c_; extra = extra_; }
    __device__ bool next(int i, Unit& u) const {
        const long L = (long)i * G + c; if (L >= nwg + extra) return false;
        if (L >= nwg) { u.pm = nM; u.pn = (int)(L - nwg); return true; }
        int wgid = (int)L; { const int q = nwg / NXCD, r = nwg % NXCD, xcd = wgid % NXCD, off = wgid / NXCD; wgid = (xcd < r ? xcd * (q + 1) : r * (q + 1) + (xcd - r) * q) + off; }
        const int nig = WGM * nN, gid = wgid / nig, fm = gid * WGM, gsz = (nM - fm) < WGM ? (nM - fm) : WGM;
        u.pm = fm + ((wgid % nig) % gsz); u.pn = (wgid % nig) / gsz; return true;
    }
};

template <class Epi>
__device__ __forceinline__ void gemm_phase(LAS unsigned char* lds, const Gemm g, const Order& S, const Epi& E) {
    const int tid = threadIdx.x, wid = __builtin_amdgcn_readfirstlane(tid >> 6), lane = tid & 63, wr = wid >> 2, wc = wid & 3, fr = lane & 15, fq = lane >> 4;
    const int K = g.K, nt = K / BK;
    unsigned voffA[2], voffB[2];
#pragma unroll
    for (int i = 0; i < 2; ++i) { int R, C; stage_rc(tid * 16 + i * 8192, R, C); const int Rb = Epi::PERM ? ((R & ~31) + perm32(R & 31)) : R;
        voffA[i] = (unsigned)(R * K + C) * 2u; voffB[i] = (unsigned)(Rb * K + C) * 2u; }
    const size_t kstep = (size_t)(BK * 2);
    const size_t hstep = (size_t)HALF * K * 2;
    const size_t tstep = 2 * hstep;
    const unsigned ldsw = (unsigned)wid * 1024u;
    const int aoff = lds_byte(wr * 64 + fr, fq * 8), boff = lds_byte(wc * 32 + fr, fq * 8);
#define PG8_SA(b, h) (((b) * 2 + (h)) * HTB)
#define PG8_SB(b, h) ((4 + (b) * 2 + (h)) * HTB)
#define PG8_STAGE(bufoff, gbase, voff) do { _Pragma("unroll") for (int _i = 0; _i < 2; ++_i) \
        __builtin_amdgcn_global_load_lds((const unsigned*)((const char*)(gbase) + (voff)[_i]), (LAS unsigned*)(lds + (bufoff) + ldsw + _i * 8192), 16, 0, 0); } while (0)
#define PG8_LDA(dst, b, h) do { _Pragma("unroll") for (int m = 0; m < 4; ++m) _Pragma("unroll") for (int k = 0; k < 2; ++k) dst[m][k] = *(const LAS h16x8*)(lds + PG8_SA(b, h) + aoff + m * 2048 + k * 1024); } while (0)
#define PG8_LDB(dst, b, h) do { _Pragma("unroll") for (int n = 0; n < 2; ++n) _Pragma("unroll") for (int k = 0; k < 2; ++k) dst[n][k] = *(const LAS h16x8*)(lds + PG8_SB(b, h) + boff + n * 2048 + k * 1024); } while (0)
#define PG8_MMA(ai, bj, At, Bt) do { __builtin_amdgcn_s_setprio(1); _Pragma("unroll") for (int m = 0; m < 4; ++m) _Pragma("unroll") for (int n = 0; n < 2; ++n) _Pragma("unroll") for (int k = 0; k < 2; ++k) \
        acc[ai][bj][m][n] = __builtin_amdgcn_mfma_f32_16x16x32_f16(Bt[n][k], At[m][k], acc[ai][bj][m][n], 0, 0, 0); __builtin_amdgcn_s_setprio(0); } while (0)
#define PG8_WAIT_V(n) asm volatile("s_waitcnt vmcnt(" #n ")" ::: "memory")
#define PG8_WAIT_L(n) asm volatile("s_waitcnt lgkmcnt(" #n ")" ::: "memory")
#define PG8_BAR __builtin_amdgcn_s_barrier()
#define PG8_SCHED __builtin_amdgcn_sched_barrier(0)
    Unit cur, nxt; int ui = 0;
    if (!S.next(0, cur)) return;
    f32x4 acc[2][2][4][2];
#pragma unroll
    for (int a = 0; a < 2; ++a)
#pragma unroll
        for (int b = 0; b < 2; ++b)
#pragma unroll
            for (int m = 0; m < 4; ++m)
#pragma unroll
                for (int n = 0; n < 2; ++n) acc[a][b][m][n] = (f32x4){0.f, 0.f, 0.f, 0.f};
    h16x8 At[4][2], B0[2][2], B1[2][2];
    const char* cA = (const char*)g.A + (size_t)cur.pm * tstep; const char* cB = (const char*)g.Bt + (size_t)cur.pn * tstep;
    PG8_STAGE(PG8_SB(0, 0), cB, voffB); PG8_STAGE(PG8_SA(0, 0), cA, voffA); PG8_STAGE(PG8_SB(0, 1), cB + hstep, voffB); PG8_STAGE(PG8_SA(0, 1), cA + hstep, voffA);
    if (wr == 1) PG8_BAR;
    PG8_WAIT_V(4); PG8_BAR;
    PG8_STAGE(PG8_SB(1, 0), cB + kstep, voffB); PG8_STAGE(PG8_SA(1, 0), cA + kstep, voffA); PG8_STAGE(PG8_SB(1, 1), cB + hstep + kstep, voffB);
    PG8_WAIT_V(6); PG8_BAR;
    for (;;) {
        const bool has_next = S.next(ui + 1, nxt);
        const char* nA = has_next ? (const char*)g.A + (size_t)nxt.pm * tstep : cA; const char* nB = has_next ? (const char*)g.Bt + (size_t)nxt.pn * tstep : cB;
        for (int t = 0; t < nt; t += 2) {
            const bool last = (t == nt - 2);
            const char* a1 = cA + (size_t)(t + 1) * kstep;
            const char* a2 = last ? nA : cA + (size_t)(t + 2) * kstep; const char* b2 = last ? nB : cB + (size_t)(t + 2) * kstep;
            const char* a3 = a2 + kstep; const char* b3 = b2 + kstep;
            PG8_LDB(B0, 0, 0); PG8_SCHED; PG8_LDA(At, 0, 0); PG8_STAGE(PG8_SA(1, 1), a1 + hstep, voffA);
            PG8_WAIT_L(8); PG8_BAR; PG8_WAIT_L(0); PG8_MMA(0, 0, At, B0); PG8_BAR; PG8_SCHED;
            PG8_LDB(B1, 0, 1); PG8_STAGE(PG8_SB(0, 0), b2, voffB);
            PG8_BAR; PG8_WAIT_L(0); PG8_MMA(0, 1, At, B1); PG8_BAR;
            PG8_LDA(At, 0, 1); PG8_STAGE(PG8_SA(0, 0), a2, voffA);
            PG8_BAR; PG8_WAIT_L(0); PG8_MMA(1, 0, At, B0); PG8_BAR; PG8_SCHED;
            PG8_STAGE(PG8_SB(0, 1), b2 + hstep, voffB);
            PG8_WAIT_V(6); PG8_BAR; PG8_MMA(1, 1, At, B1); PG8_BAR;
            PG8_LDB(B0, 1, 0); PG8_SCHED; PG8_LDA(At, 1, 0); PG8_STAGE(PG8_SA(0, 1), a2 + hstep, voffA);
            PG8_WAIT_L(8); PG8_BAR; PG8_WAIT_L(0); PG8_MMA(0, 0, At, B0); PG8_BAR; PG8_SCHED;
            PG8_LDB(B1, 1, 1); PG8_STAGE(PG8_SB(1, 0), b3, voffB);
            PG8_BAR; PG8_WAIT_L(0); PG8_MMA(0, 1, At, B1); PG8_BAR;
            PG8_LDA(At, 1, 1); PG8_STAGE(PG8_SA(1, 0), a3, voffA);
            PG8_BAR; PG8_WAIT_L(0); PG8_MMA(1, 0, At, B0); PG8_BAR; PG8_SCHED;
            PG8_STAGE(PG8_SB(1, 1), b3 + hstep, voffB);
            PG8_WAIT_V(6); PG8_BAR; PG8_MMA(1, 1, At, B1); PG8_BAR;
        }
        E(acc, cur, wr, wc, fr, fq);
        if (!has_next) break;
#pragma unroll
        for (int a = 0; a < 2; ++a)
#pragma unroll
            for (int b = 0; b < 2; ++b)
#pragma unroll
                for (int m = 0; m < 4; ++m)
#pragma unroll
                    for (int n = 0; n < 2; ++n) acc[a][b][m][n] = (f32x4){0.f, 0.f, 0.f, 0.f};
        cur = nxt; cA = nA; cB = nB; ++ui;
    }
    PG8_WAIT_V(0);
    if (wr == 0) PG8_BAR;
    PG8_BAR;
#undef PG8_SA
#undef PG8_SB
#undef PG8_STAGE
#undef PG8_LDA
#undef PG8_LDB
#undef PG8_MMA
#undef PG8_WAIT_V
#undef PG8_WAIT_L
#undef PG8_BAR
#undef PG8_SCHED
}

struct EpiSwiGLU {
    static constexpr bool PERM = false;
    h16* O; int ldo;
    __device__ __forceinline__ void operator()(const f32x4 (&acc)[2][2][4][2], const Unit& u, int wr, int wc, int fr, int fq) const {
        const int row0 = u.pm * BM + wr * 64 + fr;
#pragma unroll
        for (int ai = 0; ai < 2; ++ai)
#pragma unroll
            for (int m = 0; m < 4; ++m) { h16* rowp = O + (size_t)(row0 + ai * HALF + m * 16) * ldo;
#pragma unroll
                for (int bj = 0; bj < 2; ++bj) { const int oc = (u.pn * BM + bj * HALF + wc * 32) / 2 + 4 * fq;
                    const f32x4 gt = acc[ai][bj][m][0], up = acc[ai][bj][m][1]; float o[4];
#pragma unroll
                    for (int j = 0; j < 4; ++j) o[j] = gt[j] * sigmoidf_(gt[j]) * up[j];
                    u32x2 w; w.x = pk2h(o[0], o[1]); w.y = pk2h(o[2], o[3]);
                    *(u32x2*)(rowp + oc) = w; } }
    }
};
struct EpiRes {
    static constexpr bool PERM = false;
    const float* r0; const float* r1; float* out; float scale; int pad;
    __device__ __forceinline__ void operator()(const f32x4 (&acc)[2][2][4][2], const Unit& u, int wr, int wc, int fr, int fq) const {
        const int row0 = u.pm * BM + wr * 64 + fr, col0 = u.pn * BM + wc * 32 + 4 * fq;
        const float* rb = (u.pm * BM < MP) ? r0 : r1 - (size_t)MP * D;
#pragma unroll
        for (int ai = 0; ai < 2; ++ai)
#pragma unroll
            for (int m = 0; m < 4; ++m) { const size_t off = (size_t)(row0 + ai * HALF + m * 16) * D + col0;
#pragma unroll
                for (int bj = 0; bj < 2; ++bj)
#pragma unroll
                    for (int n = 0; n < 2; ++n) { const f32x4 rv = *(const f32x4*)(rb + off + bj * HALF + n * 16);
                        *(f32x4*)(out + off + bj * HALF + n * 16) = rv + scale * acc[ai][bj][m][n]; } }
    }
};
struct EpiP16 {
    static constexpr bool PERM = true;
    h16* P; h16* PF;
    __device__ __forceinline__ void operator()(const f32x4 (&acc)[2][2][4][2], const Unit& u, int wr, int wc, int fr, int fq) const {
        const int row0 = u.pm * BM + wr * 64 + fr;
#pragma unroll
        for (int ai = 0; ai < 2; ++ai)
#pragma unroll
            for (int m = 0; m < 4; ++m) { const int row = row0 + ai * HALF + m * 16;
#pragma unroll
                for (int bj = 0; bj < 2; ++bj) { const int col = u.pn * BM + bj * HALF + wc * 32 + 8 * fq;
                    const f32x4 v0 = acc[ai][bj][m][0], v1 = acc[ai][bj][m][1];
                    u32x4 w; w.x = pk2h(v0[0], v0[1]); w.y = pk2h(v0[2], v0[3]); w.z = pk2h(v1[0], v1[1]); w.w = pk2h(v1[2], v1[3]);
                    if (u.pm < MT / BM) *(u32x4*)(P + (size_t)row * PP + col) = w;
                    else *(u32x4*)(PF + (size_t)(row - MT) * PFW + col) = w; } }
    }
};
struct EpiEAG {
    static constexpr bool PERM = true;
    h16* O; const float* w0; const float* a0;
    __device__ __forceinline__ void operator()(const f32x4 (&acc)[2][2][4][2], const Unit& u, int wr, int wc, int fr, int fq) const {
        const int row0 = u.pm * BM + wr * 64 + fr; const int typ = u.pn >> 3;
#pragma unroll
        for (int bj = 0; bj < 2; ++bj) { const int col = u.pn * BM + bj * HALF + wc * 32 + 8 * fq;
            f32x4 b0 = (f32x4){0.f, 0.f, 0.f, 0.f}, b1 = b0;
            if (typ == 0) { b0 = *(const f32x4*)(w0 + col); b1 = *(const f32x4*)(w0 + col + 4); }
            if (typ == 1) { b0 = *(const f32x4*)(a0 + col - D); b1 = *(const f32x4*)(a0 + col - D + 4); }
#pragma unroll
            for (int ai = 0; ai < 2; ++ai)
#pragma unroll
                for (int m = 0; m < 4; ++m) { const int row = row0 + ai * HALF + m * 16;
                    f32x4 v0 = acc[ai][bj][m][0] + b0, v1 = acc[ai][bj][m][1] + b1;
                    if (typ < 2) { const float sc = typ == 0 ? 0.60653065971f : 1.0f;
#pragma unroll
                        for (int j = 0; j < 4; ++j) { v0[j] = sigmoidf_(v0[j]) * sc; v1[j] = sigmoidf_(v1[j]) * sc; } }
                    u32x4 w; w.x = pk2h(v0[0], v0[1]); w.y = pk2h(v0[2], v0[3]); w.z = pk2h(v1[0], v1[1]); w.w = pk2h(v1[2], v1[3]);
                    *(u32x4*)(O + (size_t)row * 6144 + col) = w; } }
    }
};
}

struct Args { const float* in[29]; float* out; unsigned char* ws; int ph_lo, ph_hi; };

__device__ __forceinline__ void cvt_item(int mode, const float* s0, const float* s1, int Nsrc, int K, h16* WT, LAS float* scr, int item, int nblk, int lane) {
    const int kb = item / nblk, nb = item % nblk, k0 = 64 * kb, n0 = 32 * nb;
    const int nn = lane & 31; const float* src = s0; int col = n0 + nn; bool zero = false;
    if (mode == 1) { src = (nn < 16) ? s0 : s1; col = (n0 >> 1) + (nn & 15); }
    if (mode == 2) { if (n0 >= NA && n0 < PFW) zero = true; else if (n0 >= PFW) col -= 64; }
#pragma unroll 8
    for (int i = 0; i < 32; ++i) { const int kk = 2 * i + (lane >> 5); scr[kk * 33 + nn] = zero ? 0.f : src[(size_t)(k0 + kk) * Nsrc + col]; }
    asm volatile("s_waitcnt lgkmcnt(0)" ::: "memory");
    const int c = lane & 7;
#pragma unroll
    for (int j = 0; j < 4; ++j) { const int n = (lane >> 3) + 8 * j; const LAS float* s = scr + (8 * c) * 33 + n;
        u32x4 o; o.x = pk2h(s[0 * 33], s[1 * 33]); o.y = pk2h(s[2 * 33], s[3 * 33]); o.z = pk2h(s[4 * 33], s[5 * 33]); o.w = pk2h(s[6 * 33], s[7 * 33]);
        *(u32x4*)(WT + (size_t)(n0 + n) * K + k0 + 8 * c) = o; }
    asm volatile("s_waitcnt lgkmcnt(0)" ::: "memory");
}
__device__ __forceinline__ void cvt_lora_item(const float* wl, const float* al, const float* gl, h16* WT, int item, int lane) {
    const int n = item, typ = n >> 11, col = n & 2047; unsigned w[4];
#pragma unroll
    for (int j = 0; j < 4; ++j) { float v[2];
#pragma unroll
        for (int e = 0; e < 2; ++e) { const int k = lane * 8 + j * 2 + e; float x = 0.f;
            if (typ == 0 && k < 96) x = wl[(size_t)k * D + col];
            if (typ == 1 && k >= 96 && k < 192) x = al[(size_t)(k - 96) * D + col];
            if (typ == 2 && k >= 192 && k < 448) x = gl[(size_t)(k - 192) * D + col];
            v[e] = x; }
        w[j] = pk2h(v[0], v[1]); }
    *(u32x4*)(WT + (size_t)n * LK + lane * 8) = (u32x4){w[0], w[1], w[2], w[3]};
}

__device__ __forceinline__ void rms_row_f16(const float* xrow, const float* g, h16* orow, float* f32row, int lane) {
    const f32x4* xr = (const f32x4*)xrow + lane; const f32x4* gr = (const f32x4*)g + lane;
    f32x4 v[8]; float s = 0.f;
#pragma unroll
    for (int j = 0; j < 8; ++j) { v[j] = xr[64 * j]; s += (v[j].x * v[j].x + v[j].y * v[j].y) + (v[j].z * v[j].z + v[j].w * v[j].w); }
    const float rs = rsqrtf(wave_sum(s) * (1.f / D) + 1e-6f);
#pragma unroll
    for (int j = 0; j < 8; ++j) { const f32x4 gg = gr[64 * j]; const f32x4 o = v[j] * rs * gg;
        if (orow) { u32x2 w; w.x = pk2h(o.x, o.y); w.y = pk2h(o.z, o.w); *((u32x2*)orow + lane + 64 * j) = w; }
        if (f32row) *((f32x4*)f32row + lane + 64 * j) = o; }
}

enum { PH_CVT1 = 0, PH_FFN1_GU, PH_FFN1_D, PH_RMS_MIX, PH_WIN, PH_SHIFT, PH_LORA, PH_SCAN, PH_MERGE, PH_WOUT, PH_RMS2, PH_FFN2_GU, PH_FFN2_D, PH_FINAL, PH_N };

__global__ void __launch_bounds__(NTHR, 2) fwd_kernel(Args a) {
    extern __shared__ __attribute__((aligned(16))) unsigned char lds_raw[];
    LAS unsigned char* lds = (LAS unsigned char*)lds_raw;
    const int tid = threadIdx.x, lane = tid & 63, wave = __builtin_amdgcn_readfirstlane(tid >> 6);
    const int G = gridDim.x, bx = blockIdx.x;
    const int gw = bx * NWAVES + wave, NGW = G * NWAVES;
    unsigned char* ws = a.ws; unsigned char* ob = (unsigned char*)a.out;
    h16* W1GU = (h16*)(ws + WS_W1GU); h16* W1D = (h16*)(ws + WS_W1D); h16* WIN = (h16*)(ws + WS_WIN); h16* WOUT = (h16*)(ws + WS_WOUT);
    h16* A16 = (h16*)(ws + WS_A16); h16* P16 = (h16*)(ws + WS_P16); h16* EAG = (h16*)(ws + WS_EAG); h16* HM = (h16*)(ws + WS_HM);
    h16* W2GU = (h16*)(ws + WS_W2GU); h16* W2D = (h16*)(ws + WS_W2D);
    h16* WL = (h16*)(ob + OB_WL); h16* PF = (h16*)(ws + WS_PF);
    float* Y = a.out + O_Y;
    const int lo = a.ph_lo, hi = a.ph_hi;
#define IN(k) (lo <= (k) && (k) < hi)
    cg::grid_group grid = cg::this_grid();
#define SEAM(k) do { if (IN(k) && IN((k) + 1)) grid.sync(); } while (0)

    if (IN(PH_CVT1)) {
        LAS float* scr = (LAS float*)(lds + wave * 16384);
        constexpr int I1 = (D / 64) * (2 * FF / 32), I2 = (FF / 64) * (D / 32), I3 = (D / 64) * (PP / 32), I4 = (D / 64) * (D / 32);
        for (int it = gw; it < I1 + I2 + I3 + I4; it += NGW) {
            int r = it;
            if (r < I1) { cvt_item(1, a.in[6], a.in[7], FF, D, W1GU, scr, r, 2 * FF / 32, lane); continue; } r -= I1;
            if (r < I2) { cvt_item(0, a.in[8], nullptr, D, FF, W1D, scr, r, D / 32, lane); continue; } r -= I2;
            if (r < I3) { cvt_item(2, a.in[10], nullptr, NIN, D, WIN, scr, r, PP / 32, lane); continue; } r -= I3;
            cvt_item(0, a.in[23], nullptr, D, D, WOUT, scr, r, D / 32, lane);
        }
        for (int it = gw; it < 6144; it += NGW) cvt_lora_item(a.in[13], a.in[15], a.in[16], WL, it, lane);
        for (int r = gw; r < 256; r += NGW) { h16* orow = A16 + (size_t)(MT + r) * D;
#pragma unroll
            for (int j = 0; j < 8; ++j) { u32x2 w = (u32x2){0u, 0u};
                if (r < 32) { const f32x4 v = *((const f32x4*)(a.in[2] + (size_t)r * D) + lane + 64 * j); w.x = pk2h(v.x, v.y); w.y = pk2h(v.z, v.w); }
                *((u32x2*)orow + lane + 64 * j) = w; } }
        for (int m = gw; m < MT; m += NGW) { const float* xr = m < MP ? a.in[0] + (size_t)m * D : a.in[1] + (size_t)(m - MP) * D; rms_row_f16(xr, a.in[5], A16 + (size_t)m * D, nullptr, lane); }
    }
    SEAM(PH_CVT1);
    if (IN(PH_FFN1_GU)) { pg8::Gemm g{A16, W1GU, MT, 2 * FF, D}; pg8::Order S; S.init(MT, 2 * FF, G, bx, 0); pg8::EpiSwiGLU E{HM, FF}; pg8::gemm_phase(lds, g, S, E); }
    SEAM(PH_FFN1_GU);
    if (IN(PH_FFN1_D)) { pg8::Gemm g{HM, W1D, MT, D, FF}; pg8::Order S; S.init(MT, D, G, bx, 0); pg8::EpiRes E{a.in[0], a.in[1], Y, 0.5f, 0}; pg8::gemm_phase(lds, g, S, E); }
    SEAM(PH_FFN1_D);
    if (IN(PH_RMS_MIX)) {
        for (int m = gw; m < MT; m += NGW) { float* so = nullptr;
            if (m < MP) { if ((m & 4095) == 4095) so = a.out + O_SHP + (size_t)(m >> 12) * D; } else { if (((m - MP) & 63) == 63) so = a.out + O_SHS + (size_t)((m - MP) >> 6) * D; }
            rms_row_f16(Y + (size_t)m * D, a.in[9], A16 + (size_t)m * D, so, lane); }
    }
    SEAM(PH_RMS_MIX);
    if (IN(PH_WIN)) { pg8::Gemm g{A16, WIN, MT, PP, D}; pg8::Order S; S.init(MT, PP, G, bx, PFW / 256); pg8::EpiP16 E{P16, PF}; pg8::gemm_phase(lds, g, S, E); }
    SEAM(PH_WIN);
    if (IN(PH_SHIFT)) {
        h16* AIN = A16; const float* mu = a.in[11];
        for (int item = bx * NTHR + tid; item < MT * 64; item += G * NTHR) {
            const int row = item >> 6, o = item & 63;
            if (o >= 56) { *(u32x4*)(AIN + (size_t)row * LK + 448 + (o - 56) * 8) = (u32x4){0u, 0u, 0u, 0u}; continue; }
            const int c0 = 6144 + o * 8;
            const bool st = row < MP ? ((row & 4095) == 0) : (((row - MP) & 63) == 0);
            const h16* pp = st ? (row < MP ? PF + (size_t)32 * PFW : PF + (size_t)((row - MP) >> 6) * PFW) + c0 : P16 + (size_t)(row - 1) * PP + c0;
            const h16x8 cv = *(const h16x8*)(P16 + (size_t)row * PP + c0), pv = *(const h16x8*)pp;
            const f32x4 m0 = *(const f32x4*)(mu + c0), m1 = *(const f32x4*)(mu + c0 + 4);
            const float mu8[8] = {m0.x, m0.y, m0.z, m0.w, m1.x, m1.y, m1.z, m1.w}; float s[8];
#pragma unroll
            for (int j = 0; j < 8; ++j) { const float cu = (float)cv[j]; s[j] = cu + mu8[j] * ((float)pv[j] - cu); }
            if (o < 12) {
#pragma unroll
                for (int j = 0; j < 8; ++j) s[j] = tanhf(s[j]);
            } else if (o >= 24) {
#pragma unroll
                for (int j = 0; j < 8; ++j) s[j] = sigmoidf_(s[j]);
            }
            *(u32x4*)(AIN + (size_t)row * LK + o * 8) = (u32x4){pk2h(s[0], s[1]), pk2h(s[2], s[3]), pk2h(s[4], s[5]), pk2h(s[6], s[7])};
        }
    }
    SEAM(PH_SHIFT);
    if (IN(PH_LORA)) { pg8::Gemm g{A16, WL, MT, 6144, LK}; pg8::Order S; S.init(MT, 6144, G, bx, 0); pg8::EpiEAG E{EAG, a.in[12], a.in[14]}; pg8::gemm_phase(lds, g, S, E); }
    SEAM(PH_LORA);
    if (IN(PH_SCAN)) {
        const int vcu = (G % 8 == 0) ? (bx % 8) * (G / 8) + bx / 8 : bx;
        LAS float* ring = (LAS float*)lds;
        LAS float* ybuf = (LAS float*)(lds + 2 * SC_BUF * 4);
        h16* OUT16 = A16; float* RK = (float*)(ws + WS_RK);
        const bool consumer = wave < 4;
        const int pw = wave - 4;
        f32x4 S = (f32x4){0.f, 0.f, 0.f, 0.f};
        unsigned short R[4][8];
        float c_kk = 0.f, c_ka = 0.f, c_rk = 0.f, c_mr = 0.f, c_mk = 0.f, c_mv = 0.f;
#define SC_DESC(cc, prompt, sq, h, q, t0, first, last) \
        bool prompt = (cc) < 256, first, last; int sq, h, q, t0; \
        if (prompt) { const int pair = vcu >> 2; sq = pair >> 5; h = pair & 31; q = vcu & 3; t0 = 16 * (cc); first = (cc) == 0; last = (cc) == 255; } \
        else { const int j = (cc) - 256, si = j >> 2, pair = vcu * 4 + (si >> 2); sq = pair >> 5; h = pair & 31; q = si & 3; t0 = 16 * (j & 3); first = (j & 3) == 0; last = (j & 3) == 3; }
#define SC_LOAD(cc) do { SC_DESC(cc, prompt_, sq_, h_, q_, t0_, first_, last_); (void)last_; (void)q_; const int hj_ = h_ * 64 + lane; \
            _Pragma("unroll") for (int i = 0; i < 4; ++i) { const int t_ = t0_ + 4 * pw + i; const size_t m_ = (size_t)(prompt_ ? sq_ * 4096 : MP + sq_ * 64) + t_; \
                const unsigned short* pc_ = (const unsigned short*)P16 + m_ * PP + hj_; \
                const unsigned short* pq_ = (t_ == 0) ? (const unsigned short*)PF + (size_t)(prompt_ ? 32 : sq_) * PFW + hj_ : pc_ - PP; \
                const unsigned short* pe_ = (const unsigned short*)EAG + m_ * 6144 + hj_; \
                R[i][0] = pc_[0]; R[i][1] = pc_[D]; R[i][2] = pc_[2 * D]; R[i][3] = pq_[0]; R[i][4] = pq_[D]; R[i][5] = pq_[2 * D]; R[i][6] = pe_[0]; R[i][7] = pe_[D]; } } while (0)
#define H2F(x) ((float)__builtin_bit_cast(h16, (unsigned short)(x)))
        constexpr int NCH = 320;
        if (!consumer) { SC_LOAD(0); }
        for (int c = -1; c < NCH; ++c) {
            if (consumer) {
                if (c >= 0) {
                    SC_DESC(c, prompt, sq, h, q, t0, first, last); (void)t0;
                    const int vl = lane >> 4, kq = lane & 15, row = 16 * q + 4 * wave + vl;
                    float* sp = a.out + (prompt ? O_WKP : O_WKS) + ((size_t)(sq * 32 + h) * 64 + row) * 64 + 4 * kq;
                    if (first) { S = (f32x4){0.f, 0.f, 0.f, 0.f}; if (!prompt) S = *(const f32x4*)(a.in[4] + ((size_t)(sq * 32 + h) * 64 + row) * 64 + 4 * kq); }
                    const LAS float* buf = ring + (c & 1) * SC_BUF + 4 * kq;
                    const LAS float* vb = ring + (c & 1) * SC_BUF + 320 + row;
                    LAS float* yb = ybuf + (c & 1) * 4096 + (4 * wave + vl) * 16 + kq;
#pragma unroll 4
                    for (int s = 0; s < 16; ++s) {
                        const LAS float* sl = buf + s * SC_SLOT;
                        const f32x4 kk = *(const LAS f32x4*)(sl), w = *(const LAS f32x4*)(sl + 64), ka = *(const LAS f32x4*)(sl + 128), km = *(const LAS f32x4*)(sl + 192), r = *(const LAS f32x4*)(sl + 256);
                        const float v = vb[s * SC_SLOT];
                        float p = (S.x * kk.x + S.y * kk.y) + (S.z * kk.z + S.w * kk.w);
                        p = row_allreduce16(p);
                        S = (S * w + v * km) - p * ka;
                        yb[s * 256] = (S.x * r.x + S.y * r.y) + (S.z * r.z + S.w * r.w);
                    }
                    if (last) *(f32x4*)sp = S;
                }
            } else {
                if (c + 1 < NCH) {
                    SC_DESC(c + 1, prompt, sq, h, q, t0, first, last); (void)last;
                    const int hj = h * 64 + lane;
                    if (first) { c_kk = a.in[17][hj]; c_ka = a.in[18][hj]; c_rk = a.in[19][hj]; c_mr = a.in[11][hj]; c_mk = a.in[11][D + hj]; c_mv = a.in[11][2 * D + hj]; }
                    LAS float* buf = ring + ((c + 1) & 1) * SC_BUF + lane;
#pragma unroll
                    for (int i = 0; i < 4; ++i) {
                        const int s = 4 * pw + i;
                        float r = H2F(R[i][0]), k = H2F(R[i][1]), v = H2F(R[i][2]);
                        r += c_mr * (H2F(R[i][3]) - r); k += c_mk * (H2F(R[i][4]) - k); v += c_mv * (H2F(R[i][5]) - v);
                        const float e = H2F(R[i][6]), av = H2F(R[i][7]);
                        const float w = __expf(-e);
                        const float kkr = k * c_kk; const float ss = wave_sum_dpp(kkr * kkr);
                        const float kk = kkr / fmaxf(sqrtf(ss), 1e-12f);
                        const float kmod = k * (1.f + (av - 1.f) * c_ka);
                        LAS float* sl = buf + s * SC_SLOT;
                        sl[0] = kk; sl[64] = w; sl[128] = kk * av; sl[192] = kmod; sl[256] = r; sl[320] = v;
                        if (q == 0) { const float rk = wave_sum_dpp(r * kmod * c_rk); if (lane == 0) RK[((size_t)(prompt ? sq * 4096 : MP + sq * 64) + t0 + s) * 32 + h] = rk; }
                    }
                }
                if (c + 2 < NCH) { SC_LOAD(c + 2); }
                if (c >= 1) {
                    SC_DESC(c - 1, prompt, sq, h, q, t0, first, last); (void)first; (void)last;
                    const int s = 4 * pw + (lane >> 4), rr = lane & 15;
                    const LAS f32x4* yp = (const LAS f32x4*)(ybuf + ((c - 1) & 1) * 4096 + s * 256 + rr * 16);
                    const f32x4 y0 = yp[0], y1 = yp[1], y2 = yp[2], y3 = yp[3];
                    const float o = ((y0.x + y0.y) + (y0.z + y0.w)) + ((y1.x + y1.y) + (y1.z + y1.w)) + ((y2.x + y2.y) + (y2.z + y2.w)) + ((y3.x + y3.y) + (y3.z + y3.w));
                    OUT16[((size_t)(prompt ? sq * 4096 : MP + sq * 64) + t0 + s) * D + h * 64 + 16 * q + rr] = (h16)o;
                }
            }
            __syncthreads();
        }
        if (!consumer) {
            SC_DESC(NCH - 1, prompt, sq, h, q, t0, first, last); (void)first; (void)last;
            const int s = 4 * pw + (lane >> 4), rr = lane & 15;
            const LAS f32x4* yp = (const LAS f32x4*)(ybuf + ((NCH - 1) & 1) * 4096 + s * 256 + rr * 16);
            const f32x4 y0 = yp[0], y1 = yp[1], y2 = yp[2], y3 = yp[3];
            const float o = ((y0.x + y0.y) + (y0.z + y0.w)) + ((y1.x + y1.y) + (y1.z + y1.w)) + ((y2.x + y2.y) + (y2.z + y2.w)) + ((y3.x + y3.y) + (y3.z + y3.w));
            OUT16[((size_t)(prompt ? sq * 4096 : MP + sq * 64) + t0 + s) * D + h * 64 + 16 * q + rr] = (h16)o;
        }
#undef SC_DESC
#undef SC_LOAD
#undef H2F
    }
    SEAM(PH_SCAN);
    if (IN(PH_MERGE)) {
        const float* cw = a.in[22]; const float* RK = (const float*)(ws + WS_RK);
        for (int r2 = bx; r2 < MT / 2; r2 += G) {
            const int row = 2 * r2 + (tid >> 8), o8 = tid & 255, c0 = o8 * 8, hd = o8 >> 3;
            const bool pr = row < MP; const int tt = pr ? (row & 4095) : ((row - MP) & 63), sq = pr ? (row >> 12) : ((row - MP) >> 6), T = pr ? 4096 : 64;
            const h16* prow = P16 + (size_t)row * PP;
            const h16x8 ov = *(const h16x8*)(A16 + (size_t)row * D + c0);
            const h16x8 vc = *(const h16x8*)(prow + 2 * D + c0);
            const h16x8 vp = *(const h16x8*)((tt == 0 ? PF + (size_t)(pr ? 32 : sq) * PFW : prow - PP) + 2 * D + c0);
            const h16x8 gv = *(const h16x8*)(EAG + (size_t)row * 6144 + 2 * D + c0);
            const h16x8 gb = *(const h16x8*)(prow + C_GB + c0), gc = *(const h16x8*)(prow + C_GC + c0), xc = *(const h16x8*)(prow + C_XC + c0), ga = *(const h16x8*)(prow + C_GA + c0), gg = *(const h16x8*)(prow + C_GG + c0);
            float u1[8], u2[8];
            if (tt >= 1) { const h16x8 g1 = *(const h16x8*)(prow - PP + C_GC + c0), x1 = *(const h16x8*)(prow - PP + C_XC + c0);
#pragma unroll
                for (int j = 0; j < 8; ++j) u1[j] = (float)g1[j] * (float)x1[j];
            } else {
#pragma unroll
                for (int j = 0; j < 8; ++j) u1[j] = pr ? 0.f : a.in[3][(size_t)sq * 2 * D + D + c0 + j]; }
            if (tt >= 2) { const h16x8 g2 = *(const h16x8*)(prow - 2 * PP + C_GC + c0), x2 = *(const h16x8*)(prow - 2 * PP + C_XC + c0);
#pragma unroll
                for (int j = 0; j < 8; ++j) u2[j] = (float)g2[j] * (float)x2[j];
            } else {
#pragma unroll
                for (int j = 0; j < 8; ++j) u2[j] = pr ? 0.f : a.in[3][(size_t)sq * 2 * D + (size_t)tt * D + c0 + j]; }
            const float rk = RK[(size_t)row * 32 + hd];
            float of[8], s1 = 0.f;
#pragma unroll
            for (int j = 0; j < 8; ++j) { of[j] = (float)ov[j]; s1 += of[j]; }
            const float mean = row_allreduce8(s1) * (1.f / 64.f); float s2 = 0.f;
#pragma unroll
            for (int j = 0; j < 8; ++j) { of[j] -= mean; s2 += of[j] * of[j]; }
            const float rstd = rsqrtf(row_allreduce8(s2) * (1.f / 64.f) + 64e-5f);
            float mg[8], u0[8];
#pragma unroll
            for (int j = 0; j < 8; ++j) {
                const float vs = (float)vc[j] + a.in[11][2 * D + c0 + j] * ((float)vp[j] - (float)vc[j]);
                const float ya = (of[j] * rstd * a.in[20][c0 + j] + a.in[21][c0 + j] + rk * vs) * (float)gv[j];
                u0[j] = (float)gc[j] * (float)xc[j];
                const float cv = cw[c0 + j] * u2[j] + cw[D + c0 + j] * u1[j] + cw[2 * D + c0 + j] * u0[j];
                mg[j] = sigmoidf_((float)ga[j]) * ya + sigmoidf_((float)gg[j]) * ((float)gb[j] * cv); }
            *(u32x4*)(A16 + (size_t)row * D + c0) = (u32x4){pk2h(mg[0], mg[1]), pk2h(mg[2], mg[3]), pk2h(mg[4], mg[5]), pk2h(mg[6], mg[7])};
            if (tt >= T - 2) { float* q = a.out + (pr ? O_CVP : O_CVS) + (size_t)sq * 2 * D + (size_t)(tt - (T - 2)) * D + c0;
                *(f32x4*)q = (f32x4){u0[0], u0[1], u0[2], u0[3]}; *(f32x4*)(q + 4) = (f32x4){u0[4], u0[5], u0[6], u0[7]}; }
        }
    }
    SEAM(PH_MERGE);
    if (IN(PH_WOUT)) {
        { pg8::Gemm g{A16, WOUT, MT, D, D}; pg8::Order S; S.init(MT, D, G, bx, 0); pg8::EpiRes E{Y, Y + (size_t)MP * D, Y, 1.0f, 0}; pg8::gemm_phase(lds, g, S, E); }
        LAS float* scr = (LAS float*)(lds + wave * 16384);
        constexpr int I1 = (D / 64) * (2 * FF / 32), I2 = (FF / 64) * (D / 32);
        for (int it = gw; it < I1 + I2; it += NGW) {
            if (it < I1) cvt_item(1, a.in[25], a.in[26], FF, D, W2GU, scr, it, 2 * FF / 32, lane);
            else cvt_item(0, a.in[27], nullptr, D, FF, W2D, scr, it - I1, D / 32, lane);
        }
    }
    SEAM(PH_WOUT);
    if (IN(PH_RMS2)) { for (int m = gw; m < MT; m += NGW) rms_row_f16(Y + (size_t)m * D, a.in[24], A16 + (size_t)m * D, nullptr, lane); }
    SEAM(PH_RMS2);
    if (IN(PH_FFN2_GU)) { pg8::Gemm g{A16, W2GU, MT, 2 * FF, D}; pg8::Order S; S.init(MT, 2 * FF, G, bx, 0); pg8::EpiSwiGLU E{HM, FF}; pg8::gemm_phase(lds, g, S, E); }
    SEAM(PH_FFN2_GU);
    if (IN(PH_FFN2_D)) { pg8::Gemm g{HM, W2D, MT, D, FF}; pg8::Order S; S.init(MT, D, G, bx, 0); pg8::EpiRes E{Y, Y + (size_t)MP * D, Y, 0.5f, 0}; pg8::gemm_phase(lds, g, S, E); }
    SEAM(PH_FFN2_D);
    if (IN(PH_FINAL)) { for (int m = gw; m < MT; m += NGW) rms_row_f16(Y + (size_t)m * D, a.in[28], nullptr, Y + (size_t)m * D, lane); }
#undef IN
#undef SEAM
}

extern "C" void kernel_launch(void* const* d_in, const int* in_sizes, int n_in, void* d_out, int out_size, void* d_ws, size_t ws_size, hipStream_t stream) {
    static int grid = 0;
    if (grid == 0) {
        if (n_in != 29 || (size_t)out_size != O_END || ws_size < WS_END) { fprintf(stderr, "kernel_launch: unexpected shapes (n_in %d out %d ws %zu need %zu)\n", n_in, out_size, ws_size, (size_t)WS_END); grid = -1; return; }
        int dev = 0, cus = 0, per_cu = 0;
        if (hipGetDevice(&dev) != hipSuccess || hipDeviceGetAttribute(&cus, hipDeviceAttributeMultiprocessorCount, dev) != hipSuccess) { grid = -1; return; }
        if (hipFuncSetAttribute((const void*)fwd_kernel, hipFuncAttributeMaxDynamicSharedMemorySize, LDS_BYTES) != hipSuccess) { grid = -1; return; }
        if (hipOccupancyMaxActiveBlocksPerMultiprocessor(&per_cu, (const void*)fwd_kernel, NTHR, LDS_BYTES) != hipSuccess || per_cu < 1) { fprintf(stderr, "kernel_launch: occupancy query failed (%d)\n", per_cu); grid = -1; return; }
        grid = cus;
    }
    if (grid < 0) return;
    Args a{};
    for (int i = 0; i < 29; ++i) a.in[i] = (const float*)d_in[i];
    a.out = (float*)d_out; a.ws = (unsigned char*)d_ws; a.ph_lo = 0; a.ph_hi = PH_N;
    void* kargs[] = {&a};
    hipError_t e = hipLaunchCooperativeKernel((const void*)fwd_kernel, dim3(grid), dim3(NTHR), kargs, LDS_BYTES, stream);
    if (e != hipSuccess) fprintf(stderr, "kernel_launch: cooperative launch failed: %s (grid %d)\n", hipGetErrorString(e), grid);
}
```

```cpp
#include <hip/hip_runtime.h>
#include <hip/hip_cooperative_groups.h>
#include <cstdio>
namespace cg = cooperative_groups;

#define LAS __attribute__((address_space(3)))
typedef _Float16 h16;
typedef _Float16 h16x2 __attribute__((ext_vector_type(2)));
typedef _Float16 h16x4 __attribute__((ext_vector_type(4)));
typedef _Float16 h16x8 __attribute__((ext_vector_type(8)));
typedef float f32x4 __attribute__((ext_vector_type(4)));
typedef float f32x2 __attribute__((ext_vector_type(2)));
typedef unsigned u32x4 __attribute__((ext_vector_type(4)));
typedef unsigned u32x2 __attribute__((ext_vector_type(2)));

constexpr int D = 2048, FF = 5632, NA = 6592, NIN = 16832;
constexpr int MP = 8192, MS = 2048, MT = MP + MS;
constexpr int MA = MT + 256;
constexpr int PP = 16896;
constexpr int PFW = 6656;
constexpr int C_GB = 6656, C_GC = 8704, C_XC = 10752, C_GA = 12800, C_GG = 14848;
constexpr int LK = 512;
constexpr int NCHUNK = MT / 64;
constexpr size_t O_Y = 0, O_SHP = 20971520, O_CVP = 20975616, O_WKP = 20983808, O_SHS = 21245952, O_CVS = 21311488, O_WKS = 21442560, O_END = 25636864;
constexpr size_t WS_CTL = 0;
constexpr size_t WS_W1GU = 1u << 20;
constexpr size_t WS_W1D = WS_W1GU + (size_t)2 * FF * D * 2;
constexpr size_t WS_WIN = WS_W1D + (size_t)D * FF * 2;
constexpr size_t WS_WOUT = WS_WIN + (size_t)PP * D * 2;
constexpr size_t WS_A16 = WS_WOUT + (size_t)D * D * 2;
constexpr size_t WS_P16 = WS_A16 + (size_t)MA * D * 2;
constexpr size_t WS_PF = WS_P16 + (size_t)MT * PP * 2;
constexpr size_t WS_END = WS_PF + (size_t)256 * PFW * 2;
constexpr size_t WS_EAG = WS_W1GU;
constexpr size_t WS_HM = WS_P16;
constexpr size_t WS_W2GU = WS_P16 + (size_t)MT * FF * 2;
constexpr size_t WS_W2D = WS_W2GU + (size_t)2 * FF * D * 2;
static_assert((size_t)MT * 6144 * 2 <= WS_WOUT - WS_W1GU, "EAG overlay");
static_assert(WS_W2D + (size_t)D * FF * 2 <= WS_PF, "W2 overlay");
constexpr size_t OB_WL = O_WKS * 4;
static_assert(OB_WL + (size_t)6144 * LK * 2 <= O_END * 4, "d_out scratch");

constexpr size_t WS_RK = WS_EAG + (size_t)MT * 6144 * 2;
static_assert(WS_RK + (size_t)MT * 32 * 4 <= WS_WOUT, "RK");
constexpr int SC_SLOT = 6 * 64, SC_BUF = 16 * SC_SLOT;
constexpr int NWAVES = 8, NTHR = 512;
constexpr int LDS_BYTES = 147456;

__device__ __forceinline__ unsigned pk2h(float a, float b) { h16x2 v = {(h16)a, (h16)b}; return __builtin_bit_cast(unsigned, v); }
__device__ __forceinline__ float wave_sum(float v) {
#pragma unroll
    for (int o = 1; o < 64; o <<= 1) v += __shfl_xor(v, o);
    return v;
}
template <int CTRL> __device__ __forceinline__ float dpp_f(float x) { return __builtin_bit_cast(float, __builtin_amdgcn_update_dpp(0, __builtin_bit_cast(int, x), CTRL, 0xF, 0xF, false)); }
__device__ __forceinline__ float row_allreduce8(float x) { x += dpp_f<0xB1>(x); x += dpp_f<0x4E>(x); x += dpp_f<0x141>(x); return x; }
__device__ __forceinline__ float row_allreduce16(float x) { x = row_allreduce8(x); x += dpp_f<0x140>(x); return x; }
__device__ __forceinline__ float rl_f(float x, int l) { return __builtin_bit_cast(float, __builtin_amdgcn_readlane(__builtin_bit_cast(int, x), l)); }
__device__ __forceinline__ float wave_sum_dpp(float x) { x = row_allreduce16(x); return (rl_f(x, 0) + rl_f(x, 16)) + (rl_f(x, 32) + rl_f(x, 48)); }
__device__ __forceinline__ float sigmoidf_(float x) { return 1.0f / (1.0f + __expf(-x)); }

namespace pg8 {
constexpr int BM = 256, BK = 64, HALF = 128, HTB = HALF * BK * 2, STAGE_BYTES = 8 * HTB, NXCD = 8, WGM = 8;
__host__ __device__ __forceinline__ int lds_byte(int r, int c) { const int st = (r >> 4) * 2 + (c >> 5), rr = r & 15, cc = c & 31, ob = rr * 64 + cc * 2; return st * 1024 + (ob ^ (((ob >> 9) & 1) << 5)); }
__host__ __device__ __forceinline__ void stage_rc(int b, int& R, int& C) { const int st = b / 1024, sb = b % 1024, swz = sb ^ (((sb >> 9) & 1) << 5); R = (st >> 1) * 16 + swz / 64; C = (st & 1) * 32 + (swz % 64) / 2; }
__host__ __device__ __forceinline__ int perm32(int rho) { const int n = rho >> 4, i = rho & 15; return 8 * (i >> 2) + 4 * n + (i & 3); }
struct Unit { int pm, pn; };
struct Gemm { const h16* A; const h16* Bt; int M, N, K; };
struct Order {
    int nM, nN, nwg, G, c, extra;
    __device__ void init(int M, int N, int G_, int c_, int extra_) { nM = M / BM; nN = N / BM; nwg = nM * nN; G = G_; c = c_; extra = extra_; }
    __device__ bool next(int i, Unit& u) const {
        const long L = (long)i * G + c; if (L >= nwg + extra) return false;
        if (L >= nwg) { u.pm = nM; u.pn = (int)(L - nwg); return true; }
        int wgid = (int)L; { const int q = nwg / NXCD, r = nwg % NXCD, xcd = wgid % NXCD, off = wgid / NXCD; wgid = (xcd < r ? xcd * (q + 1) : r * (q + 1) + (xcd - r) * q) + off; }
        const int nig = WGM * nN, gid = wgid / nig, fm = gid * WGM, gsz = (nM - fm) < WGM ? (nM - fm) : WGM;
        u.pm = fm + ((wgid % nig) % gsz); u.pn = (wgid % nig) / gsz; return true;
    }
};

template <class Epi>
__device__ __forceinline__ void gemm_phase(LAS unsigned char* lds, const Gemm g, const Order& S, const Epi& E) {
    const int tid = threadIdx.x, wid = __builtin_amdgcn_readfirstlane(tid >> 6), lane = tid & 63, wr = wid >> 2, wc = wid & 3, fr = lane & 15, fq = lane >> 4;
    const int K = g.K, nt = K / BK;
    unsigned voffA[2], voffB[2];
#pragma unroll
    for (int i = 0; i < 2; ++i) { int R, C; stage_rc(tid * 16 + i * 8192, R, C); const int Rb = Epi::PERM ? ((R & ~31) + perm32(R & 31)) : R;
        voffA[i] = (unsigned)(R * K + C) * 2u; voffB[i] = (unsigned)(Rb * K + C) * 2u; }
    const size_t kstep = (size_t)(BK * 2);
    const size_t hstep = (size_t)HALF * K * 2;
    const size_t tstep = 2 * hstep;
    const unsigned ldsw = (unsigned)wid * 1024u;
    const int aoff = lds_byte(wr * 64 + fr, fq * 8), boff = lds_byte(wc * 32 + fr, fq * 8);
#define PG8_SA(b, h) (((b) * 2 + (h)) * HTB)
#define PG8_SB(b, h) ((4 + (b) * 2 + (h)) * HTB)
#define PG8_STAGE(bufoff, gbase, voff) do { _Pragma("unroll") for (int _i = 0; _i < 2; ++_i) \
        __builtin_amdgcn_global_load_lds((const unsigned*)((const char*)(gbase) + (voff)[_i]), (LAS unsigned*)(lds + (bufoff) + ldsw + _i * 8192), 16, 0, 0); } while (0)
#define PG8_LDA(dst, b, h) do { _Pragma("unroll") for (int m = 0; m < 4; ++m) _Pragma("unroll") for (int k = 0; k < 2; ++k) dst[m][k] = *(const LAS h16x8*)(lds + PG8_SA(b, h) + aoff + m * 2048 + k * 1024); } while (0)
#define PG8_LDB(dst, b, h) do { _Pragma("unroll") for (int n = 0; n < 2; ++n) _Pragma("unroll") for (int k = 0; k < 2; ++k) dst[n][k] = *(const LAS h16x8*)(lds + PG8_SB(b, h) + boff + n * 2048 + k * 1024); } while (0)
#define PG8_MMA(ai, bj, At, Bt) do { __builtin_amdgcn_s_setprio(1); _Pragma("unroll") for (int m = 0; m < 4; ++m) _Pragma("unroll") for (int n = 0; n < 2; ++n) _Pragma("unroll") for (int k = 0; k < 2; ++k) \
        acc[ai][bj][m][n] = __builtin_amdgcn_mfma_f32_16x16x32_f16(Bt[n][k], At[m][k], acc[ai][bj][m][n], 0, 0, 0); __builtin_amdgcn_s_setprio(0); } while (0)
#define PG8_WAIT_V(n) asm volatile("s_waitcnt vmcnt(" #n ")" ::: "memory")
#define PG8_WAIT_L(n) asm volatile("s_waitcnt lgkmcnt(" #n ")" ::: "memory")
#define PG8_BAR __builtin_amdgcn_s_barrier()
#define PG8_SCHED __builtin_amdgcn_sched_barrier(0)
    Unit cur, nxt; int ui = 0;
    if (!S.next(0, cur)) return;
    f32x4 acc[2][2][4][2];
#pragma unroll
    for (int a = 0; a < 2; ++a)
#pragma unroll
        for (int b = 0; b < 2; ++b)
#pragma unroll
            for (int m = 0; m < 4; ++m)
#pragma unroll
                for (int n = 0; n < 2; ++n) acc[a][b][m][n] = (f32x4){0.f, 0.f, 0.f, 0.f};
    h16x8 At[4][2], B0[2][2], B1[2][2];
    const char* cA = (const char*)g.A + (size_t)cur.pm * tstep; const char* cB = (const char*)g.Bt + (size_t)cur.pn * tstep;
    PG8_STAGE(PG8_SB(0, 0), cB, voffB); PG8_STAGE(PG8_SA(0, 0), cA, voffA); PG8_STAGE(PG8_SB(0, 1), cB + hstep, voffB); PG8_STAGE(PG8_SA(0, 1), cA + hstep, voffA);
    if (wr == 1) PG8_BAR;
    PG8_WAIT_V(4); PG8_BAR;
    PG8_STAGE(PG8_SB(1, 0), cB + kstep, voffB); PG8_STAGE(PG8_SA(1, 0), cA + kstep, voffA); PG8_STAGE(PG8_SB(1, 1), cB + hstep + kstep, voffB);
    PG8_WAIT_V(6); PG8_BAR;
    for (;;) {
        const bool has_next = S.next(ui + 1, nxt);
        const char* nA = has_next ? (const char*)g.A + (size_t)nxt.pm * tstep : cA; const char* nB = has_next ? (const char*)g.Bt + (size_t)nxt.pn * tstep : cB;
        for (int t = 0; t < nt; t += 2) {
            const bool last = (t == nt - 2);
            const char* a1 = cA + (size_t)(t + 1) * kstep;
            const char* a2 = last ? nA : cA + (size_t)(t + 2) * kstep; const char* b2 = last ? nB : cB + (size_t)(t + 2) * kstep;
            const char* a3 = a2 + kstep; const char* b3 = b2 + kstep;
            PG8_LDB(B0, 0, 0); PG8_SCHED; PG8_LDA(At, 0, 0); PG8_STAGE(PG8_SA(1, 1), a1 + hstep, voffA);
            PG8_WAIT_L(8); PG8_BAR; PG8_WAIT_L(0); PG8_MMA(0, 0, At, B0); PG8_BAR; PG8_SCHED;
            PG8_LDB(B1, 0, 1); PG8_STAGE(PG8_SB(0, 0), b2, voffB);
            PG8_BAR; PG8_WAIT_L(0); PG8_MMA(0, 1, At, B1); PG8_BAR;
            PG8_LDA(At, 0, 1); PG8_STAGE(PG8_SA(0, 0), a2, voffA);
            PG8_BAR; PG8_WAIT_L(0); PG8_MMA(1, 0, At, B0); PG8_BAR; PG8_SCHED;
            PG8_STAGE(PG8_SB(0, 1), b2 + hstep, voffB);
            PG8_WAIT_V(6); PG8_BAR; PG8_MMA(1, 1, At, B1); PG8_BAR;
            PG8_LDB(B0, 1, 0); PG8_SCHED; PG8_LDA(At, 1, 0); PG8_STAGE(PG8_SA(0, 1), a2 + hstep, voffA);
            PG8_WAIT_L(8); PG8_BAR; PG8_WAIT_L(0); PG8_MMA(0, 0, At, B0); PG8_BAR; PG8_SCHED;
            PG8_LDB(B1, 1, 1); PG8_STAGE(PG8_SB(1, 0), b3, voffB);
            PG8_BAR; PG8_WAIT_L(0); PG8_MMA(0, 1, At, B1); PG8_BAR;
            PG8_LDA(At, 1, 1); PG8_STAGE(PG8_SA(1, 0), a3, voffA);
            PG8_BAR; PG8_WAIT_L(0); PG8_MMA(1, 0, At, B0); PG8_BAR; PG8_SCHED;
            PG8_STAGE(PG8_SB(1, 1), b3 + hstep, voffB);
            PG8_WAIT_V(6); PG8_BAR; PG8_MMA(1, 1, At, B1); PG8_BAR;
        }
        E(acc, cur, wr, wc, fr, fq);
        if (!has_next) break;
#pragma unroll
        for (int a = 0; a < 2; ++a)
#pragma unroll
            for (int b = 0; b < 2; ++b)
#pragma unroll
                for (int m = 0; m < 4; ++m)
#pragma unroll
                    for (int n = 0; n < 2; ++n) acc[a][b][m][n] = (f32x4){0.f, 0.f, 0.f, 0.f};
        cur = nxt; cA = nA; cB = nB; ++ui;
    }
    PG8_WAIT_V(0);
    if (wr == 0) PG8_BAR;
    PG8_BAR;
#undef PG8_SA
#undef PG8_SB
#undef PG8_STAGE
#undef PG8_LDA
#undef PG8_LDB
#undef PG8_MMA
#undef PG8_WAIT_V
#undef PG8_WAIT_L
#undef PG8_BAR
#undef PG8_SCHED
}

struct EpiSwiGLU {
    static constexpr bool PERM = false;
    h16* O; int ldo;
    __device__ __forceinline__ void operator()(const f32x4 (&acc)[2][2][4][2], const Unit& u, int wr, int wc, int fr, int fq) const {
        const int row0 = u.pm * BM + wr * 64 + fr;
#pragma unroll
        for (int ai = 0; ai < 2; ++ai)
#pragma unroll
            for (int m = 0; m < 4; ++m) { h16* rowp = O + (size_t)(row0 + ai * HALF + m * 16) * ldo;
#pragma unroll
                for (int bj = 0; bj < 2; ++bj) { const int oc = (u.pn * BM + bj * HALF + wc * 32) / 2 + 4 * fq;
                    const f32x4 gt = acc[ai][bj][m][0], up = acc[ai][bj][m][1]; float o[4];
#pragma unroll
                    for (int j = 0; j < 4; ++j) o[j] = gt[j] * sigmoidf_(gt[j]) * up[j];
                    u32x2 w; w.x = pk2h(o[0], o[1]); w.y = pk2h(o[2], o[3]);
                    *(u32x2*)(rowp + oc) = w; } }
    }
};
struct EpiRes {
    static constexpr bool PERM = false;
    const float* r0; const float* r1; float* out; float scale; int pad;
    __device__ __forceinline__ void operator()(const f32x4 (&acc)[2][2][4][2], const Unit& u, int wr, int wc, int fr, int fq) const {
        const int row0 = u.pm * BM + wr * 64 + fr, col0 = u.pn * BM + wc * 32 + 4 * fq;
        const float* rb = (u.pm * BM < MP) ? r0 : r1 - (size_t)MP * D;
#pragma unroll
        for (int ai = 0; ai < 2; ++ai)
#pragma unroll
            for (int m = 0; m < 4; ++m) { const size_t off = (size_t)(row0 + ai * HALF + m * 16) * D + col0;
#pragma unroll
                for (int bj = 0; bj < 2; ++bj)
#pragma unroll
                    for (int n = 0; n < 2; ++n) { const f32x4 rv = *(const f32x4*)(rb + off + bj * HALF + n * 16);
                        *(f32x4*)(out + off + bj * HALF + n * 16) = rv + scale * acc[ai][bj][m][n]; } }
    }
};
struct EpiP16 {
    static constexpr bool PERM = true;
    h16* P; h16* PF;
    __device__ __forceinline__ void operator()(const f32x4 (&acc)[2][2][4][2], const Unit& u, int wr, int wc, int fr, int fq) const {
        const int row0 = u.pm * BM + wr * 64 + fr;
#pragma unroll
        for (int ai = 0; ai < 2; ++ai)
#pragma unroll
            for (int m = 0; m < 4; ++m) { const int row = row0 + ai * HALF + m * 16;
#pragma unroll
                for (int bj = 0; bj < 2; ++bj) { const int col = u.pn * BM + bj * HALF + wc * 32 + 8 * fq;
                    const f32x4 v0 = acc[ai][bj][m][0], v1 = acc[ai][bj][m][1];
                    u32x4 w; w.x = pk2h(v0[0], v0[1]); w.y = pk2h(v0[2], v0[3]); w.z = pk2h(v1[0], v1[1]); w.w = pk2h(v1[2], v1[3]);
                    if (u.pm < MT / BM) *(u32x4*)(P + (size_t)row * PP + col) = w;
                    else *(u32x4*)(PF + (size_t)(row - MT) * PFW + col) = w; } }
    }
};
struct EpiEAG {
    static constexpr bool PERM = true;
    h16* O; const float* w0; const float* a0;
    __device__ __forceinline__ void operator()(const f32x4 (&acc)[2][2][4][2], const Unit& u, int wr, int wc, int fr, int fq) const {
        const int row0 = u.pm * BM + wr * 64 + fr; const int typ = u.pn >> 3;
#pragma unroll
        for (int bj = 0; bj < 2; ++bj) { const int col = u.pn * BM + bj * HALF + wc * 32 + 8 * fq;
            f32x4 b0 = (f32x4){0.f, 0.f, 0.f, 0.f}, b1 = b0;
            if (typ == 0) { b0 = *(const f32x4*)(w0 + col); b1 = *(const f32x4*)(w0 + col + 4); }
            if (typ == 1) { b0 = *(const f32x4*)(a0 + col - D); b1 = *(const f32x4*)(a0 + col - D + 4); }
#pragma unroll
            for (int ai = 0; ai < 2; ++ai)
#pragma unroll
                for (int m = 0; m < 4; ++m) { const int row = row0 + ai * HALF + m * 16;
                    f32x4 v0 = acc[ai][bj][m][0] + b0, v1 = acc[ai][bj][m][1] + b1;
                    if (typ < 2) { const float sc = typ == 0 ? 0.60653065971f : 1.0f;
#pragma unroll
                        for (int j = 0; j < 4; ++j) { v0[j] = sigmoidf_(v0[j]) * sc; v1[j] = sigmoidf_(v1[j]) * sc; } }
                    u32x4 w; w.x = pk2h(v0[0], v0[1]); w.y = pk2h(v0[2], v0[3]); w.z = pk2h(v1[0], v1[1]); w.w = pk2h(v1[2], v1[3]);
                    *(u32x4*)(O + (size_t)row * 6144 + col) = w; } }
    }
};
}


#define XB_TMO      128
#define XB_XCNT(j)  (256  + 64 * (j))
#define XB_XSUB(j)  (1280 + 64 * (j))
#define XB_XGEN(j)  (2304 + 64 * (j))
#define XB_TOP      3328
#define XB_TOPGEN   3392
#define XCD_BAR_WORDS 3456
#define XB_SPIN_CAP (1u << 22)
__device__ __forceinline__ unsigned xb_ld(unsigned* p)              { return __hip_atomic_load(p, __ATOMIC_RELAXED, __HIP_MEMORY_SCOPE_AGENT); }
__device__ __forceinline__ unsigned xb_add(unsigned* p, unsigned v) { return __hip_atomic_fetch_add(p, v, __ATOMIC_RELAXED, __HIP_MEMORY_SCOPE_AGENT); }
__device__ __forceinline__ unsigned xb_xcc_id() { return (unsigned)__builtin_amdgcn_s_getreg((3 << 11) | 20) & 0xFu; }
#define XB_SPIN(cond, bar) do { unsigned _sp = 0; while (cond) { __builtin_amdgcn_s_sleep(1); \
    if ((++_sp & 255u) == 0u) { if (xb_ld(&(bar)[XB_TMO])) break; if (_sp > XB_SPIN_CAP) { atomicAdd(&(bar)[XB_TMO], 1u); break; } } } } while (0)
struct XcdBarrier { unsigned* bar; unsigned x; volatile LAS unsigned* st; };
__device__ __forceinline__ XcdBarrier xcd_barrier_post(unsigned* bar, volatile LAS unsigned* st) {
    XcdBarrier b; b.bar = bar; b.x = xb_xcc_id(); b.st = st;
    if (threadIdx.x == 0) (void)xb_add(&bar[XB_XCNT(b.x)], 1u);
    return b;
}
__device__ __forceinline__ void xcd_barrier_complete(unsigned* bar, unsigned x, unsigned& nloc, unsigned& nx) {
    const unsigned G = gridDim.x * gridDim.y * gridDim.z;
    unsigned sum, cnt, mine, sp = 0u;
    for (;;) {
        sum = 0u; cnt = 0u; mine = 0u;
#pragma unroll
        for (unsigned j = 0; j < 16; ++j) { const unsigned c = xb_ld(&bar[XB_XCNT(j)]); sum += c; cnt += (c > 0u) ? 1u : 0u; mine = (j == x) ? c : mine; }
        if (sum == G) break;
        __builtin_amdgcn_s_sleep(1);
        if ((++sp & 255u) == 0u) { if (xb_ld(&bar[XB_TMO])) break; if (sp > XB_SPIN_CAP) { atomicAdd(&bar[XB_TMO], 1u); break; } }
    }
    nloc = mine > 0u ? mine : 1u; nx = cnt > 0u ? cnt : 1u;
}
__device__ __forceinline__ void xcd_barrier(const XcdBarrier& b) {
    asm volatile("s_waitcnt vmcnt(0)" ::: "memory");
    __syncthreads();
    if (threadIdx.x == 0) {
        unsigned* bar = b.bar;
        __builtin_amdgcn_s_waitcnt(0);
        unsigned nloc = b.st[0], nx = b.st[1];
        if (nloc == 0u) { xcd_barrier_complete(bar, b.x, nloc, nx); b.st[0] = nloc; b.st[1] = nx; }
        const unsigned old = xb_add(&bar[XB_XSUB(b.x)], 1u);
        const unsigned gen = old / nloc;
        if (old + 1u == (gen + 1u) * nloc) {
            __builtin_amdgcn_fence(__ATOMIC_RELEASE, "agent");
            asm volatile("s_waitcnt vmcnt(0)" ::: "memory");
            const unsigned og = xb_add(&bar[XB_TOP], 1u);
            const unsigned tg = og / nx;
            if (og + 1u == (tg + 1u) * nx) xb_add(&bar[XB_TOPGEN], 1u);
            else XB_SPIN(xb_ld(&bar[XB_TOPGEN]) == tg, bar);
            __builtin_amdgcn_fence(__ATOMIC_ACQUIRE, "agent");
            xb_add(&bar[XB_XGEN(b.x)], 1u);
            asm volatile("s_waitcnt vmcnt(0)" ::: "memory");
        } else {
            XB_SPIN(xb_ld(&bar[XB_XGEN(b.x)]) == gen, bar);
            __builtin_amdgcn_fence(__ATOMIC_ACQUIRE, "agent");
            asm volatile("s_waitcnt vmcnt(0)" ::: "memory");
        }
    }
    __syncthreads();
}

struct Args { const float* in[29]; float* out; unsigned char* ws; int ph_lo, ph_hi; };

__device__ __forceinline__ void cvt_item(int mode, const float* s0, const float* s1, int Nsrc, int K, h16* WT, LAS float* scr, int item, int nblk, int lane) {
    const int kb = item / nblk, nb = item % nblk, k0 = 64 * kb, n0 = 32 * nb;
    const int nn = lane & 31; const float* src = s0; int col = n0 + nn; bool zero = false;
    if (mode == 1) { src = (nn < 16) ? s0 : s1; col = (n0 >> 1) + (nn & 15); }
    if (mode == 2) { if (n0 >= NA && n0 < PFW) zero = true; else if (n0 >= PFW) col -= 64; }
#pragma unroll 8
    for (int i = 0; i < 32; ++i) { const int kk = 2 * i + (lane >> 5); scr[kk * 33 + nn] = zero ? 0.f : src[(size_t)(k0 + kk) * Nsrc + col]; }
    asm volatile("s_waitcnt lgkmcnt(0)" ::: "memory");
    const int c = lane & 7;
#pragma unroll
    for (int j = 0; j < 4; ++j) { const int n = (lane >> 3) + 8 * j; const LAS float* s = scr + (8 * c) * 33 + n;
        u32x4 o; o.x = pk2h(s[0 * 33], s[1 * 33]); o.y = pk2h(s[2 * 33], s[3 * 33]); o.z = pk2h(s[4 * 33], s[5 * 33]); o.w = pk2h(s[6 * 33], s[7 * 33]);
        *(u32x4*)(WT + (size_t)(n0 + n) * K + k0 + 8 * c) = o; }
    asm volatile("s_waitcnt lgkmcnt(0)" ::: "memory");
}
__device__ __forceinline__ void cvt_lora_item(const float* wl, const float* al, const float* gl, h16* WT, int item, int lane) {
    const int n = item, typ = n >> 11, col = n & 2047; unsigned w[4];
#pragma unroll
    for (int j = 0; j < 4; ++j) { float v[2];
#pragma unroll
        for (int e = 0; e < 2; ++e) { const int k = lane * 8 + j * 2 + e; float x = 0.f;
            if (typ == 0 && k < 96) x = wl[(size_t)k * D + col];
            if (typ == 1 && k >= 96 && k < 192) x = al[(size_t)(k - 96) * D + col];
            if (typ == 2 && k >= 192 && k < 448) x = gl[(size_t)(k - 192) * D + col];
            v[e] = x; }
        w[j] = pk2h(v[0], v[1]); }
    *(u32x4*)(WT + (size_t)n * LK + lane * 8) = (u32x4){w[0], w[1], w[2], w[3]};
}

__device__ __forceinline__ void rms_row_f16(const float* xrow, const float* g, h16* orow, float* f32row, int lane) {
    const f32x4* xr = (const f32x4*)xrow + lane; const f32x4* gr = (const f32x4*)g + lane;
    f32x4 v[8]; float s = 0.f;
#pragma unroll
    for (int j = 0; j < 8; ++j) { v[j] = xr[64 * j]; s += (v[j].x * v[j].x + v[j].y * v[j].y) + (v[j].z * v[j].z + v[j].w * v[j].w); }
    const float rs = rsqrtf(wave_sum(s) * (1.f / D) + 1e-6f);
#pragma unroll
    for (int j = 0; j < 8; ++j) { const f32x4 gg = gr[64 * j]; const f32x4 o = v[j] * rs * gg;
        if (orow) { u32x2 w; w.x = pk2h(o.x, o.y); w.y = pk2h(o.z, o.w); *((u32x2*)orow + lane + 64 * j) = w; }
        if (f32row) *((f32x4*)f32row + lane + 64 * j) = o; }
}

enum { PH_CVT1 = 0, PH_FFN1_GU, PH_FFN1_D, PH_RMS_MIX, PH_WIN, PH_SHIFT, PH_LORA, PH_SCAN, PH_MERGE, PH_WOUT, PH_RMS2, PH_FFN2_GU, PH_FFN2_D, PH_FINAL, PH_N };

__global__ void __launch_bounds__(NTHR, 2) fwd_kernel(Args a) {
    extern __shared__ __attribute__((aligned(16))) unsigned char lds_raw[];
    LAS unsigned char* lds = (LAS unsigned char*)lds_raw;
    const int tid = threadIdx.x, lane = tid & 63, wave = __builtin_amdgcn_readfirstlane(tid >> 6);
    const int G = gridDim.x, bx = blockIdx.x;
    const int gw = bx * NWAVES + wave, NGW = G * NWAVES;
    unsigned char* ws = a.ws; unsigned char* ob = (unsigned char*)a.out;
    h16* W1GU = (h16*)(ws + WS_W1GU); h16* W1D = (h16*)(ws + WS_W1D); h16* WIN = (h16*)(ws + WS_WIN); h16* WOUT = (h16*)(ws + WS_WOUT);
    h16* A16 = (h16*)(ws + WS_A16); h16* P16 = (h16*)(ws + WS_P16); h16* EAG = (h16*)(ws + WS_EAG); h16* HM = (h16*)(ws + WS_HM);
    h16* W2GU = (h16*)(ws + WS_W2GU); h16* W2D = (h16*)(ws + WS_W2D);
    h16* WL = (h16*)(ob + OB_WL); h16* PF = (h16*)(ws + WS_PF);
    float* Y = a.out + O_Y;
    const int lo = a.ph_lo, hi = a.ph_hi;
#define IN(k) (lo <= (k) && (k) < hi)
    cg::grid_group grid = cg::this_grid();
    volatile LAS unsigned* xst = (volatile LAS unsigned*)(lds + LDS_BYTES - 16);
    if (tid < 2) xst[tid] = 0u;
    __syncthreads();
    const XcdBarrier xbar = xcd_barrier_post((unsigned*)(ws + WS_CTL), xst);
#ifndef PROBE_MASK
#define PROBE_MASK 0u
#endif
    unsigned long long pr_t[PH_N + 1]; (void)pr_t;
    if (PROBE_MASK) pr_t[0] = __builtin_amdgcn_s_memrealtime();
#define SEAM(k) do { if (IN(k) && IN((k) + 1)) { if ((k) == PH_CVT1) grid.sync(); else xcd_barrier(xbar); } if (PROBE_MASK) pr_t[(k) + 1] = __builtin_amdgcn_s_memrealtime(); } while (0)

    if (IN(PH_CVT1)) {
        LAS float* scr = (LAS float*)(lds + wave * 16384);
        constexpr int I1 = (D / 64) * (2 * FF / 32), I2 = (FF / 64) * (D / 32), I3 = (D / 64) * (PP / 32), I4 = (D / 64) * (D / 32);
        for (int it = gw; it < I1 + I2 + I3 + I4; it += NGW) {
            int r = it;
            if (r < I1) { cvt_item(1, a.in[6], a.in[7], FF, D, W1GU, scr, r, 2 * FF / 32, lane); continue; } r -= I1;
            if (r < I2) { cvt_item(0, a.in[8], nullptr, D, FF, W1D, scr, r, D / 32, lane); continue; } r -= I2;
            if (r < I3) { cvt_item(2, a.in[10], nullptr, NIN, D, WIN, scr, r, PP / 32, lane); continue; } r -= I3;
            cvt_item(0, a.in[23], nullptr, D, D, WOUT, scr, r, D / 32, lane);
        }
        for (int it = gw; it < 6144; it += NGW) cvt_lora_item(a.in[13], a.in[15], a.in[16], WL, it, lane);
        for (int r = gw; r < 256; r += NGW) { h16* orow = A16 + (size_t)(MT + r) * D;
#pragma unroll
            for (int j = 0; j < 8; ++j) { u32x2 w = (u32x2){0u, 0u};
                if (r < 32) { const f32x4 v = *((const f32x4*)(a.in[2] + (size_t)r * D) + lane + 64 * j); w.x = pk2h(v.x, v.y); w.y = pk2h(v.z, v.w); }
                *((u32x2*)orow + lane + 64 * j) = w; } }
        for (int m = gw; m < MT; m += NGW) { const float* xr = m < MP ? a.in[0] + (size_t)m * D : a.in[1] + (size_t)(m - MP) * D; rms_row_f16(xr, a.in[5], A16 + (size_t)m * D, nullptr, lane); }
    }
    SEAM(PH_CVT1);
    if (IN(PH_FFN1_GU)) { pg8::Gemm g{A16, W1GU, MT, 2 * FF, D}; pg8::Order S; S.init(MT, 2 * FF, G, bx, 0); pg8::EpiSwiGLU E{HM, FF}; pg8::gemm_phase(lds, g, S, E); }
    SEAM(PH_FFN1_GU);
    if (IN(PH_FFN1_D)) { pg8::Gemm g{HM, W1D, MT, D, FF}; pg8::Order S; S.init(MT, D, G, bx, 0); pg8::EpiRes E{a.in[0], a.in[1], Y, 0.5f, 0}; pg8::gemm_phase(lds, g, S, E); }
    SEAM(PH_FFN1_D);
    if (IN(PH_RMS_MIX)) {
        for (int m = gw; m < MT; m += NGW) { float* so = nullptr;
            if (m < MP) { if ((m & 4095) == 4095) so = a.out + O_SHP + (size_t)(m >> 12) * D; } else { if (((m - MP) & 63) == 63) so = a.out + O_SHS + (size_t)((m - MP) >> 6) * D; }
            rms_row_f16(Y + (size_t)m * D, a.in[9], A16 + (size_t)m * D, so, lane); }
    }
    SEAM(PH_RMS_MIX);
    if (IN(PH_WIN)) { pg8::Gemm g{A16, WIN, MT, PP, D}; pg8::Order S; S.init(MT, PP, G, bx, PFW / 256); pg8::EpiP16 E{P16, PF}; pg8::gemm_phase(lds, g, S, E); }
    SEAM(PH_WIN);
    if (IN(PH_SHIFT)) {
        h16* AIN = A16; const float* mu = a.in[11];
        for (int item = bx * NTHR + tid; item < MT * 64; item += G * NTHR) {
            const int row = item >> 6, o = item & 63;
            if (o >= 56) { *(u32x4*)(AIN + (size_t)row * LK + 448 + (o - 56) * 8) = (u32x4){0u, 0u, 0u, 0u}; continue; }
            const int c0 = 6144 + o * 8;
            const bool st = row < MP ? ((row & 4095) == 0) : (((row - MP) & 63) == 0);
            const h16* pp = st ? (row < MP ? PF + (size_t)32 * PFW : PF + (size_t)((row - MP) >> 6) * PFW) + c0 : P16 + (size_t)(row - 1) * PP + c0;
            const h16x8 cv = *(const h16x8*)(P16 + (size_t)row * PP + c0), pv = *(const h16x8*)pp;
            const f32x4 m0 = *(const f32x4*)(mu + c0), m1 = *(const f32x4*)(mu + c0 + 4);
            const float mu8[8] = {m0.x, m0.y, m0.z, m0.w, m1.x, m1.y, m1.z, m1.w}; float s[8];
#pragma unroll
            for (int j = 0; j < 8; ++j) { const float cu = (float)cv[j]; s[j] = cu + mu8[j] * ((float)pv[j] - cu); }
            if (o < 12) {
#pragma unroll
                for (int j = 0; j < 8; ++j) s[j] = tanhf(s[j]);
            } else if (o >= 24) {
#pragma unroll
                for (int j = 0; j < 8; ++j) s[j] = sigmoidf_(s[j]);
            }
            *(u32x4*)(AIN + (size_t)row * LK + o * 8) = (u32x4){pk2h(s[0], s[1]), pk2h(s[2], s[3]), pk2h(s[4], s[5]), pk2h(s[6], s[7])};
        }
    }
    SEAM(PH_SHIFT);
    if (IN(PH_LORA)) { pg8::Gemm g{A16, WL, MT, 6144, LK}; pg8::Order S; S.init(MT, 6144, G, bx, 0); pg8::EpiEAG E{EAG, a.in[12], a.in[14]}; pg8::gemm_phase(lds, g, S, E); }
    SEAM(PH_LORA);
    if (IN(PH_SCAN)) {
        const int vcu = (G % 8 == 0) ? (bx % 8) * (G / 8) + bx / 8 : bx;
        LAS float* ring = (LAS float*)lds;
        LAS float* ybuf = (LAS float*)(lds + 2 * SC_BUF * 4);
        LAS unsigned char* raw = lds + 2 * SC_BUF * 4 + 32768;
        LAS float* ctab = (LAS float*)(raw + 4 * 88 * 128);
        h16* OUT16 = A16; float* RK = (float*)(ws + WS_RK);
        constexpr int NCH = 320, RAWB = 88 * 128;
        for (int i = tid; i < 5 * 384; i += NTHR) { const int hi = i / 384, ci = (i % 384) >> 6, j = i & 63;
            const int h_ = (hi == 0 ? (vcu >> 2) : vcu * 4 + (hi - 1)) & 31; const int hj_ = h_ * 64 + j;
            ctab[i] = ci == 0 ? a.in[17][hj_] : ci == 1 ? a.in[18][hj_] : ci == 2 ? a.in[19][hj_] : a.in[11][(ci - 3) * D + hj_]; }
        __syncthreads();
        f32x2 S01 = (f32x2){0.f, 0.f}, S23 = S01;
        float c_kk = 0.f, c_ka = 0.f, c_rk = 0.f, c_mr = 0.f, c_mk = 0.f, c_mv = 0.f;
#define SC_DESC(cc, prompt, sq, h, q, t0, first, last) \
        bool prompt = (cc) < 256, first, last; int sq, h, q, t0; \
        if (prompt) { const int pair = vcu >> 2; sq = pair >> 5; h = pair & 31; q = vcu & 3; t0 = 16 * (cc); first = (cc) == 0; last = (cc) == 255; } \
        else { const int j = (cc) - 256, si = j >> 2, pair = vcu * 4 + (si >> 2); sq = pair >> 5; h = pair & 31; q = si & 3; t0 = 16 * (j & 3); first = (j & 3) == 0; last = (j & 3) == 3; }
#define SC_DMA(cc) do { if ((cc) < NCH) { SC_DESC(cc, prompt_, sq_, h_, q_, t0_, first_, last_); (void)last_; (void)q_; (void)first_; \
            const size_t rowb_ = (size_t)(prompt_ ? sq_ * 4096 : MP + sq_ * 64) + t0_; const int part_ = lane & 7; \
            _Pragma("unroll") for (int i = 0; i < 11; ++i) { int slot_ = i * 8 + (lane >> 3); slot_ = slot_ > 82 ? 82 : slot_; \
                const int arr_ = slot_ < 17 ? 0 : slot_ < 34 ? 1 : slot_ < 51 ? 2 : slot_ < 67 ? 3 : 4; const int ri_ = slot_ - (arr_ == 0 ? 0 : arr_ == 1 ? 17 : arr_ == 2 ? 34 : arr_ == 3 ? 51 : 67); \
                const h16* src_; \
                if (arr_ < 3) { src_ = (t0_ == 0 && ri_ == 0) ? PF + (size_t)(prompt_ ? 32 : sq_) * PFW : P16 + (rowb_ + ri_ - 1) * PP; src_ += arr_ * D + h_ * 64 + part_ * 8; } \
                else src_ = EAG + (rowb_ + ri_) * 6144 + (arr_ - 3) * D + h_ * 64 + part_ * 8; \
                __builtin_amdgcn_global_load_lds((const unsigned*)src_, (LAS unsigned*)(raw + ((cc) & 3) * RAWB + i * 1024), 16, 0, 0); } } } while (0)
#define RAWH(slot) ((float)*(const LAS h16*)(rw + (slot) * 128))
#define SC_PUBLISH(cc) do { if ((cc) < NCH) { SC_DESC(cc, prompt, sq, h, q, t0, first, last); (void)last; \
            const int hj = h * 64 + lane; \
            if (first) { const LAS float* ct = ctab + (prompt ? 0 : 1 + (((cc) - 256) >> 4)) * 384 + lane; (void)hj; \
                c_kk = ct[0]; c_ka = ct[64]; c_rk = ct[128]; c_mr = ct[192]; c_mk = ct[256]; c_mv = ct[320]; } \
            LAS float* buf = ring + ((cc) & 1) * SC_BUF + lane; const LAS unsigned char* rw = raw + ((cc) & 3) * RAWB + lane * 2; \
            _Pragma("unroll") for (int si = 0; si < 6; ++si) { const int s = (wave - 4) + 3 * si; if (s < 16) { \
                float r = RAWH(s + 1), k = RAWH(17 + s + 1), v = RAWH(34 + s + 1); \
                r += c_mr * (RAWH(s) - r); k += c_mk * (RAWH(17 + s) - k); v += c_mv * (RAWH(34 + s) - v); \
                const float e = RAWH(51 + s), av = RAWH(67 + s); \
                const float w = __expf(-e); \
                const float kkr = k * c_kk; const float ss = wave_sum_dpp(kkr * kkr); \
                const float kk = kkr * rsqrtf(fmaxf(ss, 1e-24f)); \
                const float kmod = k * (1.f + (av - 1.f) * c_ka); \
                LAS float* sl = buf + s * SC_SLOT; \
                sl[0] = kk; sl[64] = w; sl[128] = -kk * av; sl[192] = kmod; sl[256] = r; sl[320] = v; \
                if (q == 0) { const float rk = wave_sum_dpp(r * kmod * c_rk); if (lane == 0) RK[((size_t)(prompt ? sq * 4096 : MP + sq * 64) + t0 + s) * 32 + h] = rk; } } } } } while (0)
#define SC_YOUT(cc, sb) do { if ((cc) >= 0 && (cc) < NCH) { SC_DESC(cc, prompt, sq, h, q, t0, first, last); (void)first; (void)last; \
            const int s = (sb) + (lane >> 4), rr = lane & 15; \
            const LAS f32x4* yp = (const LAS f32x4*)(ybuf + ((cc) & 1) * 4096 + s * 256 + rr * 16); \
            const f32x4 y0 = yp[0], y1 = yp[1], y2 = yp[2], y3 = yp[3]; \
            const float o = ((y0.x + y0.y) + (y0.z + y0.w)) + ((y1.x + y1.y) + (y1.z + y1.w)) + ((y2.x + y2.y) + (y2.z + y2.w)) + ((y3.x + y3.y) + (y3.z + y3.w)); \
            OUT16[((size_t)(prompt ? sq * 4096 : MP + sq * 64) + t0 + s) * D + h * 64 + 16 * q + rr] = (h16)o; } } while (0)
#define SC_OPS(s) const f32x4 kk##s = *(const LAS f32x4*)(buf + (s) * SC_SLOT), w##s = *(const LAS f32x4*)(buf + (s) * SC_SLOT + 64), ka##s = *(const LAS f32x4*)(buf + (s) * SC_SLOT + 128), \
            km##s = *(const LAS f32x4*)(buf + (s) * SC_SLOT + 192), r##s = *(const LAS f32x4*)(buf + (s) * SC_SLOT + 256); const float v##s = vb[(s) * SC_SLOT]; asm volatile("" ::: "memory");
#define SC_STEP(s) do { f32x2 t = S01 * (f32x2){kk##s.x, kk##s.y}; t = __builtin_elementwise_fma(S23, (f32x2){kk##s.z, kk##s.w}, t); \
            float p = row_allreduce16(t.x + t.y); const f32x2 vv = (f32x2){v##s, v##s}, pp = (f32x2){p, p}; \
            S01 = __builtin_elementwise_fma(pp, (f32x2){ka##s.x, ka##s.y}, __builtin_elementwise_fma(S01, (f32x2){w##s.x, w##s.y}, vv * (f32x2){km##s.x, km##s.y})); \
            S23 = __builtin_elementwise_fma(pp, (f32x2){ka##s.z, ka##s.w}, __builtin_elementwise_fma(S23, (f32x2){w##s.z, w##s.w}, vv * (f32x2){km##s.z, km##s.w})); \
            f32x2 y = S01 * (f32x2){r##s.x, r##s.y}; y = __builtin_elementwise_fma(S23, (f32x2){r##s.z, r##s.w}, y); yb[(s) * 256] = y.x + y.y; } while (0)
#define SC_CONSUME(cc) do { if ((cc) >= 0 && (cc) < NCH) { SC_DESC(cc, prompt, sq, h, q, t0, first, last); (void)t0; \
            const int vl = lane >> 4, kq = lane & 15, row = 16 * q + 4 * wave + vl; \
            if (first) { S01 = (f32x2){0.f, 0.f}; S23 = S01; if (!prompt) { const f32x4 s4 = *(const f32x4*)(a.in[4] + ((size_t)(sq * 32 + h) * 64 + row) * 64 + 4 * kq); S01 = (f32x2){s4.x, s4.y}; S23 = (f32x2){s4.z, s4.w}; } } \
            const LAS float* buf = ring + ((cc) & 1) * SC_BUF + 4 * kq; \
            const LAS float* vb = ring + ((cc) & 1) * SC_BUF + 320 + row; \
            LAS float* yb = ybuf + ((cc) & 1) * 4096 + (4 * wave + vl) * 16 + kq; \
            SC_OPS(0) SC_OPS(1) SC_OPS(2) SC_STEP(0); SC_OPS(3) SC_STEP(1); SC_OPS(4) SC_STEP(2); SC_OPS(5) SC_STEP(3); SC_OPS(6) SC_STEP(4); SC_OPS(7) SC_STEP(5); SC_OPS(8) SC_STEP(6); SC_OPS(9) SC_STEP(7); \
            SC_OPS(10) SC_STEP(8); SC_OPS(11) SC_STEP(9); SC_OPS(12) SC_STEP(10); SC_OPS(13) SC_STEP(11); SC_OPS(14) SC_STEP(12); SC_OPS(15) SC_STEP(13); SC_STEP(14); SC_STEP(15); \
            if (last) *(f32x4*)(a.out + (prompt ? O_WKP : O_WKS) + ((size_t)(sq * 32 + h) * 64 + row) * 64 + 4 * kq) = (f32x4){S01.x, S01.y, S23.x, S23.y}; } } while (0)
#define SC_BARRIER() do { asm volatile("s_waitcnt lgkmcnt(0)" ::: "memory"); __builtin_amdgcn_s_barrier(); asm volatile("" ::: "memory"); } while (0)
#ifndef PROBE_SCAN
#define PROBE_SCAN 0
#endif
        unsigned long long pacc = 0; (void)pacc;
#define PT0() unsigned long long pt0_ = 0; if (PROBE_SCAN) pt0_ = __builtin_amdgcn_s_memrealtime()
#define PT1() do { if (PROBE_SCAN) pacc += __builtin_amdgcn_s_memrealtime() - pt0_; } while (0)
        if (wave < 4) {
            SC_BARRIER();
            for (int it = 0; it <= NCH + 1; ++it) { PT0(); SC_CONSUME(it - 1); asm volatile("s_waitcnt lgkmcnt(0)" ::: "memory"); if (PROBE_SCAN == 1) PT1(); SC_BARRIER(); }
            if (PROBE_SCAN == 1 && bx == 0 && tid == 0) *(unsigned long long*)(ws + 64) = pacc;
        } else if (wave == 7) {
            SC_DMA(0); SC_DMA(1); SC_DMA(2);
            asm volatile("s_waitcnt vmcnt(22)" ::: "memory");
            SC_BARRIER();
            for (int it = 0; it <= NCH + 1; ++it) {
                SC_DMA(it + 3);
                PT0();
                if (it + 3 < NCH) asm volatile("s_waitcnt vmcnt(22)" ::: "memory");
                else asm volatile("s_waitcnt vmcnt(0)" ::: "memory");
                if (PROBE_SCAN == 3) PT1();
                SC_BARRIER();
            }
            if (PROBE_SCAN == 3 && bx == 0 && lane == 0) *(unsigned long long*)(ws + 64) = pacc;
        } else {
            SC_BARRIER();
            for (int it = 0; it <= NCH + 1; ++it) { PT0(); SC_PUBLISH(it); if (wave != 4) { SC_YOUT(it - 2, 8 * (wave - 5)); SC_YOUT(it - 2, 8 * (wave - 5) + 4); } asm volatile("s_waitcnt lgkmcnt(0)" ::: "memory"); if (PROBE_SCAN == 2) PT1(); SC_BARRIER(); }
            if (PROBE_SCAN == 2 && bx == 0 && wave == 4 && lane == 0) *(unsigned long long*)(ws + 64) = pacc;
        }
#undef PT0
#undef PT1
#undef SC_DESC
#undef SC_DMA
#undef RAWH
#undef SC_PUBLISH
#undef SC_YOUT
#undef SC_OPS
#undef SC_STEP
#undef SC_CONSUME
#undef SC_BARRIER
    }
    SEAM(PH_SCAN);
    if (IN(PH_MERGE)) {
        const float* cw = a.in[22]; const float* RK = (const float*)(ws + WS_RK);
        for (int r2 = bx; r2 < MT / 2; r2 += G) {
            const int row = 2 * r2 + (tid >> 8), o8 = tid & 255, c0 = o8 * 8, hd = o8 >> 3;
            const bool pr = row < MP; const int tt = pr ? (row & 4095) : ((row - MP) & 63), sq = pr ? (row >> 12) : ((row - MP) >> 6), T = pr ? 4096 : 64;
            const h16* prow = P16 + (size_t)row * PP;
            const h16x8 ov = *(const h16x8*)(A16 + (size_t)row * D + c0);
            const h16x8 vc = *(const h16x8*)(prow + 2 * D + c0);
            const h16x8 vp = *(const h16x8*)((tt == 0 ? PF + (size_t)(pr ? 32 : sq) * PFW : prow - PP) + 2 * D + c0);
            const h16x8 gv = *(const h16x8*)(EAG + (size_t)row * 6144 + 2 * D + c0);
            const h16x8 gb = *(const h16x8*)(prow + C_GB + c0), gc = *(const h16x8*)(prow + C_GC + c0), xc = *(const h16x8*)(prow + C_XC + c0), ga = *(const h16x8*)(prow + C_GA + c0), gg = *(const h16x8*)(prow + C_GG + c0);
            float u1[8], u2[8];
            if (tt >= 1) { const h16x8 g1 = *(const h16x8*)(prow - PP + C_GC + c0), x1 = *(const h16x8*)(prow - PP + C_XC + c0);
#pragma unroll
                for (int j = 0; j < 8; ++j) u1[j] = (float)g1[j] * (float)x1[j];
            } else {
#pragma unroll
                for (int j = 0; j < 8; ++j) u1[j] = pr ? 0.f : a.in[3][(size_t)sq * 2 * D + D + c0 + j]; }
            if (tt >= 2) { const h16x8 g2 = *(const h16x8*)(prow - 2 * PP + C_GC + c0), x2 = *(const h16x8*)(prow - 2 * PP + C_XC + c0);
#pragma unroll
                for (int j = 0; j < 8; ++j) u2[j] = (float)g2[j] * (float)x2[j];
            } else {
#pragma unroll
                for (int j = 0; j < 8; ++j) u2[j] = pr ? 0.f : a.in[3][(size_t)sq * 2 * D + (size_t)tt * D + c0 + j]; }
            const float rk = RK[(size_t)row * 32 + hd];
            float of[8], s1 = 0.f;
#pragma unroll
            for (int j = 0; j < 8; ++j) { of[j] = (float)ov[j]; s1 += of[j]; }
            const float mean = row_allreduce8(s1) * (1.f / 64.f); float s2 = 0.f;
#pragma unroll
            for (int j = 0; j < 8; ++j) { of[j] -= mean; s2 += of[j] * of[j]; }
            const float rstd = rsqrtf(row_allreduce8(s2) * (1.f / 64.f) + 64e-5f);
            float mg[8], u0[8];
#pragma unroll
            for (int j = 0; j < 8; ++j) {
                const float vs = (float)vc[j] + a.in[11][2 * D + c0 + j] * ((float)vp[j] - (float)vc[j]);
                const float ya = (of[j] * rstd * a.in[20][c0 + j] + a.in[21][c0 + j] + rk * vs) * (float)gv[j];
                u0[j] = (float)gc[j] * (float)xc[j];
                const float cv = cw[c0 + j] * u2[j] + cw[D + c0 + j] * u1[j] + cw[2 * D + c0 + j] * u0[j];
                mg[j] = sigmoidf_((float)ga[j]) * ya + sigmoidf_((float)gg[j]) * ((float)gb[j] * cv); }
            *(u32x4*)(A16 + (size_t)row * D + c0) = (u32x4){pk2h(mg[0], mg[1]), pk2h(mg[2], mg[3]), pk2h(mg[4], mg[5]), pk2h(mg[6], mg[7])};
            if (tt >= T - 2) { float* q = a.out + (pr ? O_CVP : O_CVS) + (size_t)sq * 2 * D + (size_t)(tt - (T - 2)) * D + c0;
                *(f32x4*)q = (f32x4){u0[0], u0[1], u0[2], u0[3]}; *(f32x4*)(q + 4) = (f32x4){u0[4], u0[5], u0[6], u0[7]}; }
        }
    }
    SEAM(PH_MERGE);
    if (IN(PH_WOUT)) {
        { pg8::Gemm g{A16, WOUT, MT, D, D}; pg8::Order S; S.init(MT, D, G, bx, 0); pg8::EpiRes E{Y, Y + (size_t)MP * D, Y, 1.0f, 0}; pg8::gemm_phase(lds, g, S, E); }
        LAS float* scr = (LAS float*)(lds + wave * 16384);
        constexpr int I1 = (D / 64) * (2 * FF / 32), I2 = (FF / 64) * (D / 32);
        for (int it = gw; it < I1 + I2; it += NGW) {
            if (it < I1) cvt_item(1, a.in[25], a.in[26], FF, D, W2GU, scr, it, 2 * FF / 32, lane);
            else cvt_item(0, a.in[27], nullptr, D, FF, W2D, scr, it - I1, D / 32, lane);
        }
    }
    SEAM(PH_WOUT);
    if (IN(PH_RMS2)) { for (int m = gw; m < MT; m += NGW) rms_row_f16(Y + (size_t)m * D, a.in[24], A16 + (size_t)m * D, nullptr, lane); }
    SEAM(PH_RMS2);
    if (IN(PH_FFN2_GU)) { pg8::Gemm g{A16, W2GU, MT, 2 * FF, D}; pg8::Order S; S.init(MT, 2 * FF, G, bx, 0); pg8::EpiSwiGLU E{HM, FF}; pg8::gemm_phase(lds, g, S, E); }
    SEAM(PH_FFN2_GU);
    if (IN(PH_FFN2_D)) { pg8::Gemm g{HM, W2D, MT, D, FF}; pg8::Order S; S.init(MT, D, G, bx, 0); pg8::EpiRes E{Y, Y + (size_t)MP * D, Y, 0.5f, 0}; pg8::gemm_phase(lds, g, S, E); }
    SEAM(PH_FFN2_D);
    if (IN(PH_FINAL)) { for (int m = gw; m < MT; m += NGW) rms_row_f16(Y + (size_t)m * D, a.in[28], nullptr, Y + (size_t)m * D, lane); }
    if (PROBE_MASK || PROBE_SCAN) {
        pr_t[PH_N] = __builtin_amdgcn_s_memrealtime();
        if (bx == 0 && tid == 0) { unsigned long long tot = 0;
#pragma unroll
            for (int k = 0; k < PH_N; ++k) if ((PROBE_MASK >> k) & 1u) tot += pr_t[k + 1] - pr_t[k];
            if (PROBE_SCAN) tot += __hip_atomic_load((unsigned long long*)(ws + 64), __ATOMIC_RELAXED, __HIP_MEMORY_SCOPE_AGENT);
            const unsigned long long t0 = __builtin_amdgcn_s_memrealtime();
            while (__builtin_amdgcn_s_memrealtime() - t0 < tot) __builtin_amdgcn_s_sleep(8);
        }
    }
#undef IN
#undef SEAM
}

extern "C" void kernel_launch(void* const* d_in, const int* in_sizes, int n_in, void* d_out, int out_size, void* d_ws, size_t ws_size, hipStream_t stream) {
    static int grid = 0;
    if (grid == 0) {
        if (n_in != 29 || (size_t)out_size != O_END || ws_size < WS_END) { fprintf(stderr, "kernel_launch: unexpected shapes (n_in %d out %d ws %zu need %zu)\n", n_in, out_size, ws_size, (size_t)WS_END); grid = -1; return; }
        int dev = 0, cus = 0, per_cu = 0;
        if (hipGetDevice(&dev) != hipSuccess || hipDeviceGetAttribute(&cus, hipDeviceAttributeMultiprocessorCount, dev) != hipSuccess) { grid = -1; return; }
        if (hipFuncSetAttribute((const void*)fwd_kernel, hipFuncAttributeMaxDynamicSharedMemorySize, LDS_BYTES) != hipSuccess) { grid = -1; return; }
        if (hipOccupancyMaxActiveBlocksPerMultiprocessor(&per_cu, (const void*)fwd_kernel, NTHR, LDS_BYTES) != hipSuccess || per_cu < 1) { fprintf(stderr, "kernel_launch: occupancy query failed (%d)\n", per_cu); grid = -1; return; }
        grid = cus;
    }
    if (grid < 0) return;
    if (hipMemsetAsync((char*)d_ws + WS_CTL, 0, XCD_BAR_WORDS * 4, stream) != hipSuccess) return;
    Args a{};
    for (int i = 0; i < 29; ++i) a.in[i] = (const float*)d_in[i];
    a.out = (float*)d_out; a.ws = (unsigned char*)d_ws; a.ph_lo = 0; a.ph_hi = PH_N;
    void* kargs[] = {&a};
    hipError_t e = hipLaunchCooperativeKernel((const void*)fwd_kernel, dim3(grid), dim3(NTHR), kargs, LDS_BYTES, stream);
    if (e != hipSuccess) fprintf(stderr, "kernel_launch: cooperative launch failed: %s (grid %d)\n", hipGetErrorString(e), grid);
}
```

```cpp
#include <hip/hip_runtime.h>
#include <hip/hip_cooperative_groups.h>
#include <cstdio>
namespace cg = cooperative_groups;

#define LAS __attribute__((address_space(3)))
typedef _Float16 h16;
typedef _Float16 h16x2 __attribute__((ext_vector_type(2)));
typedef _Float16 h16x4 __attribute__((ext_vector_type(4)));
typedef _Float16 h16x8 __attribute__((ext_vector_type(8)));
typedef float f32x4 __attribute__((ext_vector_type(4)));
typedef float f32x2 __attribute__((ext_vector_type(2)));
typedef unsigned u32x4 __attribute__((ext_vector_type(4)));
typedef unsigned u32x2 __attribute__((ext_vector_type(2)));

constexpr int D = 2048, FF = 5632, NA = 6592, NIN = 16832;
constexpr int MP = 8192, MS = 2048, MT = MP + MS;
constexpr int MA = MT + 256;
constexpr int PP = 16896;
constexpr int PFW = 6656;
constexpr int C_GB = 6656, C_GC = 8704, C_XC = 10752, C_GA = 12800, C_GG = 14848;
constexpr int LK = 512;
constexpr int NCHUNK = MT / 64;
constexpr size_t O_Y = 0, O_SHP = 20971520, O_CVP = 20975616, O_WKP = 20983808, O_SHS = 21245952, O_CVS = 21311488, O_WKS = 21442560, O_END = 25636864;
constexpr size_t WS_CTL = 0;
constexpr size_t WS_W1GU = 1u << 20;
constexpr size_t WS_W1D = WS_W1GU + (size_t)2 * FF * D * 2;
constexpr size_t WS_WIN = WS_W1D + (size_t)D * FF * 2;
constexpr size_t WS_WOUT = WS_WIN + (size_t)PP * D * 2;
constexpr size_t WS_A16 = WS_WOUT + (size_t)D * D * 2;
constexpr size_t WS_P16 = WS_A16 + (size_t)MA * D * 2;
constexpr size_t WS_PF = WS_P16 + (size_t)MT * PP * 2;
constexpr size_t WS_END = WS_PF + (size_t)256 * PFW * 2;
constexpr size_t WS_EAG = WS_W1GU;
constexpr size_t WS_HM = WS_P16;
constexpr size_t WS_W2GU = WS_P16 + (size_t)MT * FF * 2;
constexpr size_t WS_W2D = WS_W2GU + (size_t)2 * FF * D * 2;
constexpr size_t WS_SLAB = WS_W2D + (size_t)D * FF * 2;
static_assert((size_t)MT * 6144 * 2 <= WS_WOUT - WS_W1GU, "EAG overlay");
static_assert(WS_SLAB + (size_t)4 * MS * D * 4 <= WS_PF, "W2 + slab overlay");
constexpr size_t OB_WL = O_WKS * 4;
static_assert(OB_WL + (size_t)6144 * LK * 2 <= O_END * 4, "d_out scratch");

constexpr size_t WS_RK = WS_EAG + (size_t)MT * 6144 * 2;
static_assert(WS_RK + (size_t)MT * 32 * 4 <= WS_WOUT, "RK");
constexpr int SC_SLOT = 6 * 64, SC_BUF = 16 * SC_SLOT;
constexpr int NWAVES = 8, NTHR = 512;
constexpr int LDS_BYTES = 147456;

__device__ __forceinline__ unsigned pk2h(float a, float b) { h16x2 v = {(h16)a, (h16)b}; return __builtin_bit_cast(unsigned, v); }
__device__ __forceinline__ float wave_sum(float v) {
#pragma unroll
    for (int o = 1; o < 64; o <<= 1) v += __shfl_xor(v, o);
    return v;
}
template <int CTRL> __device__ __forceinline__ float dpp_f(float x) { return __builtin_bit_cast(float, __builtin_amdgcn_update_dpp(0, __builtin_bit_cast(int, x), CTRL, 0xF, 0xF, false)); }
__device__ __forceinline__ float row_allreduce8(float x) { x += dpp_f<0xB1>(x); x += dpp_f<0x4E>(x); x += dpp_f<0x141>(x); return x; }
__device__ __forceinline__ float row_allreduce16(float x) { x = row_allreduce8(x); x += dpp_f<0x140>(x); return x; }
__device__ __forceinline__ float rl_f(float x, int l) { return __builtin_bit_cast(float, __builtin_amdgcn_readlane(__builtin_bit_cast(int, x), l)); }
__device__ __forceinline__ float wave_sum_dpp(float x) { x = row_allreduce16(x); return (rl_f(x, 0) + rl_f(x, 16)) + (rl_f(x, 32) + rl_f(x, 48)); }
__device__ __forceinline__ float sigmoidf_(float x) { return 1.0f / (1.0f + __expf(-x)); }

namespace pg8 {
constexpr int BM = 256, BK = 64, HALF = 128, HTB = HALF * BK * 2, STAGE_BYTES = 8 * HTB, NXCD = 8, WGM = 8;
__host__ __device__ __forceinline__ int lds_byte(int r, int c) { const int st = (r >> 4) * 2 + (c >> 5), rr = r & 15, cc = c & 31, ob = rr * 64 + cc * 2; return st * 1024 + (ob ^ (((ob >> 9) & 1) << 5)); }
__host__ __device__ __forceinline__ void stage_rc(int b, int& R, int& C) { const int st = b / 1024, sb = b % 1024, swz = sb ^ (((sb >> 9) & 1) << 5); R = (st >> 1) * 16 + swz / 64; C = (st & 1) * 32 + (swz % 64) / 2; }
__host__ __device__ __forceinline__ int perm32(int rho) { const int n = rho >> 4, i = rho & 15; return 8 * (i >> 2) + 4 * n + (i & 3); }
struct Unit { int pm, pn, kt0, nkt, sp; };
struct Gemm { const h16* A; const h16* Bt; int M, N, K; };
struct Order {
    int nM, nN, nwg, G, c, extra, nkt, nsplit;
    __device__ void init(int M, int N, int K, int G_, int c_, int extra_, int nMw) { nM = M / BM; nN = N / BM; nwg = (nMw < 0 ? nM : nMw) * nN; G = G_; c = c_; extra = extra_; nkt = K / BK; nsplit = nMw < 0 ? 0 : (nM - nMw) * nN * 4; }
    __device__ bool next(int i, Unit& u) const {
        const long L = (long)i * G + c; if (L >= nwg + extra + nsplit) return false;
        u.kt0 = 0; u.nkt = nkt; u.sp = -1;
        if (L >= nwg + extra) { const int j = (int)(L - nwg - extra), tile = j >> 2; u.sp = j & 3; u.nkt = nkt >> 2; u.kt0 = u.sp * u.nkt; const int rows = nM - nwg / nN; u.pm = nwg / nN + tile % rows; u.pn = tile / rows; return true; }
        if (L >= nwg) { u.pm = nM; u.pn = (int)(L - nwg); return true; }
        const int nMe = nwg / nN;
        int wgid = (int)L; { const int q = nwg / NXCD, r = nwg % NXCD, xcd = wgid % NXCD, off = wgid / NXCD; wgid = (xcd < r ? xcd * (q + 1) : r * (q + 1) + (xcd - r) * q) + off; }
        const int nig = WGM * nN, gid = wgid / nig, fm = gid * WGM, gsz = (nMe - fm) < WGM ? (nMe - fm) : WGM;
        u.pm = fm + ((wgid % nig) % gsz); u.pn = (wgid % nig) / gsz; return true;
    }
};

template <class Epi, bool SP2 = true, bool ALIGN_EPI = true>
__device__ __forceinline__ void gemm_phase(LAS unsigned char* lds, const Gemm g, const Order& S, const Epi& E) {
    const int tid = threadIdx.x, wid = __builtin_amdgcn_readfirstlane(tid >> 6), lane = tid & 63, wr = wid >> 2, wc = wid & 3, fr = lane & 15, fq = lane >> 4;
    const int K = g.K;
    unsigned voffA[2], voffB[2];
#pragma unroll
    for (int i = 0; i < 2; ++i) { int R, C; stage_rc(tid * 16 + i * 8192, R, C); const int Rb = Epi::PERM ? ((R & ~31) + perm32(R & 31)) : R;
        voffA[i] = (unsigned)(R * K + C) * 2u; voffB[i] = (unsigned)(Rb * K + C) * 2u; }
    const size_t kstep = (size_t)(BK * 2);
    const size_t hstep = (size_t)HALF * K * 2;
    const size_t tstep = 2 * hstep;
    const unsigned ldsw = (unsigned)wid * 1024u;
    const int aoff = lds_byte(wr * 64 + fr, fq * 8), boff = lds_byte(wc * 32 + fr, fq * 8);
#define PG8_SA(b, h) (((b) * 2 + (h)) * HTB)
#define PG8_SB(b, h) ((4 + (b) * 2 + (h)) * HTB)
#define PG8_STAGE(bufoff, gbase, voff) do { _Pragma("unroll") for (int _i = 0; _i < 2; ++_i) \
        __builtin_amdgcn_global_load_lds((const unsigned*)((const char*)(gbase) + (voff)[_i]), (LAS unsigned*)(lds + (bufoff) + ldsw + _i * 8192), 16, 0, 0); } while (0)
#define PG8_LDA(dst, b, h) do { _Pragma("unroll") for (int m = 0; m < 4; ++m) _Pragma("unroll") for (int k = 0; k < 2; ++k) dst[m][k] = *(const LAS h16x8*)(lds + PG8_SA(b, h) + aoff + m * 2048 + k * 1024); } while (0)
#define PG8_LDB(dst, b, h) do { _Pragma("unroll") for (int n = 0; n < 2; ++n) _Pragma("unroll") for (int k = 0; k < 2; ++k) dst[n][k] = *(const LAS h16x8*)(lds + PG8_SB(b, h) + boff + n * 2048 + k * 1024); } while (0)
#define PG8_MMA(ai, bj, At, Bt) do { __builtin_amdgcn_s_setprio(1); _Pragma("unroll") for (int m = 0; m < 4; ++m) _Pragma("unroll") for (int n = 0; n < 2; ++n) _Pragma("unroll") for (int k = 0; k < 2; ++k) \
        acc[ai][bj][m][n] = __builtin_amdgcn_mfma_f32_16x16x32_f16(Bt[n][k], At[m][k], acc[ai][bj][m][n], 0, 0, 0); __builtin_amdgcn_s_setprio(0); } while (0)
#define PG8_WAIT_V(n) asm volatile("s_waitcnt vmcnt(" #n ")" ::: "memory")
#define PG8_WAIT_L(n) asm volatile("s_waitcnt lgkmcnt(" #n ")" ::: "memory")
#define PG8_BAR __builtin_amdgcn_s_barrier()
#define PG8_SCHED __builtin_amdgcn_sched_barrier(0)
    Unit cur, nxt; int ui = 0;
    if (!S.next(0, cur)) return;
    f32x4 acc[2][2][4][2];
#pragma unroll
    for (int a = 0; a < 2; ++a)
#pragma unroll
        for (int b = 0; b < 2; ++b)
#pragma unroll
            for (int m = 0; m < 4; ++m)
#pragma unroll
                for (int n = 0; n < 2; ++n) acc[a][b][m][n] = (f32x4){0.f, 0.f, 0.f, 0.f};
    h16x8 At[4][2], B0[2][2], B1[2][2];
    const char* cA = (const char*)g.A + (size_t)cur.pm * tstep + (size_t)cur.kt0 * kstep; const char* cB = (const char*)g.Bt + (size_t)cur.pn * tstep + (size_t)cur.kt0 * kstep;
    if constexpr (SP2) {
        PG8_STAGE(PG8_SB(0, 0), cB, voffB); PG8_STAGE(PG8_SB(0, 1), cB + hstep, voffB); PG8_STAGE(PG8_SA(0, 0), cA, voffA); PG8_STAGE(PG8_SA(0, 1), cA + hstep, voffA);
        if (wr == 1) PG8_BAR;
        PG8_WAIT_V(2); PG8_BAR;
        PG8_STAGE(PG8_SB(1, 0), cB + kstep, voffB); PG8_STAGE(PG8_SA(1, 0), cA + kstep, voffA); PG8_STAGE(PG8_SB(1, 1), cB + hstep + kstep, voffB);
        PG8_WAIT_V(6); PG8_BAR;
    } else {
        PG8_STAGE(PG8_SB(0, 0), cB, voffB); PG8_STAGE(PG8_SA(0, 0), cA, voffA); PG8_STAGE(PG8_SB(0, 1), cB + hstep, voffB); PG8_STAGE(PG8_SA(0, 1), cA + hstep, voffA);
        if (wr == 1) PG8_BAR;
        PG8_WAIT_V(4); PG8_BAR;
        PG8_STAGE(PG8_SB(1, 0), cB + kstep, voffB); PG8_STAGE(PG8_SA(1, 0), cA + kstep, voffA); PG8_STAGE(PG8_SB(1, 1), cB + hstep + kstep, voffB);
        PG8_WAIT_V(6); PG8_BAR;
    }
    for (;;) {
        const bool has_next = S.next(ui + 1, nxt);
        const char* nA = has_next ? (const char*)g.A + (size_t)nxt.pm * tstep + (size_t)nxt.kt0 * kstep : cA; const char* nB = has_next ? (const char*)g.Bt + (size_t)nxt.pn * tstep + (size_t)nxt.kt0 * kstep : cB;
        const int nt = cur.nkt;
        for (int t = 0; t < nt; t += 2) {
            const bool last = (t == nt - 2);
            const char* a1 = cA + (size_t)(t + 1) * kstep;
            const char* a2 = last ? nA : cA + (size_t)(t + 2) * kstep; const char* b2 = last ? nB : cB + (size_t)(t + 2) * kstep;
            const char* a3 = a2 + kstep; const char* b3 = b2 + kstep;
            if constexpr (SP2) {
            PG8_LDB(B0, 0, 0); PG8_LDB(B1, 0, 1); PG8_SCHED; PG8_LDA(At, 0, 0); PG8_STAGE(PG8_SA(1, 1), a1 + hstep, voffA);
            PG8_WAIT_V(8); PG8_WAIT_L(0); PG8_BAR; PG8_MMA(0, 0, At, B0); PG8_MMA(0, 1, At, B1); PG8_BAR; PG8_SCHED;
            PG8_LDA(At, 0, 1); PG8_STAGE(PG8_SB(0, 0), b2, voffB); PG8_STAGE(PG8_SB(0, 1), b2 + hstep, voffB); PG8_STAGE(PG8_SA(0, 0), a2, voffA);
            PG8_WAIT_V(8); PG8_WAIT_L(0); PG8_BAR; PG8_MMA(1, 0, At, B0); PG8_MMA(1, 1, At, B1); PG8_BAR; PG8_SCHED;
            PG8_LDB(B0, 1, 0); PG8_LDB(B1, 1, 1); PG8_SCHED; PG8_LDA(At, 1, 0); PG8_STAGE(PG8_SA(0, 1), a2 + hstep, voffA);
            PG8_WAIT_V(8); PG8_WAIT_L(0); PG8_BAR; PG8_MMA(0, 0, At, B0); PG8_MMA(0, 1, At, B1); PG8_BAR; PG8_SCHED;
            PG8_LDA(At, 1, 1); PG8_STAGE(PG8_SB(1, 0), b3, voffB); PG8_STAGE(PG8_SB(1, 1), b3 + hstep, voffB); PG8_STAGE(PG8_SA(1, 0), a3, voffA);
            PG8_WAIT_V(8); PG8_WAIT_L(0); PG8_BAR; PG8_MMA(1, 0, At, B0); PG8_MMA(1, 1, At, B1); PG8_BAR; PG8_SCHED;
            } else {
            PG8_LDB(B0, 0, 0); PG8_SCHED; PG8_LDA(At, 0, 0); PG8_STAGE(PG8_SA(1, 1), a1 + hstep, voffA);
            PG8_WAIT_L(8); PG8_BAR; PG8_WAIT_L(0); PG8_MMA(0, 0, At, B0); PG8_BAR; PG8_SCHED;
            PG8_LDB(B1, 0, 1); PG8_STAGE(PG8_SB(0, 0), b2, voffB);
            PG8_BAR; PG8_WAIT_L(0); PG8_MMA(0, 1, At, B1); PG8_BAR;
            PG8_LDA(At, 0, 1); PG8_STAGE(PG8_SA(0, 0), a2, voffA);
            PG8_BAR; PG8_WAIT_L(0); PG8_MMA(1, 0, At, B0); PG8_BAR; PG8_SCHED;
            PG8_STAGE(PG8_SB(0, 1), b2 + hstep, voffB);
            PG8_WAIT_V(6); PG8_BAR; PG8_MMA(1, 1, At, B1); PG8_BAR;
            PG8_LDB(B0, 1, 0); PG8_SCHED; PG8_LDA(At, 1, 0); PG8_STAGE(PG8_SA(0, 1), a2 + hstep, voffA);
            PG8_WAIT_L(8); PG8_BAR; PG8_WAIT_L(0); PG8_MMA(0, 0, At, B0); PG8_BAR; PG8_SCHED;
            PG8_LDB(B1, 1, 1); PG8_STAGE(PG8_SB(1, 0), b3, voffB);
            PG8_BAR; PG8_WAIT_L(0); PG8_MMA(0, 1, At, B1); PG8_BAR;
            PG8_LDA(At, 1, 1); PG8_STAGE(PG8_SA(1, 0), a3, voffA);
            PG8_BAR; PG8_WAIT_L(0); PG8_MMA(1, 0, At, B0); PG8_BAR; PG8_SCHED;
            PG8_STAGE(PG8_SB(1, 1), b3 + hstep, voffB);
            PG8_WAIT_V(6); PG8_BAR; PG8_MMA(1, 1, At, B1); PG8_BAR;
                    }
        }
        if constexpr (ALIGN_EPI) { if (wr == 0) PG8_BAR; }
        E(acc, cur, wr, wc, fr, fq);
        if (!has_next) break;
#pragma unroll
        for (int a = 0; a < 2; ++a)
#pragma unroll
            for (int b = 0; b < 2; ++b)
#pragma unroll
                for (int m = 0; m < 4; ++m)
#pragma unroll
                    for (int n = 0; n < 2; ++n) acc[a][b][m][n] = (f32x4){0.f, 0.f, 0.f, 0.f};
        cur = nxt; cA = nA; cB = nB; ++ui;
        if constexpr (ALIGN_EPI) { if (wr == 1) PG8_BAR; }
    }
    PG8_WAIT_V(0);
    if constexpr (!ALIGN_EPI) { if (wr == 0) PG8_BAR; }
    PG8_BAR;
#undef PG8_SA
#undef PG8_SB
#undef PG8_STAGE
#undef PG8_LDA
#undef PG8_LDB
#undef PG8_MMA
#undef PG8_WAIT_V
#undef PG8_WAIT_L
#undef PG8_BAR
#undef PG8_SCHED
}

struct EpiSwiGLU {
    static constexpr bool PERM = false;
    h16* O; int ldo;
    __device__ __forceinline__ void operator()(const f32x4 (&acc)[2][2][4][2], const Unit& u, int wr, int wc, int fr, int fq) const {
        const int row0 = u.pm * BM + wr * 64 + fr;
#pragma unroll
        for (int ai = 0; ai < 2; ++ai)
#pragma unroll
            for (int m = 0; m < 4; ++m) { h16* rowp = O + (size_t)(row0 + ai * HALF + m * 16) * ldo;
#pragma unroll
                for (int bj = 0; bj < 2; ++bj) { const int oc = (u.pn * BM + bj * HALF + wc * 32) / 2 + 4 * fq;
                    const f32x4 gt = acc[ai][bj][m][0], up = acc[ai][bj][m][1]; float o[4];
#pragma unroll
                    for (int j = 0; j < 4; ++j) o[j] = gt[j] * sigmoidf_(gt[j]) * up[j];
                    u32x2 w; w.x = pk2h(o[0], o[1]); w.y = pk2h(o[2], o[3]);
                    *(u32x2*)(rowp + oc) = w; } }
    }
};
struct EpiRes {
    static constexpr bool PERM = false;
    const float* r0; const float* r1; float* out; float* slab; float scale; int pad;
    __device__ __forceinline__ void operator()(const f32x4 (&acc)[2][2][4][2], const Unit& u, int wr, int wc, int fr, int fq) const {
        const int row0 = u.pm * BM + wr * 64 + fr, col0 = u.pn * BM + wc * 32 + 4 * fq;
        if (u.sp >= 0) {
            float* sb = slab + ((size_t)u.sp * MS - MP) * D;
#pragma unroll
            for (int ai = 0; ai < 2; ++ai)
#pragma unroll
                for (int m = 0; m < 4; ++m) { const size_t off = (size_t)(row0 + ai * HALF + m * 16) * D + col0;
#pragma unroll
                    for (int bj = 0; bj < 2; ++bj)
#pragma unroll
                        for (int n = 0; n < 2; ++n) *(f32x4*)(sb + off + bj * HALF + n * 16) = acc[ai][bj][m][n]; }
            return;
        }
        const float* rb = (u.pm * BM < MP) ? r0 : r1 - (size_t)MP * D;
#pragma unroll
        for (int ai = 0; ai < 2; ++ai)
#pragma unroll
            for (int m = 0; m < 4; ++m) { const size_t off = (size_t)(row0 + ai * HALF + m * 16) * D + col0;
#pragma unroll
                for (int bj = 0; bj < 2; ++bj)
#pragma unroll
                    for (int n = 0; n < 2; ++n) { const f32x4 rv = *(const f32x4*)(rb + off + bj * HALF + n * 16);
                        *(f32x4*)(out + off + bj * HALF + n * 16) = rv + scale * acc[ai][bj][m][n]; } }
    }
};
struct EpiP16 {
    static constexpr bool PERM = true;
    h16* P; h16* PF;
    __device__ __forceinline__ void operator()(const f32x4 (&acc)[2][2][4][2], const Unit& u, int wr, int wc, int fr, int fq) const {
        const int row0 = u.pm * BM + wr * 64 + fr;
#pragma unroll
        for (int ai = 0; ai < 2; ++ai)
#pragma unroll
            for (int m = 0; m < 4; ++m) { const int row = row0 + ai * HALF + m * 16;
#pragma unroll
                for (int bj = 0; bj < 2; ++bj) { const int col = u.pn * BM + bj * HALF + wc * 32 + 8 * fq;
                    const f32x4 v0 = acc[ai][bj][m][0], v1 = acc[ai][bj][m][1];
                    u32x4 w; w.x = pk2h(v0[0], v0[1]); w.y = pk2h(v0[2], v0[3]); w.z = pk2h(v1[0], v1[1]); w.w = pk2h(v1[2], v1[3]);
                    if (u.pm < MT / BM) *(u32x4*)(P + (size_t)row * PP + col) = w;
                    else *(u32x4*)(PF + (size_t)(row - MT) * PFW + col) = w; } }
    }
};
struct EpiEAG {
    static constexpr bool PERM = true;
    h16* O; const float* w0; const float* a0;
    __device__ __forceinline__ void operator()(const f32x4 (&acc)[2][2][4][2], const Unit& u, int wr, int wc, int fr, int fq) const {
        const int row0 = u.pm * BM + wr * 64 + fr; const int typ = u.pn >> 3;
#pragma unroll
        for (int bj = 0; bj < 2; ++bj) { const int col = u.pn * BM + bj * HALF + wc * 32 + 8 * fq;
            f32x4 b0 = (f32x4){0.f, 0.f, 0.f, 0.f}, b1 = b0;
            if (typ == 0) { b0 = *(const f32x4*)(w0 + col); b1 = *(const f32x4*)(w0 + col + 4); }
            if (typ == 1) { b0 = *(const f32x4*)(a0 + col - D); b1 = *(const f32x4*)(a0 + col - D + 4); }
#pragma unroll
            for (int ai = 0; ai < 2; ++ai)
#pragma unroll
                for (int m = 0; m < 4; ++m) { const int row = row0 + ai * HALF + m * 16;
                    f32x4 v0 = acc[ai][bj][m][0] + b0, v1 = acc[ai][bj][m][1] + b1;
                    if (typ < 2) { const float sc = typ == 0 ? 0.60653065971f : 1.0f;
#pragma unroll
                        for (int j = 0; j < 4; ++j) { v0[j] = sigmoidf_(v0[j]) * sc; v1[j] = sigmoidf_(v1[j]) * sc; } }
                    u32x4 w; w.x = pk2h(v0[0], v0[1]); w.y = pk2h(v0[2], v0[3]); w.z = pk2h(v1[0], v1[1]); w.w = pk2h(v1[2], v1[3]);
                    *(u32x4*)(O + (size_t)row * 6144 + col) = w; } }
    }
};
}


#define XB_TMO      128
#define XB_XCNT(j)  (256  + 64 * (j))
#define XB_XSUB(j)  (1280 + 64 * (j))
#define XB_XGEN(j)  (2304 + 64 * (j))
#define XB_TOP      3328
#define XB_TOPGEN   3392
#define XCD_BAR_WORDS 3456
#define XB_SPIN_CAP (1u << 22)
__device__ __forceinline__ unsigned xb_ld(unsigned* p)              { return __hip_atomic_load(p, __ATOMIC_RELAXED, __HIP_MEMORY_SCOPE_AGENT); }
__device__ __forceinline__ unsigned xb_add(unsigned* p, unsigned v) { return __hip_atomic_fetch_add(p, v, __ATOMIC_RELAXED, __HIP_MEMORY_SCOPE_AGENT); }
__device__ __forceinline__ unsigned xb_xcc_id() { return (unsigned)__builtin_amdgcn_s_getreg((3 << 11) | 20) & 0xFu; }
#define XB_SPIN(cond, bar) do { unsigned _sp = 0; while (cond) { __builtin_amdgcn_s_sleep(1); \
    if ((++_sp & 255u) == 0u) { if (xb_ld(&(bar)[XB_TMO])) break; if (_sp > XB_SPIN_CAP) { atomicAdd(&(bar)[XB_TMO], 1u); break; } } } } while (0)
struct XcdBarrier { unsigned* bar; unsigned x; volatile LAS unsigned* st; };
__device__ __forceinline__ XcdBarrier xcd_barrier_post(unsigned* bar, volatile LAS unsigned* st) {
    XcdBarrier b; b.bar = bar; b.x = xb_xcc_id(); b.st = st;
    if (threadIdx.x == 0) (void)xb_add(&bar[XB_XCNT(b.x)], 1u);
    return b;
}
__device__ __forceinline__ void xcd_barrier_complete(unsigned* bar, unsigned x, unsigned& nloc, unsigned& nx) {
    const unsigned G = gridDim.x * gridDim.y * gridDim.z;
    unsigned sum, cnt, mine, sp = 0u;
    for (;;) {
        sum = 0u; cnt = 0u; mine = 0u;
#pragma unroll
        for (unsigned j = 0; j < 16; ++j) { const unsigned c = xb_ld(&bar[XB_XCNT(j)]); sum += c; cnt += (c > 0u) ? 1u : 0u; mine = (j == x) ? c : mine; }
        if (sum == G) break;
        __builtin_amdgcn_s_sleep(1);
        if ((++sp & 255u) == 0u) { if (xb_ld(&bar[XB_TMO])) break; if (sp > XB_SPIN_CAP) { atomicAdd(&bar[XB_TMO], 1u); break; } }
    }
    nloc = mine > 0u ? mine : 1u; nx = cnt > 0u ? cnt : 1u;
}
__device__ __forceinline__ void xcd_barrier(const XcdBarrier& b) {
    asm volatile("s_waitcnt vmcnt(0)" ::: "memory");
    __syncthreads();
    if (threadIdx.x == 0) {
        unsigned* bar = b.bar;
        __builtin_amdgcn_s_waitcnt(0);
        unsigned nloc = b.st[0], nx = b.st[1];
        if (nloc == 0u) { xcd_barrier_complete(bar, b.x, nloc, nx); b.st[0] = nloc; b.st[1] = nx; }
        const unsigned old = xb_add(&bar[XB_XSUB(b.x)], 1u);
        const unsigned gen = old / nloc;
        if (old + 1u == (gen + 1u) * nloc) {
            __builtin_amdgcn_fence(__ATOMIC_RELEASE, "agent");
            asm volatile("s_waitcnt vmcnt(0)" ::: "memory");
            const unsigned og = xb_add(&bar[XB_TOP], 1u);
            const unsigned tg = og / nx;
            if (og + 1u == (tg + 1u) * nx) xb_add(&bar[XB_TOPGEN], 1u);
            else XB_SPIN(xb_ld(&bar[XB_TOPGEN]) == tg, bar);
            __builtin_amdgcn_fence(__ATOMIC_ACQUIRE, "agent");
            xb_add(&bar[XB_XGEN(b.x)], 1u);
            asm volatile("s_waitcnt vmcnt(0)" ::: "memory");
        } else {
            XB_SPIN(xb_ld(&bar[XB_XGEN(b.x)]) == gen, bar);
            __builtin_amdgcn_fence(__ATOMIC_ACQUIRE, "agent");
            asm volatile("s_waitcnt vmcnt(0)" ::: "memory");
        }
    }
    __syncthreads();
}

struct Args { const float* in[29]; float* out; unsigned char* ws; int ph_lo, ph_hi; };

__device__ __forceinline__ void cvt_item(int mode, const float* s0, const float* s1, int Nsrc, int K, h16* WT, LAS float* scr, int item, int nblk, int lane) {
    const int kb = item / nblk, nb = item % nblk, k0 = 64 * kb, n0 = 32 * nb;
    const int nn = lane & 31; const float* src = s0; int col = n0 + nn; bool zero = false;
    if (mode == 1) { src = (nn < 16) ? s0 : s1; col = (n0 >> 1) + (nn & 15); }
    if (mode == 2) { if (n0 >= NA && n0 < PFW) zero = true; else if (n0 >= PFW) col -= 64; }
#pragma unroll 8
    for (int i = 0; i < 32; ++i) { const int kk = 2 * i + (lane >> 5); scr[kk * 33 + nn] = zero ? 0.f : src[(size_t)(k0 + kk) * Nsrc + col]; }
    asm volatile("s_waitcnt lgkmcnt(0)" ::: "memory");
    const int c = lane & 7;
#pragma unroll
    for (int j = 0; j < 4; ++j) { const int n = (lane >> 3) + 8 * j; const LAS float* s = scr + (8 * c) * 33 + n;
        u32x4 o; o.x = pk2h(s[0 * 33], s[1 * 33]); o.y = pk2h(s[2 * 33], s[3 * 33]); o.z = pk2h(s[4 * 33], s[5 * 33]); o.w = pk2h(s[6 * 33], s[7 * 33]);
        *(u32x4*)(WT + (size_t)(n0 + n) * K + k0 + 8 * c) = o; }
    asm volatile("s_waitcnt lgkmcnt(0)" ::: "memory");
}
__device__ __forceinline__ void cvt_lora_item(const float* wl, const float* al, const float* gl, h16* WT, int item, int lane) {
    const int n = item, typ = n >> 11, col = n & 2047; unsigned w[4];
#pragma unroll
    for (int j = 0; j < 4; ++j) { float v[2];
#pragma unroll
        for (int e = 0; e < 2; ++e) { const int k = lane * 8 + j * 2 + e; float x = 0.f;
            if (typ == 0 && k < 96) x = wl[(size_t)k * D + col];
            if (typ == 1 && k >= 96 && k < 192) x = al[(size_t)(k - 96) * D + col];
            if (typ == 2 && k >= 192 && k < 448) x = gl[(size_t)(k - 192) * D + col];
            v[e] = x; }
        w[j] = pk2h(v[0], v[1]); }
    *(u32x4*)(WT + (size_t)n * LK + lane * 8) = (u32x4){w[0], w[1], w[2], w[3]};
}

__device__ __forceinline__ void rms_row_f16(const float* xrow, const float* g, h16* orow, float* f32row, int lane, const float* part = nullptr, float pscale = 0.f, float* xout = nullptr) {
    const f32x4* xr = (const f32x4*)xrow + lane; const f32x4* gr = (const f32x4*)g + lane;
    f32x4 v[8]; float s = 0.f;
#pragma unroll
    for (int j = 0; j < 8; ++j) { v[j] = xr[64 * j];
        if (part) { const f32x4* pp = (const f32x4*)part + lane + 64 * j; const size_t st = (size_t)MS * D / 4;
            v[j] += pscale * ((pp[0] + pp[st]) + (pp[2 * st] + pp[3 * st])); if (xout) *((f32x4*)xout + lane + 64 * j) = v[j]; }
        s += (v[j].x * v[j].x + v[j].y * v[j].y) + (v[j].z * v[j].z + v[j].w * v[j].w); }
    const float rs = rsqrtf(wave_sum(s) * (1.f / D) + 1e-6f);
#pragma unroll
    for (int j = 0; j < 8; ++j) { const f32x4 gg = gr[64 * j]; const f32x4 o = v[j] * rs * gg;
        if (orow) { u32x2 w; w.x = pk2h(o.x, o.y); w.y = pk2h(o.z, o.w); *((u32x2*)orow + lane + 64 * j) = w; }
        if (f32row) *((f32x4*)f32row + lane + 64 * j) = o; }
}

enum { PH_CVT1 = 0, PH_FFN1_GU, PH_FFN1_D, PH_RMS_MIX, PH_WIN, PH_SHIFT, PH_LORA, PH_SCAN, PH_MERGE, PH_WOUT, PH_RMS2, PH_FFN2_GU, PH_FFN2_D, PH_FINAL, PH_N };

__global__ void __launch_bounds__(NTHR, 2) fwd_kernel(Args a) {
    extern __shared__ __attribute__((aligned(16))) unsigned char lds_raw[];
    LAS unsigned char* lds = (LAS unsigned char*)lds_raw;
    const int tid = threadIdx.x, lane = tid & 63, wave = __builtin_amdgcn_readfirstlane(tid >> 6);
    const int G = gridDim.x, bx = blockIdx.x;
    const int gw = bx * NWAVES + wave, NGW = G * NWAVES;
    unsigned char* ws = a.ws; unsigned char* ob = (unsigned char*)a.out;
    h16* W1GU = (h16*)(ws + WS_W1GU); h16* W1D = (h16*)(ws + WS_W1D); h16* WIN = (h16*)(ws + WS_WIN); h16* WOUT = (h16*)(ws + WS_WOUT);
    h16* A16 = (h16*)(ws + WS_A16); h16* P16 = (h16*)(ws + WS_P16); h16* EAG = (h16*)(ws + WS_EAG); h16* HM = (h16*)(ws + WS_HM);
    h16* W2GU = (h16*)(ws + WS_W2GU); h16* W2D = (h16*)(ws + WS_W2D);
    h16* WL = (h16*)(ob + OB_WL); h16* PF = (h16*)(ws + WS_PF);
    float* Y = a.out + O_Y; float* SLAB = (float*)(ws + WS_SLAB);
    const int lo = a.ph_lo, hi = a.ph_hi;
#define IN(k) (lo <= (k) && (k) < hi)
    cg::grid_group grid = cg::this_grid();
    volatile LAS unsigned* xst = (volatile LAS unsigned*)(lds + LDS_BYTES - 16);
    if (tid < 2) xst[tid] = 0u;
    __syncthreads();
    const XcdBarrier xbar = xcd_barrier_post((unsigned*)(ws + WS_CTL), xst);
#ifndef PROBE_MASK
#define PROBE_MASK 0u
#endif
    unsigned long long pr_t[PH_N + 1]; (void)pr_t;
    if (PROBE_MASK) pr_t[0] = __builtin_amdgcn_s_memrealtime();
#define SEAM(k) do { if (IN(k) && IN((k) + 1)) { if ((k) == PH_CVT1) grid.sync(); else xcd_barrier(xbar); } if (PROBE_MASK) pr_t[(k) + 1] = __builtin_amdgcn_s_memrealtime(); } while (0)

    if (IN(PH_CVT1)) {
        LAS float* scr = (LAS float*)(lds + wave * 16384);
        constexpr int I1 = (D / 64) * (2 * FF / 32), I2 = (FF / 64) * (D / 32), I3 = (D / 64) * (PP / 32), I4 = (D / 64) * (D / 32);
        for (int it = gw; it < I1 + I2 + I3 + I4; it += NGW) {
            int r = it;
            if (r < I1) { cvt_item(1, a.in[6], a.in[7], FF, D, W1GU, scr, r, 2 * FF / 32, lane); continue; } r -= I1;
            if (r < I2) { cvt_item(0, a.in[8], nullptr, D, FF, W1D, scr, r, D / 32, lane); continue; } r -= I2;
            if (r < I3) { cvt_item(2, a.in[10], nullptr, NIN, D, WIN, scr, r, PP / 32, lane); continue; } r -= I3;
            cvt_item(0, a.in[23], nullptr, D, D, WOUT, scr, r, D / 32, lane);
        }
        for (int it = gw; it < 6144; it += NGW) cvt_lora_item(a.in[13], a.in[15], a.in[16], WL, it, lane);
        for (int r = gw; r < 256; r += NGW) { h16* orow = A16 + (size_t)(MT + r) * D;
#pragma unroll
            for (int j = 0; j < 8; ++j) { u32x2 w = (u32x2){0u, 0u};
                if (r < 32) { const f32x4 v = *((const f32x4*)(a.in[2] + (size_t)r * D) + lane + 64 * j); w.x = pk2h(v.x, v.y); w.y = pk2h(v.z, v.w); }
                *((u32x2*)orow + lane + 64 * j) = w; } }
        for (int m = gw; m < MT; m += NGW) { const float* xr = m < MP ? a.in[0] + (size_t)m * D : a.in[1] + (size_t)(m - MP) * D; rms_row_f16(xr, a.in[5], A16 + (size_t)m * D, nullptr, lane); }
    }
    SEAM(PH_CVT1);
    if (IN(PH_FFN1_GU)) { pg8::Gemm g{A16, W1GU, MT, 2 * FF, D}; pg8::Order S; S.init(MT, 2 * FF, D, G, bx, 0, -1); pg8::EpiSwiGLU E{HM, FF}; pg8::gemm_phase(lds, g, S, E); }
    SEAM(PH_FFN1_GU);
    if (IN(PH_FFN1_D)) { pg8::Gemm g{HM, W1D, MT, D, FF}; pg8::Order S; S.init(MT, D, FF, G, bx, 0, MP / 256); pg8::EpiRes E{a.in[0], a.in[1], Y, SLAB, 0.5f, 0}; pg8::gemm_phase(lds, g, S, E); }
    SEAM(PH_FFN1_D);
    if (IN(PH_RMS_MIX)) {
        for (int m = gw; m < MT; m += NGW) { float* so = nullptr;
            if (m < MP) { if ((m & 4095) == 4095) so = a.out + O_SHP + (size_t)(m >> 12) * D; } else { if (((m - MP) & 63) == 63) so = a.out + O_SHS + (size_t)((m - MP) >> 6) * D; }
            if (m < MP) rms_row_f16(Y + (size_t)m * D, a.in[9], A16 + (size_t)m * D, so, lane);
            else rms_row_f16(a.in[1] + (size_t)(m - MP) * D, a.in[9], A16 + (size_t)m * D, so, lane, SLAB + (size_t)(m - MP) * D, 0.5f, Y + (size_t)m * D); }
    }
    SEAM(PH_RMS_MIX);
    if (IN(PH_WIN)) { pg8::Gemm g{A16, WIN, MT, PP, D}; pg8::Order S; S.init(MT, PP, D, G, bx, PFW / 256, -1); pg8::EpiP16 E{P16, PF}; pg8::gemm_phase(lds, g, S, E); }
    SEAM(PH_WIN);
    if (IN(PH_SHIFT)) {
        h16* AIN = A16; const float* mu = a.in[11];
        for (int item = bx * NTHR + tid; item < MT * 64; item += G * NTHR) {
            const int row = item >> 6, o = item & 63;
            if (o >= 56) { *(u32x4*)(AIN + (size_t)row * LK + 448 + (o - 56) * 8) = (u32x4){0u, 0u, 0u, 0u}; continue; }
            const int c0 = 6144 + o * 8;
            const bool st = row < MP ? ((row & 4095) == 0) : (((row - MP) & 63) == 0);
            const h16* pp = st ? (row < MP ? PF + (size_t)32 * PFW : PF + (size_t)((row - MP) >> 6) * PFW) + c0 : P16 + (size_t)(row - 1) * PP + c0;
            const h16x8 cv = *(const h16x8*)(P16 + (size_t)row * PP + c0), pv = *(const h16x8*)pp;
            const f32x4 m0 = *(const f32x4*)(mu + c0), m1 = *(const f32x4*)(mu + c0 + 4);
            const float mu8[8] = {m0.x, m0.y, m0.z, m0.w, m1.x, m1.y, m1.z, m1.w}; float s[8];
#pragma unroll
            for (int j = 0; j < 8; ++j) { const float cu = (float)cv[j]; s[j] = cu + mu8[j] * ((float)pv[j] - cu); }
            if (o < 12) {
#pragma unroll
                for (int j = 0; j < 8; ++j) s[j] = tanhf(s[j]);
            } else if (o >= 24) {
#pragma unroll
                for (int j = 0; j < 8; ++j) s[j] = sigmoidf_(s[j]);
            }
            *(u32x4*)(AIN + (size_t)row * LK + o * 8) = (u32x4){pk2h(s[0], s[1]), pk2h(s[2], s[3]), pk2h(s[4], s[5]), pk2h(s[6], s[7])};
        }
    }
    SEAM(PH_SHIFT);
    if (IN(PH_LORA)) { pg8::Gemm g{A16, WL, MT, 6144, LK}; pg8::Order S; S.init(MT, 6144, LK, G, bx, 0, -1); pg8::EpiEAG E{EAG, a.in[12], a.in[14]}; pg8::gemm_phase(lds, g, S, E); }
    SEAM(PH_LORA);
    if (IN(PH_SCAN)) {
        const int vcu = (G % 8 == 0) ? (bx % 8) * (G / 8) + bx / 8 : bx;
        LAS float* ring = (LAS float*)lds;
        LAS float* ybuf = (LAS float*)(lds + 2 * SC_BUF * 4);
        LAS unsigned char* raw = lds + 2 * SC_BUF * 4 + 32768;
        LAS float* ctab = (LAS float*)(raw + 4 * 88 * 128);
        h16* OUT16 = A16; float* RK = (float*)(ws + WS_RK);
        constexpr int NCH = 320, RAWB = 88 * 128;
        for (int i = tid; i < 5 * 384; i += NTHR) { const int hi = i / 384, ci = (i % 384) >> 6, j = i & 63;
            const int h_ = (hi == 0 ? (vcu >> 2) : vcu * 4 + (hi - 1)) & 31; const int hj_ = h_ * 64 + j;
            ctab[i] = ci == 0 ? a.in[17][hj_] : ci == 1 ? a.in[18][hj_] : ci == 2 ? a.in[19][hj_] : a.in[11][(ci - 3) * D + hj_]; }
        __syncthreads();
        f32x2 S01 = (f32x2){0.f, 0.f}, S23 = S01;
        float c_kk = 0.f, c_ka = 0.f, c_rk = 0.f, c_mr = 0.f, c_mk = 0.f, c_mv = 0.f;
#define SC_DESC(cc, prompt, sq, h, q, t0, first, last) \
        bool prompt = (cc) < 256, first, last; int sq, h, q, t0; \
        if (prompt) { const int pair = vcu >> 2; sq = pair >> 5; h = pair & 31; q = vcu & 3; t0 = 16 * (cc); first = (cc) == 0; last = (cc) == 255; } \
        else { const int j = (cc) - 256, si = j >> 2, pair = vcu * 4 + (si >> 2); sq = pair >> 5; h = pair & 31; q = si & 3; t0 = 16 * (j & 3); first = (j & 3) == 0; last = (j & 3) == 3; }
#define SC_DMA(cc) do { if ((cc) < NCH) { SC_DESC(cc, prompt_, sq_, h_, q_, t0_, first_, last_); (void)last_; (void)q_; (void)first_; \
            const size_t rowb_ = (size_t)(prompt_ ? sq_ * 4096 : MP + sq_ * 64) + t0_; const int part_ = lane & 7; \
            _Pragma("unroll") for (int i = 0; i < 11; ++i) { int slot_ = i * 8 + (lane >> 3); slot_ = slot_ > 82 ? 82 : slot_; \
                const int arr_ = slot_ < 17 ? 0 : slot_ < 34 ? 1 : slot_ < 51 ? 2 : slot_ < 67 ? 3 : 4; const int ri_ = slot_ - (arr_ == 0 ? 0 : arr_ == 1 ? 17 : arr_ == 2 ? 34 : arr_ == 3 ? 51 : 67); \
                const h16* src_; \
                if (arr_ < 3) { src_ = (t0_ == 0 && ri_ == 0) ? PF + (size_t)(prompt_ ? 32 : sq_) * PFW : P16 + (rowb_ + ri_ - 1) * PP; src_ += arr_ * D + h_ * 64 + part_ * 8; } \
                else src_ = EAG + (rowb_ + ri_) * 6144 + (arr_ - 3) * D + h_ * 64 + part_ * 8; \
                __builtin_amdgcn_global_load_lds((const unsigned*)src_, (LAS unsigned*)(raw + ((cc) & 3) * RAWB + i * 1024), 16, 0, 0); } } } while (0)
#define RAWH(slot) ((float)*(const LAS h16*)(rw + (slot) * 128))
#define SC_PUBLISH(cc) do { if ((cc) < NCH) { SC_DESC(cc, prompt, sq, h, q, t0, first, last); (void)last; \
            const int hj = h * 64 + lane; \
            if (first) { const LAS float* ct = ctab + (prompt ? 0 : 1 + (((cc) - 256) >> 4)) * 384 + lane; (void)hj; \
                c_kk = ct[0]; c_ka = ct[64]; c_rk = ct[128]; c_mr = ct[192]; c_mk = ct[256]; c_mv = ct[320]; } \
            LAS float* buf = ring + ((cc) & 1) * SC_BUF + lane; const LAS unsigned char* rw = raw + ((cc) & 3) * RAWB + lane * 2; \
            _Pragma("unroll") for (int si = 0; si < 6; ++si) { const int s = (wave - 4) + 3 * si; if (s < 16) { \
                float r = RAWH(s + 1), k = RAWH(17 + s + 1), v = RAWH(34 + s + 1); \
                r += c_mr * (RAWH(s) - r); k += c_mk * (RAWH(17 + s) - k); v += c_mv * (RAWH(34 + s) - v); \
                const float e = RAWH(51 + s), av = RAWH(67 + s); \
                const float w = __expf(-e); \
                const float kkr = k * c_kk; const float ss = wave_sum_dpp(kkr * kkr); \
                const float kk = kkr * rsqrtf(fmaxf(ss, 1e-24f)); \
                const float kmod = k * (1.f + (av - 1.f) * c_ka); \
                LAS float* sl = buf + s * SC_SLOT; \
                sl[0] = kk; sl[64] = w; sl[128] = -kk * av; sl[192] = kmod; sl[256] = r; sl[320] = v; \
                if (q == 0) { const float rk = wave_sum_dpp(r * kmod * c_rk); if (lane == 0) RK[((size_t)(prompt ? sq * 4096 : MP + sq * 64) + t0 + s) * 32 + h] = rk; } } } } } while (0)
#define SC_YOUT(cc, sb) do { if ((cc) >= 0 && (cc) < NCH) { SC_DESC(cc, prompt, sq, h, q, t0, first, last); (void)first; (void)last; \
            const int s = (sb) + (lane >> 4), rr = lane & 15; \
            const LAS f32x4* yp = (const LAS f32x4*)(ybuf + ((cc) & 1) * 4096 + s * 256 + rr * 16); \
            const f32x4 y0 = yp[0], y1 = yp[1], y2 = yp[2], y3 = yp[3]; \
            const float o = ((y0.x + y0.y) + (y0.z + y0.w)) + ((y1.x + y1.y) + (y1.z + y1.w)) + ((y2.x + y2.y) + (y2.z + y2.w)) + ((y3.x + y3.y) + (y3.z + y3.w)); \
            OUT16[((size_t)(prompt ? sq * 4096 : MP + sq * 64) + t0 + s) * D + h * 64 + 16 * q + rr] = (h16)o; } } while (0)
#define SC_OPS(s) const f32x4 kk##s = *(const LAS f32x4*)(buf + (s) * SC_SLOT), w##s = *(const LAS f32x4*)(buf + (s) * SC_SLOT + 64), ka##s = *(const LAS f32x4*)(buf + (s) * SC_SLOT + 128), \
            km##s = *(const LAS f32x4*)(buf + (s) * SC_SLOT + 192), r##s = *(const LAS f32x4*)(buf + (s) * SC_SLOT + 256); const float v##s = vb[(s) * SC_SLOT]; asm volatile("" ::: "memory");
#define SC_STEP(s) do { f32x2 t = S01 * (f32x2){kk##s.x, kk##s.y}; t = __builtin_elementwise_fma(S23, (f32x2){kk##s.z, kk##s.w}, t); \
            float p = row_allreduce16(t.x + t.y); const f32x2 vv = (f32x2){v##s, v##s}, pp = (f32x2){p, p}; \
            S01 = __builtin_elementwise_fma(pp, (f32x2){ka##s.x, ka##s.y}, __builtin_elementwise_fma(S01, (f32x2){w##s.x, w##s.y}, vv * (f32x2){km##s.x, km##s.y})); \
            S23 = __builtin_elementwise_fma(pp, (f32x2){ka##s.z, ka##s.w}, __builtin_elementwise_fma(S23, (f32x2){w##s.z, w##s.w}, vv * (f32x2){km##s.z, km##s.w})); \
            f32x2 y = S01 * (f32x2){r##s.x, r##s.y}; y = __builtin_elementwise_fma(S23, (f32x2){r##s.z, r##s.w}, y); yb[(s) * 256] = y.x + y.y; } while (0)
#define SC_CONSUME(cc) do { if ((cc) >= 0 && (cc) < NCH) { SC_DESC(cc, prompt, sq, h, q, t0, first, last); (void)t0; \
            const int vl = lane >> 4, kq = lane & 15, row = 16 * q + 4 * wave + vl; \
            if (first) { S01 = (f32x2){0.f, 0.f}; S23 = S01; if (!prompt) { const f32x4 s4 = *(const f32x4*)(a.in[4] + ((size_t)(sq * 32 + h) * 64 + row) * 64 + 4 * kq); S01 = (f32x2){s4.x, s4.y}; S23 = (f32x2){s4.z, s4.w}; } } \
            const LAS float* buf = ring + ((cc) & 1) * SC_BUF + 4 * kq; \
            const LAS float* vb = ring + ((cc) & 1) * SC_BUF + 320 + row; \
            LAS float* yb = ybuf + ((cc) & 1) * 4096 + (4 * wave + vl) * 16 + kq; \
            SC_OPS(0) SC_OPS(1) SC_OPS(2) SC_STEP(0); SC_OPS(3) SC_STEP(1); SC_OPS(4) SC_STEP(2); SC_OPS(5) SC_STEP(3); SC_OPS(6) SC_STEP(4); SC_OPS(7) SC_STEP(5); SC_OPS(8) SC_STEP(6); SC_OPS(9) SC_STEP(7); \
            SC_OPS(10) SC_STEP(8); SC_OPS(11) SC_STEP(9); SC_OPS(12) SC_STEP(10); SC_OPS(13) SC_STEP(11); SC_OPS(14) SC_STEP(12); SC_OPS(15) SC_STEP(13); SC_STEP(14); SC_STEP(15); \
            if (last) *(f32x4*)(a.out + (prompt ? O_WKP : O_WKS) + ((size_t)(sq * 32 + h) * 64 + row) * 64 + 4 * kq) = (f32x4){S01.x, S01.y, S23.x, S23.y}; } } while (0)
#define SC_BARRIER() do { asm volatile("s_waitcnt lgkmcnt(0)" ::: "memory"); __builtin_amdgcn_s_barrier(); asm volatile("" ::: "memory"); } while (0)
#ifndef PROBE_SCAN
#define PROBE_SCAN 0
#endif
        unsigned long long pacc = 0; (void)pacc;
#define PT0() unsigned long long pt0_ = 0; if (PROBE_SCAN) pt0_ = __builtin_amdgcn_s_memrealtime()
#define PT1() do { if (PROBE_SCAN) pacc += __builtin_amdgcn_s_memrealtime() - pt0_; } while (0)
        if (wave < 4) {
            SC_BARRIER();
            for (int it = 0; it <= NCH + 1; ++it) { PT0(); SC_CONSUME(it - 1); asm volatile("s_waitcnt lgkmcnt(0)" ::: "memory"); if (PROBE_SCAN == 1) PT1(); SC_BARRIER(); }
            if (PROBE_SCAN == 1 && bx == 0 && tid == 0) *(unsigned long long*)(ws + 64) = pacc;
        } else if (wave == 7) {
            SC_DMA(0); SC_DMA(1); SC_DMA(2);
            asm volatile("s_waitcnt vmcnt(22)" ::: "memory");
            SC_BARRIER();
            for (int it = 0; it <= NCH + 1; ++it) {
                SC_DMA(it + 3);
                PT0();
                if (it + 3 < NCH) asm volatile("s_waitcnt vmcnt(22)" ::: "memory");
                else asm volatile("s_waitcnt vmcnt(0)" ::: "memory");
                if (PROBE_SCAN == 3) PT1();
                SC_BARRIER();
            }
            if (PROBE_SCAN == 3 && bx == 0 && lane == 0) *(unsigned long long*)(ws + 64) = pacc;
        } else {
            SC_BARRIER();
            for (int it = 0; it <= NCH + 1; ++it) { PT0(); SC_PUBLISH(it); if (wave != 4) { SC_YOUT(it - 2, 8 * (wave - 5)); SC_YOUT(it - 2, 8 * (wave - 5) + 4); } asm volatile("s_waitcnt lgkmcnt(0)" ::: "memory"); if (PROBE_SCAN == 2) PT1(); SC_BARRIER(); }
            if (PROBE_SCAN == 2 && bx == 0 && wave == 4 && lane == 0) *(unsigned long long*)(ws + 64) = pacc;
        }
#undef PT0
#undef PT1
#undef SC_DESC
#undef SC_DMA
#undef RAWH
#undef SC_PUBLISH
#undef SC_YOUT
#undef SC_OPS
#undef SC_STEP
#undef SC_CONSUME
#undef SC_BARRIER
    }
    SEAM(PH_SCAN);
    if (IN(PH_MERGE)) {
        const float* cw = a.in[22]; const float* RK = (const float*)(ws + WS_RK);
        for (int r2 = bx; r2 < MT / 2; r2 += G) {
            const int row = 2 * r2 + (tid >> 8), o8 = tid & 255, c0 = o8 * 8, hd = o8 >> 3;
            const bool pr = row < MP; const int tt = pr ? (row & 4095) : ((row - MP) & 63), sq = pr ? (row >> 12) : ((row - MP) >> 6), T = pr ? 4096 : 64;
            const h16* prow = P16 + (size_t)row * PP;
            const h16x8 ov = *(const h16x8*)(A16 + (size_t)row * D + c0);
            const h16x8 vc = *(const h16x8*)(prow + 2 * D + c0);
            const h16x8 vp = *(const h16x8*)((tt == 0 ? PF + (size_t)(pr ? 32 : sq) * PFW : prow - PP) + 2 * D + c0);
            const h16x8 gv = *(const h16x8*)(EAG + (size_t)row * 6144 + 2 * D + c0);
            const h16x8 gb = *(const h16x8*)(prow + C_GB + c0), gc = *(const h16x8*)(prow + C_GC + c0), xc = *(const h16x8*)(prow + C_XC + c0), ga = *(const h16x8*)(prow + C_GA + c0), gg = *(const h16x8*)(prow + C_GG + c0);
            float u1[8], u2[8];
            if (tt >= 1) { const h16x8 g1 = *(const h16x8*)(prow - PP + C_GC + c0), x1 = *(const h16x8*)(prow - PP + C_XC + c0);
#pragma unroll
                for (int j = 0; j < 8; ++j) u1[j] = (float)g1[j] * (float)x1[j];
            } else {
#pragma unroll
                for (int j = 0; j < 8; ++j) u1[j] = pr ? 0.f : a.in[3][(size_t)sq * 2 * D + D + c0 + j]; }
            if (tt >= 2) { const h16x8 g2 = *(const h16x8*)(prow - 2 * PP + C_GC + c0), x2 = *(const h16x8*)(prow - 2 * PP + C_XC + c0);
#pragma unroll
                for (int j = 0; j < 8; ++j) u2[j] = (float)g2[j] * (float)x2[j];
            } else {
#pragma unroll
                for (int j = 0; j < 8; ++j) u2[j] = pr ? 0.f : a.in[3][(size_t)sq * 2 * D + (size_t)tt * D + c0 + j]; }
            const float rk = RK[(size_t)row * 32 + hd];
            float of[8], s1 = 0.f;
#pragma unroll
            for (int j = 0; j < 8; ++j) { of[j] = (float)ov[j]; s1 += of[j]; }
            const float mean = row_allreduce8(s1) * (1.f / 64.f); float s2 = 0.f;
#pragma unroll
            for (int j = 0; j < 8; ++j) { of[j] -= mean; s2 += of[j] * of[j]; }
            const float rstd = rsqrtf(row_allreduce8(s2) * (1.f / 64.f) + 64e-5f);
            float mg[8], u0[8];
#pragma unroll
            for (int j = 0; j < 8; ++j) {
                const float vs = (float)vc[j] + a.in[11][2 * D + c0 + j] * ((float)vp[j] - (float)vc[j]);
                const float ya = (of[j] * rstd * a.in[20][c0 + j] + a.in[21][c0 + j] + rk * vs) * (float)gv[j];
                u0[j] = (float)gc[j] * (float)xc[j];
                const float cv = cw[c0 + j] * u2[j] + cw[D + c0 + j] * u1[j] + cw[2 * D + c0 + j] * u0[j];
                mg[j] = sigmoidf_((float)ga[j]) * ya + sigmoidf_((float)gg[j]) * ((float)gb[j] * cv); }
            *(u32x4*)(A16 + (size_t)row * D + c0) = (u32x4){pk2h(mg[0], mg[1]), pk2h(mg[2], mg[3]), pk2h(mg[4], mg[5]), pk2h(mg[6], mg[7])};
            if (tt >= T - 2) { float* q = a.out + (pr ? O_CVP : O_CVS) + (size_t)sq * 2 * D + (size_t)(tt - (T - 2)) * D + c0;
                *(f32x4*)q = (f32x4){u0[0], u0[1], u0[2], u0[3]}; *(f32x4*)(q + 4) = (f32x4){u0[4], u0[5], u0[6], u0[7]}; }
        }
    }
    SEAM(PH_MERGE);
    if (IN(PH_WOUT)) {
        { pg8::Gemm g{A16, WOUT, MT, D, D}; pg8::Order S; S.init(MT, D, D, G, bx, 0, MP / 256); pg8::EpiRes E{Y, Y + (size_t)MP * D, Y, SLAB, 1.0f, 0}; pg8::gemm_phase(lds, g, S, E); }
        LAS float* scr = (LAS float*)(lds + wave * 16384);
        constexpr int I1 = (D / 64) * (2 * FF / 32), I2 = (FF / 64) * (D / 32);
        for (int it = gw; it < I1 + I2; it += NGW) {
            if (it < I1) cvt_item(1, a.in[25], a.in[26], FF, D, W2GU, scr, it, 2 * FF / 32, lane);
            else cvt_item(0, a.in[27], nullptr, D, FF, W2D, scr, it - I1, D / 32, lane);
        }
    }
    SEAM(PH_WOUT);
    if (IN(PH_RMS2)) { for (int m = gw; m < MT; m += NGW) { if (m < MP) rms_row_f16(Y + (size_t)m * D, a.in[24], A16 + (size_t)m * D, nullptr, lane);
            else rms_row_f16(Y + (size_t)m * D, a.in[24], A16 + (size_t)m * D, nullptr, lane, SLAB + (size_t)(m - MP) * D, 1.0f, Y + (size_t)m * D); } }
    SEAM(PH_RMS2);
    if (IN(PH_FFN2_GU)) { pg8::Gemm g{A16, W2GU, MT, 2 * FF, D}; pg8::Order S; S.init(MT, 2 * FF, D, G, bx, 0, -1); pg8::EpiSwiGLU E{HM, FF}; pg8::gemm_phase(lds, g, S, E); }
    SEAM(PH_FFN2_GU);
    if (IN(PH_FFN2_D)) { pg8::Gemm g{HM, W2D, MT, D, FF}; pg8::Order S; S.init(MT, D, FF, G, bx, 0, MP / 256); pg8::EpiRes E{Y, Y + (size_t)MP * D, Y, SLAB, 0.5f, 0}; pg8::gemm_phase(lds, g, S, E); }
    SEAM(PH_FFN2_D);
    if (IN(PH_FINAL)) { for (int m = gw; m < MT; m += NGW) { if (m < MP) rms_row_f16(Y + (size_t)m * D, a.in[28], nullptr, Y + (size_t)m * D, lane);
            else rms_row_f16(Y + (size_t)m * D, a.in[28], nullptr, Y + (size_t)m * D, lane, SLAB + (size_t)(m - MP) * D, 0.5f, nullptr); } }
    if (PROBE_MASK || PROBE_SCAN) {
        pr_t[PH_N] = __builtin_amdgcn_s_memrealtime();
        if (bx == 0 && tid == 0) { unsigned long long tot = 0;
#pragma unroll
            for (int k = 0; k < PH_N; ++k) if ((PROBE_MASK >> k) & 1u) tot += pr_t[k + 1] - pr_t[k];
            if (PROBE_SCAN) tot += __hip_atomic_load((unsigned long long*)(ws + 64), __ATOMIC_RELAXED, __HIP_MEMORY_SCOPE_AGENT);
            const unsigned long long t0 = __builtin_amdgcn_s_memrealtime();
            while (__builtin_amdgcn_s_memrealtime() - t0 < tot) __builtin_amdgcn_s_sleep(8);
        }
    }
#undef IN
#undef SEAM
}

extern "C" void kernel_launch(void* const* d_in, const int* in_sizes, int n_in, void* d_out, int out_size, void* d_ws, size_t ws_size, hipStream_t stream) {
    static int grid = 0;
    if (grid == 0) {
        if (n_in != 29 || (size_t)out_size != O_END || ws_size < WS_END) { fprintf(stderr, "kernel_launch: unexpected shapes (n_in %d out %d ws %zu need %zu)\n", n_in, out_size, ws_size, (size_t)WS_END); grid = -1; return; }
        int dev = 0, cus = 0, per_cu = 0;
        if (hipGetDevice(&dev) != hipSuccess || hipDeviceGetAttribute(&cus, hipDeviceAttributeMultiprocessorCount, dev) != hipSuccess) { grid = -1; return; }
        if (hipFuncSetAttribute((const void*)fwd_kernel, hipFuncAttributeMaxDynamicSharedMemorySize, LDS_BYTES) != hipSuccess) { grid = -1; return; }
        if (hipOccupancyMaxActiveBlocksPerMultiprocessor(&per_cu, (const void*)fwd_kernel, NTHR, LDS_BYTES) != hipSuccess || per_cu < 1) { fprintf(stderr, "kernel_launch: occupancy query failed (%d)\n", per_cu); grid = -1; return; }
        grid = cus;
    }
    if (grid < 0) return;
    if (hipMemsetAsync((char*)d_ws + WS_CTL, 0, XCD_BAR_WORDS * 4, stream) != hipSuccess) return;
    Args a{};
    for (int i = 0; i < 29; ++i) a.in[i] = (const float*)d_in[i];
    a.out = (float*)d_out; a.ws = (unsigned char*)d_ws; a.ph_lo = 0; a.ph_hi = PH_N;
    void* kargs[] = {&a};
    hipError_t e = hipLaunchCooperativeKernel((const void*)fwd_kernel, dim3(grid), dim3(NTHR), kargs, LDS_BYTES, stream);
    if (e != hipSuccess) fprintf(stderr, "kernel_launch: cooperative launch failed: %s (grid %d)\n", hipGetErrorString(e), grid);
}
```

```cpp
#include <hip/hip_runtime.h>
#include <hip/hip_cooperative_groups.h>
#include <cstdio>
namespace cg = cooperative_groups;

#define LAS __attribute__((address_space(3)))
typedef _Float16 h16;
typedef _Float16 h16x2 __attribute__((ext_vector_type(2)));
typedef _Float16 h16x4 __attribute__((ext_vector_type(4)));
typedef _Float16 h16x8 __attribute__((ext_vector_type(8)));
typedef short s16x4 __attribute__((ext_vector_type(4)));
typedef float f32x4 __attribute__((ext_vector_type(4)));
typedef float f32x2 __attribute__((ext_vector_type(2)));
typedef unsigned u32x4 __attribute__((ext_vector_type(4)));
typedef unsigned u32x2 __attribute__((ext_vector_type(2)));

constexpr int D = 2048, FF = 5632, NA = 6592, NIN = 16832;
constexpr int MP = 8192, MS = 2048, MT = MP + MS;
constexpr int MA = MT + 256;
constexpr int PP = 16896;
constexpr int PFW = 6656;
constexpr int C_GB = 6656, C_GC = 8704, C_XC = 10752, C_GA = 12800, C_GG = 14848;
constexpr int LK = 512;
constexpr int NCHUNK = MT / 64;
constexpr size_t O_Y = 0, O_SHP = 20971520, O_CVP = 20975616, O_WKP = 20983808, O_SHS = 21245952, O_CVS = 21311488, O_WKS = 21442560, O_END = 25636864;
constexpr size_t WS_CTL = 0;
constexpr size_t WS_W1GU = 1u << 20;
constexpr size_t WS_W1D = WS_W1GU + (size_t)2 * FF * D * 2;
constexpr size_t WS_WIN = WS_W1D + (size_t)D * FF * 2;
constexpr size_t WS_WOUT = WS_WIN + (size_t)PP * D * 2;
constexpr size_t WS_A16 = WS_WOUT + (size_t)D * D * 2;
constexpr size_t WS_P16 = WS_A16 + (size_t)MA * D * 2;
constexpr size_t WS_PF = WS_P16 + (size_t)MT * PP * 2;
constexpr size_t WS_END = WS_PF + (size_t)256 * PFW * 2;
constexpr size_t WS_EAG = WS_W1GU;
constexpr size_t WS_HM = WS_P16;
constexpr size_t WS_W2GU = WS_P16 + (size_t)MT * FF * 2;
constexpr size_t WS_W2D = WS_W2GU + (size_t)2 * FF * D * 2;
constexpr size_t WS_SLAB = WS_W2D + (size_t)D * FF * 2;
static_assert((size_t)MT * 6144 * 2 <= WS_WOUT - WS_W1GU, "EAG overlay");
static_assert(WS_SLAB + (size_t)4 * MS * D * 4 <= WS_PF, "W2 + slab overlay");
constexpr size_t OB_WL = O_WKS * 4;
constexpr size_t OB_SIDE = OB_WL + (size_t)6144 * LK * 2;
static_assert(OB_SIDE + (size_t)(MT / 16) * 6144 * 2 <= O_END * 4, "d_out scratch");

constexpr size_t WS_RK = WS_EAG + (size_t)MT * 6144 * 2;
constexpr size_t WS_LM = WS_RK + (size_t)MT * 32 * 4;
static_assert(WS_LM + (size_t)(MT / 16) * 32 * 128 * 4 <= WS_WOUT, "RK + LM");
constexpr int SC_SLOT = 6 * 64, SC_BUF = 16 * SC_SLOT;
constexpr int NWAVES = 8, NTHR = 512;
constexpr int LDS_BYTES = 147456;

__device__ __forceinline__ unsigned pk2h(float a, float b) { h16x2 v = {(h16)a, (h16)b}; return __builtin_bit_cast(unsigned, v); }
__device__ __forceinline__ float wave_sum(float v) {
#pragma unroll
    for (int o = 1; o < 64; o <<= 1) v += __shfl_xor(v, o);
    return v;
}
template <int CTRL> __device__ __forceinline__ float dpp_f(float x) { return __builtin_bit_cast(float, __builtin_amdgcn_update_dpp(0, __builtin_bit_cast(int, x), CTRL, 0xF, 0xF, false)); }
__device__ __forceinline__ float row_allreduce8(float x) { x += dpp_f<0xB1>(x); x += dpp_f<0x4E>(x); x += dpp_f<0x141>(x); return x; }
__device__ __forceinline__ float row_allreduce16(float x) { x = row_allreduce8(x); x += dpp_f<0x140>(x); return x; }
__device__ __forceinline__ float rl_f(float x, int l) { return __builtin_bit_cast(float, __builtin_amdgcn_readlane(__builtin_bit_cast(int, x), l)); }
__device__ __forceinline__ float wave_sum_dpp(float x) { x = row_allreduce16(x); return (rl_f(x, 0) + rl_f(x, 16)) + (rl_f(x, 32) + rl_f(x, 48)); }
__device__ __forceinline__ float sigmoidf_(float x) { return 1.0f / (1.0f + __expf(-x)); }

namespace pg8 {
constexpr int BM = 256, BK = 64, HALF = 128, HTB = HALF * BK * 2, STAGE_BYTES = 8 * HTB, NXCD = 8, WGM = 8;
__host__ __device__ __forceinline__ int lds_byte(int r, int c) { const int st = (r >> 4) * 2 + (c >> 5), rr = r & 15, cc = c & 31, ob = rr * 64 + cc * 2; return st * 1024 + (ob ^ (((ob >> 9) & 1) << 5)); }
__host__ __device__ __forceinline__ void stage_rc(int b, int& R, int& C) { const int st = b / 1024, sb = b % 1024, swz = sb ^ (((sb >> 9) & 1) << 5); R = (st >> 1) * 16 + swz / 64; C = (st & 1) * 32 + (swz % 64) / 2; }
__host__ __device__ __forceinline__ int perm32(int rho) { const int n = rho >> 4, i = rho & 15; return 8 * (i >> 2) + 4 * n + (i & 3); }
struct Unit { int pm, pn, kt0, nkt, sp; };
struct Gemm { const h16* A; const h16* Bt; int M, N, K; };
struct Order {
    int nM, nN, nwg, G, c, extra, nkt, nsplit;
    __device__ void init(int M, int N, int K, int G_, int c_, int extra_, int nMw) { nM = M / BM; nN = N / BM; nwg = (nMw < 0 ? nM : nMw) * nN; G = G_; c = c_; extra = extra_; nkt = K / BK; nsplit = nMw < 0 ? 0 : (nM - nMw) * nN * 4; }
    __device__ bool next(int i, Unit& u) const {
        const long L = (long)i * G + c; if (L >= nwg + extra + nsplit) return false;
        u.kt0 = 0; u.nkt = nkt; u.sp = -1;
        if (L >= nwg + extra) { const int j = (int)(L - nwg - extra), tile = j >> 2; u.sp = j & 3; u.nkt = nkt >> 2; u.kt0 = u.sp * u.nkt; const int rows = nM - nwg / nN; u.pm = nwg / nN + tile % rows; u.pn = tile / rows; return true; }
        if (L >= nwg) { u.pm = nM; u.pn = (int)(L - nwg); return true; }
        const int nMe = nwg / nN;
        int wgid = (int)L; { const int q = nwg / NXCD, r = nwg % NXCD, xcd = wgid % NXCD, off = wgid / NXCD; wgid = (xcd < r ? xcd * (q + 1) : r * (q + 1) + (xcd - r) * q) + off; }
        const int nig = WGM * nN, gid = wgid / nig, fm = gid * WGM, gsz = (nMe - fm) < WGM ? (nMe - fm) : WGM;
        u.pm = fm + ((wgid % nig) % gsz); u.pn = (wgid % nig) / gsz; return true;
    }
};

template <class Epi, bool SP2 = true, bool ALIGN_EPI = true>
__device__ __forceinline__ void gemm_phase(LAS unsigned char* lds, const Gemm g, const Order& S, const Epi& E) {
    const int tid = threadIdx.x, wid = __builtin_amdgcn_readfirstlane(tid >> 6), lane = tid & 63, wr = wid >> 2, wc = wid & 3, fr = lane & 15, fq = lane >> 4;
    const int K = g.K;
    unsigned voffA[2], voffB[2];
#pragma unroll
    for (int i = 0; i < 2; ++i) { int R, C; stage_rc(tid * 16 + i * 8192, R, C); const int Rb = Epi::PERM ? ((R & ~31) + perm32(R & 31)) : R;
        voffA[i] = (unsigned)(R * K + C) * 2u; voffB[i] = (unsigned)(Rb * K + C) * 2u; }
    const size_t kstep = (size_t)(BK * 2);
    const size_t hstep = (size_t)HALF * K * 2;
    const size_t tstep = 2 * hstep;
    const unsigned ldsw = (unsigned)wid * 1024u;
    const int aoff = lds_byte(wr * 64 + fr, fq * 8), boff = lds_byte(wc * 32 + fr, fq * 8);
#define PG8_SA(b, h) (((b) * 2 + (h)) * HTB)
#define PG8_SB(b, h) ((4 + (b) * 2 + (h)) * HTB)
#define PG8_STAGE(bufoff, gbase, voff) do { _Pragma("unroll") for (int _i = 0; _i < 2; ++_i) \
        __builtin_amdgcn_global_load_lds((const unsigned*)((const char*)(gbase) + (voff)[_i]), (LAS unsigned*)(lds + (bufoff) + ldsw + _i * 8192), 16, 0, 0); } while (0)
#define PG8_LDA(dst, b, h) do { _Pragma("unroll") for (int m = 0; m < 4; ++m) _Pragma("unroll") for (int k = 0; k < 2; ++k) dst[m][k] = *(const LAS h16x8*)(lds + PG8_SA(b, h) + aoff + m * 2048 + k * 1024); } while (0)
#define PG8_LDB(dst, b, h) do { _Pragma("unroll") for (int n = 0; n < 2; ++n) _Pragma("unroll") for (int k = 0; k < 2; ++k) dst[n][k] = *(const LAS h16x8*)(lds + PG8_SB(b, h) + boff + n * 2048 + k * 1024); } while (0)
#define PG8_MMA(ai, bj, At, Bt) do { __builtin_amdgcn_s_setprio(1); _Pragma("unroll") for (int m = 0; m < 4; ++m) _Pragma("unroll") for (int n = 0; n < 2; ++n) _Pragma("unroll") for (int k = 0; k < 2; ++k) \
        acc[ai][bj][m][n] = __builtin_amdgcn_mfma_f32_16x16x32_f16(Bt[n][k], At[m][k], acc[ai][bj][m][n], 0, 0, 0); __builtin_amdgcn_s_setprio(0); } while (0)
#define PG8_WAIT_V(n) asm volatile("s_waitcnt vmcnt(" #n ")" ::: "memory")
#define PG8_WAIT_L(n) asm volatile("s_waitcnt lgkmcnt(" #n ")" ::: "memory")
#define PG8_BAR __builtin_amdgcn_s_barrier()
#define PG8_SCHED __builtin_amdgcn_sched_barrier(0)
    Unit cur, nxt; int ui = 0;
    if (!S.next(0, cur)) return;
    f32x4 acc[2][2][4][2];
#pragma unroll
    for (int a = 0; a < 2; ++a)
#pragma unroll
        for (int b = 0; b < 2; ++b)
#pragma unroll
            for (int m = 0; m < 4; ++m)
#pragma unroll
                for (int n = 0; n < 2; ++n) acc[a][b][m][n] = (f32x4){0.f, 0.f, 0.f, 0.f};
    h16x8 At[4][2], B0[2][2], B1[2][2];
    const char* cA = (const char*)g.A + (size_t)cur.pm * tstep + (size_t)cur.kt0 * kstep; const char* cB = (const char*)g.Bt + (size_t)cur.pn * tstep + (size_t)cur.kt0 * kstep;
    if constexpr (SP2) {
        PG8_STAGE(PG8_SB(0, 0), cB, voffB); PG8_STAGE(PG8_SB(0, 1), cB + hstep, voffB); PG8_STAGE(PG8_SA(0, 0), cA, voffA); PG8_STAGE(PG8_SA(0, 1), cA + hstep, voffA);
        if (wr == 1) PG8_BAR;
        PG8_WAIT_V(2); PG8_BAR;
        PG8_STAGE(PG8_SB(1, 0), cB + kstep, voffB); PG8_STAGE(PG8_SA(1, 0), cA + kstep, voffA); PG8_STAGE(PG8_SB(1, 1), cB + hstep + kstep, voffB);
        PG8_WAIT_V(6); PG8_BAR;
    } else {
        PG8_STAGE(PG8_SB(0, 0), cB, voffB); PG8_STAGE(PG8_SA(0, 0), cA, voffA); PG8_STAGE(PG8_SB(0, 1), cB + hstep, voffB); PG8_STAGE(PG8_SA(0, 1), cA + hstep, voffA);
        if (wr == 1) PG8_BAR;
        PG8_WAIT_V(4); PG8_BAR;
        PG8_STAGE(PG8_SB(1, 0), cB + kstep, voffB); PG8_STAGE(PG8_SA(1, 0), cA + kstep, voffA); PG8_STAGE(PG8_SB(1, 1), cB + hstep + kstep, voffB);
        PG8_WAIT_V(6); PG8_BAR;
    }
    for (;;) {
        const bool has_next = S.next(ui + 1, nxt);
        const char* nA = has_next ? (const char*)g.A + (size_t)nxt.pm * tstep + (size_t)nxt.kt0 * kstep : cA; const char* nB = has_next ? (const char*)g.Bt + (size_t)nxt.pn * tstep + (size_t)nxt.kt0 * kstep : cB;
        const int nt = cur.nkt;
        for (int t = 0; t < nt; t += 2) {
            const bool last = (t == nt - 2);
            const char* a1 = cA + (size_t)(t + 1) * kstep;
            const char* a2 = last ? nA : cA + (size_t)(t + 2) * kstep; const char* b2 = last ? nB : cB + (size_t)(t + 2) * kstep;
            const char* a3 = a2 + kstep; const char* b3 = b2 + kstep;
            if constexpr (SP2) {
            PG8_LDB(B0, 0, 0); PG8_LDB(B1, 0, 1); PG8_SCHED; PG8_LDA(At, 0, 0); PG8_STAGE(PG8_SA(1, 1), a1 + hstep, voffA);
            PG8_WAIT_V(8); PG8_WAIT_L(0); PG8_BAR; PG8_MMA(0, 0, At, B0); PG8_MMA(0, 1, At, B1); PG8_BAR; PG8_SCHED;
            PG8_LDA(At, 0, 1); PG8_STAGE(PG8_SB(0, 0), b2, voffB); PG8_STAGE(PG8_SB(0, 1), b2 + hstep, voffB); PG8_STAGE(PG8_SA(0, 0), a2, voffA);
            PG8_WAIT_V(8); PG8_WAIT_L(0); PG8_BAR; PG8_MMA(1, 0, At, B0); PG8_MMA(1, 1, At, B1); PG8_BAR; PG8_SCHED;
            PG8_LDB(B0, 1, 0); PG8_LDB(B1, 1, 1); PG8_SCHED; PG8_LDA(At, 1, 0); PG8_STAGE(PG8_SA(0, 1), a2 + hstep, voffA);
            PG8_WAIT_V(8); PG8_WAIT_L(0); PG8_BAR; PG8_MMA(0, 0, At, B0); PG8_MMA(0, 1, At, B1); PG8_BAR; PG8_SCHED;
            PG8_LDA(At, 1, 1); PG8_STAGE(PG8_SB(1, 0), b3, voffB); PG8_STAGE(PG8_SB(1, 1), b3 + hstep, voffB); PG8_STAGE(PG8_SA(1, 0), a3, voffA);
            PG8_WAIT_V(8); PG8_WAIT_L(0); PG8_BAR; PG8_MMA(1, 0, At, B0); PG8_MMA(1, 1, At, B1); PG8_BAR; PG8_SCHED;
            } else {
            PG8_LDB(B0, 0, 0); PG8_SCHED; PG8_LDA(At, 0, 0); PG8_STAGE(PG8_SA(1, 1), a1 + hstep, voffA);
            PG8_WAIT_L(8); PG8_BAR; PG8_WAIT_L(0); PG8_MMA(0, 0, At, B0); PG8_BAR; PG8_SCHED;
            PG8_LDB(B1, 0, 1); PG8_STAGE(PG8_SB(0, 0), b2, voffB);
            PG8_BAR; PG8_WAIT_L(0); PG8_MMA(0, 1, At, B1); PG8_BAR;
            PG8_LDA(At, 0, 1); PG8_STAGE(PG8_SA(0, 0), a2, voffA);
            PG8_BAR; PG8_WAIT_L(0); PG8_MMA(1, 0, At, B0); PG8_BAR; PG8_SCHED;
            PG8_STAGE(PG8_SB(0, 1), b2 + hstep, voffB);
            PG8_WAIT_V(6); PG8_BAR; PG8_MMA(1, 1, At, B1); PG8_BAR;
            PG8_LDB(B0, 1, 0); PG8_SCHED; PG8_LDA(At, 1, 0); PG8_STAGE(PG8_SA(0, 1), a2 + hstep, voffA);
            PG8_WAIT_L(8); PG8_BAR; PG8_WAIT_L(0); PG8_MMA(0, 0, At, B0); PG8_BAR; PG8_SCHED;
            PG8_LDB(B1, 1, 1); PG8_STAGE(PG8_SB(1, 0), b3, voffB);
            PG8_BAR; PG8_WAIT_L(0); PG8_MMA(0, 1, At, B1); PG8_BAR;
            PG8_LDA(At, 1, 1); PG8_STAGE(PG8_SA(1, 0), a3, voffA);
            PG8_BAR; PG8_WAIT_L(0); PG8_MMA(1, 0, At, B0); PG8_BAR; PG8_SCHED;
            PG8_STAGE(PG8_SB(1, 1), b3 + hstep, voffB);
            PG8_WAIT_V(6); PG8_BAR; PG8_MMA(1, 1, At, B1); PG8_BAR;
                    }
        }
        if constexpr (ALIGN_EPI) { if (wr == 0) PG8_BAR; }
        E(acc, cur, wr, wc, fr, fq);
        if (!has_next) break;
#pragma unroll
        for (int a = 0; a < 2; ++a)
#pragma unroll
            for (int b = 0; b < 2; ++b)
#pragma unroll
                for (int m = 0; m < 4; ++m)
#pragma unroll
                    for (int n = 0; n < 2; ++n) acc[a][b][m][n] = (f32x4){0.f, 0.f, 0.f, 0.f};
        cur = nxt; cA = nA; cB = nB; ++ui;
        if constexpr (ALIGN_EPI) { if (wr == 1) PG8_BAR; }
    }
    PG8_WAIT_V(0);
    if constexpr (!ALIGN_EPI) { if (wr == 0) PG8_BAR; }
    PG8_BAR;
#undef PG8_SA
#undef PG8_SB
#undef PG8_STAGE
#undef PG8_LDA
#undef PG8_LDB
#undef PG8_MMA
#undef PG8_WAIT_V
#undef PG8_WAIT_L
#undef PG8_BAR
#undef PG8_SCHED
}

struct EpiSwiGLU {
    static constexpr bool PERM = false;
    h16* O; int ldo;
    __device__ __forceinline__ void operator()(const f32x4 (&acc)[2][2][4][2], const Unit& u, int wr, int wc, int fr, int fq) const {
        const int row0 = u.pm * BM + wr * 64 + fr;
#pragma unroll
        for (int ai = 0; ai < 2; ++ai)
#pragma unroll
            for (int m = 0; m < 4; ++m) { h16* rowp = O + (size_t)(row0 + ai * HALF + m * 16) * ldo;
#pragma unroll
                for (int bj = 0; bj < 2; ++bj) { const int oc = (u.pn * BM + bj * HALF + wc * 32) / 2 + 4 * fq;
                    const f32x4 gt = acc[ai][bj][m][0], up = acc[ai][bj][m][1]; float o[4];
#pragma unroll
                    for (int j = 0; j < 4; ++j) o[j] = gt[j] * sigmoidf_(gt[j]) * up[j];
                    u32x2 w; w.x = pk2h(o[0], o[1]); w.y = pk2h(o[2], o[3]);
                    *(u32x2*)(rowp + oc) = w; } }
    }
};
struct EpiRes {
    static constexpr bool PERM = false;
    const float* r0; const float* r1; float* out; float* slab; float scale; int pad;
    __device__ __forceinline__ void operator()(const f32x4 (&acc)[2][2][4][2], const Unit& u, int wr, int wc, int fr, int fq) const {
        const int row0 = u.pm * BM + wr * 64 + fr, col0 = u.pn * BM + wc * 32 + 4 * fq;
        if (u.sp >= 0) {
            float* sb = slab + ((size_t)u.sp * MS - MP) * D;
#pragma unroll
            for (int ai = 0; ai < 2; ++ai)
#pragma unroll
                for (int m = 0; m < 4; ++m) { const size_t off = (size_t)(row0 + ai * HALF + m * 16) * D + col0;
#pragma unroll
                    for (int bj = 0; bj < 2; ++bj)
#pragma unroll
                        for (int n = 0; n < 2; ++n) *(f32x4*)(sb + off + bj * HALF + n * 16) = acc[ai][bj][m][n]; }
            return;
        }
        const float* rb = (u.pm * BM < MP) ? r0 : r1 - (size_t)MP * D;
#pragma unroll
        for (int ai = 0; ai < 2; ++ai)
#pragma unroll
            for (int m = 0; m < 4; ++m) { const size_t off = (size_t)(row0 + ai * HALF + m * 16) * D + col0;
#pragma unroll
                for (int bj = 0; bj < 2; ++bj)
#pragma unroll
                    for (int n = 0; n < 2; ++n) { const f32x4 rv = *(const f32x4*)(rb + off + bj * HALF + n * 16);
                        *(f32x4*)(out + off + bj * HALF + n * 16) = rv + scale * acc[ai][bj][m][n]; } }
    }
};
struct EpiP16 {
    static constexpr bool PERM = true;
    h16* P; h16* PF;
    __device__ __forceinline__ void operator()(const f32x4 (&acc)[2][2][4][2], const Unit& u, int wr, int wc, int fr, int fq) const {
        const int row0 = u.pm * BM + wr * 64 + fr;
#pragma unroll
        for (int ai = 0; ai < 2; ++ai)
#pragma unroll
            for (int m = 0; m < 4; ++m) { const int row = row0 + ai * HALF + m * 16;
#pragma unroll
                for (int bj = 0; bj < 2; ++bj) { const int col = u.pn * BM + bj * HALF + wc * 32 + 8 * fq;
                    const f32x4 v0 = acc[ai][bj][m][0], v1 = acc[ai][bj][m][1];
                    u32x4 w; w.x = pk2h(v0[0], v0[1]); w.y = pk2h(v0[2], v0[3]); w.z = pk2h(v1[0], v1[1]); w.w = pk2h(v1[2], v1[3]);
                    if (u.pm < MT / BM) *(u32x4*)(P + (size_t)row * PP + col) = w;
                    else *(u32x4*)(PF + (size_t)(row - MT) * PFW + col) = w; } }
    }
};
struct EpiEAG {
    static constexpr bool PERM = true;
    h16* O; const float* w0; const float* a0;
    __device__ __forceinline__ void operator()(const f32x4 (&acc)[2][2][4][2], const Unit& u, int wr, int wc, int fr, int fq) const {
        const int row0 = u.pm * BM + wr * 64 + fr; const int typ = u.pn >> 3;
#pragma unroll
        for (int bj = 0; bj < 2; ++bj) { const int col = u.pn * BM + bj * HALF + wc * 32 + 8 * fq;
            f32x4 b0 = (f32x4){0.f, 0.f, 0.f, 0.f}, b1 = b0;
            if (typ == 0) { b0 = *(const f32x4*)(w0 + col); b1 = *(const f32x4*)(w0 + col + 4); }
            if (typ == 1) { b0 = *(const f32x4*)(a0 + col - D); b1 = *(const f32x4*)(a0 + col - D + 4); }
#pragma unroll
            for (int ai = 0; ai < 2; ++ai)
#pragma unroll
                for (int m = 0; m < 4; ++m) { const int row = row0 + ai * HALF + m * 16;
                    f32x4 v0 = acc[ai][bj][m][0] + b0, v1 = acc[ai][bj][m][1] + b1;
                    if (typ < 2) { const float sc = typ == 0 ? 0.60653065971f : 1.0f;
#pragma unroll
                        for (int j = 0; j < 4; ++j) { v0[j] = sigmoidf_(v0[j]) * sc; v1[j] = sigmoidf_(v1[j]) * sc; } }
                    u32x4 w; w.x = pk2h(v0[0], v0[1]); w.y = pk2h(v0[2], v0[3]); w.z = pk2h(v1[0], v1[1]); w.w = pk2h(v1[2], v1[3]);
                    *(u32x4*)(O + (size_t)row * 6144 + col) = w; } }
    }
};
}


#define XB_TMO      128
#define XB_XCNT(j)  (256  + 64 * (j))
#define XB_XSUB(j)  (1280 + 64 * (j))
#define XB_XGEN(j)  (2304 + 64 * (j))
#define XB_TOP      3328
#define XB_TOPGEN   3392
#define XCD_BAR_WORDS 3456
#define XB_SPIN_CAP (1u << 22)
__device__ __forceinline__ unsigned xb_ld(unsigned* p)              { return __hip_atomic_load(p, __ATOMIC_RELAXED, __HIP_MEMORY_SCOPE_AGENT); }
__device__ __forceinline__ unsigned xb_add(unsigned* p, unsigned v) { return __hip_atomic_fetch_add(p, v, __ATOMIC_RELAXED, __HIP_MEMORY_SCOPE_AGENT); }
__device__ __forceinline__ unsigned xb_xcc_id() { return (unsigned)__builtin_amdgcn_s_getreg((3 << 11) | 20) & 0xFu; }
#define XB_SPIN(cond, bar) do { unsigned _sp = 0; while (cond) { __builtin_amdgcn_s_sleep(1); \
    if ((++_sp & 255u) == 0u) { if (xb_ld(&(bar)[XB_TMO])) break; if (_sp > XB_SPIN_CAP) { atomicAdd(&(bar)[XB_TMO], 1u); break; } } } } while (0)
struct XcdBarrier { unsigned* bar; unsigned x; volatile LAS unsigned* st; };
__device__ __forceinline__ XcdBarrier xcd_barrier_post(unsigned* bar, volatile LAS unsigned* st) {
    XcdBarrier b; b.bar = bar; b.x = xb_xcc_id(); b.st = st;
    if (threadIdx.x == 0) (void)xb_add(&bar[XB_XCNT(b.x)], 1u);
    return b;
}
__device__ __forceinline__ void xcd_barrier_complete(unsigned* bar, unsigned x, unsigned& nloc, unsigned& nx) {
    const unsigned G = gridDim.x * gridDim.y * gridDim.z;
    unsigned sum, cnt, mine, sp = 0u;
    for (;;) {
        sum = 0u; cnt = 0u; mine = 0u;
#pragma unroll
        for (unsigned j = 0; j < 16; ++j) { const unsigned c = xb_ld(&bar[XB_XCNT(j)]); sum += c; cnt += (c > 0u) ? 1u : 0u; mine = (j == x) ? c : mine; }
        if (sum == G) break;
        __builtin_amdgcn_s_sleep(1);
        if ((++sp & 255u) == 0u) { if (xb_ld(&bar[XB_TMO])) break; if (sp > XB_SPIN_CAP) { atomicAdd(&bar[XB_TMO], 1u); break; } }
    }
    nloc = mine > 0u ? mine : 1u; nx = cnt > 0u ? cnt : 1u;
}
__device__ __forceinline__ void xcd_barrier(const XcdBarrier& b) {
    asm volatile("s_waitcnt vmcnt(0)" ::: "memory");
    __syncthreads();
    if (threadIdx.x == 0) {
        unsigned* bar = b.bar;
        __builtin_amdgcn_s_waitcnt(0);
        unsigned nloc = b.st[0], nx = b.st[1];
        if (nloc == 0u) { xcd_barrier_complete(bar, b.x, nloc, nx); b.st[0] = nloc; b.st[1] = nx; }
        const unsigned old = xb_add(&bar[XB_XSUB(b.x)], 1u);
        const unsigned gen = old / nloc;
        if (old + 1u == (gen + 1u) * nloc) {
            __builtin_amdgcn_fence(__ATOMIC_RELEASE, "agent");
            asm volatile("s_waitcnt vmcnt(0)" ::: "memory");
            const unsigned og = xb_add(&bar[XB_TOP], 1u);
            const unsigned tg = og / nx;
            if (og + 1u == (tg + 1u) * nx) xb_add(&bar[XB_TOPGEN], 1u);
            else XB_SPIN(xb_ld(&bar[XB_TOPGEN]) == tg, bar);
            __builtin_amdgcn_fence(__ATOMIC_ACQUIRE, "agent");
            xb_add(&bar[XB_XGEN(b.x)], 1u);
            asm volatile("s_waitcnt vmcnt(0)" ::: "memory");
        } else {
            XB_SPIN(xb_ld(&bar[XB_XGEN(b.x)]) == gen, bar);
            __builtin_amdgcn_fence(__ATOMIC_ACQUIRE, "agent");
            asm volatile("s_waitcnt vmcnt(0)" ::: "memory");
        }
    }
    __syncthreads();
}

struct Args { const float* in[29]; float* out; unsigned char* ws; int ph_lo, ph_hi; };

__device__ __forceinline__ void cvt_item(int mode, const float* s0, const float* s1, int Nsrc, int K, h16* WT, LAS float* scr, int item, int nblk, int lane) {
    const int kb = item / nblk, nb = item % nblk, k0 = 64 * kb, n0 = 32 * nb;
    const int nn = lane & 31; const float* src = s0; int col = n0 + nn; bool zero = false;
    if (mode == 1) { src = (nn < 16) ? s0 : s1; col = (n0 >> 1) + (nn & 15); }
    if (mode == 2) { if (n0 >= NA && n0 < PFW) zero = true; else if (n0 >= PFW) col -= 64; }
#pragma unroll 8
    for (int i = 0; i < 32; ++i) { const int kk = 2 * i + (lane >> 5); scr[kk * 33 + nn] = zero ? 0.f : src[(size_t)(k0 + kk) * Nsrc + col]; }
    asm volatile("s_waitcnt lgkmcnt(0)" ::: "memory");
    const int c = lane & 7;
#pragma unroll
    for (int j = 0; j < 4; ++j) { const int n = (lane >> 3) + 8 * j; const LAS float* s = scr + (8 * c) * 33 + n;
        u32x4 o; o.x = pk2h(s[0 * 33], s[1 * 33]); o.y = pk2h(s[2 * 33], s[3 * 33]); o.z = pk2h(s[4 * 33], s[5 * 33]); o.w = pk2h(s[6 * 33], s[7 * 33]);
        *(u32x4*)(WT + (size_t)(n0 + n) * K + k0 + 8 * c) = o; }
    asm volatile("s_waitcnt lgkmcnt(0)" ::: "memory");
}
__device__ __forceinline__ void cvt_lora_item(const float* wl, const float* al, const float* gl, h16* WT, int item, int lane) {
    const int n = item, typ = n >> 11, col = n & 2047; unsigned w[4];
#pragma unroll
    for (int j = 0; j < 4; ++j) { float v[2];
#pragma unroll
        for (int e = 0; e < 2; ++e) { const int k = lane * 8 + j * 2 + e; float x = 0.f;
            if (typ == 0 && k < 96) x = wl[(size_t)k * D + col];
            if (typ == 1 && k >= 96 && k < 192) x = al[(size_t)(k - 96) * D + col];
            if (typ == 2 && k >= 192 && k < 448) x = gl[(size_t)(k - 192) * D + col];
            v[e] = x; }
        w[j] = pk2h(v[0], v[1]); }
    *(u32x4*)(WT + (size_t)n * LK + lane * 8) = (u32x4){w[0], w[1], w[2], w[3]};
}

__device__ __forceinline__ void rms_row_f16(const float* xrow, const float* g, h16* orow, float* f32row, int lane, const float* part = nullptr, float pscale = 0.f, float* xout = nullptr) {
    const f32x4* xr = (const f32x4*)xrow + lane; const f32x4* gr = (const f32x4*)g + lane;
    f32x4 v[8]; float s = 0.f;
#pragma unroll
    for (int j = 0; j < 8; ++j) { v[j] = xr[64 * j];
        if (part) { const f32x4* pp = (const f32x4*)part + lane + 64 * j; const size_t st = (size_t)MS * D / 4;
            v[j] += pscale * ((pp[0] + pp[st]) + (pp[2 * st] + pp[3 * st])); if (xout) *((f32x4*)xout + lane + 64 * j) = v[j]; }
        s += (v[j].x * v[j].x + v[j].y * v[j].y) + (v[j].z * v[j].z + v[j].w * v[j].w); }
    const float rs = rsqrtf(wave_sum(s) * (1.f / D) + 1e-6f);
#pragma unroll
    for (int j = 0; j < 8; ++j) { const f32x4 gg = gr[64 * j]; const f32x4 o = v[j] * rs * gg;
        if (orow) { u32x2 w; w.x = pk2h(o.x, o.y); w.y = pk2h(o.z, o.w); *((u32x2*)orow + lane + 64 * j) = w; }
        if (f32row) *((f32x4*)f32row + lane + 64 * j) = o; }
}

enum { PH_CVT1 = 0, PH_FFN1_GU, PH_FFN1_D, PH_RMS_MIX, PH_WIN, PH_SHIFT, PH_LORA, PH_PREP, PH_SCAN, PH_MERGE, PH_WOUT, PH_RMS2, PH_FFN2_GU, PH_FFN2_D, PH_FINAL, PH_N };

__global__ void __launch_bounds__(NTHR, 2) fwd_kernel(Args a) {
    extern __shared__ __attribute__((aligned(16))) unsigned char lds_raw[];
    LAS unsigned char* lds = (LAS unsigned char*)lds_raw;
    const int tid = threadIdx.x, lane = tid & 63, wave = __builtin_amdgcn_readfirstlane(tid >> 6);
    const int G = gridDim.x, bx = blockIdx.x;
    const int gw = bx * NWAVES + wave, NGW = G * NWAVES;
    unsigned char* ws = a.ws; unsigned char* ob = (unsigned char*)a.out;
    h16* W1GU = (h16*)(ws + WS_W1GU); h16* W1D = (h16*)(ws + WS_W1D); h16* WIN = (h16*)(ws + WS_WIN); h16* WOUT = (h16*)(ws + WS_WOUT);
    h16* A16 = (h16*)(ws + WS_A16); h16* P16 = (h16*)(ws + WS_P16); h16* EAG = (h16*)(ws + WS_EAG); h16* HM = (h16*)(ws + WS_HM);
    h16* W2GU = (h16*)(ws + WS_W2GU); h16* W2D = (h16*)(ws + WS_W2D);
    h16* WL = (h16*)(ob + OB_WL); h16* PF = (h16*)(ws + WS_PF);
    float* Y = a.out + O_Y; float* SLAB = (float*)(ws + WS_SLAB);
    const int lo = a.ph_lo, hi = a.ph_hi;
#define IN(k) (lo <= (k) && (k) < hi)
    cg::grid_group grid = cg::this_grid();
    volatile LAS unsigned* xst = (volatile LAS unsigned*)(lds + LDS_BYTES - 16);
    if (tid < 2) xst[tid] = 0u;
    __syncthreads();
    const XcdBarrier xbar = xcd_barrier_post((unsigned*)(ws + WS_CTL), xst);
#ifndef PROBE_MASK
#define PROBE_MASK 0u
#endif
    unsigned long long pr_t[PH_N + 1]; (void)pr_t;
    if (PROBE_MASK) pr_t[0] = __builtin_amdgcn_s_memrealtime();
#define SEAM(k) do { if (IN(k) && IN((k) + 1)) { if ((k) == PH_CVT1) grid.sync(); else xcd_barrier(xbar); } if (PROBE_MASK) pr_t[(k) + 1] = __builtin_amdgcn_s_memrealtime(); } while (0)

    if (IN(PH_CVT1)) {
        LAS float* scr = (LAS float*)(lds + wave * 16384);
        constexpr int I1 = (D / 64) * (2 * FF / 32), I2 = (FF / 64) * (D / 32), I3 = (D / 64) * (PP / 32), I4 = (D / 64) * (D / 32);
        for (int it = gw; it < I1 + I2 + I3 + I4; it += NGW) {
            int r = it;
            if (r < I1) { cvt_item(1, a.in[6], a.in[7], FF, D, W1GU, scr, r, 2 * FF / 32, lane); continue; } r -= I1;
            if (r < I2) { cvt_item(0, a.in[8], nullptr, D, FF, W1D, scr, r, D / 32, lane); continue; } r -= I2;
            if (r < I3) { cvt_item(2, a.in[10], nullptr, NIN, D, WIN, scr, r, PP / 32, lane); continue; } r -= I3;
            cvt_item(0, a.in[23], nullptr, D, D, WOUT, scr, r, D / 32, lane);
        }
        for (int it = gw; it < 6144; it += NGW) cvt_lora_item(a.in[13], a.in[15], a.in[16], WL, it, lane);
        for (int r = gw; r < 256; r += NGW) { h16* orow = A16 + (size_t)(MT + r) * D;
#pragma unroll
            for (int j = 0; j < 8; ++j) { u32x2 w = (u32x2){0u, 0u};
                if (r < 32) { const f32x4 v = *((const f32x4*)(a.in[2] + (size_t)r * D) + lane + 64 * j); w.x = pk2h(v.x, v.y); w.y = pk2h(v.z, v.w); }
                *((u32x2*)orow + lane + 64 * j) = w; } }
        for (int m = gw; m < MT; m += NGW) { const float* xr = m < MP ? a.in[0] + (size_t)m * D : a.in[1] + (size_t)(m - MP) * D; rms_row_f16(xr, a.in[5], A16 + (size_t)m * D, nullptr, lane); }
    }
    SEAM(PH_CVT1);
    if (IN(PH_FFN1_GU)) { pg8::Gemm g{A16, W1GU, MT, 2 * FF, D}; pg8::Order S; S.init(MT, 2 * FF, D, G, bx, 0, -1); pg8::EpiSwiGLU E{HM, FF}; pg8::gemm_phase(lds, g, S, E); }
    SEAM(PH_FFN1_GU);
    if (IN(PH_FFN1_D)) { pg8::Gemm g{HM, W1D, MT, D, FF}; pg8::Order S; S.init(MT, D, FF, G, bx, 0, MP / 256); pg8::EpiRes E{a.in[0], a.in[1], Y, SLAB, 0.5f, 0}; pg8::gemm_phase(lds, g, S, E); }
    SEAM(PH_FFN1_D);
    if (IN(PH_RMS_MIX)) {
        for (int m = gw; m < MT; m += NGW) { float* so = nullptr;
            if (m < MP) { if ((m & 4095) == 4095) so = a.out + O_SHP + (size_t)(m >> 12) * D; } else { if (((m - MP) & 63) == 63) so = a.out + O_SHS + (size_t)((m - MP) >> 6) * D; }
            if (m < MP) rms_row_f16(Y + (size_t)m * D, a.in[9], A16 + (size_t)m * D, so, lane);
            else rms_row_f16(a.in[1] + (size_t)(m - MP) * D, a.in[9], A16 + (size_t)m * D, so, lane, SLAB + (size_t)(m - MP) * D, 0.5f, Y + (size_t)m * D); }
    }
    SEAM(PH_RMS_MIX);
    if (IN(PH_WIN)) { pg8::Gemm g{A16, WIN, MT, PP, D}; pg8::Order S; S.init(MT, PP, D, G, bx, PFW / 256, -1); pg8::EpiP16 E{P16, PF}; pg8::gemm_phase(lds, g, S, E); }
    SEAM(PH_WIN);
    if (IN(PH_SHIFT)) {
        for (int item = bx * NTHR + tid; item < (MT / 16) * 768; item += G * NTHR) { const int c = item / 768, o = item % 768;
            *(u32x4*)((h16*)(ob + OB_SIDE) + (size_t)c * 6144 + o * 8) = *(const u32x4*)(P16 + (size_t)(16 * c + 15) * PP + o * 8); }
    }
    if (IN(PH_SHIFT)) {
        h16* AIN = A16; const float* mu = a.in[11];
        for (int item = bx * NTHR + tid; item < MT * 64; item += G * NTHR) {
            const int row = item >> 6, o = item & 63;
            if (o >= 56) { *(u32x4*)(AIN + (size_t)row * LK + 448 + (o - 56) * 8) = (u32x4){0u, 0u, 0u, 0u}; continue; }
            const int c0 = 6144 + o * 8;
            const bool st = row < MP ? ((row & 4095) == 0) : (((row - MP) & 63) == 0);
            const h16* pp = st ? (row < MP ? PF + (size_t)32 * PFW : PF + (size_t)((row - MP) >> 6) * PFW) + c0 : P16 + (size_t)(row - 1) * PP + c0;
            const h16x8 cv = *(const h16x8*)(P16 + (size_t)row * PP + c0), pv = *(const h16x8*)pp;
            const f32x4 m0 = *(const f32x4*)(mu + c0), m1 = *(const f32x4*)(mu + c0 + 4);
            const float mu8[8] = {m0.x, m0.y, m0.z, m0.w, m1.x, m1.y, m1.z, m1.w}; float s[8];
#pragma unroll
            for (int j = 0; j < 8; ++j) { const float cu = (float)cv[j]; s[j] = cu + mu8[j] * ((float)pv[j] - cu); }
            if (o < 12) {
#pragma unroll
                for (int j = 0; j < 8; ++j) s[j] = tanhf(s[j]);
            } else if (o >= 24) {
#pragma unroll
                for (int j = 0; j < 8; ++j) s[j] = sigmoidf_(s[j]);
            }
            *(u32x4*)(AIN + (size_t)row * LK + o * 8) = (u32x4){pk2h(s[0], s[1]), pk2h(s[2], s[3]), pk2h(s[4], s[5]), pk2h(s[6], s[7])};
        }
    }
    SEAM(PH_SHIFT);
    if (IN(PH_LORA)) { pg8::Gemm g{A16, WL, MT, 6144, LK}; pg8::Order S; S.init(MT, 6144, LK, G, bx, 0, -1); pg8::EpiEAG E{EAG, a.in[12], a.in[14]}; pg8::gemm_phase(lds, g, S, E); }
    SEAM(PH_LORA);
    if (IN(PH_PREP)) {
        LAS unsigned char* sc = lds + wave * 5120;
        const unsigned short* P16u = (const unsigned short*)P16; const unsigned short* EAGu = (const unsigned short*)EAG;
        float* RK = (float*)(ws + WS_RK); float* LM = (float*)(ws + WS_LM); const unsigned short* SIDEu = (const unsigned short*)(ob + OB_SIDE); const unsigned short* PFu = (const unsigned short*)PF;
#define H2F(x) ((float)__builtin_bit_cast(h16, (unsigned short)(x)))
        for (int item = gw; item < (MT / 16) * 32; item += NGW) {
            const int c = item >> 5, h = item & 31, row0 = 16 * c, hj = h * 64 + lane;
            const float c_kk = a.in[17][hj], c_ka = a.in[18][hj], c_rk = a.in[19][hj], c_mr = a.in[11][hj], c_mk = a.in[11][D + hj], c_mv = a.in[11][2 * D + hj];
            const bool pr = row0 < MP; const bool st = pr ? ((row0 & 4095) == 0) : (((row0 - MP) & 63) == 0);
            const unsigned short* pq = st ? PFu + (size_t)(pr ? 32 : ((row0 - MP) >> 6)) * PFW + hj : SIDEu + (size_t)(c - 1) * 6144 + hj;
            const unsigned short* pp = P16u + (size_t)row0 * PP + hj; const unsigned short* pe = EAGu + (size_t)row0 * 6144 + hj;
            unsigned rr[17], kk[17], vv[17], ee[16], aa[16];
            rr[0] = pq[0]; kk[0] = pq[D]; vv[0] = pq[2 * D];
#pragma unroll
            for (int t = 0; t < 16; ++t) { rr[t + 1] = pp[(size_t)t * PP]; kk[t + 1] = pp[(size_t)t * PP + D]; vv[t + 1] = pp[(size_t)t * PP + 2 * D]; ee[t] = pe[(size_t)t * 6144]; aa[t] = pe[(size_t)t * 6144 + D]; }
            float L[16]; { float acc = 0.f;
#pragma unroll
                for (int t = 0; t < 16; ++t) { acc -= H2F(ee[t]); L[t] = acc; } }
            const float M_ = L[7], L15 = L[15];
            LM[(size_t)item * 128 + lane] = M_; LM[(size_t)item * 128 + 64 + lane] = L15;
            h16 vh[16];
            h16* eo = EAG + (size_t)row0 * 6144 + hj; h16* po = P16 + (size_t)row0 * PP + hj;
#pragma unroll
            for (int t = 0; t < 16; ++t) {
                float r = H2F(rr[t + 1]), k = H2F(kk[t + 1]), v = H2F(vv[t + 1]);
                r += c_mr * (H2F(rr[t]) - r); k += c_mk * (H2F(kk[t]) - k); v += c_mv * (H2F(vv[t]) - v);
                const float av = H2F(aa[t]);
                const float kkr = k * c_kk; const float ss = wave_sum_dpp(kkr * kkr);
                const float kap = kkr * rsqrtf(fmaxf(ss, 1e-24f));
                const float kmod = k * (1.f + (av - 1.f) * c_ka);
                const float Lp = t ? L[t > 0 ? t - 1 : 0] : 0.f;
                const float E1 = __expf(Lp - M_), E2 = __expf(M_ - L[t]), E3 = __expf(L[t] - M_);
                const h16 hat = (h16)(kap * E1), hrt = (h16)(r * E3), hbb = (h16)(kap * av * E2), hkb = (h16)(kmod * E2);
                const float rk = wave_sum_dpp(r * kmod * c_rk); if (lane == 0) RK[(size_t)(row0 + t) * 32 + h] = rk;
                eo[(size_t)t * 6144] = hat; eo[(size_t)t * 6144 + D] = hbb; po[(size_t)t * PP] = hrt; po[(size_t)t * PP + D] = hkb;
                ((LAS h16*)sc)[t * 64 + lane] = hat; ((LAS h16*)(sc + 2048))[t * 64 + lane] = hbb;
                vh[t] = (h16)v;
            }
            { h16* vo = P16 + (size_t)(row0 + (lane >> 2)) * PP + 2 * D + h * 64 + (lane & 3) * 16;
              *(h16x8*)vo = (h16x8){vh[0], vh[1], vh[2], vh[3], vh[4], vh[5], vh[6], vh[7]}; *(h16x8*)(vo + 8) = (h16x8){vh[8], vh[9], vh[10], vh[11], vh[12], vh[13], vh[14], vh[15]}; }
            asm volatile("s_waitcnt lgkmcnt(0)" ::: "memory");
            const int fr = lane & 15, fq = lane >> 4;
            f32x4 acc = (f32x4){0.f, 0.f, 0.f, 0.f};
#pragma unroll
            for (int kt = 0; kt < 4; ++kt) acc = __builtin_amdgcn_mfma_f32_16x16x16f16(*(const LAS h16x4*)(sc + (fr * 64 + 16 * kt + 4 * fq) * 2), *(const LAS h16x4*)(sc + 2048 + (fr * 64 + 16 * kt + 4 * fq) * 2), acc, 0, 0, 0);
            LAS float* Pm = (LAS float*)(sc + 4096);
#pragma unroll
            for (int g_ = 0; g_ < 4; ++g_) Pm[(4 * fq + g_) * 16 + fr] = (fr < 4 * fq + g_) ? acc[g_] : 0.f;
            asm volatile("s_waitcnt lgkmcnt(0)" ::: "memory");
            float Tc[16];
#pragma unroll
            for (int t = 0; t < 16; ++t) { float x = (t == fr) ? 1.f : 0.f;
#pragma unroll
                for (int j4 = 0; j4 < (t + 3) / 4; ++j4) { const f32x4 p4 = *(const LAS f32x4*)(Pm + t * 16 + 4 * j4);
                    if (4 * j4 + 0 < t) x -= p4.x * Tc[4 * j4 + 0]; if (4 * j4 + 1 < t) x -= p4.y * Tc[4 * j4 + 1]; if (4 * j4 + 2 < t) x -= p4.z * Tc[4 * j4 + 2]; if (4 * j4 + 3 < t) x -= p4.w * Tc[4 * j4 + 3]; }
                Tc[t] = x; }
            if (lane < 16) { h16* to = P16 + (size_t)row0 * PP + 6144 + h * 16 + fr;
#pragma unroll
                for (int t = 0; t < 16; ++t) to[(size_t)t * PP] = (h16)Tc[t]; }
            asm volatile("s_waitcnt lgkmcnt(0)" ::: "memory");
        }
#undef H2F
    }
    SEAM(PH_PREP);
    if (IN(PH_SCAN)) {
        const int vcu = (G % 8 == 0) ? (bx % 8) * (G / 8) + bx / 8 : bx;
        constexpr int RAWB = 12288, NSL = 7, CSET = 2560, O_RAW = 0, O_CO = NSL * RAWB, O_YB = O_CO + 2 * CSET;
        static_assert(O_YB + 2 * 2048 <= LDS_BYTES - 16, "scan LDS map");
        h16* OUT16 = A16; const float* LM = (const float*)(ws + WS_LM);
        const bool pblk = vcu < 64;
        const int nitem = pblk ? 1 : (1024 - (vcu - 64) + 191) / 192;
        const int NCHB = pblk ? 256 : 4 * nitem;
#define SC_DESC(cc, prompt, sq, h, t0, first, last) \
        const bool prompt = pblk; bool first, last; int sq, h, t0; \
        if (prompt) { sq = vcu >> 5; h = vcu & 31; t0 = 16 * (cc); first = (cc) == 0; last = (cc) == 255; } \
        else { const int pair = (vcu - 64) + 192 * ((cc) >> 2); sq = pair >> 5; h = pair & 31; t0 = 16 * ((cc) & 3); first = ((cc) & 3) == 0; last = ((cc) & 3) == 3; }
#define SC_DMA(cc) do { if ((cc) < NCHB) { SC_DESC(cc, prompt_, sq_, h_, t0_, first_, last_); (void)last_; (void)first_; \
            const size_t rowb_ = (size_t)(prompt_ ? sq_ * 4096 : MP + sq_ * 64) + t0_; \
            LAS unsigned char* dst_ = lds + O_RAW + ((cc) % NSL) * RAWB; \
            const int sw_ = ((lane & 7) ^ (lane >> 3)) * 8;     \
            const h16* e0_ = EAG + (rowb_ + (lane >> 3)) * 6144 + h_ * 64 + sw_; const h16* p0_ = P16 + (rowb_ + (lane >> 3)) * PP + h_ * 64 + sw_; \
            __builtin_amdgcn_global_load_lds((const unsigned*)(e0_), (LAS unsigned*)(dst_), 16, 0, 0); \
            __builtin_amdgcn_global_load_lds((const unsigned*)(e0_ + 8 * 6144), (LAS unsigned*)(dst_ + 1024), 16, 0, 0); \
            __builtin_amdgcn_global_load_lds((const unsigned*)(p0_), (LAS unsigned*)(dst_ + 2048), 16, 0, 0); \
            __builtin_amdgcn_global_load_lds((const unsigned*)(p0_ + 8 * PP), (LAS unsigned*)(dst_ + 3072), 16, 0, 0); \
            __builtin_amdgcn_global_load_lds((const unsigned*)(e0_ + D), (LAS unsigned*)(dst_ + 4096), 16, 0, 0); \
            __builtin_amdgcn_global_load_lds((const unsigned*)(e0_ + D + 8 * 6144), (LAS unsigned*)(dst_ + 5120), 16, 0, 0); \
            __builtin_amdgcn_global_load_lds((const unsigned*)(p0_ + D), (LAS unsigned*)(dst_ + 6144), 16, 0, 0); \
            __builtin_amdgcn_global_load_lds((const unsigned*)(p0_ + D + 8 * PP), (LAS unsigned*)(dst_ + 7168), 16, 0, 0); \
            __builtin_amdgcn_global_load_lds((const unsigned*)(p0_ - sw_ + (lane & 7) * 8 + 2 * D), (LAS unsigned*)(dst_ + 8192), 16, 0, 0); \
            __builtin_amdgcn_global_load_lds((const unsigned*)(p0_ - sw_ + (lane & 7) * 8 + 2 * D + 8 * PP), (LAS unsigned*)(dst_ + 9216), 16, 0, 0); \
            __builtin_amdgcn_global_load_lds((const unsigned*)(P16 + (rowb_ + ((lane & 31) >> 1)) * PP + 6144 + h_ * 16 + (lane & 1) * 8), (LAS unsigned*)(dst_ + 10240), 16, 0, 0); \
            __builtin_amdgcn_global_load_lds((const unsigned*)(LM + ((rowb_ >> 4) * 32 + h_) * 128 + (lane & 31) * 4), (LAS unsigned*)(dst_ + 11264), 16, 0, 0); } } while (0)
#define MF(a_, b_, c_) __builtin_amdgcn_mfma_f32_16x16x16f16(a_, b_, c_, 0, 0, 0)
#define SC_C(cc) do { if ((cc) >= 0 && (cc) < NCHB) { \
            const LAS unsigned char* rs = lds + O_RAW + ((cc) % NSL) * RAWB; LAS unsigned char* co = lds + O_CO + ((cc) & 1) * CSET; \
            const int fr = lane & 15, fq = lane >> 4; const int oa = wave == 4 ? 0 : 2048, ob_ = wave == 6 ? 4096 : 6144; \
            f32x4 acc = (f32x4){0.f, 0.f, 0.f, 0.f}; \
            _Pragma("unroll") for (int kt = 0; kt < 4; ++kt) { const int o_ = fr * 128 + (((2 * kt + (fq >> 1)) ^ (fr & 7)) << 4) + 8 * (fq & 1); acc = MF(*(const LAS h16x4*)(rs + oa + o_), *(const LAS h16x4*)(rs + ob_ + o_), acc); } \
            _Pragma("unroll") for (int g_ = 0; g_ < 4; ++g_) { const int t = 4 * fq + g_; const bool keep = wave == 4 ? (fr < t) : (fr <= t); ((LAS h16*)(co + (wave - 4) * 512))[t * 16 + fr] = (h16)(keep ? acc[g_] : 0.f); } \
            if (wave == 4) { const float M_ = ((const LAS float*)(rs + 11264))[lane], L15 = ((const LAS float*)(rs + 11264 + 256))[lane]; \
                ((LAS float*)(co + 1536))[lane] = __expf(M_); ((LAS float*)(co + 1792))[lane] = __expf(L15 - M_); ((LAS float*)(co + 2048))[lane] = __expf(L15); } } } while (0)
        f32x4 St[4];
#pragma unroll
        for (int n = 0; n < 4; ++n) St[n] = (f32x4){0.f, 0.f, 0.f, 0.f};
#define CVT4(x_) ((h16x4){(h16)(x_)[0], (h16)(x_)[1], (h16)(x_)[2], (h16)(x_)[3]})
#define TRR(p_) __builtin_bit_cast(h16x4, __builtin_amdgcn_ds_read_tr16_b64_v4i16((LAS s16x4*)(p_)))
#define SC_ROW(cc, PROMPT) do { if ((cc) >= 0 && (cc) < NCHB) { SC_DESC(cc, prompt, sq, h, t0, first, last); \
            const int fr = lane & 15, fq = lane >> 4; \
            float* sp = a.out + (prompt ? O_WKP : O_WKS) + ((size_t)(sq * 32 + h) * 64 + 16 * wave + fr) * 64 + 4 * fq; \
            if (first) { _Pragma("unroll") for (int n = 0; n < 4; ++n) { St[n] = (f32x4){0.f, 0.f, 0.f, 0.f}; if (!(PROMPT)) St[n] = *(const f32x4*)(a.in[4] + ((size_t)(sq * 32 + h) * 64 + 16 * wave + fr) * 64 + 16 * n + 4 * fq); } } \
            LAS unsigned char* rs = lds + O_RAW + ((cc) % NSL) * RAWB; const LAS unsigned char* co = lds + O_CO + ((cc) & 1) * CSET; \
            h16x4 sh[4]; \
            _Pragma("unroll") for (int n = 0; n < 4; ++n) { const f32x4 em = *(const LAS f32x4*)(co + 1536 + (16 * n + 4 * fq) * 4); const f32x4 x = St[n] * em; sh[n] = CVT4(x); } \
            const h16x4 vm = *(const LAS h16x4*)(rs + 8192 + ((16 * wave + fr) * 16 + 4 * fq) * 2); \
            f32x4 W1 = (f32x4){0.f, 0.f, 0.f, 0.f}, Yt = W1; \
            _Pragma("unroll") for (int n = 0; n < 4; ++n) { const int o_ = fr * 128 + (((2 * n + (fq >> 1)) ^ (fr & 7)) << 4) + 8 * (fq & 1); \
                W1 = MF(*(const LAS h16x4*)(rs + o_), sh[n], W1); Yt = MF(*(const LAS h16x4*)(rs + 2048 + o_), sh[n], Yt); } \
            W1 = MF(*(const LAS h16x4*)(co + (fr * 16 + 4 * fq) * 2), vm, W1); \
            Yt = MF(*(const LAS h16x4*)(co + 512 + (fr * 16 + 4 * fq) * 2), vm, Yt); \
            const h16x4 w1h = CVT4(W1); \
            f32x4 U = MF(*(const LAS h16x4*)(rs + 10240 + (fr * 16 + 4 * fq) * 2), w1h, ((f32x4){0.f, 0.f, 0.f, 0.f})); \
            const f32x4 nU = -U; const h16x4 uh = CVT4(nU); \
            Yt = MF(*(const LAS h16x4*)(co + 1024 + (fr * 16 + 4 * fq) * 2), uh, Yt); \
            _Pragma("unroll") for (int n = 0; n < 4; ++n) { const int tr_ = 4 * fq + (fr >> 2); const int o_ = tr_ * 128 + (((2 * n + ((fr & 3) >> 1)) ^ (tr_ & 7)) << 4) + 8 * (fr & 1);     \
                f32x4 tmp = MF(TRR(rs + 6144 + o_), vm, ((f32x4){0.f, 0.f, 0.f, 0.f})); tmp = MF(TRR(rs + 4096 + o_), uh, tmp); \
                const f32x4 gm = *(const LAS f32x4*)(co + 2048 + (16 * n + 4 * fq) * 4), e4 = *(const LAS f32x4*)(co + 1792 + (16 * n + 4 * fq) * 4); \
                St[n] = gm * St[n] + e4 * tmp; } \
            { LAS h16* yb = (LAS h16*)(lds + O_YB + ((cc) & 1) * 2048) + (4 * fq) * 64 + 16 * wave + fr; (void)t0; \
              yb[0] = (h16)Yt[0]; yb[64] = (h16)Yt[1]; yb[128] = (h16)Yt[2]; yb[192] = (h16)Yt[3]; } \
            if (last) { _Pragma("unroll") for (int n = 0; n < 4; ++n) *(f32x4*)(sp + 16 * n) = St[n]; } } } while (0)
#define SC_YOUT(cc) do { if ((cc) >= 0 && (cc) < NCHB && wave >= 5) { SC_DESC(cc, prompt, sq, h, t0, first, last); (void)first; (void)last; \
            const int L_ = (wave - 5) * 64 + lane, t_ = L_ >> 3, part_ = L_ & 7; \
            *(u32x4*)(OUT16 + ((size_t)(prompt ? sq * 4096 : MP + sq * 64) + t0 + t_) * D + h * 64 + part_ * 8) = *(const LAS u32x4*)(lds + O_YB + ((cc) & 1) * 2048 + t_ * 128 + part_ * 16); } } while (0)
#define SC_BARRIER() do { asm volatile("s_waitcnt lgkmcnt(0)" ::: "memory"); __builtin_amdgcn_s_barrier(); asm volatile("" ::: "memory"); } while (0)
        if (wave < 4) {
            SC_BARRIER();
            if (pblk) { for (int it = -1; it <= NCHB; ++it) { SC_ROW(it, true); SC_BARRIER(); } }
            else { for (int it = -1; it <= NCHB; ++it) { SC_ROW(it, false); SC_BARRIER(); } }
        } else if (wave == 7) {
            SC_DMA(0); SC_DMA(1); SC_DMA(2); SC_DMA(3); SC_DMA(4);
            asm volatile("s_waitcnt vmcnt(48)" ::: "memory");
            SC_BARRIER();
            for (int it = -1; it <= NCHB; ++it) {
                SC_DMA(it + 6);
                if (it + 6 < NCHB) asm volatile("s_waitcnt vmcnt(48)" ::: "memory");
                else asm volatile("s_waitcnt vmcnt(0)" ::: "memory");
                SC_BARRIER();
            }
        } else {
            SC_BARRIER();
            for (int it = -1; it <= NCHB; ++it) { SC_C(it + 1); SC_YOUT(it - 1); SC_BARRIER(); }
        }
#undef SC_DESC
#undef SC_DMA
#undef MF
#undef SC_C
#undef CVT4
#undef TRR
#undef SC_ROW
#undef SC_BARRIER
#undef SC_YOUT
    }
    SEAM(PH_SCAN);
    if (IN(PH_MERGE)) {
        const float* cw = a.in[22]; const float* RK = (const float*)(ws + WS_RK);
        for (int r2 = bx; r2 < MT / 2; r2 += G) {
            const int row = 2 * r2 + (tid >> 8), o8 = tid & 255, c0 = o8 * 8, hd = o8 >> 3;
            const bool pr = row < MP; const int tt = pr ? (row & 4095) : ((row - MP) & 63), sq = pr ? (row >> 12) : ((row - MP) >> 6), T = pr ? 4096 : 64;
            const h16* prow = P16 + (size_t)row * PP;
            const h16x8 ov = *(const h16x8*)(A16 + (size_t)row * D + c0);
            float vsh[8];
            { const h16* vb = P16 + (size_t)((row & ~15) + ((c0 & 63) >> 2)) * PP + 2 * D + (c0 & ~63) + (row & 15);
#pragma unroll
              for (int j = 0; j < 8; ++j) vsh[j] = (float)vb[(size_t)(j >> 2) * PP + (j & 3) * 16]; }
            const h16x8 gv = *(const h16x8*)(EAG + (size_t)row * 6144 + 2 * D + c0);
            const h16x8 gb = *(const h16x8*)(prow + C_GB + c0), gc = *(const h16x8*)(prow + C_GC + c0), xc = *(const h16x8*)(prow + C_XC + c0), ga = *(const h16x8*)(prow + C_GA + c0), gg = *(const h16x8*)(prow + C_GG + c0);
            float u1[8], u2[8];
            if (tt >= 1) { const h16x8 g1 = *(const h16x8*)(prow - PP + C_GC + c0), x1 = *(const h16x8*)(prow - PP + C_XC + c0);
#pragma unroll
                for (int j = 0; j < 8; ++j) u1[j] = (float)g1[j] * (float)x1[j];
            } else {
#pragma unroll
                for (int j = 0; j < 8; ++j) u1[j] = pr ? 0.f : a.in[3][(size_t)sq * 2 * D + D + c0 + j]; }
            if (tt >= 2) { const h16x8 g2 = *(const h16x8*)(prow - 2 * PP + C_GC + c0), x2 = *(const h16x8*)(prow - 2 * PP + C_XC + c0);
#pragma unroll
                for (int j = 0; j < 8; ++j) u2[j] = (float)g2[j] * (float)x2[j];
            } else {
#pragma unroll
                for (int j = 0; j < 8; ++j) u2[j] = pr ? 0.f : a.in[3][(size_t)sq * 2 * D + (size_t)tt * D + c0 + j]; }
            const float rk = RK[(size_t)row * 32 + hd];
            float of[8], s1 = 0.f;
#pragma unroll
            for (int j = 0; j < 8; ++j) { of[j] = (float)ov[j]; s1 += of[j]; }
            const float mean = row_allreduce8(s1) * (1.f / 64.f); float s2 = 0.f;
#pragma unroll
            for (int j = 0; j < 8; ++j) { of[j] -= mean; s2 += of[j] * of[j]; }
            const float rstd = rsqrtf(row_allreduce8(s2) * (1.f / 64.f) + 64e-5f);
            float mg[8], u0[8];
#pragma unroll
            for (int j = 0; j < 8; ++j) {
                const float vs = vsh[j];
                const float ya = (of[j] * rstd * a.in[20][c0 + j] + a.in[21][c0 + j] + rk * vs) * (float)gv[j];
                u0[j] = (float)gc[j] * (float)xc[j];
                const float cv = cw[c0 + j] * u2[j] + cw[D + c0 + j] * u1[j] + cw[2 * D + c0 + j] * u0[j];
                mg[j] = sigmoidf_((float)ga[j]) * ya + sigmoidf_((float)gg[j]) * ((float)gb[j] * cv); }
            *(u32x4*)(A16 + (size_t)row * D + c0) = (u32x4){pk2h(mg[0], mg[1]), pk2h(mg[2], mg[3]), pk2h(mg[4], mg[5]), pk2h(mg[6], mg[7])};
            if (tt >= T - 2) { float* q = a.out + (pr ? O_CVP : O_CVS) + (size_t)sq * 2 * D + (size_t)(tt - (T - 2)) * D + c0;
                *(f32x4*)q = (f32x4){u0[0], u0[1], u0[2], u0[3]}; *(f32x4*)(q + 4) = (f32x4){u0[4], u0[5], u0[6], u0[7]}; }
        }
    }
    SEAM(PH_MERGE);
    if (IN(PH_WOUT)) {
        { pg8::Gemm g{A16, WOUT, MT, D, D}; pg8::Order S; S.init(MT, D, D, G, bx, 0, MP / 256); pg8::EpiRes E{Y, Y + (size_t)MP * D, Y, SLAB, 1.0f, 0}; pg8::gemm_phase(lds, g, S, E); }
        LAS float* scr = (LAS float*)(lds + wave * 16384);
        constexpr int I1 = (D / 64) * (2 * FF / 32), I2 = (FF / 64) * (D / 32);
        for (int it = gw; it < I1 + I2; it += NGW) {
            if (it < I1) cvt_item(1, a.in[25], a.in[26], FF, D, W2GU, scr, it, 2 * FF / 32, lane);
            else cvt_item(0, a.in[27], nullptr, D, FF, W2D, scr, it - I1, D / 32, lane);
        }
    }
    SEAM(PH_WOUT);
    if (IN(PH_RMS2)) { for (int m = gw; m < MT; m += NGW) { if (m < MP) rms_row_f16(Y + (size_t)m * D, a.in[24], A16 + (size_t)m * D, nullptr, lane);
            else rms_row_f16(Y + (size_t)m * D, a.in[24], A16 + (size_t)m * D, nullptr, lane, SLAB + (size_t)(m - MP) * D, 1.0f, Y + (size_t)m * D); } }
    SEAM(PH_RMS2);
    if (IN(PH_FFN2_GU)) { pg8::Gemm g{A16, W2GU, MT, 2 * FF, D}; pg8::Order S; S.init(MT, 2 * FF, D, G, bx, 0, -1); pg8::EpiSwiGLU E{HM, FF}; pg8::gemm_phase(lds, g, S, E); }
    SEAM(PH_FFN2_GU);
    if (IN(PH_FFN2_D)) { pg8::Gemm g{HM, W2D, MT, D, FF}; pg8::Order S; S.init(MT, D, FF, G, bx, 0, MP / 256); pg8::EpiRes E{Y, Y + (size_t)MP * D, Y, SLAB, 0.5f, 0}; pg8::gemm_phase(lds, g, S, E); }
    SEAM(PH_FFN2_D);
    if (IN(PH_FINAL)) { for (int m = gw; m < MT; m += NGW) { if (m < MP) rms_row_f16(Y + (size_t)m * D, a.in[28], nullptr, Y + (size_t)m * D, lane);
            else rms_row_f16(Y + (size_t)m * D, a.in[28], nullptr, Y + (size_t)m * D, lane, SLAB + (size_t)(m - MP) * D, 0.5f, nullptr); } }
    if (PROBE_MASK) {
        pr_t[PH_N] = __builtin_amdgcn_s_memrealtime();
        if (bx == 0 && tid == 0) { unsigned long long tot = 0;
#pragma unroll
            for (int k = 0; k < PH_N; ++k) if ((PROBE_MASK >> k) & 1u) tot += pr_t[k + 1] - pr_t[k];
            const unsigned long long t0 = __builtin_amdgcn_s_memrealtime();
            while (__builtin_amdgcn_s_memrealtime() - t0 < tot) __builtin_amdgcn_s_sleep(8);
        }
    }
#undef IN
#undef SEAM
}

extern "C" void kernel_launch(void* const* d_in, const int* in_sizes, int n_in, void* d_out, int out_size, void* d_ws, size_t ws_size, hipStream_t stream) {
    static int grid = 0;
    if (grid == 0) {
        if (n_in != 29 || (size_t)out_size != O_END || ws_size < WS_END) { fprintf(stderr, "kernel_launch: unexpected shapes (n_in %d out %d ws %zu need %zu)\n", n_in, out_size, ws_size, (size_t)WS_END); grid = -1; return; }
        int dev = 0, cus = 0, per_cu = 0;
        if (hipGetDevice(&dev) != hipSuccess || hipDeviceGetAttribute(&cus, hipDeviceAttributeMultiprocessorCount, dev) != hipSuccess) { grid = -1; return; }
        if (hipFuncSetAttribute((const void*)fwd_kernel, hipFuncAttributeMaxDynamicSharedMemorySize, LDS_BYTES) != hipSuccess) { grid = -1; return; }
        if (hipOccupancyMaxActiveBlocksPerMultiprocessor(&per_cu, (const void*)fwd_kernel, NTHR, LDS_BYTES) != hipSuccess || per_cu < 1) { fprintf(stderr, "kernel_launch: occupancy query failed (%d)\n", per_cu); grid = -1; return; }
        grid = cus;
    }
    if (grid < 0) return;
    if (hipMemsetAsync((char*)d_ws + WS_CTL, 0, XCD_BAR_WORDS * 4, stream) != hipSuccess) return;
    Args a{};
    for (int i = 0; i < 29; ++i) a.in[i] = (const float*)d_in[i];
    a.out = (float*)d_out; a.ws = (unsigned char*)d_ws; a.ph_lo = 0; a.ph_hi = PH_N;
    void* kargs[] = {&a};
    hipError_t e = hipLaunchCooperativeKernel((const void*)fwd_kernel, dim3(grid), dim3(NTHR), kargs, LDS_BYTES, stream);
    if (e != hipSuccess) fprintf(stderr, "kernel_launch: cooperative launch failed: %s (grid %d)\n", hipGetErrorString(e), grid);
}
```

```cpp
#include <hip/hip_runtime.h>
#include <hip/hip_cooperative_groups.h>
#include <cstdio>
namespace cg = cooperative_groups;

#define LAS __attribute__((address_space(3)))
typedef _Float16 h16;
typedef _Float16 h16x2 __attribute__((ext_vector_type(2)));
typedef _Float16 h16x4 __attribute__((ext_vector_type(4)));
typedef _Float16 h16x8 __attribute__((ext_vector_type(8)));
typedef short s16x4 __attribute__((ext_vector_type(4)));
typedef float f32x4 __attribute__((ext_vector_type(4)));
typedef float f32x2 __attribute__((ext_vector_type(2)));
typedef unsigned u32x4 __attribute__((ext_vector_type(4)));
typedef unsigned u32x2 __attribute__((ext_vector_type(2)));

constexpr int D = 2048, FF = 5632, NA = 6592, NIN = 16832;
constexpr int MP = 8192, MS = 2048, MT = MP + MS;
constexpr int MA = MT + 256;
constexpr int PP = 16896;
constexpr int PFW = 6656;
constexpr int C_GB = 6656, C_GC = 8704, C_XC = 10752, C_GA = 12800, C_GG = 14848;
constexpr int LK = 512;
constexpr int NCHUNK = MT / 64;
constexpr size_t O_Y = 0, O_SHP = 20971520, O_CVP = 20975616, O_WKP = 20983808, O_SHS = 21245952, O_CVS = 21311488, O_WKS = 21442560, O_END = 25636864;
constexpr size_t WS_CTL = 0;
constexpr size_t WS_W1GU = 1u << 20;
constexpr size_t WS_W1D = WS_W1GU + (size_t)2 * FF * D * 2;
constexpr size_t WS_WIN = WS_W1D + (size_t)D * FF * 2;
constexpr size_t WS_WOUT = WS_WIN + (size_t)PP * D * 2;
constexpr size_t WS_A16 = WS_WOUT + (size_t)D * D * 2;
constexpr size_t WS_P16 = WS_A16 + (size_t)MA * D * 2;
constexpr size_t WS_PF = WS_P16 + (size_t)MT * PP * 2;
constexpr size_t WS_END = WS_PF + (size_t)256 * PFW * 2;
constexpr size_t WS_EAG = WS_W1GU;
constexpr size_t WS_HM = WS_P16;
constexpr size_t WS_W2GU = WS_P16 + (size_t)MT * FF * 2;
constexpr size_t WS_W2D = WS_W2GU + (size_t)2 * FF * D * 2;
constexpr size_t WS_SLAB = WS_W2D + (size_t)D * FF * 2;
static_assert((size_t)MT * 6144 * 2 <= WS_WOUT - WS_W1GU, "EAG overlay");
static_assert(WS_SLAB + (size_t)4 * MS * D * 4 <= WS_PF, "W2 + slab overlay");
constexpr size_t OB_WL = O_WKS * 4;
constexpr size_t OB_SIDE = OB_WL + (size_t)6144 * LK * 2;
static_assert(OB_SIDE + (size_t)(MT / 16) * 6144 * 2 <= O_END * 4, "d_out scratch");

constexpr size_t WS_RK = WS_EAG + (size_t)MT * 6144 * 2;
constexpr size_t WS_LM = WS_RK + (size_t)MT * 32 * 4;
static_assert(WS_LM + (size_t)(MT / 16) * 32 * 128 * 4 <= WS_WOUT, "RK + LM");
constexpr int SC_SLOT = 6 * 64, SC_BUF = 16 * SC_SLOT;
constexpr int NWAVES = 8, NTHR = 512;
constexpr int LDS_BYTES = 147456;

__device__ __forceinline__ unsigned pk2h(float a, float b) { h16x2 v = {(h16)a, (h16)b}; return __builtin_bit_cast(unsigned, v); }
__device__ __forceinline__ float wave_sum(float v) {
#pragma unroll
    for (int o = 1; o < 64; o <<= 1) v += __shfl_xor(v, o);
    return v;
}
template <int CTRL> __device__ __forceinline__ float dpp_f(float x) { return __builtin_bit_cast(float, __builtin_amdgcn_update_dpp(0, __builtin_bit_cast(int, x), CTRL, 0xF, 0xF, false)); }
__device__ __forceinline__ float row_allreduce8(float x) { x += dpp_f<0xB1>(x); x += dpp_f<0x4E>(x); x += dpp_f<0x141>(x); return x; }
__device__ __forceinline__ float row_allreduce16(float x) { x = row_allreduce8(x); x += dpp_f<0x140>(x); return x; }
__device__ __forceinline__ float rl_f(float x, int l) { return __builtin_bit_cast(float, __builtin_amdgcn_readlane(__builtin_bit_cast(int, x), l)); }
__device__ __forceinline__ float wave_sum_dpp(float x) { x = row_allreduce16(x); return (rl_f(x, 0) + rl_f(x, 16)) + (rl_f(x, 32) + rl_f(x, 48)); }
__device__ __forceinline__ float wave_sum_bc(float x) {
    x = row_allreduce16(x);
    x += __builtin_bit_cast(float, __builtin_amdgcn_update_dpp(0, __builtin_bit_cast(int, x), 0x142, 0xA, 0xF, false));
    x += __builtin_bit_cast(float, __builtin_amdgcn_update_dpp(0, __builtin_bit_cast(int, x), 0x143, 0xC, 0xF, false));
    return rl_f(x, 63); }
__device__ __forceinline__ float sigmoidf_(float x) { return 1.0f / (1.0f + __expf(-x)); }

namespace pg8 {
constexpr int BM = 256, BK = 64, HALF = 128, HTB = HALF * BK * 2, STAGE_BYTES = 8 * HTB, NXCD = 8, WGM = 8;
__host__ __device__ __forceinline__ int lds_byte(int r, int c) { const int st = (r >> 4) * 2 + (c >> 5), rr = r & 15, cc = c & 31, ob = rr * 64 + cc * 2; return st * 1024 + (ob ^ (((ob >> 9) & 1) << 5)); }
__host__ __device__ __forceinline__ void stage_rc(int b, int& R, int& C) { const int st = b / 1024, sb = b % 1024, swz = sb ^ (((sb >> 9) & 1) << 5); R = (st >> 1) * 16 + swz / 64; C = (st & 1) * 32 + (swz % 64) / 2; }
__host__ __device__ __forceinline__ int perm32(int rho) { const int n = rho >> 4, i = rho & 15; return 8 * (i >> 2) + 4 * n + (i & 3); }
struct Unit { int pm, pn, kt0, nkt, sp; };
struct Gemm { const h16* A; const h16* Bt; int M, N, K; };
struct Order {
    int nM, nN, nwg, G, c, extra, nkt, nsplit;
    __device__ void init(int M, int N, int K, int G_, int c_, int extra_, int nMw) { nM = M / BM; nN = N / BM; nwg = (nMw < 0 ? nM : nMw) * nN; G = G_; c = c_; extra = extra_; nkt = K / BK; nsplit = nMw < 0 ? 0 : (nM - nMw) * nN * 4; }
    __device__ bool next(int i, Unit& u) const {
        const long L = (long)i * G + c; if (L >= nwg + extra + nsplit) return false;
        u.kt0 = 0; u.nkt = nkt; u.sp = -1;
        if (L >= nwg + extra) { const int j = (int)(L - nwg - extra), rows = nM - nwg / nN; u.nkt = nkt >> 2;
            if (rows == 8 && nN == 8) {
                const int xcd = j & 7, idx = j >> 3; u.sp = xcd >> 1; u.pn = 4 * (xcd & 1) + (idx >> 3); u.pm = nwg / nN + (idx & 7); }
            else { const int tile = j >> 2; u.sp = j & 3; u.pm = nwg / nN + tile % rows; u.pn = tile / rows; }
            u.kt0 = u.sp * u.nkt; return true; }
        if (L >= nwg) { u.pm = nM; u.pn = (int)(L - nwg); return true; }
        const int nMe = nwg / nN;
        int wgid = (int)L; { const int q = nwg / NXCD, r = nwg % NXCD, xcd = wgid % NXCD, off = wgid / NXCD; wgid = (xcd < r ? xcd * (q + 1) : r * (q + 1) + (xcd - r) * q) + off; }
        const int nig = WGM * nN, gid = wgid / nig, fm = gid * WGM, gsz = (nMe - fm) < WGM ? (nMe - fm) : WGM;
        u.pm = fm + ((wgid % nig) % gsz); u.pn = (wgid % nig) / gsz; return true;
    }
};

template <class Epi, bool SP2 = true, bool ALIGN_EPI = true>
__device__ __forceinline__ void gemm_phase(LAS unsigned char* lds, const Gemm g, const Order& S, const Epi& E) {
    const int tid = threadIdx.x, wid = __builtin_amdgcn_readfirstlane(tid >> 6), lane = tid & 63, wr = wid >> 2, wc = wid & 3, fr = lane & 15, fq = lane >> 4;
    const int K = g.K;
    unsigned voffA[2], voffB[2];
#pragma unroll
    for (int i = 0; i < 2; ++i) { int R, C; stage_rc(tid * 16 + i * 8192, R, C); const int Rb = Epi::PERM ? ((R & ~31) + perm32(R & 31)) : R;
        voffA[i] = (unsigned)(R * K + C) * 2u; voffB[i] = (unsigned)(Rb * K + C) * 2u; }
    const size_t kstep = (size_t)(BK * 2);
    const size_t hstep = (size_t)HALF * K * 2;
    const size_t tstep = 2 * hstep;
    const unsigned ldsw = (unsigned)wid * 1024u;
    const int aoff = lds_byte(wr * 64 + fr, fq * 8), boff = lds_byte(wc * 32 + fr, fq * 8);
#define PG8_SA(b, h) (((b) * 2 + (h)) * HTB)
#define PG8_SB(b, h) ((4 + (b) * 2 + (h)) * HTB)
#define PG8_STAGE(bufoff, gbase, voff) do { _Pragma("unroll") for (int _i = 0; _i < 2; ++_i) \
        __builtin_amdgcn_global_load_lds((const unsigned*)((const char*)(gbase) + (voff)[_i]), (LAS unsigned*)(lds + (bufoff) + ldsw + _i * 8192), 16, 0, 0); } while (0)
#define PG8_LDA(dst, b, h) do { _Pragma("unroll") for (int m = 0; m < 4; ++m) _Pragma("unroll") for (int k = 0; k < 2; ++k) dst[m][k] = *(const LAS h16x8*)(lds + PG8_SA(b, h) + aoff + m * 2048 + k * 1024); } while (0)
#define PG8_LDB(dst, b, h) do { _Pragma("unroll") for (int n = 0; n < 2; ++n) _Pragma("unroll") for (int k = 0; k < 2; ++k) dst[n][k] = *(const LAS h16x8*)(lds + PG8_SB(b, h) + boff + n * 2048 + k * 1024); } while (0)
#define PG8_MMA(ai, bj, At, Bt) do { __builtin_amdgcn_s_setprio(1); _Pragma("unroll") for (int m = 0; m < 4; ++m) _Pragma("unroll") for (int n = 0; n < 2; ++n) _Pragma("unroll") for (int k = 0; k < 2; ++k) \
        acc[ai][bj][m][n] = __builtin_amdgcn_mfma_f32_16x16x32_f16(Bt[n][k], At[m][k], acc[ai][bj][m][n], 0, 0, 0); __builtin_amdgcn_s_setprio(0); } while (0)
#define PG8_WAIT_V(n) asm volatile("s_waitcnt vmcnt(" #n ")" ::: "memory")
#define PG8_WAIT_L(n) asm volatile("s_waitcnt lgkmcnt(" #n ")" ::: "memory")
#define PG8_BAR __builtin_amdgcn_s_barrier()
#define PG8_SCHED __builtin_amdgcn_sched_barrier(0)
    Unit cur, nxt; int ui = 0;
    if (!S.next(0, cur)) return;
    f32x4 acc[2][2][4][2];
#pragma unroll
    for (int a = 0; a < 2; ++a)
#pragma unroll
        for (int b = 0; b < 2; ++b)
#pragma unroll
            for (int m = 0; m < 4; ++m)
#pragma unroll
                for (int n = 0; n < 2; ++n) acc[a][b][m][n] = (f32x4){0.f, 0.f, 0.f, 0.f};
    h16x8 At[4][2], B0[2][2], B1[2][2];
    const char* cA = (const char*)g.A + (size_t)cur.pm * tstep + (size_t)cur.kt0 * kstep; const char* cB = (const char*)g.Bt + (size_t)cur.pn * tstep + (size_t)cur.kt0 * kstep;
    if constexpr (SP2) {
        PG8_STAGE(PG8_SB(0, 0), cB, voffB); PG8_STAGE(PG8_SB(0, 1), cB + hstep, voffB); PG8_STAGE(PG8_SA(0, 0), cA, voffA); PG8_STAGE(PG8_SA(0, 1), cA + hstep, voffA);
        if (wr == 1) PG8_BAR;
        PG8_WAIT_V(2); PG8_BAR;
        PG8_STAGE(PG8_SB(1, 0), cB + kstep, voffB); PG8_STAGE(PG8_SA(1, 0), cA + kstep, voffA); PG8_STAGE(PG8_SB(1, 1), cB + hstep + kstep, voffB);
        PG8_WAIT_V(6); PG8_BAR;
    } else {
        PG8_STAGE(PG8_SB(0, 0), cB, voffB); PG8_STAGE(PG8_SA(0, 0), cA, voffA); PG8_STAGE(PG8_SB(0, 1), cB + hstep, voffB); PG8_STAGE(PG8_SA(0, 1), cA + hstep, voffA);
        if (wr == 1) PG8_BAR;
        PG8_WAIT_V(4); PG8_BAR;
        PG8_STAGE(PG8_SB(1, 0), cB + kstep, voffB); PG8_STAGE(PG8_SA(1, 0), cA + kstep, voffA); PG8_STAGE(PG8_SB(1, 1), cB + hstep + kstep, voffB);
        PG8_WAIT_V(6); PG8_BAR;
    }
    for (;;) {
        const bool has_next = S.next(ui + 1, nxt);
        const char* nA = has_next ? (const char*)g.A + (size_t)nxt.pm * tstep + (size_t)nxt.kt0 * kstep : cA; const char* nB = has_next ? (const char*)g.Bt + (size_t)nxt.pn * tstep + (size_t)nxt.kt0 * kstep : cB;
        const int nt = cur.nkt;
        for (int t = 0; t < nt; t += 2) {
            const bool last = (t == nt - 2);
            const char* a1 = cA + (size_t)(t + 1) * kstep;
            const char* a2 = last ? nA : cA + (size_t)(t + 2) * kstep; const char* b2 = last ? nB : cB + (size_t)(t + 2) * kstep;
            const char* a3 = a2 + kstep; const char* b3 = b2 + kstep;
            if constexpr (SP2) {
            PG8_LDB(B0, 0, 0); PG8_LDB(B1, 0, 1); PG8_SCHED; PG8_LDA(At, 0, 0); PG8_STAGE(PG8_SA(1, 1), a1 + hstep, voffA);
            PG8_WAIT_V(8); PG8_WAIT_L(0); PG8_BAR; PG8_MMA(0, 0, At, B0); PG8_MMA(0, 1, At, B1); PG8_BAR; PG8_SCHED;
            PG8_LDA(At, 0, 1); PG8_STAGE(PG8_SB(0, 0), b2, voffB); PG8_STAGE(PG8_SB(0, 1), b2 + hstep, voffB); PG8_STAGE(PG8_SA(0, 0), a2, voffA);
            PG8_WAIT_V(8); PG8_WAIT_L(0); PG8_BAR; PG8_MMA(1, 0, At, B0); PG8_MMA(1, 1, At, B1); PG8_BAR; PG8_SCHED;
            PG8_LDB(B0, 1, 0); PG8_LDB(B1, 1, 1); PG8_SCHED; PG8_LDA(At, 1, 0); PG8_STAGE(PG8_SA(0, 1), a2 + hstep, voffA);
            PG8_WAIT_V(8); PG8_WAIT_L(0); PG8_BAR; PG8_MMA(0, 0, At, B0); PG8_MMA(0, 1, At, B1); PG8_BAR; PG8_SCHED;
            PG8_LDA(At, 1, 1); PG8_STAGE(PG8_SB(1, 0), b3, voffB); PG8_STAGE(PG8_SB(1, 1), b3 + hstep, voffB); PG8_STAGE(PG8_SA(1, 0), a3, voffA);
            PG8_WAIT_V(8); PG8_WAIT_L(0); PG8_BAR; PG8_MMA(1, 0, At, B0); PG8_MMA(1, 1, At, B1); PG8_BAR; PG8_SCHED;
            } else {
            PG8_LDB(B0, 0, 0); PG8_SCHED; PG8_LDA(At, 0, 0); PG8_STAGE(PG8_SA(1, 1), a1 + hstep, voffA);
            PG8_WAIT_L(8); PG8_BAR; PG8_WAIT_L(0); PG8_MMA(0, 0, At, B0); PG8_BAR; PG8_SCHED;
            PG8_LDB(B1, 0, 1); PG8_STAGE(PG8_SB(0, 0), b2, voffB);
            PG8_BAR; PG8_WAIT_L(0); PG8_MMA(0, 1, At, B1); PG8_BAR;
            PG8_LDA(At, 0, 1); PG8_STAGE(PG8_SA(0, 0), a2, voffA);
            PG8_BAR; PG8_WAIT_L(0); PG8_MMA(1, 0, At, B0); PG8_BAR; PG8_SCHED;
            PG8_STAGE(PG8_SB(0, 1), b2 + hstep, voffB);
            PG8_WAIT_V(6); PG8_BAR; PG8_MMA(1, 1, At, B1); PG8_BAR;
            PG8_LDB(B0, 1, 0); PG8_SCHED; PG8_LDA(At, 1, 0); PG8_STAGE(PG8_SA(0, 1), a2 + hstep, voffA);
            PG8_WAIT_L(8); PG8_BAR; PG8_WAIT_L(0); PG8_MMA(0, 0, At, B0); PG8_BAR; PG8_SCHED;
            PG8_LDB(B1, 1, 1); PG8_STAGE(PG8_SB(1, 0), b3, voffB);
            PG8_BAR; PG8_WAIT_L(0); PG8_MMA(0, 1, At, B1); PG8_BAR;
            PG8_LDA(At, 1, 1); PG8_STAGE(PG8_SA(1, 0), a3, voffA);
            PG8_BAR; PG8_WAIT_L(0); PG8_MMA(1, 0, At, B0); PG8_BAR; PG8_SCHED;
            PG8_STAGE(PG8_SB(1, 1), b3 + hstep, voffB);
            PG8_WAIT_V(6); PG8_BAR; PG8_MMA(1, 1, At, B1); PG8_BAR;
                    }
        }
        if constexpr (ALIGN_EPI) { if (wr == 0) PG8_BAR; }
        E(acc, cur, wr, wc, fr, fq);
        if (!has_next) break;
#pragma unroll
        for (int a = 0; a < 2; ++a)
#pragma unroll
            for (int b = 0; b < 2; ++b)
#pragma unroll
                for (int m = 0; m < 4; ++m)
#pragma unroll
                    for (int n = 0; n < 2; ++n) acc[a][b][m][n] = (f32x4){0.f, 0.f, 0.f, 0.f};
        cur = nxt; cA = nA; cB = nB; ++ui;
        if constexpr (ALIGN_EPI) { if (wr == 1) PG8_BAR; }
    }
    PG8_WAIT_V(0);
    if constexpr (!ALIGN_EPI) { if (wr == 0) PG8_BAR; }
    PG8_BAR;
#undef PG8_SA
#undef PG8_SB
#undef PG8_STAGE
#undef PG8_LDA
#undef PG8_LDB
#undef PG8_MMA
#undef PG8_WAIT_V
#undef PG8_WAIT_L
#undef PG8_BAR
#undef PG8_SCHED
}

struct EpiSwiGLU {
    static constexpr bool PERM = false;
    h16* O; int ldo;
    __device__ __forceinline__ void operator()(const f32x4 (&acc)[2][2][4][2], const Unit& u, int wr, int wc, int fr, int fq) const {
        const int row0 = u.pm * BM + wr * 64 + fr;
#pragma unroll
        for (int ai = 0; ai < 2; ++ai)
#pragma unroll
            for (int m = 0; m < 4; ++m) { h16* rowp = O + (size_t)(row0 + ai * HALF + m * 16) * ldo;
#pragma unroll
                for (int bj = 0; bj < 2; ++bj) { const int oc = (u.pn * BM + bj * HALF + wc * 32) / 2 + 4 * fq;
                    const f32x4 gt = acc[ai][bj][m][0], up = acc[ai][bj][m][1]; float o[4];
#pragma unroll
                    for (int j = 0; j < 4; ++j) o[j] = gt[j] * sigmoidf_(gt[j]) * up[j];
                    u32x2 w; w.x = pk2h(o[0], o[1]); w.y = pk2h(o[2], o[3]);
                    *(u32x2*)(rowp + oc) = w; } }
    }
};
struct EpiRes {
    static constexpr bool PERM = false;
    const float* r0; const float* r1; float* out; float* slab; float scale; int pad;
    __device__ __forceinline__ void operator()(const f32x4 (&acc)[2][2][4][2], const Unit& u, int wr, int wc, int fr, int fq) const {
        const int row0 = u.pm * BM + wr * 64 + fr, col0 = u.pn * BM + wc * 32 + 4 * fq;
        if (u.sp >= 0) {
            float* sb = slab + ((size_t)u.sp * MS - MP) * D;
#pragma unroll
            for (int ai = 0; ai < 2; ++ai)
#pragma unroll
                for (int m = 0; m < 4; ++m) { const size_t off = (size_t)(row0 + ai * HALF + m * 16) * D + col0;
#pragma unroll
                    for (int bj = 0; bj < 2; ++bj)
#pragma unroll
                        for (int n = 0; n < 2; ++n) *(f32x4*)(sb + off + bj * HALF + n * 16) = acc[ai][bj][m][n]; }
            return;
        }
        const float* rb = (u.pm * BM < MP) ? r0 : r1 - (size_t)MP * D;
#pragma unroll
        for (int ai = 0; ai < 2; ++ai)
#pragma unroll
            for (int m = 0; m < 4; ++m) { const size_t off = (size_t)(row0 + ai * HALF + m * 16) * D + col0;
#pragma unroll
                for (int bj = 0; bj < 2; ++bj)
#pragma unroll
                    for (int n = 0; n < 2; ++n) { const f32x4 rv = *(const f32x4*)(rb + off + bj * HALF + n * 16);
                        *(f32x4*)(out + off + bj * HALF + n * 16) = rv + scale * acc[ai][bj][m][n]; } }
    }
};
struct EpiP16 {
    static constexpr bool PERM = true;
    h16* P; h16* PF;
    __device__ __forceinline__ void operator()(const f32x4 (&acc)[2][2][4][2], const Unit& u, int wr, int wc, int fr, int fq) const {
        const int row0 = u.pm * BM + wr * 64 + fr;
#pragma unroll
        for (int ai = 0; ai < 2; ++ai)
#pragma unroll
            for (int m = 0; m < 4; ++m) { const int row = row0 + ai * HALF + m * 16;
#pragma unroll
                for (int bj = 0; bj < 2; ++bj) { const int col = u.pn * BM + bj * HALF + wc * 32 + 8 * fq;
                    const f32x4 v0 = acc[ai][bj][m][0], v1 = acc[ai][bj][m][1];
                    u32x4 w; w.x = pk2h(v0[0], v0[1]); w.y = pk2h(v0[2], v0[3]); w.z = pk2h(v1[0], v1[1]); w.w = pk2h(v1[2], v1[3]);
                    if (u.pm < MT / BM) *(u32x4*)(P + (size_t)row * PP + col) = w;
                    else *(u32x4*)(PF + (size_t)(row - MT) * PFW + col) = w; } }
    }
};
struct EpiEAG {
    static constexpr bool PERM = true;
    h16* O; const float* w0; const float* a0;
    __device__ __forceinline__ void operator()(const f32x4 (&acc)[2][2][4][2], const Unit& u, int wr, int wc, int fr, int fq) const {
        const int row0 = u.pm * BM + wr * 64 + fr; const int typ = u.pn >> 3;
#pragma unroll
        for (int bj = 0; bj < 2; ++bj) { const int col = u.pn * BM + bj * HALF + wc * 32 + 8 * fq;
            f32x4 b0 = (f32x4){0.f, 0.f, 0.f, 0.f}, b1 = b0;
            if (typ == 0) { b0 = *(const f32x4*)(w0 + col); b1 = *(const f32x4*)(w0 + col + 4); }
            if (typ == 1) { b0 = *(const f32x4*)(a0 + col - D); b1 = *(const f32x4*)(a0 + col - D + 4); }
#pragma unroll
            for (int ai = 0; ai < 2; ++ai)
#pragma unroll
                for (int m = 0; m < 4; ++m) { const int row = row0 + ai * HALF + m * 16;
                    f32x4 v0 = acc[ai][bj][m][0] + b0, v1 = acc[ai][bj][m][1] + b1;
                    if (typ < 2) { const float sc = typ == 0 ? 0.60653065971f : 1.0f;
#pragma unroll
                        for (int j = 0; j < 4; ++j) { v0[j] = sigmoidf_(v0[j]) * sc; v1[j] = sigmoidf_(v1[j]) * sc; } }
                    u32x4 w; w.x = pk2h(v0[0], v0[1]); w.y = pk2h(v0[2], v0[3]); w.z = pk2h(v1[0], v1[1]); w.w = pk2h(v1[2], v1[3]);
                    *(u32x4*)(O + (size_t)row * 6144 + col) = w; } }
    }
};
}


#define XB_TMO      128
#define XB_XCNT(j)  (256  + 64 * (j))
#define XB_XSUB(j)  (1280 + 64 * (j))
#define XB_XGEN(j)  (2304 + 64 * (j))
#define XB_TOP      3328
#define XB_TOPGEN   3392
#define XCD_BAR_WORDS 3456
#define XB_SPIN_CAP (1u << 22)
__device__ __forceinline__ unsigned xb_ld(unsigned* p)              { return __hip_atomic_load(p, __ATOMIC_RELAXED, __HIP_MEMORY_SCOPE_AGENT); }
__device__ __forceinline__ unsigned xb_add(unsigned* p, unsigned v) { return __hip_atomic_fetch_add(p, v, __ATOMIC_RELAXED, __HIP_MEMORY_SCOPE_AGENT); }
__device__ __forceinline__ unsigned xb_xcc_id() { return (unsigned)__builtin_amdgcn_s_getreg((3 << 11) | 20) & 0xFu; }
#define XB_SPIN(cond, bar) do { unsigned _sp = 0; while (cond) { __builtin_amdgcn_s_sleep(1); \
    if ((++_sp & 255u) == 0u) { if (xb_ld(&(bar)[XB_TMO])) break; if (_sp > XB_SPIN_CAP) { atomicAdd(&(bar)[XB_TMO], 1u); break; } } } } while (0)
struct XcdBarrier { unsigned* bar; unsigned x; volatile LAS unsigned* st; };
__device__ __forceinline__ XcdBarrier xcd_barrier_post(unsigned* bar, volatile LAS unsigned* st) {
    XcdBarrier b; b.bar = bar; b.x = xb_xcc_id(); b.st = st;
    if (threadIdx.x == 0) (void)xb_add(&bar[XB_XCNT(b.x)], 1u);
    return b;
}
__device__ __forceinline__ void xcd_barrier_complete(unsigned* bar, unsigned x, unsigned& nloc, unsigned& nx) {
    const unsigned G = gridDim.x * gridDim.y * gridDim.z;
    unsigned sum, cnt, mine, sp = 0u;
    for (;;) {
        sum = 0u; cnt = 0u; mine = 0u;
#pragma unroll
        for (unsigned j = 0; j < 16; ++j) { const unsigned c = xb_ld(&bar[XB_XCNT(j)]); sum += c; cnt += (c > 0u) ? 1u : 0u; mine = (j == x) ? c : mine; }
        if (sum == G) break;
        __builtin_amdgcn_s_sleep(1);
        if ((++sp & 255u) == 0u) { if (xb_ld(&bar[XB_TMO])) break; if (sp > XB_SPIN_CAP) { atomicAdd(&bar[XB_TMO], 1u); break; } }
    }
    nloc = mine > 0u ? mine : 1u; nx = cnt > 0u ? cnt : 1u;
}
__device__ __forceinline__ void xcd_barrier(const XcdBarrier& b) {
    asm volatile("s_waitcnt vmcnt(0)" ::: "memory");
    __syncthreads();
    if (threadIdx.x == 0) {
        unsigned* bar = b.bar;
        __builtin_amdgcn_s_waitcnt(0);
        unsigned nloc = b.st[0], nx = b.st[1];
        if (nloc == 0u) { xcd_barrier_complete(bar, b.x, nloc, nx); b.st[0] = nloc; b.st[1] = nx; }
        const unsigned old = xb_add(&bar[XB_XSUB(b.x)], 1u);
        const unsigned gen = old / nloc;
        if (old + 1u == (gen + 1u) * nloc) {
            __builtin_amdgcn_fence(__ATOMIC_RELEASE, "agent");
            asm volatile("s_waitcnt vmcnt(0)" ::: "memory");
            const unsigned og = xb_add(&bar[XB_TOP], 1u);
            const unsigned tg = og / nx;
            if (og + 1u == (tg + 1u) * nx) xb_add(&bar[XB_TOPGEN], 1u);
            else XB_SPIN(xb_ld(&bar[XB_TOPGEN]) == tg, bar);
            __builtin_amdgcn_fence(__ATOMIC_ACQUIRE, "agent");
            xb_add(&bar[XB_XGEN(b.x)], 1u);
            asm volatile("s_waitcnt vmcnt(0)" ::: "memory");
        } else {
            XB_SPIN(xb_ld(&bar[XB_XGEN(b.x)]) == gen, bar);
            __builtin_amdgcn_fence(__ATOMIC_ACQUIRE, "agent");
            asm volatile("s_waitcnt vmcnt(0)" ::: "memory");
        }
    }
    __syncthreads();
}

struct Args { const float* in[29]; float* out; unsigned char* ws; int ph_lo, ph_hi; };

__device__ __forceinline__ void cvt_item(int mode, const float* s0, const float* s1, int Nsrc, int K, h16* WT, LAS float* scr, int item, int nblk, int lane) {
    const int kb = item / nblk, nb = item % nblk, k0 = 64 * kb, n0 = 32 * nb;
    const int nn = lane & 31; const float* src = s0; int col = n0 + nn; bool zero = false;
    if (mode == 1) { src = (nn < 16) ? s0 : s1; col = (n0 >> 1) + (nn & 15); }
    if (mode == 2) { if (n0 >= NA && n0 < PFW) zero = true; else if (n0 >= PFW) col -= 64; }
#pragma unroll 8
    for (int i = 0; i < 32; ++i) { const int kk = 2 * i + (lane >> 5); scr[kk * 33 + nn] = zero ? 0.f : src[(size_t)(k0 + kk) * Nsrc + col]; }
    asm volatile("s_waitcnt lgkmcnt(0)" ::: "memory");
    const int c = lane & 7;
#pragma unroll
    for (int j = 0; j < 4; ++j) { const int n = (lane >> 3) + 8 * j; const LAS float* s = scr + (8 * c) * 33 + n;
        u32x4 o; o.x = pk2h(s[0 * 33], s[1 * 33]); o.y = pk2h(s[2 * 33], s[3 * 33]); o.z = pk2h(s[4 * 33], s[5 * 33]); o.w = pk2h(s[6 * 33], s[7 * 33]);
        *(u32x4*)(WT + (size_t)(n0 + n) * K + k0 + 8 * c) = o; }
    asm volatile("s_waitcnt lgkmcnt(0)" ::: "memory");
}
struct CvtIt { const float* p; h16* q; int Nsrc, K; bool zero; };
__device__ __forceinline__ CvtIt cvt_decode(int mode, const float* s0, const float* s1, int Nsrc, int K, h16* WT, int nblk, int item, int lane) {
    const int kb = item / nblk, nb = item % nblk, k0 = 64 * kb, n0 = 32 * nb, nn = lane & 31;
    const float* src = s0; int col = n0 + nn; bool zero = false;
    if (mode == 1) { src = (nn < 16) ? s0 : s1; col = (n0 >> 1) + (nn & 15); }
    if (mode == 2) { if (n0 >= NA && n0 < PFW) { zero = true; col = 0; } else if (n0 >= PFW) col -= 64; }
    CvtIt r; r.p = src + (size_t)(k0 + (lane >> 5)) * Nsrc + col; r.q = WT + (size_t)(n0 + (lane >> 3)) * K + k0 + 8 * (lane & 7); r.Nsrc = Nsrc; r.K = K; r.zero = zero; return r;
}
__device__ __forceinline__ void cvt_load(const CvtIt& t, float (&v)[32]) {
#pragma unroll
    for (int i = 0; i < 32; ++i) v[i] = t.p[(size_t)(2 * i) * t.Nsrc];
}
__device__ __forceinline__ void cvt_finish(const CvtIt& t, const float (&v)[32], LAS float* scr, int lane) {
    const int nn = lane & 31;
#pragma unroll
    for (int i = 0; i < 32; ++i) scr[(2 * i + (lane >> 5)) * 33 + nn] = t.zero ? 0.f : v[i];
    asm volatile("s_waitcnt lgkmcnt(0)" ::: "memory");
    const int c = lane & 7;
#pragma unroll
    for (int j = 0; j < 4; ++j) { const int n = (lane >> 3) + 8 * j; const LAS float* s = scr + (8 * c) * 33 + n;
        u32x4 o; o.x = pk2h(s[0 * 33], s[1 * 33]); o.y = pk2h(s[2 * 33], s[3 * 33]); o.z = pk2h(s[4 * 33], s[5 * 33]); o.w = pk2h(s[6 * 33], s[7 * 33]);
        *(u32x4*)(t.q + (size_t)(8 * j) * t.K) = o; }
    asm volatile("s_waitcnt lgkmcnt(0)" ::: "memory");
}
#define CVT_RUN(total_, PICK) do { float va[32], vb[32]; CvtIt A_, B_; int it_ = gw; if (it_ < (total_)) { PICK(it_, A_); cvt_load(A_, va); \
        for (;;) { const int itb_ = it_ + NGW; const bool hb_ = itb_ < (total_); if (hb_) { PICK(itb_, B_); cvt_load(B_, vb); } cvt_finish(A_, va, scr, lane); if (!hb_) break; \
            it_ = itb_ + NGW; const bool ha_ = it_ < (total_); if (ha_) { PICK(it_, A_); cvt_load(A_, va); } cvt_finish(B_, vb, scr, lane); if (!ha_) break; } } } while (0)
__device__ __forceinline__ void cvt_lora_item(const float* wl, const float* al, const float* gl, h16* WT, int item, int lane) {
    const int n = item, typ = n >> 11, col = n & 2047; unsigned w[4];
#pragma unroll
    for (int j = 0; j < 4; ++j) { float v[2];
#pragma unroll
        for (int e = 0; e < 2; ++e) { const int k = lane * 8 + j * 2 + e; float x = 0.f;
            if (typ == 0 && k < 96) x = wl[(size_t)k * D + col];
            if (typ == 1 && k >= 96 && k < 192) x = al[(size_t)(k - 96) * D + col];
            if (typ == 2 && k >= 192 && k < 448) x = gl[(size_t)(k - 192) * D + col];
            v[e] = x; }
        w[j] = pk2h(v[0], v[1]); }
    *(u32x4*)(WT + (size_t)n * LK + lane * 8) = (u32x4){w[0], w[1], w[2], w[3]};
}

__device__ __forceinline__ void rms_row_f16(const float* xrow, const float* g, h16* orow, float* f32row, int lane, const float* part = nullptr, float pscale = 0.f, float* xout = nullptr) {
    const f32x4* xr = (const f32x4*)xrow + lane; const f32x4* gr = (const f32x4*)g + lane;
    f32x4 v[8]; float s = 0.f;
#pragma unroll
    for (int j = 0; j < 8; ++j) { v[j] = xr[64 * j];
        if (part) { const f32x4* pp = (const f32x4*)part + lane + 64 * j; const size_t st = (size_t)MS * D / 4;
            v[j] += pscale * ((pp[0] + pp[st]) + (pp[2 * st] + pp[3 * st])); if (xout) *((f32x4*)xout + lane + 64 * j) = v[j]; }
        s += (v[j].x * v[j].x + v[j].y * v[j].y) + (v[j].z * v[j].z + v[j].w * v[j].w); }
    const float rs = rsqrtf(wave_sum(s) * (1.f / D) + 1e-6f);
#pragma unroll
    for (int j = 0; j < 8; ++j) { const f32x4 gg = gr[64 * j]; const f32x4 o = v[j] * rs * gg;
        if (orow) { u32x2 w; w.x = pk2h(o.x, o.y); w.y = pk2h(o.z, o.w); *((u32x2*)orow + lane + 64 * j) = w; }
        if (f32row) *((f32x4*)f32row + lane + 64 * j) = o; }
}

enum { PH_CVT1 = 0, PH_FFN1_GU, PH_FFN1_D, PH_RMS_MIX, PH_WIN, PH_SHIFT, PH_LORA, PH_PREP, PH_SCAN, PH_MERGE, PH_WOUT, PH_RMS2, PH_FFN2_GU, PH_FFN2_D, PH_FINAL, PH_N };

__global__ void __launch_bounds__(NTHR, 2) fwd_kernel(Args a) {
    extern __shared__ __attribute__((aligned(16))) unsigned char lds_raw[];
    LAS unsigned char* lds = (LAS unsigned char*)lds_raw;
    const int tid = threadIdx.x, lane = tid & 63, wave = __builtin_amdgcn_readfirstlane(tid >> 6);
    const int G = gridDim.x, bx = blockIdx.x;
    const int gw = bx * NWAVES + wave, NGW = G * NWAVES;
    unsigned char* ws = a.ws; unsigned char* ob = (unsigned char*)a.out;
    h16* W1GU = (h16*)(ws + WS_W1GU); h16* W1D = (h16*)(ws + WS_W1D); h16* WIN = (h16*)(ws + WS_WIN); h16* WOUT = (h16*)(ws + WS_WOUT);
    h16* A16 = (h16*)(ws + WS_A16); h16* P16 = (h16*)(ws + WS_P16); h16* EAG = (h16*)(ws + WS_EAG); h16* HM = (h16*)(ws + WS_HM);
    h16* W2GU = (h16*)(ws + WS_W2GU); h16* W2D = (h16*)(ws + WS_W2D);
    h16* WL = (h16*)(ob + OB_WL); h16* PF = (h16*)(ws + WS_PF);
    float* Y = a.out + O_Y; float* SLAB = (float*)(ws + WS_SLAB);
    const int lo = a.ph_lo, hi = a.ph_hi;
#define IN(k) (lo <= (k) && (k) < hi)
    cg::grid_group grid = cg::this_grid();
    volatile LAS unsigned* xst = (volatile LAS unsigned*)(lds + LDS_BYTES - 16);
    if (tid < 2) xst[tid] = 0u;
    __syncthreads();
    const XcdBarrier xbar = xcd_barrier_post((unsigned*)(ws + WS_CTL), xst);
#ifndef PROBE_MASK
#define PROBE_MASK 0u
#endif
    unsigned long long pr_t[PH_N + 1]; (void)pr_t;
    if (PROBE_MASK) pr_t[0] = __builtin_amdgcn_s_memrealtime();
#define SEAM(k) do { if (IN(k) && IN((k) + 1)) { if ((k) == PH_CVT1) grid.sync(); else xcd_barrier(xbar); } if (PROBE_MASK) pr_t[(k) + 1] = __builtin_amdgcn_s_memrealtime(); } while (0)

    if (IN(PH_CVT1)) {
        LAS float* scr = (LAS float*)(lds + wave * 16384);
        constexpr int I1 = (D / 64) * (2 * FF / 32), I2 = (FF / 64) * (D / 32), I3 = (D / 64) * (PP / 32), I4 = (D / 64) * (D / 32);
#define PICK1(it, out) do { int r_ = (it); if (r_ < I1) out = cvt_decode(1, a.in[6], a.in[7], FF, D, W1GU, 2 * FF / 32, r_, lane); else if ((r_ -= I1) < I2) out = cvt_decode(0, a.in[8], a.in[8], D, FF, W1D, D / 32, r_, lane); \
            else if ((r_ -= I2) < I3) out = cvt_decode(2, a.in[10], a.in[10], NIN, D, WIN, PP / 32, r_, lane); else out = cvt_decode(0, a.in[23], a.in[23], D, D, WOUT, D / 32, r_ - I3, lane); } while (0)
        CVT_RUN(I1 + I2 + I3 + I4, PICK1);
#undef PICK1
        for (int it = gw; it < 6144; it += NGW) cvt_lora_item(a.in[13], a.in[15], a.in[16], WL, it, lane);
        for (int r = gw; r < 256; r += NGW) { h16* orow = A16 + (size_t)(MT + r) * D;
#pragma unroll
            for (int j = 0; j < 8; ++j) { u32x2 w = (u32x2){0u, 0u};
                if (r < 32) { const f32x4 v = *((const f32x4*)(a.in[2] + (size_t)r * D) + lane + 64 * j); w.x = pk2h(v.x, v.y); w.y = pk2h(v.z, v.w); }
                *((u32x2*)orow + lane + 64 * j) = w; } }
        for (int m = gw; m < MT; m += NGW) { const float* xr = m < MP ? a.in[0] + (size_t)m * D : a.in[1] + (size_t)(m - MP) * D; rms_row_f16(xr, a.in[5], A16 + (size_t)m * D, nullptr, lane); }
    }
    SEAM(PH_CVT1);
    if (IN(PH_FFN1_GU)) { pg8::Gemm g{A16, W1GU, MT, 2 * FF, D}; pg8::Order S; S.init(MT, 2 * FF, D, G, bx, 0, -1); pg8::EpiSwiGLU E{HM, FF}; pg8::gemm_phase(lds, g, S, E); }
    SEAM(PH_FFN1_GU);
    if (IN(PH_FFN1_D)) { pg8::Gemm g{HM, W1D, MT, D, FF}; pg8::Order S; S.init(MT, D, FF, G, bx, 0, MP / 256); pg8::EpiRes E{a.in[0], a.in[1], Y, SLAB, 0.5f, 0}; pg8::gemm_phase(lds, g, S, E); }
    SEAM(PH_FFN1_D);
    if (IN(PH_RMS_MIX)) {
        for (int m = gw; m < MT; m += NGW) { float* so = nullptr;
            if (m < MP) { if ((m & 4095) == 4095) so = a.out + O_SHP + (size_t)(m >> 12) * D; } else { if (((m - MP) & 63) == 63) so = a.out + O_SHS + (size_t)((m - MP) >> 6) * D; }
            if (m < MP) rms_row_f16(Y + (size_t)m * D, a.in[9], A16 + (size_t)m * D, so, lane);
            else rms_row_f16(a.in[1] + (size_t)(m - MP) * D, a.in[9], A16 + (size_t)m * D, so, lane, SLAB + (size_t)(m - MP) * D, 0.5f, Y + (size_t)m * D); }
    }
    SEAM(PH_RMS_MIX);
    if (IN(PH_WIN)) { pg8::Gemm g{A16, WIN, MT, PP, D}; pg8::Order S; S.init(MT, PP, D, G, bx, PFW / 256, -1); pg8::EpiP16 E{P16, PF}; pg8::gemm_phase(lds, g, S, E); }
    SEAM(PH_WIN);
    if (IN(PH_SHIFT)) {
        for (int item = bx * NTHR + tid; item < (MT / 16) * 768; item += G * NTHR) { const int c = item / 768, o = item % 768;
            *(u32x4*)((h16*)(ob + OB_SIDE) + (size_t)c * 6144 + o * 8) = *(const u32x4*)(P16 + (size_t)(16 * c + 15) * PP + o * 8); }
    }
    if (IN(PH_SHIFT)) {
        h16* AIN = A16; const float* mu = a.in[11];
        for (int item = bx * NTHR + tid; item < MT * 64; item += G * NTHR) {
            const int row = item >> 6, o = item & 63;
            if (o >= 56) { *(u32x4*)(AIN + (size_t)row * LK + 448 + (o - 56) * 8) = (u32x4){0u, 0u, 0u, 0u}; continue; }
            const int c0 = 6144 + o * 8;
            const bool st = row < MP ? ((row & 4095) == 0) : (((row - MP) & 63) == 0);
            const h16* pp = st ? (row < MP ? PF + (size_t)32 * PFW : PF + (size_t)((row - MP) >> 6) * PFW) + c0 : P16 + (size_t)(row - 1) * PP + c0;
            const h16x8 cv = *(const h16x8*)(P16 + (size_t)row * PP + c0), pv = *(const h16x8*)pp;
            const f32x4 m0 = *(const f32x4*)(mu + c0), m1 = *(const f32x4*)(mu + c0 + 4);
            const float mu8[8] = {m0.x, m0.y, m0.z, m0.w, m1.x, m1.y, m1.z, m1.w}; float s[8];
#pragma unroll
            for (int j = 0; j < 8; ++j) { const float cu = (float)cv[j]; s[j] = cu + mu8[j] * ((float)pv[j] - cu); }
            if (o < 12) {
#pragma unroll
                for (int j = 0; j < 8; ++j) s[j] = tanhf(s[j]);
            } else if (o >= 24) {
#pragma unroll
                for (int j = 0; j < 8; ++j) s[j] = sigmoidf_(s[j]);
            }
            *(u32x4*)(AIN + (size_t)row * LK + o * 8) = (u32x4){pk2h(s[0], s[1]), pk2h(s[2], s[3]), pk2h(s[4], s[5]), pk2h(s[6], s[7])};
        }
    }
    SEAM(PH_SHIFT);
    if (IN(PH_LORA)) { pg8::Gemm g{A16, WL, MT, 6144, LK}; pg8::Order S; S.init(MT, 6144, LK, G, bx, 0, -1); pg8::EpiEAG E{EAG, a.in[12], a.in[14]}; pg8::gemm_phase(lds, g, S, E); }
    SEAM(PH_LORA);
    if (IN(PH_PREP)) {
        LAS unsigned char* sc = lds + wave * 5120;
        float* RK = (float*)(ws + WS_RK); float* LM = (float*)(ws + WS_LM);
        const int cp = lane & 31, hs = lane >> 5;
#define H2LO(x) ((float)__builtin_bit_cast(h16, (unsigned short)((x) & 0xffffu)))
#define H2HI(x) ((float)__builtin_bit_cast(h16, (unsigned short)((x) >> 16)))
#define HSUM(x_, out_) do { float y_ = row_allreduce16(x_); y_ += __builtin_bit_cast(float, __builtin_amdgcn_update_dpp(0, __builtin_bit_cast(int, y_), 0x142, 0xA, 0xF, false)); \
            const float s31_ = rl_f(y_, 31), s63_ = rl_f(y_, 63); out_ = hs ? s63_ : s31_; } while (0)
        for (int item = gw; item < (MT / 16) * 32; item += NGW) {
            const int c = item >> 5, h = item & 31, row0 = 16 * c, hj2 = h * 64 + 2 * cp;
            const f32x2 c_kk = *(const f32x2*)(a.in[17] + hj2), c_ka = *(const f32x2*)(a.in[18] + hj2), c_rk = *(const f32x2*)(a.in[19] + hj2), c_mr = *(const f32x2*)(a.in[11] + hj2), c_mk = *(const f32x2*)(a.in[11] + D + hj2), c_mv = *(const f32x2*)(a.in[11] + 2 * D + hj2);
            const bool pr = row0 < MP; const bool st = pr ? ((row0 & 4095) == 0) : (((row0 - MP) & 63) == 0);
            const h16* pq = hs ? P16 + (size_t)(row0 + 7) * PP + hj2 : (st ? PF + (size_t)(pr ? 32 : ((row0 - MP) >> 6)) * PFW + hj2 : (const h16*)(ob + OB_SIDE) + (size_t)(c - 1) * 6144 + hj2);
            const h16* pp = P16 + (size_t)(row0 + 8 * hs) * PP + hj2; const h16* pe = EAG + (size_t)(row0 + 8 * hs) * 6144 + hj2;
            unsigned rr[9], kk[9], vv[9], ee[8], aa[8];
            rr[0] = *(const unsigned*)pq; kk[0] = *(const unsigned*)(pq + D); vv[0] = *(const unsigned*)(pq + 2 * D);
#pragma unroll
            for (int s_ = 0; s_ < 8; ++s_) { rr[s_ + 1] = *(const unsigned*)(pp + (size_t)s_ * PP); kk[s_ + 1] = *(const unsigned*)(pp + (size_t)s_ * PP + D); vv[s_ + 1] = *(const unsigned*)(pp + (size_t)s_ * PP + 2 * D);
                ee[s_] = *(const unsigned*)(pe + (size_t)s_ * 6144); aa[s_] = *(const unsigned*)(pe + (size_t)s_ * 6144 + D); }
            f32x2 Ll[8]; { f32x2 acc = (f32x2){0.f, 0.f};
#pragma unroll
                for (int s_ = 0; s_ < 8; ++s_) { acc -= (f32x2){H2LO(ee[s_]), H2HI(ee[s_])}; Ll[s_] = acc; } }
            const f32x2 oth = (f32x2){__shfl_xor(Ll[7].x, 32), __shfl_xor(Ll[7].y, 32)};
            const f32x2 M_ = hs ? oth : Ll[7]; const f32x2 L15 = M_ + (hs ? Ll[7] : oth);
            *(f32x2*)(LM + (size_t)item * 128 + 64 * hs + 2 * cp) = hs ? L15 : M_;
            const f32x2 off = hs ? (f32x2){0.f, 0.f} : M_;
            unsigned vpk[8];
            h16* eo = EAG + (size_t)(row0 + 8 * hs) * 6144 + hj2; h16* po = P16 + (size_t)(row0 + 8 * hs) * PP + hj2;
            f32x2 E3p = (f32x2){__expf(-off.x), __expf(-off.y)};
#pragma unroll
            for (int s_ = 0; s_ < 8; ++s_) { const int t = 8 * hs + s_;
                f32x2 r = (f32x2){H2LO(rr[s_ + 1]), H2HI(rr[s_ + 1])}, k = (f32x2){H2LO(kk[s_ + 1]), H2HI(kk[s_ + 1])}, v = (f32x2){H2LO(vv[s_ + 1]), H2HI(vv[s_ + 1])};
                r += c_mr * ((f32x2){H2LO(rr[s_]), H2HI(rr[s_])} - r); k += c_mk * ((f32x2){H2LO(kk[s_]), H2HI(kk[s_])} - k); v += c_mv * ((f32x2){H2LO(vv[s_]), H2HI(vv[s_])} - v);
                const f32x2 av = (f32x2){H2LO(aa[s_]), H2HI(aa[s_])};
                const f32x2 kkr = k * c_kk; float ss; HSUM(kkr.x * kkr.x + kkr.y * kkr.y, ss);
                const float rn = rsqrtf(fmaxf(ss, 1e-24f)); const f32x2 kap = kkr * rn;
                const f32x2 kmod = k * (1.f + (av - 1.f) * c_ka);
                const f32x2 Dm = Ll[s_] - off; const f32x2 E1 = E3p, E2 = (f32x2){__expf(-Dm.x), __expf(-Dm.y)}, E3 = (f32x2){__expf(Dm.x), __expf(Dm.y)}; E3p = E3;
                const f32x2 fat = kap * E1, frt = r * E3, fbb = kap * av * E2, fkb = kmod * E2;
                const unsigned hat = pk2h(fat.x, fat.y), hrt = pk2h(frt.x, frt.y), hbb = pk2h(fbb.x, fbb.y), hkb = pk2h(fkb.x, fkb.y);
                const f32x2 rkm = r * kmod * c_rk; float rk; HSUM(rkm.x + rkm.y, rk); if (cp == 0) RK[(size_t)(row0 + t) * 32 + h] = rk;
                *(unsigned*)(eo + (size_t)s_ * 6144) = hat; *(unsigned*)(eo + (size_t)s_ * 6144 + D) = hbb; *(unsigned*)(po + (size_t)s_ * PP) = hrt; *(unsigned*)(po + (size_t)s_ * PP + D) = hkb;
                ((LAS unsigned*)sc)[t * 32 + cp] = hat; ((LAS unsigned*)(sc + 2048))[t * 32 + cp] = hbb;
                vpk[s_] = pk2h(v.x, v.y);
            }
            { u32x4 lo, hi;
              lo.x = (vpk[0] & 0xffffu) | (vpk[1] << 16); lo.y = (vpk[2] & 0xffffu) | (vpk[3] << 16); lo.z = (vpk[4] & 0xffffu) | (vpk[5] << 16); lo.w = (vpk[6] & 0xffffu) | (vpk[7] << 16);
              hi.x = (vpk[0] >> 16) | (vpk[1] & 0xffff0000u); hi.y = (vpk[2] >> 16) | (vpk[3] & 0xffff0000u); hi.z = (vpk[4] >> 16) | (vpk[5] & 0xffff0000u); hi.w = (vpk[6] >> 16) | (vpk[7] & 0xffff0000u);
              const int i0 = 2 * cp;
              *(u32x4*)(P16 + (size_t)(row0 + (i0 >> 2)) * PP + 2 * D + h * 64 + (i0 & 3) * 16 + 8 * hs) = lo;
              *(u32x4*)(P16 + (size_t)(row0 + ((i0 + 1) >> 2)) * PP + 2 * D + h * 64 + ((i0 + 1) & 3) * 16 + 8 * hs) = hi; }
            asm volatile("s_waitcnt lgkmcnt(0)" ::: "memory");
            const int fr = lane & 15, fq = lane >> 4;
            f32x4 acc = (f32x4){0.f, 0.f, 0.f, 0.f};
#pragma unroll
            for (int kt = 0; kt < 4; ++kt) acc = __builtin_amdgcn_mfma_f32_16x16x16f16(*(const LAS h16x4*)(sc + (fr * 64 + 16 * kt + 4 * fq) * 2), *(const LAS h16x4*)(sc + 2048 + (fr * 64 + 16 * kt + 4 * fq) * 2), acc, 0, 0, 0);
            LAS float* Pm = (LAS float*)(sc + 4096);
#pragma unroll
            for (int g_ = 0; g_ < 4; ++g_) Pm[(4 * fq + g_) * 16 + fr] = (fr < 4 * fq + g_) ? acc[g_] : 0.f;
            asm volatile("s_waitcnt lgkmcnt(0)" ::: "memory");
            float Tc[16];
#pragma unroll
            for (int t = 0; t < 16; ++t) { float x = (t == fr) ? 1.f : 0.f;
#pragma unroll
                for (int j4 = 0; j4 < (t + 3) / 4; ++j4) { const f32x4 p4 = *(const LAS f32x4*)(Pm + t * 16 + 4 * j4);
                    if (4 * j4 + 0 < t) x -= p4.x * Tc[4 * j4 + 0]; if (4 * j4 + 1 < t) x -= p4.y * Tc[4 * j4 + 1]; if (4 * j4 + 2 < t) x -= p4.z * Tc[4 * j4 + 2]; if (4 * j4 + 3 < t) x -= p4.w * Tc[4 * j4 + 3]; }
                Tc[t] = x; }
            if (lane < 16) { h16* to = P16 + (size_t)row0 * PP + 6144 + h * 16 + fr;
#pragma unroll
                for (int t = 0; t < 16; ++t) to[(size_t)t * PP] = (h16)Tc[t]; }
            asm volatile("s_waitcnt lgkmcnt(0)" ::: "memory");
        }
#undef H2LO
#undef H2HI
#undef HSUM
    }
    SEAM(PH_PREP);
    if (IN(PH_SCAN)) {
        const int vcu = (G % 8 == 0) ? (bx % 8) * (G / 8) + bx / 8 : bx;
        constexpr int RAWB = 12288, NSL = 7, CSET = 2560, O_RAW = 0, O_CO = NSL * RAWB, O_YB = O_CO + 2 * CSET;
        static_assert(O_YB + 2 * 2048 <= LDS_BYTES - 16, "scan LDS map");
        h16* OUT16 = A16; const float* LM = (const float*)(ws + WS_LM);
        const bool pblk = vcu < 64;
        const int nitem = pblk ? 1 : (1024 - (vcu - 64) + 191) / 192;
        const int NCHB = pblk ? 256 : 4 * nitem;
#define SC_DESC(cc, prompt, sq, h, t0, first, last) \
        const bool prompt = pblk; bool first, last; int sq, h, t0; \
        if (prompt) { sq = vcu >> 5; h = vcu & 31; t0 = 16 * (cc); first = (cc) == 0; last = (cc) == 255; } \
        else { const int pair = (vcu - 64) + 192 * ((cc) >> 2); sq = pair >> 5; h = pair & 31; t0 = 16 * ((cc) & 3); first = ((cc) & 3) == 0; last = ((cc) & 3) == 3; }
#define SC_DMA(cc) do { if ((cc) < NCHB) { SC_DESC(cc, prompt_, sq_, h_, t0_, first_, last_); (void)last_; (void)first_; \
            const size_t rowb_ = (size_t)(prompt_ ? sq_ * 4096 : MP + sq_ * 64) + t0_; \
            LAS unsigned char* dst_ = lds + O_RAW + ((cc) % NSL) * RAWB; \
            const int sw_ = ((lane & 7) ^ (lane >> 3)) * 8;     \
            const h16* e0_ = EAG + (rowb_ + (lane >> 3)) * 6144 + h_ * 64 + sw_; const h16* p0_ = P16 + (rowb_ + (lane >> 3)) * PP + h_ * 64 + sw_; \
            __builtin_amdgcn_global_load_lds((const unsigned*)(e0_), (LAS unsigned*)(dst_), 16, 0, 0); \
            __builtin_amdgcn_global_load_lds((const unsigned*)(e0_ + 8 * 6144), (LAS unsigned*)(dst_ + 1024), 16, 0, 0); \
            __builtin_amdgcn_global_load_lds((const unsigned*)(p0_), (LAS unsigned*)(dst_ + 2048), 16, 0, 0); \
            __builtin_amdgcn_global_load_lds((const unsigned*)(p0_ + 8 * PP), (LAS unsigned*)(dst_ + 3072), 16, 0, 0); \
            __builtin_amdgcn_global_load_lds((const unsigned*)(e0_ + D), (LAS unsigned*)(dst_ + 4096), 16, 0, 0); \
            __builtin_amdgcn_global_load_lds((const unsigned*)(e0_ + D + 8 * 6144), (LAS unsigned*)(dst_ + 5120), 16, 0, 0); \
            __builtin_amdgcn_global_load_lds((const unsigned*)(p0_ + D), (LAS unsigned*)(dst_ + 6144), 16, 0, 0); \
            __builtin_amdgcn_global_load_lds((const unsigned*)(p0_ + D + 8 * PP), (LAS unsigned*)(dst_ + 7168), 16, 0, 0); \
            __builtin_amdgcn_global_load_lds((const unsigned*)(p0_ - sw_ + (lane & 7) * 8 + 2 * D), (LAS unsigned*)(dst_ + 8192), 16, 0, 0); \
            __builtin_amdgcn_global_load_lds((const unsigned*)(p0_ - sw_ + (lane & 7) * 8 + 2 * D + 8 * PP), (LAS unsigned*)(dst_ + 9216), 16, 0, 0); \
            __builtin_amdgcn_global_load_lds((const unsigned*)(P16 + (rowb_ + ((lane & 31) >> 1)) * PP + 6144 + h_ * 16 + (lane & 1) * 8), (LAS unsigned*)(dst_ + 10240), 16, 0, 0); \
            __builtin_amdgcn_global_load_lds((const unsigned*)(LM + ((rowb_ >> 4) * 32 + h_) * 128 + (lane & 31) * 4), (LAS unsigned*)(dst_ + 11264), 16, 0, 0); } } while (0)
#define MF(a_, b_, c_) __builtin_amdgcn_mfma_f32_16x16x32_f16(a_, b_, c_, 0, 0, 0)
#define CAT8(lo_, hi_) ((h16x8){(lo_)[0], (lo_)[1], (lo_)[2], (lo_)[3], (hi_)[0], (hi_)[1], (hi_)[2], (hi_)[3]})
#define SC_C(cc) do { if ((cc) >= 0 && (cc) < NCHB) { \
            const LAS unsigned char* rs = lds + O_RAW + ((cc) % NSL) * RAWB; LAS unsigned char* co = lds + O_CO + ((cc) & 1) * CSET; \
            const int fr = lane & 15, fq = lane >> 4; const int oa = wave == 4 ? 0 : 2048, ob_ = wave == 6 ? 4096 : 6144; \
            f32x4 acc = (f32x4){0.f, 0.f, 0.f, 0.f}; \
            _Pragma("unroll") for (int kb = 0; kb < 2; ++kb) { const int o_ = fr * 128 + (((4 * kb + fq) ^ (fr & 7)) << 4); acc = MF(*(const LAS h16x8*)(rs + oa + o_), *(const LAS h16x8*)(rs + ob_ + o_), acc); } \
            _Pragma("unroll") for (int g_ = 0; g_ < 4; ++g_) { const int t = 4 * fq + g_; const bool keep = wave == 4 ? (fr < t) : (fr <= t); ((LAS h16*)(co + (wave - 4) * 512))[t * 16 + fr] = (h16)(keep ? acc[g_] : 0.f); } \
            if (wave == 4) { const float M_ = ((const LAS float*)(rs + 11264))[lane], L15 = ((const LAS float*)(rs + 11264 + 256))[lane]; \
                ((LAS float*)(co + 1536))[lane] = __expf(M_); ((LAS float*)(co + 1792))[lane] = __expf(L15 - M_); ((LAS float*)(co + 2048))[lane] = __expf(L15); } } } while (0)
        f32x4 St[4];
#pragma unroll
        for (int n = 0; n < 4; ++n) St[n] = (f32x4){0.f, 0.f, 0.f, 0.f};
#define CVT4(x_) ((h16x4){(h16)(x_)[0], (h16)(x_)[1], (h16)(x_)[2], (h16)(x_)[3]})
#define TRR(p_) __builtin_bit_cast(h16x4, __builtin_amdgcn_ds_read_tr16_b64_v4i16((LAS s16x4*)(p_)))
#define SC_ROW(cc, PROMPT) do { if ((cc) >= 0 && (cc) < NCHB) { SC_DESC(cc, prompt, sq, h, t0, first, last); \
            const int fr = lane & 15, fq = lane >> 4; \
            float* sp = a.out + (prompt ? O_WKP : O_WKS) + ((size_t)(sq * 32 + h) * 64 + 16 * wave + fr) * 64 + 4 * fq; \
            if (first) { _Pragma("unroll") for (int n = 0; n < 4; ++n) { St[n] = (f32x4){0.f, 0.f, 0.f, 0.f}; if (!(PROMPT)) St[n] = *(const f32x4*)(a.in[4] + ((size_t)(sq * 32 + h) * 64 + 16 * wave + fr) * 64 + 16 * n + 4 * fq); } } \
            LAS unsigned char* rs = lds + O_RAW + ((cc) % NSL) * RAWB; const LAS unsigned char* co = lds + O_CO + ((cc) & 1) * CSET; \
              \
            f32x4 em[4], gm[4], e4[4]; h16x4 atl[2][2], rtl[2][2], kbt[4], bbt[4]; \
            _Pragma("unroll") for (int n = 0; n < 4; ++n) { em[n] = *(const LAS f32x4*)(co + 1536 + (16 * n + 4 * fq) * 4); gm[n] = *(const LAS f32x4*)(co + 2048 + (16 * n + 4 * fq) * 4); e4[n] = *(const LAS f32x4*)(co + 1792 + (16 * n + 4 * fq) * 4); } \
            _Pragma("unroll") for (int b = 0; b < 2; ++b) { \
                const int o0_ = fr * 128 + (((4 * b + (fq >> 1)) ^ (fr & 7)) << 4) + 8 * (fq & 1), o1_ = fr * 128 + (((4 * b + 2 + (fq >> 1)) ^ (fr & 7)) << 4) + 8 * (fq & 1); \
                atl[b][0] = *(const LAS h16x4*)(rs + o0_); atl[b][1] = *(const LAS h16x4*)(rs + o1_); rtl[b][0] = *(const LAS h16x4*)(rs + 2048 + o0_); rtl[b][1] = *(const LAS h16x4*)(rs + 2048 + o1_); } \
            const h16x4 vm = *(const LAS h16x4*)(rs + 8192 + ((16 * wave + fr) * 16 + 4 * fq) * 2), aak = *(const LAS h16x4*)(co + (fr * 16 + 4 * fq) * 2), tA = *(const LAS h16x4*)(rs + 10240 + (fr * 16 + 4 * fq) * 2), \
                        ark = *(const LAS h16x4*)(co + 512 + (fr * 16 + 4 * fq) * 2), arb = *(const LAS h16x4*)(co + 1024 + (fr * 16 + 4 * fq) * 2); \
            _Pragma("unroll") for (int n = 0; n < 4; ++n) { const int tr_ = 4 * fq + (fr >> 2); const int o_ = tr_ * 128 + (((2 * n + ((fr & 3) >> 1)) ^ (tr_ & 7)) << 4) + 8 * (fr & 1); kbt[n] = TRR(rs + 6144 + o_); bbt[n] = TRR(rs + 4096 + o_); } \
            asm volatile("s_waitcnt lgkmcnt(0)" ::: "memory"); \
            const h16x4 z4 = (h16x4){(h16)0.f, (h16)0.f, (h16)0.f, (h16)0.f}; \
            h16x4 sh[4]; \
            _Pragma("unroll") for (int n = 0; n < 4; ++n) { const f32x4 x = St[n] * em[n]; sh[n] = CVT4(x); } \
            f32x4 W1 = (f32x4){0.f, 0.f, 0.f, 0.f}, Yt = W1; \
              \
            _Pragma("unroll") for (int b = 0; b < 2; ++b) { const h16x8 sb = CAT8(sh[2 * b], sh[2 * b + 1]); \
                W1 = MF(CAT8(atl[b][0], atl[b][1]), sb, W1); Yt = MF(CAT8(rtl[b][0], rtl[b][1]), sb, Yt); } \
            W1 = MF(CAT8(aak, z4), CAT8(vm, z4), W1); \
            const h16x4 w1h = CVT4(W1); \
            f32x4 U = MF(CAT8(tA, z4), CAT8(w1h, z4), ((f32x4){0.f, 0.f, 0.f, 0.f})); \
            const f32x4 nU = -U; const h16x4 uh = CVT4(nU); const h16x8 vu = CAT8(vm, uh);     \
            Yt = MF(CAT8(ark, arb), vu, Yt); \
            _Pragma("unroll") for (int n = 0; n < 4; ++n) { const f32x4 tmp = MF(CAT8(kbt[n], bbt[n]), vu, ((f32x4){0.f, 0.f, 0.f, 0.f})); St[n] = gm[n] * St[n] + e4[n] * tmp; } \
            { LAS h16* yb = (LAS h16*)(lds + O_YB + ((cc) & 1) * 2048) + (4 * fq) * 64 + 16 * wave + fr; (void)t0; \
              yb[0] = (h16)Yt[0]; yb[64] = (h16)Yt[1]; yb[128] = (h16)Yt[2]; yb[192] = (h16)Yt[3]; } \
            if (last) { _Pragma("unroll") for (int n = 0; n < 4; ++n) *(f32x4*)(sp + 16 * n) = St[n]; } } } while (0)
#define SC_YOUT(cc) do { if ((cc) >= 0 && (cc) < NCHB && wave >= 5) { SC_DESC(cc, prompt, sq, h, t0, first, last); (void)first; (void)last; \
            const int L_ = (wave - 5) * 64 + lane, t_ = L_ >> 3, part_ = L_ & 7; \
            *(u32x4*)(OUT16 + ((size_t)(prompt ? sq * 4096 : MP + sq * 64) + t0 + t_) * D + h * 64 + part_ * 8) = *(const LAS u32x4*)(lds + O_YB + ((cc) & 1) * 2048 + t_ * 128 + part_ * 16); } } while (0)
#define SC_BARRIER() do { asm volatile("s_waitcnt lgkmcnt(0)" ::: "memory"); __builtin_amdgcn_s_barrier(); asm volatile("" ::: "memory"); } while (0)
        if (wave < 4) {
            SC_BARRIER();
            if (pblk) { for (int it = -1; it <= NCHB; ++it) { SC_ROW(it, true); SC_BARRIER(); } }
            else { for (int it = -1; it <= NCHB; ++it) { SC_ROW(it, false); SC_BARRIER(); } }
        } else if (wave == 7) {
            SC_DMA(0); SC_DMA(1); SC_DMA(2); SC_DMA(3); SC_DMA(4);
            asm volatile("s_waitcnt vmcnt(48)" ::: "memory");
            SC_BARRIER();
            for (int it = -1; it <= NCHB; ++it) {
                SC_DMA(it + 6);
                if (it + 6 < NCHB) asm volatile("s_waitcnt vmcnt(48)" ::: "memory");
                else asm volatile("s_waitcnt vmcnt(0)" ::: "memory");
                SC_BARRIER();
            }
        } else {
            SC_BARRIER();
            for (int it = -1; it <= NCHB; ++it) { SC_C(it + 1); SC_YOUT(it - 1); SC_BARRIER(); }
        }
#undef SC_DESC
#undef SC_DMA
#undef MF
#undef CAT8
#undef SC_C
#undef CVT4
#undef TRR
#undef SC_ROW
#undef SC_BARRIER
#undef SC_YOUT
    }
    SEAM(PH_SCAN);
    if (IN(PH_MERGE)) {
        const float* RK = (const float*)(ws + WS_RK);
        const int o8 = tid & 255, c0 = o8 * 8, hd = o8 >> 3, rg = tid >> 8;
        float w0[8], w1[8], w2[8], lg[8], lb[8];
#pragma unroll
        for (int j = 0; j < 8; ++j) { w0[j] = a.in[22][c0 + j]; w1[j] = a.in[22][D + c0 + j]; w2[j] = a.in[22][2 * D + c0 + j]; lg[j] = a.in[20][c0 + j]; lb[j] = a.in[21][c0 + j]; }
        for (int c = bx; c < MT / 16; c += G) {
            const int row0 = 16 * c + 8 * rg;
            const bool pr = row0 < MP; const int tt0 = pr ? (row0 & 4095) : ((row0 - MP) & 63), sq = pr ? (row0 >> 12) : ((row0 - MP) >> 6), T = pr ? 4096 : 64;
            h16x8 vt[8];
            { const h16* vb = P16 + (size_t)(16 * c + ((c0 & 63) >> 2)) * PP + 2 * D + (c0 & ~63) + 8 * rg;
#pragma unroll
              for (int j = 0; j < 8; ++j) vt[j] = *(const h16x8*)(vb + (size_t)(j >> 2) * PP + (j & 3) * 16); }
            float u1[8], u2[8];
            { const h16* prow = P16 + (size_t)row0 * PP;
              if (tt0 >= 2) { const h16x8 g1 = *(const h16x8*)(prow - PP + C_GC + c0), x1 = *(const h16x8*)(prow - PP + C_XC + c0), g2 = *(const h16x8*)(prow - 2 * PP + C_GC + c0), x2 = *(const h16x8*)(prow - 2 * PP + C_XC + c0);
#pragma unroll
                  for (int j = 0; j < 8; ++j) { u1[j] = (float)g1[j] * (float)x1[j]; u2[j] = (float)g2[j] * (float)x2[j]; }
              } else {
#pragma unroll
                  for (int j = 0; j < 8; ++j) { u2[j] = pr ? 0.f : a.in[3][(size_t)sq * 2 * D + c0 + j]; u1[j] = pr ? 0.f : a.in[3][(size_t)sq * 2 * D + D + c0 + j]; } } }
#pragma unroll
            for (int hf = 0; hf < 4; ++hf) {
                h16x8 ov[2], gv[2], gb[2], gc[2], xc[2], ga[2], gg[2]; float rk[2];
#pragma unroll
                for (int r = 0; r < 2; ++r) { const int row = row0 + 2 * hf + r; const h16* prow = P16 + (size_t)row * PP;
                    ov[r] = *(const h16x8*)(A16 + (size_t)row * D + c0); gv[r] = *(const h16x8*)(EAG + (size_t)row * 6144 + 2 * D + c0);
                    gb[r] = *(const h16x8*)(prow + C_GB + c0); gc[r] = *(const h16x8*)(prow + C_GC + c0); xc[r] = *(const h16x8*)(prow + C_XC + c0); ga[r] = *(const h16x8*)(prow + C_GA + c0); gg[r] = *(const h16x8*)(prow + C_GG + c0);
                    rk[r] = RK[(size_t)row * 32 + hd]; }
#pragma unroll
                for (int r = 0; r < 2; ++r) { const int row = row0 + 2 * hf + r, tt = tt0 + 2 * hf + r;
                    float of[8], s1 = 0.f;
#pragma unroll
                    for (int j = 0; j < 8; ++j) { of[j] = (float)ov[r][j]; s1 += of[j]; }
                    const float mean = row_allreduce8(s1) * (1.f / 64.f); float s2 = 0.f;
#pragma unroll
                    for (int j = 0; j < 8; ++j) { of[j] -= mean; s2 += of[j] * of[j]; }
                    const float rstd = rsqrtf(row_allreduce8(s2) * (1.f / 64.f) + 64e-5f);
                    float mg[8], u0[8];
#pragma unroll
                    for (int j = 0; j < 8; ++j) {
                        const float vs = (float)vt[j][2 * hf + r];
                        const float ya = (of[j] * rstd * lg[j] + lb[j] + rk[r] * vs) * (float)gv[r][j];
                        u0[j] = (float)gc[r][j] * (float)xc[r][j];
                        const float cv = w0[j] * u2[j] + w1[j] * u1[j] + w2[j] * u0[j];
                        mg[j] = sigmoidf_((float)ga[r][j]) * ya + sigmoidf_((float)gg[r][j]) * ((float)gb[r][j] * cv); u2[j] = u1[j]; u1[j] = u0[j]; }
                    *(u32x4*)(A16 + (size_t)row * D + c0) = (u32x4){pk2h(mg[0], mg[1]), pk2h(mg[2], mg[3]), pk2h(mg[4], mg[5]), pk2h(mg[6], mg[7])};
                    if (tt >= T - 2) { float* q = a.out + (pr ? O_CVP : O_CVS) + (size_t)sq * 2 * D + (size_t)(tt - (T - 2)) * D + c0;
                        *(f32x4*)q = (f32x4){u0[0], u0[1], u0[2], u0[3]}; *(f32x4*)(q + 4) = (f32x4){u0[4], u0[5], u0[6], u0[7]}; }
                }
            }
        }
    }
    SEAM(PH_MERGE);
    if (IN(PH_WOUT)) {
        { pg8::Gemm g{A16, WOUT, MT, D, D}; pg8::Order S; S.init(MT, D, D, G, bx, 0, MP / 256); pg8::EpiRes E{Y, Y + (size_t)MP * D, Y, SLAB, 1.0f, 0}; pg8::gemm_phase(lds, g, S, E); }
        LAS float* scr = (LAS float*)(lds + wave * 16384);
        constexpr int I1 = (D / 64) * (2 * FF / 32), I2 = (FF / 64) * (D / 32);
#define PICK2(it, out) do { int r_ = (it); if (r_ < I1) out = cvt_decode(1, a.in[25], a.in[26], FF, D, W2GU, 2 * FF / 32, r_, lane); else out = cvt_decode(0, a.in[27], a.in[27], D, FF, W2D, D / 32, r_ - I1, lane); } while (0)
        CVT_RUN(I1 + I2, PICK2);
#undef PICK2
    }
    SEAM(PH_WOUT);
    if (IN(PH_RMS2)) { for (int m = gw; m < MT; m += NGW) { if (m < MP) rms_row_f16(Y + (size_t)m * D, a.in[24], A16 + (size_t)m * D, nullptr, lane);
            else rms_row_f16(Y + (size_t)m * D, a.in[24], A16 + (size_t)m * D, nullptr, lane, SLAB + (size_t)(m - MP) * D, 1.0f, Y + (size_t)m * D); } }
    SEAM(PH_RMS2);
    if (IN(PH_FFN2_GU)) { pg8::Gemm g{A16, W2GU, MT, 2 * FF, D}; pg8::Order S; S.init(MT, 2 * FF, D, G, bx, 0, -1); pg8::EpiSwiGLU E{HM, FF}; pg8::gemm_phase(lds, g, S, E); }
    SEAM(PH_FFN2_GU);
    if (IN(PH_FFN2_D)) { pg8::Gemm g{HM, W2D, MT, D, FF}; pg8::Order S; S.init(MT, D, FF, G, bx, 0, MP / 256); pg8::EpiRes E{Y, Y + (size_t)MP * D, Y, SLAB, 0.5f, 0}; pg8::gemm_phase(lds, g, S, E); }
    SEAM(PH_FFN2_D);
    if (IN(PH_FINAL)) { for (int m = gw; m < MT; m += NGW) { if (m < MP) rms_row_f16(Y + (size_t)m * D, a.in[28], nullptr, Y + (size_t)m * D, lane);
            else rms_row_f16(Y + (size_t)m * D, a.in[28], nullptr, Y + (size_t)m * D, lane, SLAB + (size_t)(m - MP) * D, 0.5f, nullptr); } }
    if (PROBE_MASK) {
        pr_t[PH_N] = __builtin_amdgcn_s_memrealtime();
        if (bx == 0 && tid == 0) { unsigned long long tot = 0;
#pragma unroll
            for (int k = 0; k < PH_N; ++k) if ((PROBE_MASK >> k) & 1u) tot += pr_t[k + 1] - pr_t[k];
            const unsigned long long t0 = __builtin_amdgcn_s_memrealtime();
            while (__builtin_amdgcn_s_memrealtime() - t0 < tot) __builtin_amdgcn_s_sleep(8);
        }
    }
#undef IN
#undef SEAM
}

extern "C" void kernel_launch(void* const* d_in, const int* in_sizes, int n_in, void* d_out, int out_size, void* d_ws, size_t ws_size, hipStream_t stream) {
    static int grid = 0;
    if (grid == 0) {
        if (n_in != 29 || (size_t)out_size != O_END || ws_size < WS_END) { fprintf(stderr, "kernel_launch: unexpected shapes (n_in %d out %d ws %zu need %zu)\n", n_in, out_size, ws_size, (size_t)WS_END); grid = -1; return; }
        int dev = 0, cus = 0, per_cu = 0;
        if (hipGetDevice(&dev) != hipSuccess || hipDeviceGetAttribute(&cus, hipDeviceAttributeMultiprocessorCount, dev) != hipSuccess) { grid = -1; return; }
        if (hipFuncSetAttribute((const void*)fwd_kernel, hipFuncAttributeMaxDynamicSharedMemorySize, LDS_BYTES) != hipSuccess) { grid = -1; return; }
        if (hipOccupancyMaxActiveBlocksPerMultiprocessor(&per_cu, (const void*)fwd_kernel, NTHR, LDS_BYTES) != hipSuccess || per_cu < 1) { fprintf(stderr, "kernel_launch: occupancy query failed (%d)\n", per_cu); grid = -1; return; }
        grid = cus;
    }
    if (grid < 0) return;
    if (hipMemsetAsync((char*)d_ws + WS_CTL, 0, XCD_BAR_WORDS * 4, stream) != hipSuccess) return;
    Args a{};
    for (int i = 0; i < 29; ++i) a.in[i] = (const float*)d_in[i];
    a.out = (float*)d_out; a.ws = (unsigned char*)d_ws; a.ph_lo = 0; a.ph_hi = PH_N;
    void* kargs[] = {&a};
    hipError_t e = hipLaunchCooperativeKernel((const void*)fwd_kernel, dim3(grid), dim3(NTHR), kargs, LDS_BYTES, stream);
    if (e != hipSuccess) fprintf(stderr, "kernel_launch: cooperative launch failed: %s (grid %d)\n", hipGetErrorString(e), grid);
}
```

```cpp
#include <hip/hip_runtime.h>
#include <hip/hip_cooperative_groups.h>
#include <cstdio>
namespace cg = cooperative_groups;

#define LAS __attribute__((address_space(3)))
typedef _Float16 h16;
typedef _Float16 h16x2 __attribute__((ext_vector_type(2)));
typedef _Float16 h16x4 __attribute__((ext_vector_type(4)));
typedef _Float16 h16x8 __attribute__((ext_vector_type(8)));
typedef short s16x4 __attribute__((ext_vector_type(4)));
typedef float f32x4 __attribute__((ext_vector_type(4)));
typedef float f32x2 __attribute__((ext_vector_type(2)));
typedef unsigned u32x4 __attribute__((ext_vector_type(4)));
typedef unsigned u32x2 __attribute__((ext_vector_type(2)));

constexpr int D = 2048, FF = 5632, NA = 6592, NIN = 16832;
constexpr int MP = 8192, MS = 2048, MT = MP + MS;
constexpr int MA = MT + 256;
constexpr int PP = 12800;
constexpr int NW = 16896;
constexpr int PFW = 6656;
constexpr int C_U = 6656, C_Q = 8704, C_SA = 10752;
constexpr int LK = 512;
constexpr int NCHUNK = MT / 64;
constexpr size_t O_Y = 0, O_SHP = 20971520, O_CVP = 20975616, O_WKP = 20983808, O_SHS = 21245952, O_CVS = 21311488, O_WKS = 21442560, O_END = 25636864;
constexpr size_t WS_CTL = 0;
constexpr size_t WS_W1GU = 1u << 20;
constexpr size_t WS_W1D = WS_W1GU + (size_t)2 * FF * D * 2;
constexpr size_t WS_WIN = WS_W1D + (size_t)D * FF * 2;
constexpr size_t WS_WOUT = WS_WIN + (size_t)NW * D * 2;
constexpr size_t WS_A16 = WS_WOUT + (size_t)D * D * 2;
constexpr size_t WS_P16 = WS_A16 + (size_t)MA * D * 2;
constexpr size_t WS_W2GU = WS_P16 + (size_t)MT * PP * 2;
constexpr size_t WS_W2D = WS_W2GU + (size_t)2 * FF * D * 2;
constexpr size_t WS_PF = WS_W2D + (size_t)D * FF * 2;
constexpr size_t WS_END = WS_PF + (size_t)256 * PFW * 2;
constexpr size_t WS_EAG = WS_W1GU;
constexpr size_t WS_HM = WS_P16;
constexpr size_t WS_SLAB = WS_HM + (size_t)MT * FF * 2;
static_assert((size_t)MT * 6144 * 2 <= WS_WOUT - WS_W1GU, "EAG overlay");
static_assert(WS_SLAB + (size_t)4 * MS * D * 4 <= WS_W2GU, "HM + slab overlay of P16");
constexpr size_t OB_WL = O_WKS * 4;
constexpr size_t OB_SIDE = OB_WL + (size_t)6144 * LK * 2;
static_assert(OB_SIDE + (size_t)(MT / 16) * 6144 * 2 <= O_END * 4, "d_out scratch");

constexpr size_t WS_RK = WS_EAG + (size_t)MT * 6144 * 2;
constexpr size_t WS_LM = WS_RK + (size_t)MT * 32 * 4;
static_assert(WS_LM + (size_t)(MT / 16) * 32 * 128 * 4 <= WS_WOUT, "RK + LM");
constexpr int SC_SLOT = 6 * 64, SC_BUF = 16 * SC_SLOT;
constexpr int NWAVES = 8, NTHR = 512;
constexpr int LDS_BYTES = 147456;

__device__ __forceinline__ unsigned pk2h(float a, float b) { h16x2 v = {(h16)a, (h16)b}; return __builtin_bit_cast(unsigned, v); }
__device__ __forceinline__ float wave_sum(float v) {
#pragma unroll
    for (int o = 1; o < 64; o <<= 1) v += __shfl_xor(v, o);
    return v;
}
template <int CTRL> __device__ __forceinline__ float dpp_f(float x) { return __builtin_bit_cast(float, __builtin_amdgcn_update_dpp(0, __builtin_bit_cast(int, x), CTRL, 0xF, 0xF, false)); }
__device__ __forceinline__ float row_allreduce8(float x) { x += dpp_f<0xB1>(x); x += dpp_f<0x4E>(x); x += dpp_f<0x141>(x); return x; }
__device__ __forceinline__ float row_allreduce16(float x) { x = row_allreduce8(x); x += dpp_f<0x140>(x); return x; }
__device__ __forceinline__ float rl_f(float x, int l) { return __builtin_bit_cast(float, __builtin_amdgcn_readlane(__builtin_bit_cast(int, x), l)); }
__device__ __forceinline__ float wave_sum_dpp(float x) { x = row_allreduce16(x); return (rl_f(x, 0) + rl_f(x, 16)) + (rl_f(x, 32) + rl_f(x, 48)); }
__device__ __forceinline__ float wave_sum_bc(float x) {
    x = row_allreduce16(x);
    x += __builtin_bit_cast(float, __builtin_amdgcn_update_dpp(0, __builtin_bit_cast(int, x), 0x142, 0xA, 0xF, false));
    x += __builtin_bit_cast(float, __builtin_amdgcn_update_dpp(0, __builtin_bit_cast(int, x), 0x143, 0xC, 0xF, false));
    return rl_f(x, 63); }
__device__ __forceinline__ float sigmoidf_(float x) { return 1.0f / (1.0f + __expf(-x)); }

namespace pg8 {
constexpr int BM = 256, BK = 64, HALF = 128, HTB = HALF * BK * 2, STAGE_BYTES = 8 * HTB, NXCD = 8, WGM = 8;
__host__ __device__ __forceinline__ int lds_byte(int r, int c) { const int st = (r >> 4) * 2 + (c >> 5), rr = r & 15, cc = c & 31, ob = rr * 64 + cc * 2; return st * 1024 + (ob ^ (((ob >> 9) & 1) << 5)); }
__host__ __device__ __forceinline__ void stage_rc(int b, int& R, int& C) { const int st = b / 1024, sb = b % 1024, swz = sb ^ (((sb >> 9) & 1) << 5); R = (st >> 1) * 16 + swz / 64; C = (st & 1) * 32 + (swz % 64) / 2; }
__host__ __device__ __forceinline__ int perm32(int rho) { const int n = rho >> 4, i = rho & 15; return 8 * (i >> 2) + 4 * n + (i & 3); }
struct Unit { int pm, pn, kt0, nkt, sp; };
struct Gemm { const h16* A; const h16* Bt; int M, N, K; };
struct Order {
    int nM, nN, nwg, G, c, extra, nkt, nsplit;
    __device__ void init(int M, int N, int K, int G_, int c_, int extra_, int nMw) { nM = M / BM; nN = N / BM; nwg = (nMw < 0 ? nM : nMw) * nN; G = G_; c = c_; extra = extra_; nkt = K / BK; nsplit = nMw < 0 ? 0 : (nM - nMw) * nN * 4; }
    __device__ bool next(int i, Unit& u) const {
        const long L = (long)i * G + c; if (L >= nwg + extra + nsplit) return false;
        u.kt0 = 0; u.nkt = nkt; u.sp = -1;
        if (L >= nwg + extra) { const int j = (int)(L - nwg - extra), rows = nM - nwg / nN; u.nkt = nkt >> 2;
            if (rows == 8 && nN == 8) {
                const int xcd = j & 7, idx = j >> 3; u.sp = xcd >> 1; u.pn = 4 * (xcd & 1) + (idx >> 3); u.pm = nwg / nN + (idx & 7); }
            else { const int tile = j >> 2; u.sp = j & 3; u.pm = nwg / nN + tile % rows; u.pn = tile / rows; }
            u.kt0 = u.sp * u.nkt; return true; }
        if (L >= nwg) { u.pm = nM; u.pn = (int)(L - nwg); return true; }
        const int nMe = nwg / nN;
        int wgid = (int)L; { const int q = nwg / NXCD, r = nwg % NXCD, xcd = wgid % NXCD, off = wgid / NXCD; wgid = (xcd < r ? xcd * (q + 1) : r * (q + 1) + (xcd - r) * q) + off; }
        const int nig = WGM * nN, gid = wgid / nig, fm = gid * WGM, gsz = (nMe - fm) < WGM ? (nMe - fm) : WGM;
        u.pm = fm + ((wgid % nig) % gsz); u.pn = (wgid % nig) / gsz; return true;
    }
};

template <class Epi, bool SP2 = true, bool ALIGN_EPI = true>
__device__ __forceinline__ void gemm_phase(LAS unsigned char* lds, const Gemm g, const Order& S, const Epi& E) {
    const int tid = threadIdx.x, wid = __builtin_amdgcn_readfirstlane(tid >> 6), lane = tid & 63, wr = wid >> 2, wc = wid & 3, fr = lane & 15, fq = lane >> 4;
    const int K = g.K;
    unsigned voffA[2], voffB[2];
#pragma unroll
    for (int i = 0; i < 2; ++i) { int R, C; stage_rc(tid * 16 + i * 8192, R, C); const int Rb = Epi::PERM ? ((R & ~31) + perm32(R & 31)) : R;
        voffA[i] = (unsigned)(R * K + C) * 2u; voffB[i] = (unsigned)(Rb * K + C) * 2u; }
    const size_t kstep = (size_t)(BK * 2);
    const size_t hstep = (size_t)HALF * K * 2;
    const size_t tstep = 2 * hstep;
    const unsigned ldsw = (unsigned)wid * 1024u;
    const int aoff = lds_byte(wr * 64 + fr, fq * 8), boff = lds_byte(wc * 32 + fr, fq * 8);
#define PG8_SA(b, h) (((b) * 2 + (h)) * HTB)
#define PG8_SB(b, h) ((4 + (b) * 2 + (h)) * HTB)
#define PG8_STAGE(bufoff, gbase, voff) do { _Pragma("unroll") for (int _i = 0; _i < 2; ++_i) \
        __builtin_amdgcn_global_load_lds((const unsigned*)((const char*)(gbase) + (voff)[_i]), (LAS unsigned*)(lds + (bufoff) + ldsw + _i * 8192), 16, 0, 0); } while (0)
#define PG8_LDA(dst, b, h) do { _Pragma("unroll") for (int m = 0; m < 4; ++m) _Pragma("unroll") for (int k = 0; k < 2; ++k) dst[m][k] = *(const LAS h16x8*)(lds + PG8_SA(b, h) + aoff + m * 2048 + k * 1024); } while (0)
#define PG8_LDB(dst, b, h) do { _Pragma("unroll") for (int n = 0; n < 2; ++n) _Pragma("unroll") for (int k = 0; k < 2; ++k) dst[n][k] = *(const LAS h16x8*)(lds + PG8_SB(b, h) + boff + n * 2048 + k * 1024); } while (0)
#define PG8_MMA(ai, bj, At, Bt) do { __builtin_amdgcn_s_setprio(1); _Pragma("unroll") for (int m = 0; m < 4; ++m) _Pragma("unroll") for (int n = 0; n < 2; ++n) _Pragma("unroll") for (int k = 0; k < 2; ++k) \
        acc[ai][bj][m][n] = __builtin_amdgcn_mfma_f32_16x16x32_f16(Bt[n][k], At[m][k], acc[ai][bj][m][n], 0, 0, 0); __builtin_amdgcn_s_setprio(0); } while (0)
#define PG8_WAIT_V(n) asm volatile("s_waitcnt vmcnt(" #n ")" ::: "memory")
#define PG8_WAIT_L(n) asm volatile("s_waitcnt lgkmcnt(" #n ")" ::: "memory")
#define PG8_BAR __builtin_amdgcn_s_barrier()
#define PG8_SCHED __builtin_amdgcn_sched_barrier(0)
    Unit cur, nxt; int ui = 0;
    if (!S.next(0, cur)) return;
    f32x4 acc[2][2][4][2];
#pragma unroll
    for (int a = 0; a < 2; ++a)
#pragma unroll
        for (int b = 0; b < 2; ++b)
#pragma unroll
            for (int m = 0; m < 4; ++m)
#pragma unroll
                for (int n = 0; n < 2; ++n) acc[a][b][m][n] = (f32x4){0.f, 0.f, 0.f, 0.f};
    h16x8 At[4][2], B0[2][2], B1[2][2];
    const char* cA = (const char*)g.A + (size_t)cur.pm * tstep + (size_t)cur.kt0 * kstep; const char* cB = (const char*)g.Bt + (size_t)cur.pn * tstep + (size_t)cur.kt0 * kstep;
    if constexpr (SP2) {
        PG8_STAGE(PG8_SB(0, 0), cB, voffB); PG8_STAGE(PG8_SB(0, 1), cB + hstep, voffB); PG8_STAGE(PG8_SA(0, 0), cA, voffA); PG8_STAGE(PG8_SA(0, 1), cA + hstep, voffA);
        if (wr == 1) PG8_BAR;
        PG8_WAIT_V(2); PG8_BAR;
        PG8_STAGE(PG8_SB(1, 0), cB + kstep, voffB); PG8_STAGE(PG8_SA(1, 0), cA + kstep, voffA); PG8_STAGE(PG8_SB(1, 1), cB + hstep + kstep, voffB);
        PG8_WAIT_V(6); PG8_BAR;
    } else {
        PG8_STAGE(PG8_SB(0, 0), cB, voffB); PG8_STAGE(PG8_SA(0, 0), cA, voffA); PG8_STAGE(PG8_SB(0, 1), cB + hstep, voffB); PG8_STAGE(PG8_SA(0, 1), cA + hstep, voffA);
        if (wr == 1) PG8_BAR;
        PG8_WAIT_V(4); PG8_BAR;
        PG8_STAGE(PG8_SB(1, 0), cB + kstep, voffB); PG8_STAGE(PG8_SA(1, 0), cA + kstep, voffA); PG8_STAGE(PG8_SB(1, 1), cB + hstep + kstep, voffB);
        PG8_WAIT_V(6); PG8_BAR;
    }
    for (;;) {
        const bool has_next = S.next(ui + 1, nxt);
        const char* nA = has_next ? (const char*)g.A + (size_t)nxt.pm * tstep + (size_t)nxt.kt0 * kstep : cA; const char* nB = has_next ? (const char*)g.Bt + (size_t)nxt.pn * tstep + (size_t)nxt.kt0 * kstep : cB;
        const int nt = cur.nkt;
        for (int t = 0; t < nt; t += 2) {
            const bool last = (t == nt - 2);
            const char* a1 = cA + (size_t)(t + 1) * kstep;
            const char* a2 = last ? nA : cA + (size_t)(t + 2) * kstep; const char* b2 = last ? nB : cB + (size_t)(t + 2) * kstep;
            const char* a3 = a2 + kstep; const char* b3 = b2 + kstep;
            if constexpr (SP2) {
            PG8_LDB(B0, 0, 0); PG8_LDB(B1, 0, 1); PG8_SCHED; PG8_LDA(At, 0, 0); PG8_STAGE(PG8_SA(1, 1), a1 + hstep, voffA);
            PG8_WAIT_V(8); PG8_WAIT_L(0); PG8_BAR; PG8_MMA(0, 0, At, B0); PG8_MMA(0, 1, At, B1); PG8_BAR; PG8_SCHED;
            PG8_LDA(At, 0, 1); PG8_STAGE(PG8_SB(0, 0), b2, voffB); PG8_STAGE(PG8_SB(0, 1), b2 + hstep, voffB); PG8_STAGE(PG8_SA(0, 0), a2, voffA);
            PG8_WAIT_V(8); PG8_WAIT_L(0); PG8_BAR; PG8_MMA(1, 0, At, B0); PG8_MMA(1, 1, At, B1); PG8_BAR; PG8_SCHED;
            PG8_LDB(B0, 1, 0); PG8_LDB(B1, 1, 1); PG8_SCHED; PG8_LDA(At, 1, 0); PG8_STAGE(PG8_SA(0, 1), a2 + hstep, voffA);
            PG8_WAIT_V(8); PG8_WAIT_L(0); PG8_BAR; PG8_MMA(0, 0, At, B0); PG8_MMA(0, 1, At, B1); PG8_BAR; PG8_SCHED;
            PG8_LDA(At, 1, 1); PG8_STAGE(PG8_SB(1, 0), b3, voffB); PG8_STAGE(PG8_SB(1, 1), b3 + hstep, voffB); PG8_STAGE(PG8_SA(1, 0), a3, voffA);
            PG8_WAIT_V(8); PG8_WAIT_L(0); PG8_BAR; PG8_MMA(1, 0, At, B0); PG8_MMA(1, 1, At, B1); PG8_BAR; PG8_SCHED;
            } else {
            PG8_LDB(B0, 0, 0); PG8_SCHED; PG8_LDA(At, 0, 0); PG8_STAGE(PG8_SA(1, 1), a1 + hstep, voffA);
            PG8_WAIT_L(8); PG8_BAR; PG8_WAIT_L(0); PG8_MMA(0, 0, At, B0); PG8_BAR; PG8_SCHED;
            PG8_LDB(B1, 0, 1); PG8_STAGE(PG8_SB(0, 0), b2, voffB);
            PG8_BAR; PG8_WAIT_L(0); PG8_MMA(0, 1, At, B1); PG8_BAR;
            PG8_LDA(At, 0, 1); PG8_STAGE(PG8_SA(0, 0), a2, voffA);
            PG8_BAR; PG8_WAIT_L(0); PG8_MMA(1, 0, At, B0); PG8_BAR; PG8_SCHED;
            PG8_STAGE(PG8_SB(0, 1), b2 + hstep, voffB);
            PG8_WAIT_V(6); PG8_BAR; PG8_MMA(1, 1, At, B1); PG8_BAR;
            PG8_LDB(B0, 1, 0); PG8_SCHED; PG8_LDA(At, 1, 0); PG8_STAGE(PG8_SA(0, 1), a2 + hstep, voffA);
            PG8_WAIT_L(8); PG8_BAR; PG8_WAIT_L(0); PG8_MMA(0, 0, At, B0); PG8_BAR; PG8_SCHED;
            PG8_LDB(B1, 1, 1); PG8_STAGE(PG8_SB(1, 0), b3, voffB);
            PG8_BAR; PG8_WAIT_L(0); PG8_MMA(0, 1, At, B1); PG8_BAR;
            PG8_LDA(At, 1, 1); PG8_STAGE(PG8_SA(1, 0), a3, voffA);
            PG8_BAR; PG8_WAIT_L(0); PG8_MMA(1, 0, At, B0); PG8_BAR; PG8_SCHED;
            PG8_STAGE(PG8_SB(1, 1), b3 + hstep, voffB);
            PG8_WAIT_V(6); PG8_BAR; PG8_MMA(1, 1, At, B1); PG8_BAR;
                    }
        }
        if constexpr (ALIGN_EPI) { if (wr == 0) PG8_BAR; }
        E(acc, cur, wr, wc, fr, fq);
        if (!has_next) break;
#pragma unroll
        for (int a = 0; a < 2; ++a)
#pragma unroll
            for (int b = 0; b < 2; ++b)
#pragma unroll
                for (int m = 0; m < 4; ++m)
#pragma unroll
                    for (int n = 0; n < 2; ++n) acc[a][b][m][n] = (f32x4){0.f, 0.f, 0.f, 0.f};
        cur = nxt; cA = nA; cB = nB; ++ui;
        if constexpr (ALIGN_EPI) { if (wr == 1) PG8_BAR; }
    }
    PG8_WAIT_V(0);
    if constexpr (!ALIGN_EPI) { if (wr == 0) PG8_BAR; }
    PG8_BAR;
#undef PG8_SA
#undef PG8_SB
#undef PG8_STAGE
#undef PG8_LDA
#undef PG8_LDB
#undef PG8_MMA
#undef PG8_WAIT_V
#undef PG8_WAIT_L
#undef PG8_BAR
#undef PG8_SCHED
}

struct EpiSwiGLU {
    static constexpr bool PERM = false;
    h16* O; int ldo;
    __device__ __forceinline__ void operator()(const f32x4 (&acc)[2][2][4][2], const Unit& u, int wr, int wc, int fr, int fq) const {
        const int row0 = u.pm * BM + wr * 64 + fr;
#pragma unroll
        for (int ai = 0; ai < 2; ++ai)
#pragma unroll
            for (int m = 0; m < 4; ++m) { h16* rowp = O + (size_t)(row0 + ai * HALF + m * 16) * ldo;
#pragma unroll
                for (int bj = 0; bj < 2; ++bj) { const int oc = (u.pn * BM + bj * HALF + wc * 32) / 2 + 4 * fq;
                    const f32x4 gt = acc[ai][bj][m][0], up = acc[ai][bj][m][1]; float o[4];
#pragma unroll
                    for (int j = 0; j < 4; ++j) o[j] = gt[j] * sigmoidf_(gt[j]) * up[j];
                    u32x2 w; w.x = pk2h(o[0], o[1]); w.y = pk2h(o[2], o[3]);
                    *(u32x2*)(rowp + oc) = w; } }
    }
};
template <bool RES16, bool OUT16> struct EpiRes {
    static constexpr bool PERM = false;
    const void* res; void* out; float* slab; float scale; int pad;
    __device__ __forceinline__ void operator()(const f32x4 (&acc)[2][2][4][2], const Unit& u, int wr, int wc, int fr, int fq) const {
        const int row0 = u.pm * BM + wr * 64 + fr, col0 = u.pn * BM + wc * 32 + 4 * fq;
        if (u.sp >= 0) {
            float* sb = slab + ((size_t)u.sp * MS - MP) * D;
#pragma unroll
            for (int ai = 0; ai < 2; ++ai)
#pragma unroll
                for (int m = 0; m < 4; ++m) { const size_t off = (size_t)(row0 + ai * HALF + m * 16) * D + col0;
#pragma unroll
                    for (int bj = 0; bj < 2; ++bj)
#pragma unroll
                        for (int n = 0; n < 2; ++n) *(f32x4*)(sb + off + bj * HALF + n * 16) = acc[ai][bj][m][n]; }
            return;
        }
#pragma unroll
        for (int ai = 0; ai < 2; ++ai)
#pragma unroll
            for (int m = 0; m < 4; ++m) { const size_t off = (size_t)(row0 + ai * HALF + m * 16) * D + col0;
#pragma unroll
                for (int bj = 0; bj < 2; ++bj)
#pragma unroll
                    for (int n = 0; n < 2; ++n) { f32x4 rv; const size_t o_ = off + bj * HALF + n * 16;
                        if constexpr (RES16) { const h16x4 hv = *(const h16x4*)((const h16*)res + o_); rv = (f32x4){(float)hv[0], (float)hv[1], (float)hv[2], (float)hv[3]}; }
                        else rv = *(const f32x4*)((const float*)res + o_);
                        const f32x4 o = rv + scale * acc[ai][bj][m][n];
                        if constexpr (OUT16) { u32x2 w; w.x = pk2h(o[0], o[1]); w.y = pk2h(o[2], o[3]); *(u32x2*)((h16*)out + o_) = w; }
                        else *(f32x4*)((float*)out + o_) = o; } }
    }
};
struct EpiP16 {
    static constexpr bool PERM = true;
    h16* P; h16* PF;
    __device__ __forceinline__ void operator()(const f32x4 (&acc)[2][2][4][2], const Unit& u, int wr, int wc, int fr, int fq) const {
        const int row0 = u.pm * BM + wr * 64 + fr; const int kind = u.pn < 26 ? 0 : u.pn < 42 ? 1 : u.pn < 58 ? 2 : 3;
#pragma unroll
        for (int ai = 0; ai < 2; ++ai)
#pragma unroll
            for (int m = 0; m < 4; ++m) { const int row = row0 + ai * HALF + m * 16;
#pragma unroll
                for (int bj = 0; bj < 2; ++bj) { const int gcol = u.pn * BM + bj * HALF + wc * 32;
                    const f32x4 v0 = acc[ai][bj][m][0], v1 = acc[ai][bj][m][1];
                    if (kind == 0) { u32x4 w; w.x = pk2h(v0[0], v0[1]); w.y = pk2h(v0[2], v0[3]); w.z = pk2h(v1[0], v1[1]); w.w = pk2h(v1[2], v1[3]);
                        if (u.pm < MT / BM) *(u32x4*)(P + (size_t)row * PP + gcol + 8 * fq) = w;
                        else *(u32x4*)(PF + (size_t)(row - MT) * PFW + gcol + 8 * fq) = w; }
                    else if (kind == 3) { u32x4 w; w.x = pk2h(sigmoidf_(v0[0]), sigmoidf_(v0[1])); w.y = pk2h(sigmoidf_(v0[2]), sigmoidf_(v0[3])); w.z = pk2h(sigmoidf_(v1[0]), sigmoidf_(v1[1])); w.w = pk2h(sigmoidf_(v1[2]), sigmoidf_(v1[3]));
                        *(u32x4*)(P + (size_t)row * PP + C_SA + (gcol - (PFW + 8192)) + 8 * fq) = w; }
                    else { float o[4];
#pragma unroll
                        for (int j = 0; j < 4; ++j) o[j] = kind == 1 ? v0[j] * v1[j] : sigmoidf_(v1[j]) * v0[j];
                        u32x2 w; w.x = pk2h(o[0], o[1]); w.y = pk2h(o[2], o[3]);
                        *(u32x2*)(P + (size_t)row * PP + (kind == 1 ? C_U + ((gcol - PFW) >> 1) : C_Q + ((gcol - PFW - 4096) >> 1)) + 4 * fq) = w; } } }
    }
};
struct EpiEAG {
    static constexpr bool PERM = true;
    h16* O; const float* w0; const float* a0;
    __device__ __forceinline__ void operator()(const f32x4 (&acc)[2][2][4][2], const Unit& u, int wr, int wc, int fr, int fq) const {
        const int row0 = u.pm * BM + wr * 64 + fr; const int typ = u.pn >> 3;
#pragma unroll
        for (int bj = 0; bj < 2; ++bj) { const int col = u.pn * BM + bj * HALF + wc * 32 + 8 * fq;
            f32x4 b0 = (f32x4){0.f, 0.f, 0.f, 0.f}, b1 = b0;
            if (typ == 0) { b0 = *(const f32x4*)(w0 + col); b1 = *(const f32x4*)(w0 + col + 4); }
            if (typ == 1) { b0 = *(const f32x4*)(a0 + col - D); b1 = *(const f32x4*)(a0 + col - D + 4); }
#pragma unroll
            for (int ai = 0; ai < 2; ++ai)
#pragma unroll
                for (int m = 0; m < 4; ++m) { const int row = row0 + ai * HALF + m * 16;
                    f32x4 v0 = acc[ai][bj][m][0] + b0, v1 = acc[ai][bj][m][1] + b1;
                    if (typ < 2) { const float sc = typ == 0 ? 0.60653065971f : 1.0f;
#pragma unroll
                        for (int j = 0; j < 4; ++j) { v0[j] = sigmoidf_(v0[j]) * sc; v1[j] = sigmoidf_(v1[j]) * sc; } }
                    u32x4 w; w.x = pk2h(v0[0], v0[1]); w.y = pk2h(v0[2], v0[3]); w.z = pk2h(v1[0], v1[1]); w.w = pk2h(v1[2], v1[3]);
                    *(u32x4*)(O + (size_t)row * 6144 + col) = w; } }
    }
};
}


#define XB_TMO      128
#define XB_XCNT(j)  (256  + 64 * (j))
#define XB_XSUB(j)  (1280 + 64 * (j))
#define XB_XGEN(j)  (2304 + 64 * (j))
#define XB_TOP      3328
#define XB_TOPGEN   3392
#define XCD_BAR_WORDS 3456
#define XB_SPIN_CAP (1u << 22)
__device__ __forceinline__ unsigned xb_ld(unsigned* p)              { return __hip_atomic_load(p, __ATOMIC_RELAXED, __HIP_MEMORY_SCOPE_AGENT); }
__device__ __forceinline__ unsigned xb_add(unsigned* p, unsigned v) { return __hip_atomic_fetch_add(p, v, __ATOMIC_RELAXED, __HIP_MEMORY_SCOPE_AGENT); }
__device__ __forceinline__ unsigned xb_xcc_id() { return (unsigned)__builtin_amdgcn_s_getreg((3 << 11) | 20) & 0xFu; }
#define XB_SPIN(cond, bar) do { unsigned _sp = 0; while (cond) { __builtin_amdgcn_s_sleep(1); \
    if ((++_sp & 255u) == 0u) { if (xb_ld(&(bar)[XB_TMO])) break; if (_sp > XB_SPIN_CAP) { atomicAdd(&(bar)[XB_TMO], 1u); break; } } } } while (0)
struct XcdBarrier { unsigned* bar; unsigned x; volatile LAS unsigned* st; };
__device__ __forceinline__ XcdBarrier xcd_barrier_post(unsigned* bar, volatile LAS unsigned* st) {
    XcdBarrier b; b.bar = bar; b.x = xb_xcc_id(); b.st = st;
    if (threadIdx.x == 0) (void)xb_add(&bar[XB_XCNT(b.x)], 1u);
    return b;
}
__device__ __forceinline__ void xcd_barrier_complete(unsigned* bar, unsigned x, unsigned& nloc, unsigned& nx) {
    const unsigned G = gridDim.x * gridDim.y * gridDim.z;
    unsigned sum, cnt, mine, sp = 0u;
    for (;;) {
        sum = 0u; cnt = 0u; mine = 0u;
#pragma unroll
        for (unsigned j = 0; j < 16; ++j) { const unsigned c = xb_ld(&bar[XB_XCNT(j)]); sum += c; cnt += (c > 0u) ? 1u : 0u; mine = (j == x) ? c : mine; }
        if (sum == G) break;
        __builtin_amdgcn_s_sleep(1);
        if ((++sp & 255u) == 0u) { if (xb_ld(&bar[XB_TMO])) break; if (sp > XB_SPIN_CAP) { atomicAdd(&bar[XB_TMO], 1u); break; } }
    }
    nloc = mine > 0u ? mine : 1u; nx = cnt > 0u ? cnt : 1u;
}
__device__ __forceinline__ void xcd_barrier(const XcdBarrier& b) {
    asm volatile("s_waitcnt vmcnt(0)" ::: "memory");
    __syncthreads();
    if (threadIdx.x == 0) {
        unsigned* bar = b.bar;
        __builtin_amdgcn_s_waitcnt(0);
        unsigned nloc = b.st[0], nx = b.st[1];
        if (nloc == 0u) { xcd_barrier_complete(bar, b.x, nloc, nx); b.st[0] = nloc; b.st[1] = nx; }
        const unsigned old = xb_add(&bar[XB_XSUB(b.x)], 1u);
        const unsigned gen = old / nloc;
        if (old + 1u == (gen + 1u) * nloc) {
            __builtin_amdgcn_fence(__ATOMIC_RELEASE, "agent");
            asm volatile("s_waitcnt vmcnt(0)" ::: "memory");
            const unsigned og = xb_add(&bar[XB_TOP], 1u);
            const unsigned tg = og / nx;
            if (og + 1u == (tg + 1u) * nx) xb_add(&bar[XB_TOPGEN], 1u);
            else XB_SPIN(xb_ld(&bar[XB_TOPGEN]) == tg, bar);
            __builtin_amdgcn_fence(__ATOMIC_ACQUIRE, "agent");
            xb_add(&bar[XB_XGEN(b.x)], 1u);
            asm volatile("s_waitcnt vmcnt(0)" ::: "memory");
        } else {
            XB_SPIN(xb_ld(&bar[XB_XGEN(b.x)]) == gen, bar);
            __builtin_amdgcn_fence(__ATOMIC_ACQUIRE, "agent");
            asm volatile("s_waitcnt vmcnt(0)" ::: "memory");
        }
    }
    __syncthreads();
}

struct Args { const float* in[29]; float* out; unsigned char* ws; int ph_lo, ph_hi; };

__device__ __forceinline__ void cvt_item(int mode, const float* s0, const float* s1, int Nsrc, int K, h16* WT, LAS float* scr, int item, int nblk, int lane) {
    const int kb = item / nblk, nb = item % nblk, k0 = 64 * kb, n0 = 32 * nb;
    const int nn = lane & 31; const float* src = s0; int col = n0 + nn; bool zero = false;
    if (mode == 1) { src = (nn < 16) ? s0 : s1; col = (n0 >> 1) + (nn & 15); }
    if (mode == 2) { if (n0 >= NA && n0 < PFW) zero = true; else if (n0 >= PFW) col -= 64; }
#pragma unroll 8
    for (int i = 0; i < 32; ++i) { const int kk = 2 * i + (lane >> 5); scr[kk * 33 + nn] = zero ? 0.f : src[(size_t)(k0 + kk) * Nsrc + col]; }
    asm volatile("s_waitcnt lgkmcnt(0)" ::: "memory");
    const int c = lane & 7;
#pragma unroll
    for (int j = 0; j < 4; ++j) { const int n = (lane >> 3) + 8 * j; const LAS float* s = scr + (8 * c) * 33 + n;
        u32x4 o; o.x = pk2h(s[0 * 33], s[1 * 33]); o.y = pk2h(s[2 * 33], s[3 * 33]); o.z = pk2h(s[4 * 33], s[5 * 33]); o.w = pk2h(s[6 * 33], s[7 * 33]);
        *(u32x4*)(WT + (size_t)(n0 + n) * K + k0 + 8 * c) = o; }
    asm volatile("s_waitcnt lgkmcnt(0)" ::: "memory");
}
struct CvtIt { const float* p; h16* q; int Nsrc, K; bool zero; };
__device__ __forceinline__ CvtIt cvt_decode(int mode, const float* s0, const float* s1, int Nsrc, int K, h16* WT, int nblk, int item, int lane) {
    const int kb = item / nblk, nb = item % nblk, k0 = 64 * kb, n0 = 32 * nb, nn = lane & 31;
    const float* src = s0; int col = n0 + nn; bool zero = false;
    if (mode == 1) { src = (nn < 16) ? s0 : s1; col = (n0 >> 1) + (nn & 15); }
    if (mode == 2) {
        const int q = nn >> 3, sp = (nn >> 2) & 1, j = nn & 3;
        if (n0 >= NA && n0 < PFW) { zero = true; col = 0; }
        else if (n0 >= PFW && n0 < PFW + 4096) col = (sp ? NA + 2 * D : NA + D) + ((n0 - PFW) >> 1) + 4 * q + j;
        else if (n0 >= PFW + 4096 && n0 < PFW + 8192) col = (sp ? NA + 4 * D : NA) + ((n0 - PFW - 4096) >> 1) + 4 * q + j;
        else if (n0 >= PFW + 8192) col = NA + 3 * D + (n0 - PFW - 8192) + nn; }
    CvtIt r; r.p = src + (size_t)(k0 + (lane >> 5)) * Nsrc + col; r.q = WT + (size_t)(n0 + (lane >> 3)) * K + k0 + 8 * (lane & 7); r.Nsrc = Nsrc; r.K = K; r.zero = zero; return r;
}
__device__ __forceinline__ void cvt_load(const CvtIt& t, float (&v)[32]) {
#pragma unroll
    for (int i = 0; i < 32; ++i) v[i] = t.p[(size_t)(2 * i) * t.Nsrc];
}
__device__ __forceinline__ void cvt_finish(const CvtIt& t, const float (&v)[32], LAS float* scr, int lane) {
    const int nn = lane & 31;
#pragma unroll
    for (int i = 0; i < 32; ++i) scr[(2 * i + (lane >> 5)) * 33 + nn] = t.zero ? 0.f : v[i];
    asm volatile("s_waitcnt lgkmcnt(0)" ::: "memory");
    const int c = lane & 7;
#pragma unroll
    for (int j = 0; j < 4; ++j) { const int n = (lane >> 3) + 8 * j; const LAS float* s = scr + (8 * c) * 33 + n;
        u32x4 o; o.x = pk2h(s[0 * 33], s[1 * 33]); o.y = pk2h(s[2 * 33], s[3 * 33]); o.z = pk2h(s[4 * 33], s[5 * 33]); o.w = pk2h(s[6 * 33], s[7 * 33]);
        *(u32x4*)(t.q + (size_t)(8 * j) * t.K) = o; }
    asm volatile("s_waitcnt lgkmcnt(0)" ::: "memory");
}
#define CVT_RUN(total_, PICK) do { float va[32], vb[32]; CvtIt A_, B_; int it_ = gw; if (it_ < (total_)) { PICK(it_, A_); cvt_load(A_, va); \
        for (;;) { const int itb_ = it_ + NGW; const bool hb_ = itb_ < (total_); if (hb_) { PICK(itb_, B_); cvt_load(B_, vb); } cvt_finish(A_, va, scr, lane); if (!hb_) break; \
            it_ = itb_ + NGW; const bool ha_ = it_ < (total_); if (ha_) { PICK(it_, A_); cvt_load(A_, va); } cvt_finish(B_, vb, scr, lane); if (!ha_) break; } } } while (0)
__device__ __forceinline__ void cvt_lora_item(const float* wl, const float* al, const float* gl, h16* WT, int item, int lane) {
    const int n = item, typ = n >> 11, col = n & 2047; unsigned w[4];
#pragma unroll
    for (int j = 0; j < 4; ++j) { float v[2];
#pragma unroll
        for (int e = 0; e < 2; ++e) { const int k = lane * 8 + j * 2 + e; float x = 0.f;
            if (typ == 0 && k < 96) x = wl[(size_t)k * D + col];
            if (typ == 1 && k >= 96 && k < 192) x = al[(size_t)(k - 96) * D + col];
            if (typ == 2 && k >= 192 && k < 448) x = gl[(size_t)(k - 192) * D + col];
            v[e] = x; }
        w[j] = pk2h(v[0], v[1]); }
    *(u32x4*)(WT + (size_t)n * LK + lane * 8) = (u32x4){w[0], w[1], w[2], w[3]};
}

__device__ __forceinline__ void rms_row_f16(const float* xrow, const float* g, h16* orow, float* f32row, int lane, const float* part = nullptr, float pscale = 0.f, float* xout = nullptr) {
    const f32x4* xr = (const f32x4*)xrow + lane; const f32x4* gr = (const f32x4*)g + lane;
    f32x4 v[8]; float s = 0.f;
#pragma unroll
    for (int j = 0; j < 8; ++j) { v[j] = xr[64 * j];
        if (part) { const f32x4* pp = (const f32x4*)part + lane + 64 * j; const size_t st = (size_t)MS * D / 4;
            v[j] += pscale * ((pp[0] + pp[st]) + (pp[2 * st] + pp[3 * st])); if (xout) *((f32x4*)xout + lane + 64 * j) = v[j]; }
        s += (v[j].x * v[j].x + v[j].y * v[j].y) + (v[j].z * v[j].z + v[j].w * v[j].w); }
    const float rs = rsqrtf(wave_sum(s) * (1.f / D) + 1e-6f);
#pragma unroll
    for (int j = 0; j < 8; ++j) { const f32x4 gg = gr[64 * j]; const f32x4 o = v[j] * rs * gg;
        if (orow) { u32x2 w; w.x = pk2h(o.x, o.y); w.y = pk2h(o.z, o.w); *((u32x2*)orow + lane + 64 * j) = w; }
        if (f32row) *((f32x4*)f32row + lane + 64 * j) = o; }
}

__device__ __forceinline__ void rms_row_h(const h16* xrow, const float* g, h16* orow, float* f32row, int lane) {
    const f32x4* gr = (const f32x4*)g + lane;
    f32x4 v[8]; float s = 0.f;
#pragma unroll
    for (int j = 0; j < 8; ++j) { const h16x4 hv = *((const h16x4*)xrow + lane + 64 * j);
        v[j] = (f32x4){(float)hv[0], (float)hv[1], (float)hv[2], (float)hv[3]};
        s += (v[j].x * v[j].x + v[j].y * v[j].y) + (v[j].z * v[j].z + v[j].w * v[j].w); }
    const float rs = rsqrtf(wave_sum(s) * (1.f / D) + 1e-6f);
#pragma unroll
    for (int j = 0; j < 8; ++j) { const f32x4 gg = gr[64 * j]; const f32x4 o = v[j] * rs * gg;
        if (orow) { u32x2 w; w.x = pk2h(o.x, o.y); w.y = pk2h(o.z, o.w); *((u32x2*)orow + lane + 64 * j) = w; }
        if (f32row) *((f32x4*)f32row + lane + 64 * j) = o; }
}

enum { PH_CVT1 = 0, PH_FFN1_GU, PH_FFN1_D, PH_RMS_MIX, PH_WIN, PH_SHIFT, PH_LORA, PH_PREP, PH_SCAN, PH_MERGE, PH_WOUT, PH_RMS2, PH_FFN2_GU, PH_FFN2_D, PH_FINAL, PH_N };

__global__ void __launch_bounds__(NTHR, 2) fwd_kernel(Args a) {
    extern __shared__ __attribute__((aligned(16))) unsigned char lds_raw[];
    LAS unsigned char* lds = (LAS unsigned char*)lds_raw;
    const int tid = threadIdx.x, lane = tid & 63, wave = __builtin_amdgcn_readfirstlane(tid >> 6);
    const int G = gridDim.x, bx = blockIdx.x;
    const int gw = bx * NWAVES + wave, NGW = G * NWAVES;
    unsigned char* ws = a.ws; unsigned char* ob = (unsigned char*)a.out;
    h16* W1GU = (h16*)(ws + WS_W1GU); h16* W1D = (h16*)(ws + WS_W1D); h16* WIN = (h16*)(ws + WS_WIN); h16* WOUT = (h16*)(ws + WS_WOUT);
    h16* A16 = (h16*)(ws + WS_A16); h16* P16 = (h16*)(ws + WS_P16); h16* EAG = (h16*)(ws + WS_EAG); h16* HM = (h16*)(ws + WS_HM);
    h16* W2GU = (h16*)(ws + WS_W2GU); h16* W2D = (h16*)(ws + WS_W2D);
    h16* WL = (h16*)(ob + OB_WL); h16* PF = (h16*)(ws + WS_PF);
    float* Y = a.out + O_Y; float* SLAB = (float*)(ws + WS_SLAB);
    h16* XH = (h16*)(a.out + O_Y);
    const int lo = a.ph_lo, hi = a.ph_hi;
#define IN(k) (lo <= (k) && (k) < hi)
    cg::grid_group grid = cg::this_grid();
    volatile LAS unsigned* xst = (volatile LAS unsigned*)(lds + LDS_BYTES - 16);
    if (tid < 2) xst[tid] = 0u;
    __syncthreads();
    const XcdBarrier xbar = xcd_barrier_post((unsigned*)(ws + WS_CTL), xst);
#ifndef PROBE_MASK
#define PROBE_MASK 0u
#endif
    unsigned long long pr_t[PH_N + 1]; (void)pr_t;
    if (PROBE_MASK) pr_t[0] = __builtin_amdgcn_s_memrealtime();
#define SEAM(k) do { if (IN(k) && IN((k) + 1)) { if ((k) == PH_CVT1) grid.sync(); else xcd_barrier(xbar); } if (PROBE_MASK) pr_t[(k) + 1] = __builtin_amdgcn_s_memrealtime(); } while (0)

    if (IN(PH_CVT1)) {
        LAS float* scr = (LAS float*)(lds + wave * 16384);
        constexpr int I1 = (D / 64) * (2 * FF / 32), I2 = (FF / 64) * (D / 32), I3 = (D / 64) * (NW / 32), I4 = (D / 64) * (D / 32);
#define PICK1(it, out) do { int r_ = (it); if (r_ < I1) out = cvt_decode(1, a.in[6], a.in[7], FF, D, W1GU, 2 * FF / 32, r_, lane); else if ((r_ -= I1) < I2) out = cvt_decode(0, a.in[8], a.in[8], D, FF, W1D, D / 32, r_, lane); \
            else if ((r_ -= I2) < I3) out = cvt_decode(2, a.in[10], a.in[10], NIN, D, WIN, NW / 32, r_, lane); else out = cvt_decode(0, a.in[23], a.in[23], D, D, WOUT, D / 32, r_ - I3, lane); } while (0)
        CVT_RUN(I1 + I2 + I3 + I4, PICK1);
#undef PICK1
        for (int it = gw; it < 6144; it += NGW) cvt_lora_item(a.in[13], a.in[15], a.in[16], WL, it, lane);
        for (int r = gw; r < 256; r += NGW) { h16* orow = A16 + (size_t)(MT + r) * D;
#pragma unroll
            for (int j = 0; j < 8; ++j) { u32x2 w = (u32x2){0u, 0u};
                if (r < 32) { const f32x4 v = *((const f32x4*)(a.in[2] + (size_t)r * D) + lane + 64 * j); w.x = pk2h(v.x, v.y); w.y = pk2h(v.z, v.w); }
                *((u32x2*)orow + lane + 64 * j) = w; } }
        for (int m = gw; m < MT; m += NGW) { const float* xr = m < MP ? a.in[0] + (size_t)m * D : a.in[1] + (size_t)(m - MP) * D; rms_row_f16(xr, a.in[5], A16 + (size_t)m * D, nullptr, lane); }
    }
    SEAM(PH_CVT1);
    if (IN(PH_FFN1_GU)) { pg8::Gemm g{A16, W1GU, MT, 2 * FF, D}; pg8::Order S; S.init(MT, 2 * FF, D, G, bx, 0, -1); pg8::EpiSwiGLU E{HM, FF}; pg8::gemm_phase(lds, g, S, E); }
    SEAM(PH_FFN1_GU);
    if (IN(PH_FFN1_D)) { pg8::Gemm g{HM, W1D, MT, D, FF}; pg8::Order S; S.init(MT, D, FF, G, bx, 0, MP / 256); pg8::EpiRes<false, true> E{a.in[0], XH, SLAB, 0.5f, 0}; pg8::gemm_phase(lds, g, S, E); }
    SEAM(PH_FFN1_D);
    if (IN(PH_RMS_MIX)) {
        for (int m = gw; m < MT; m += NGW) { float* so = nullptr;
            if (m < MP) { if ((m & 4095) == 4095) so = a.out + O_SHP + (size_t)(m >> 12) * D; } else { if (((m - MP) & 63) == 63) so = a.out + O_SHS + (size_t)((m - MP) >> 6) * D; }
            if (m < MP) rms_row_h(XH + (size_t)m * D, a.in[9], A16 + (size_t)m * D, so, lane);
            else rms_row_f16(a.in[1] + (size_t)(m - MP) * D, a.in[9], A16 + (size_t)m * D, so, lane, SLAB + (size_t)(m - MP) * D, 0.5f, Y + (size_t)m * D); }
    }
    SEAM(PH_RMS_MIX);
    if (IN(PH_WIN)) { pg8::Gemm g{A16, WIN, MT, NW, D}; pg8::Order S; S.init(MT, NW, D, G, bx, PFW / 256, -1); pg8::EpiP16 E{P16, PF}; pg8::gemm_phase(lds, g, S, E); }
    SEAM(PH_WIN);
    if (IN(PH_SHIFT)) {
        for (int item = bx * NTHR + tid; item < (MT / 16) * 768; item += G * NTHR) { const int c = item / 768, o = item % 768;
            *(u32x4*)((h16*)(ob + OB_SIDE) + (size_t)c * 6144 + o * 8) = *(const u32x4*)(P16 + (size_t)(16 * c + 15) * PP + o * 8); }
    }
    if (IN(PH_SHIFT)) {
        h16* AIN = A16; const float* mu = a.in[11];
        for (int item = bx * NTHR + tid; item < MT * 64; item += G * NTHR) {
            const int row = item >> 6, o = item & 63;
            if (o >= 56) { *(u32x4*)(AIN + (size_t)row * LK + 448 + (o - 56) * 8) = (u32x4){0u, 0u, 0u, 0u}; continue; }
            const int c0 = 6144 + o * 8;
            const bool st = row < MP ? ((row & 4095) == 0) : (((row - MP) & 63) == 0);
            const h16* pp = st ? (row < MP ? PF + (size_t)32 * PFW : PF + (size_t)((row - MP) >> 6) * PFW) + c0 : P16 + (size_t)(row - 1) * PP + c0;
            const h16x8 cv = *(const h16x8*)(P16 + (size_t)row * PP + c0), pv = *(const h16x8*)pp;
            const f32x4 m0 = *(const f32x4*)(mu + c0), m1 = *(const f32x4*)(mu + c0 + 4);
            const float mu8[8] = {m0.x, m0.y, m0.z, m0.w, m1.x, m1.y, m1.z, m1.w}; float s[8];
#pragma unroll
            for (int j = 0; j < 8; ++j) { const float cu = (float)cv[j]; s[j] = cu + mu8[j] * ((float)pv[j] - cu); }
            if (o < 12) {
#pragma unroll
                for (int j = 0; j < 8; ++j) s[j] = tanhf(s[j]);
            } else if (o >= 24) {
#pragma unroll
                for (int j = 0; j < 8; ++j) s[j] = sigmoidf_(s[j]);
            }
            *(u32x4*)(AIN + (size_t)row * LK + o * 8) = (u32x4){pk2h(s[0], s[1]), pk2h(s[2], s[3]), pk2h(s[4], s[5]), pk2h(s[6], s[7])};
        }
    }
    SEAM(PH_SHIFT);
    if (IN(PH_LORA)) { pg8::Gemm g{A16, WL, MT, 6144, LK}; pg8::Order S; S.init(MT, 6144, LK, G, bx, 0, -1); pg8::EpiEAG E{EAG, a.in[12], a.in[14]}; pg8::gemm_phase(lds, g, S, E); }
    SEAM(PH_LORA);
    if (IN(PH_PREP)) {
        LAS unsigned char* sc = lds + wave * 5120;
        float* RK = (float*)(ws + WS_RK); float* LM = (float*)(ws + WS_LM);
        const int cp = lane & 31, hs = lane >> 5;
#define H2LO(x) ((float)__builtin_bit_cast(h16, (unsigned short)((x) & 0xffffu)))
#define H2HI(x) ((float)__builtin_bit_cast(h16, (unsigned short)((x) >> 16)))
#define HSUM(x_, out_) do { float y_ = row_allreduce16(x_); y_ += __builtin_bit_cast(float, __builtin_amdgcn_update_dpp(0, __builtin_bit_cast(int, y_), 0x142, 0xA, 0xF, false)); \
            const float s31_ = rl_f(y_, 31), s63_ = rl_f(y_, 63); out_ = hs ? s63_ : s31_; } while (0)
        for (int item = gw; item < (MT / 16) * 32; item += NGW) {
            const int c = item >> 5, h = item & 31, row0 = 16 * c, hj2 = h * 64 + 2 * cp;
            const f32x2 c_kk = *(const f32x2*)(a.in[17] + hj2), c_ka = *(const f32x2*)(a.in[18] + hj2), c_rk = *(const f32x2*)(a.in[19] + hj2), c_mr = *(const f32x2*)(a.in[11] + hj2), c_mk = *(const f32x2*)(a.in[11] + D + hj2), c_mv = *(const f32x2*)(a.in[11] + 2 * D + hj2);
            const bool pr = row0 < MP; const bool st = pr ? ((row0 & 4095) == 0) : (((row0 - MP) & 63) == 0);
            const h16* pq = hs ? P16 + (size_t)(row0 + 7) * PP + hj2 : (st ? PF + (size_t)(pr ? 32 : ((row0 - MP) >> 6)) * PFW + hj2 : (const h16*)(ob + OB_SIDE) + (size_t)(c - 1) * 6144 + hj2);
            const h16* pp = P16 + (size_t)(row0 + 8 * hs) * PP + hj2; const h16* pe = EAG + (size_t)(row0 + 8 * hs) * 6144 + hj2;
            unsigned rr[9], kk[9], vv[9], ee[8], aa[8];
            rr[0] = *(const unsigned*)pq; kk[0] = *(const unsigned*)(pq + D); vv[0] = *(const unsigned*)(pq + 2 * D);
#pragma unroll
            for (int s_ = 0; s_ < 8; ++s_) { rr[s_ + 1] = *(const unsigned*)(pp + (size_t)s_ * PP); kk[s_ + 1] = *(const unsigned*)(pp + (size_t)s_ * PP + D); vv[s_ + 1] = *(const unsigned*)(pp + (size_t)s_ * PP + 2 * D);
                ee[s_] = *(const unsigned*)(pe + (size_t)s_ * 6144); aa[s_] = *(const unsigned*)(pe + (size_t)s_ * 6144 + D); }
            f32x2 Ll[8]; { f32x2 acc = (f32x2){0.f, 0.f};
#pragma unroll
                for (int s_ = 0; s_ < 8; ++s_) { acc -= (f32x2){H2LO(ee[s_]), H2HI(ee[s_])}; Ll[s_] = acc; } }
            const f32x2 oth = (f32x2){__shfl_xor(Ll[7].x, 32), __shfl_xor(Ll[7].y, 32)};
            const f32x2 M_ = hs ? oth : Ll[7]; const f32x2 L15 = M_ + (hs ? Ll[7] : oth);
            *(f32x2*)(LM + (size_t)item * 128 + 64 * hs + 2 * cp) = hs ? L15 : M_;
            const f32x2 off = hs ? (f32x2){0.f, 0.f} : M_;
            unsigned vpk[8];
            h16* eo = EAG + (size_t)(row0 + 8 * hs) * 6144 + hj2; h16* po = P16 + (size_t)(row0 + 8 * hs) * PP + hj2;
            f32x2 E3p = (f32x2){__expf(-off.x), __expf(-off.y)};
#pragma unroll
            for (int s_ = 0; s_ < 8; ++s_) { const int t = 8 * hs + s_;
                f32x2 r = (f32x2){H2LO(rr[s_ + 1]), H2HI(rr[s_ + 1])}, k = (f32x2){H2LO(kk[s_ + 1]), H2HI(kk[s_ + 1])}, v = (f32x2){H2LO(vv[s_ + 1]), H2HI(vv[s_ + 1])};
                r += c_mr * ((f32x2){H2LO(rr[s_]), H2HI(rr[s_])} - r); k += c_mk * ((f32x2){H2LO(kk[s_]), H2HI(kk[s_])} - k); v += c_mv * ((f32x2){H2LO(vv[s_]), H2HI(vv[s_])} - v);
                const f32x2 av = (f32x2){H2LO(aa[s_]), H2HI(aa[s_])};
                const f32x2 kkr = k * c_kk; float ss; HSUM(kkr.x * kkr.x + kkr.y * kkr.y, ss);
                const float rn = rsqrtf(fmaxf(ss, 1e-24f)); const f32x2 kap = kkr * rn;
                const f32x2 kmod = k * (1.f + (av - 1.f) * c_ka);
                const f32x2 Dm = Ll[s_] - off; const f32x2 E1 = E3p, E2 = (f32x2){__expf(-Dm.x), __expf(-Dm.y)}, E3 = (f32x2){__expf(Dm.x), __expf(Dm.y)}; E3p = E3;
                const f32x2 fat = kap * E1, frt = r * E3, fbb = kap * av * E2, fkb = kmod * E2;
                const unsigned hat = pk2h(fat.x, fat.y), hrt = pk2h(frt.x, frt.y), hbb = pk2h(fbb.x, fbb.y), hkb = pk2h(fkb.x, fkb.y);
                const f32x2 rkm = r * kmod * c_rk; float rk; HSUM(rkm.x + rkm.y, rk); if (cp == 0) RK[(size_t)(row0 + t) * 32 + h] = rk;
                *(unsigned*)(eo + (size_t)s_ * 6144) = hat; *(unsigned*)(eo + (size_t)s_ * 6144 + D) = hbb; *(unsigned*)(po + (size_t)s_ * PP) = hrt; *(unsigned*)(po + (size_t)s_ * PP + D) = hkb;
                ((LAS unsigned*)sc)[t * 32 + cp] = hat; ((LAS unsigned*)(sc + 2048))[t * 32 + cp] = hbb;
                vpk[s_] = pk2h(v.x, v.y);
            }
            { u32x4 lo, hi;
              lo.x = (vpk[0] & 0xffffu) | (vpk[1] << 16); lo.y = (vpk[2] & 0xffffu) | (vpk[3] << 16); lo.z = (vpk[4] & 0xffffu) | (vpk[5] << 16); lo.w = (vpk[6] & 0xffffu) | (vpk[7] << 16);
              hi.x = (vpk[0] >> 16) | (vpk[1] & 0xffff0000u); hi.y = (vpk[2] >> 16) | (vpk[3] & 0xffff0000u); hi.z = (vpk[4] >> 16) | (vpk[5] & 0xffff0000u); hi.w = (vpk[6] >> 16) | (vpk[7] & 0xffff0000u);
              const int i0 = 2 * cp;
              *(u32x4*)(P16 + (size_t)(row0 + (i0 >> 2)) * PP + 2 * D + h * 64 + (i0 & 3) * 16 + 8 * hs) = lo;
              *(u32x4*)(P16 + (size_t)(row0 + ((i0 + 1) >> 2)) * PP + 2 * D + h * 64 + ((i0 + 1) & 3) * 16 + 8 * hs) = hi; }
            asm volatile("s_waitcnt lgkmcnt(0)" ::: "memory");
            const int fr = lane & 15, fq = lane >> 4;
            f32x4 acc = (f32x4){0.f, 0.f, 0.f, 0.f};
#pragma unroll
            for (int kt = 0; kt < 4; ++kt) acc = __builtin_amdgcn_mfma_f32_16x16x16f16(*(const LAS h16x4*)(sc + (fr * 64 + 16 * kt + 4 * fq) * 2), *(const LAS h16x4*)(sc + 2048 + (fr * 64 + 16 * kt + 4 * fq) * 2), acc, 0, 0, 0);
            LAS float* Pm = (LAS float*)(sc + 4096);
#pragma unroll
            for (int g_ = 0; g_ < 4; ++g_) Pm[(4 * fq + g_) * 16 + fr] = (fr < 4 * fq + g_) ? acc[g_] : 0.f;
            asm volatile("s_waitcnt lgkmcnt(0)" ::: "memory");
            float Tc[16];
#pragma unroll
            for (int t = 0; t < 16; ++t) { float x = (t == fr) ? 1.f : 0.f;
#pragma unroll
                for (int j4 = 0; j4 < (t + 3) / 4; ++j4) { const f32x4 p4 = *(const LAS f32x4*)(Pm + t * 16 + 4 * j4);
                    if (4 * j4 + 0 < t) x -= p4.x * Tc[4 * j4 + 0]; if (4 * j4 + 1 < t) x -= p4.y * Tc[4 * j4 + 1]; if (4 * j4 + 2 < t) x -= p4.z * Tc[4 * j4 + 2]; if (4 * j4 + 3 < t) x -= p4.w * Tc[4 * j4 + 3]; }
                Tc[t] = x; }
            if (lane < 16) { h16* to = P16 + (size_t)row0 * PP + 6144 + h * 16 + fr;
#pragma unroll
                for (int t = 0; t < 16; ++t) to[(size_t)t * PP] = (h16)Tc[t]; }
            asm volatile("s_waitcnt lgkmcnt(0)" ::: "memory");
        }
#undef H2LO
#undef H2HI
#undef HSUM
    }
    SEAM(PH_PREP);
    if (IN(PH_SCAN)) {
        const int vcu = (G % 8 == 0) ? (bx % 8) * (G / 8) + bx / 8 : bx;
        constexpr int RAWB = 12288, NSL = 7, CSET = 2560, O_RAW = 0, O_CO = NSL * RAWB, O_YB = O_CO + 2 * CSET;
        static_assert(O_YB + 2 * 2048 <= LDS_BYTES - 16, "scan LDS map");
        h16* OUT16 = A16; const float* LM = (const float*)(ws + WS_LM);
        const bool pblk = vcu < 64;
        const int nitem = pblk ? 1 : (1024 - (vcu - 64) + 191) / 192;
        const int NCHB = pblk ? 256 : 4 * nitem;
#define SC_DESC(cc, prompt, sq, h, t0, first, last) \
        const bool prompt = pblk; bool first, last; int sq, h, t0; \
        if (prompt) { sq = vcu >> 5; h = vcu & 31; t0 = 16 * (cc); first = (cc) == 0; last = (cc) == 255; } \
        else { const int pair = (vcu - 64) + 192 * ((cc) >> 2); sq = pair >> 5; h = pair & 31; t0 = 16 * ((cc) & 3); first = ((cc) & 3) == 0; last = ((cc) & 3) == 3; }
#define SC_DMA(cc) do { if ((cc) < NCHB) { SC_DESC(cc, prompt_, sq_, h_, t0_, first_, last_); (void)last_; (void)first_; \
            const size_t rowb_ = (size_t)(prompt_ ? sq_ * 4096 : MP + sq_ * 64) + t0_; \
            LAS unsigned char* dst_ = lds + O_RAW + ((cc) % NSL) * RAWB; \
            const int sw_ = ((lane & 7) ^ (lane >> 3)) * 8;     \
            const h16* e0_ = EAG + (rowb_ + (lane >> 3)) * 6144 + h_ * 64 + sw_; const h16* p0_ = P16 + (rowb_ + (lane >> 3)) * PP + h_ * 64 + sw_; \
            __builtin_amdgcn_global_load_lds((const unsigned*)(e0_), (LAS unsigned*)(dst_), 16, 0, 0); \
            __builtin_amdgcn_global_load_lds((const unsigned*)(e0_ + 8 * 6144), (LAS unsigned*)(dst_ + 1024), 16, 0, 0); \
            __builtin_amdgcn_global_load_lds((const unsigned*)(p0_), (LAS unsigned*)(dst_ + 2048), 16, 0, 0); \
            __builtin_amdgcn_global_load_lds((const unsigned*)(p0_ + 8 * PP), (LAS unsigned*)(dst_ + 3072), 16, 0, 0); \
            __builtin_amdgcn_global_load_lds((const unsigned*)(e0_ + D), (LAS unsigned*)(dst_ + 4096), 16, 0, 0); \
            __builtin_amdgcn_global_load_lds((const unsigned*)(e0_ + D + 8 * 6144), (LAS unsigned*)(dst_ + 5120), 16, 0, 0); \
            __builtin_amdgcn_global_load_lds((const unsigned*)(p0_ + D), (LAS unsigned*)(dst_ + 6144), 16, 0, 0); \
            __builtin_amdgcn_global_load_lds((const unsigned*)(p0_ + D + 8 * PP), (LAS unsigned*)(dst_ + 7168), 16, 0, 0); \
            __builtin_amdgcn_global_load_lds((const unsigned*)(p0_ - sw_ + (lane & 7) * 8 + 2 * D), (LAS unsigned*)(dst_ + 8192), 16, 0, 0); \
            __builtin_amdgcn_global_load_lds((const unsigned*)(p0_ - sw_ + (lane & 7) * 8 + 2 * D + 8 * PP), (LAS unsigned*)(dst_ + 9216), 16, 0, 0); \
            __builtin_amdgcn_global_load_lds((const unsigned*)(P16 + (rowb_ + ((lane & 31) >> 1)) * PP + 6144 + h_ * 16 + (lane & 1) * 8), (LAS unsigned*)(dst_ + 10240), 16, 0, 0); \
            __builtin_amdgcn_global_load_lds((const unsigned*)(LM + ((rowb_ >> 4) * 32 + h_) * 128 + (lane & 31) * 4), (LAS unsigned*)(dst_ + 11264), 16, 0, 0); } } while (0)
#define MF(a_, b_, c_) __builtin_amdgcn_mfma_f32_16x16x32_f16(a_, b_, c_, 0, 0, 0)
#define CAT8(lo_, hi_) ((h16x8){(lo_)[0], (lo_)[1], (lo_)[2], (lo_)[3], (hi_)[0], (hi_)[1], (hi_)[2], (hi_)[3]})
#define SC_C(cc) do { if ((cc) >= 0 && (cc) < NCHB) { \
            const LAS unsigned char* rs = lds + O_RAW + ((cc) % NSL) * RAWB; LAS unsigned char* co = lds + O_CO + ((cc) & 1) * CSET; \
            const int fr = lane & 15, fq = lane >> 4; const int oa = wave == 4 ? 0 : 2048, ob_ = wave == 6 ? 4096 : 6144; \
            f32x4 acc = (f32x4){0.f, 0.f, 0.f, 0.f}; \
            _Pragma("unroll") for (int kb = 0; kb < 2; ++kb) { const int o_ = fr * 128 + (((4 * kb + fq) ^ (fr & 7)) << 4); acc = MF(*(const LAS h16x8*)(rs + oa + o_), *(const LAS h16x8*)(rs + ob_ + o_), acc); } \
            _Pragma("unroll") for (int g_ = 0; g_ < 4; ++g_) { const int t = 4 * fq + g_; const bool keep = wave == 4 ? (fr < t) : (fr <= t); ((LAS h16*)(co + (wave - 4) * 512))[t * 16 + fr] = (h16)(keep ? acc[g_] : 0.f); } \
            if (wave == 4) { const float M_ = ((const LAS float*)(rs + 11264))[lane], L15 = ((const LAS float*)(rs + 11264 + 256))[lane]; \
                ((LAS float*)(co + 1536))[lane] = __expf(M_); ((LAS float*)(co + 1792))[lane] = __expf(L15 - M_); ((LAS float*)(co + 2048))[lane] = __expf(L15); } } } while (0)
        f32x4 St[4];
#pragma unroll
        for (int n = 0; n < 4; ++n) St[n] = (f32x4){0.f, 0.f, 0.f, 0.f};
#define CVT4(x_) ((h16x4){(h16)(x_)[0], (h16)(x_)[1], (h16)(x_)[2], (h16)(x_)[3]})
#define TRR(p_) __builtin_bit_cast(h16x4, __builtin_amdgcn_ds_read_tr16_b64_v4i16((LAS s16x4*)(p_)))
#define SC_ROW(cc, PROMPT) do { if ((cc) >= 0 && (cc) < NCHB) { SC_DESC(cc, prompt, sq, h, t0, first, last); \
            const int fr = lane & 15, fq = lane >> 4; \
            float* sp = a.out + (prompt ? O_WKP : O_WKS) + ((size_t)(sq * 32 + h) * 64 + 16 * wave + fr) * 64 + 4 * fq; \
            if (first) { _Pragma("unroll") for (int n = 0; n < 4; ++n) { St[n] = (f32x4){0.f, 0.f, 0.f, 0.f}; if (!(PROMPT)) St[n] = *(const f32x4*)(a.in[4] + ((size_t)(sq * 32 + h) * 64 + 16 * wave + fr) * 64 + 16 * n + 4 * fq); } } \
            LAS unsigned char* rs = lds + O_RAW + ((cc) % NSL) * RAWB; const LAS unsigned char* co = lds + O_CO + ((cc) & 1) * CSET; \
              \
            f32x4 em[4], gm[4], e4[4]; h16x4 atl[2][2], rtl[2][2], kbt[4], bbt[4]; \
            _Pragma("unroll") for (int n = 0; n < 4; ++n) { em[n] = *(const LAS f32x4*)(co + 1536 + (16 * n + 4 * fq) * 4); gm[n] = *(const LAS f32x4*)(co + 2048 + (16 * n + 4 * fq) * 4); e4[n] = *(const LAS f32x4*)(co + 1792 + (16 * n + 4 * fq) * 4); } \
            _Pragma("unroll") for (int b = 0; b < 2; ++b) { \
                const int o0_ = fr * 128 + (((4 * b + (fq >> 1)) ^ (fr & 7)) << 4) + 8 * (fq & 1), o1_ = fr * 128 + (((4 * b + 2 + (fq >> 1)) ^ (fr & 7)) << 4) + 8 * (fq & 1); \
                atl[b][0] = *(const LAS h16x4*)(rs + o0_); atl[b][1] = *(const LAS h16x4*)(rs + o1_); rtl[b][0] = *(const LAS h16x4*)(rs + 2048 + o0_); rtl[b][1] = *(const LAS h16x4*)(rs + 2048 + o1_); } \
            const h16x4 vm = *(const LAS h16x4*)(rs + 8192 + ((16 * wave + fr) * 16 + 4 * fq) * 2), aak = *(const LAS h16x4*)(co + (fr * 16 + 4 * fq) * 2), tA = *(const LAS h16x4*)(rs + 10240 + (fr * 16 + 4 * fq) * 2), \
                        ark = *(const LAS h16x4*)(co + 512 + (fr * 16 + 4 * fq) * 2), arb = *(const LAS h16x4*)(co + 1024 + (fr * 16 + 4 * fq) * 2); \
            _Pragma("unroll") for (int n = 0; n < 4; ++n) { const int tr_ = 4 * fq + (fr >> 2); const int o_ = tr_ * 128 + (((2 * n + ((fr & 3) >> 1)) ^ (tr_ & 7)) << 4) + 8 * (fr & 1); kbt[n] = TRR(rs + 6144 + o_); bbt[n] = TRR(rs + 4096 + o_); } \
            asm volatile("s_waitcnt lgkmcnt(0)" ::: "memory"); \
            const h16x4 z4 = (h16x4){(h16)0.f, (h16)0.f, (h16)0.f, (h16)0.f}; \
            h16x4 sh[4]; \
            _Pragma("unroll") for (int n = 0; n < 4; ++n) { const f32x4 x = St[n] * em[n]; sh[n] = CVT4(x); } \
            f32x4 W1 = (f32x4){0.f, 0.f, 0.f, 0.f}, Yt = W1; \
              \
            _Pragma("unroll") for (int b = 0; b < 2; ++b) { const h16x8 sb = CAT8(sh[2 * b], sh[2 * b + 1]); \
                W1 = MF(CAT8(atl[b][0], atl[b][1]), sb, W1); Yt = MF(CAT8(rtl[b][0], rtl[b][1]), sb, Yt); } \
            W1 = MF(CAT8(aak, z4), CAT8(vm, z4), W1); \
            const h16x4 w1h = CVT4(W1); \
            f32x4 U = MF(CAT8(tA, z4), CAT8(w1h, z4), ((f32x4){0.f, 0.f, 0.f, 0.f})); \
            const f32x4 nU = -U; const h16x4 uh = CVT4(nU); const h16x8 vu = CAT8(vm, uh);     \
            Yt = MF(CAT8(ark, arb), vu, Yt); \
            _Pragma("unroll") for (int n = 0; n < 4; ++n) { const f32x4 tmp = MF(CAT8(kbt[n], bbt[n]), vu, ((f32x4){0.f, 0.f, 0.f, 0.f})); St[n] = gm[n] * St[n] + e4[n] * tmp; } \
            { LAS h16* yb = (LAS h16*)(lds + O_YB + ((cc) & 1) * 2048) + (4 * fq) * 64 + 16 * wave + fr; (void)t0; \
              yb[0] = (h16)Yt[0]; yb[64] = (h16)Yt[1]; yb[128] = (h16)Yt[2]; yb[192] = (h16)Yt[3]; } \
            if (last) { _Pragma("unroll") for (int n = 0; n < 4; ++n) *(f32x4*)(sp + 16 * n) = St[n]; } } } while (0)
#define SC_YOUT(cc) do { if ((cc) >= 0 && (cc) < NCHB && wave >= 5) { SC_DESC(cc, prompt, sq, h, t0, first, last); (void)first; (void)last; \
            const int L_ = (wave - 5) * 64 + lane, t_ = L_ >> 3, part_ = L_ & 7; \
            *(u32x4*)(OUT16 + ((size_t)(prompt ? sq * 4096 : MP + sq * 64) + t0 + t_) * D + h * 64 + part_ * 8) = *(const LAS u32x4*)(lds + O_YB + ((cc) & 1) * 2048 + t_ * 128 + part_ * 16); } } while (0)
#define SC_BARRIER() do { asm volatile("s_waitcnt lgkmcnt(0)" ::: "memory"); __builtin_amdgcn_s_barrier(); asm volatile("" ::: "memory"); } while (0)
        if (wave < 4) {
            SC_BARRIER();
            if (pblk) { for (int it = -1; it <= NCHB; ++it) { SC_ROW(it, true); SC_BARRIER(); } }
            else { for (int it = -1; it <= NCHB; ++it) { SC_ROW(it, false); SC_BARRIER(); } }
        } else if (wave == 7) {
            SC_DMA(0); SC_DMA(1); SC_DMA(2); SC_DMA(3); SC_DMA(4);
            asm volatile("s_waitcnt vmcnt(48)" ::: "memory");
            SC_BARRIER();
            for (int it = -1; it <= NCHB; ++it) {
                SC_DMA(it + 6);
                if (it + 6 < NCHB) asm volatile("s_waitcnt vmcnt(48)" ::: "memory");
                else asm volatile("s_waitcnt vmcnt(0)" ::: "memory");
                SC_BARRIER();
            }
        } else {
            SC_BARRIER();
            for (int it = -1; it <= NCHB; ++it) { SC_C(it + 1); SC_YOUT(it - 1); SC_BARRIER(); }
        }
        if (!pblk) {
            __syncthreads();
            LAS float* scr = (LAS float*)(lds + wave * 16384);
            constexpr int I1 = (D / 64) * (2 * FF / 32), I2 = (FF / 64) * (D / 32);
            const int gw = (vcu - 64) * NWAVES + wave, NGW = (G - 64) * NWAVES;
#define PICK2(it, out) do { int r_ = (it); if (r_ < I1) out = cvt_decode(1, a.in[25], a.in[26], FF, D, W2GU, 2 * FF / 32, r_, lane); else out = cvt_decode(0, a.in[27], a.in[27], D, FF, W2D, D / 32, r_ - I1, lane); } while (0)
            CVT_RUN(I1 + I2, PICK2);
#undef PICK2
        }
#undef SC_DESC
#undef SC_DMA
#undef MF
#undef CAT8
#undef SC_C
#undef CVT4
#undef TRR
#undef SC_ROW
#undef SC_BARRIER
#undef SC_YOUT
    }
    SEAM(PH_SCAN);
    if (IN(PH_MERGE)) {
        const float* RK = (const float*)(ws + WS_RK);
        const int o8 = tid & 255, c0 = o8 * 8, hd = o8 >> 3, rg = tid >> 8;
        float w0[8], w1[8], w2[8], lg[8], lb[8];
#pragma unroll
        for (int j = 0; j < 8; ++j) { w0[j] = a.in[22][c0 + j]; w1[j] = a.in[22][D + c0 + j]; w2[j] = a.in[22][2 * D + c0 + j]; lg[j] = a.in[20][c0 + j]; lb[j] = a.in[21][c0 + j]; }
        for (int c = bx; c < MT / 16; c += G) {
            const int row0 = 16 * c + 8 * rg;
            const bool pr = row0 < MP; const int tt0 = pr ? (row0 & 4095) : ((row0 - MP) & 63), sq = pr ? (row0 >> 12) : ((row0 - MP) >> 6), T = pr ? 4096 : 64;
            h16x8 vt[8];
            { const h16* vb = P16 + (size_t)(16 * c + ((c0 & 63) >> 2)) * PP + 2 * D + (c0 & ~63) + 8 * rg;
#pragma unroll
              for (int j = 0; j < 8; ++j) vt[j] = *(const h16x8*)(vb + (size_t)(j >> 2) * PP + (j & 3) * 16); }
            float u1[8], u2[8];
            { const h16* prow = P16 + (size_t)row0 * PP;
              if (tt0 >= 2) { const h16x8 p1 = *(const h16x8*)(prow - PP + C_U + c0), p2 = *(const h16x8*)(prow - 2 * PP + C_U + c0);
#pragma unroll
                  for (int j = 0; j < 8; ++j) { u1[j] = (float)p1[j]; u2[j] = (float)p2[j]; }
              } else {
#pragma unroll
                  for (int j = 0; j < 8; ++j) { u2[j] = pr ? 0.f : a.in[3][(size_t)sq * 2 * D + c0 + j]; u1[j] = pr ? 0.f : a.in[3][(size_t)sq * 2 * D + D + c0 + j]; } } }
#pragma unroll
            for (int hf = 0; hf < 4; ++hf) {
                h16x8 ov[2], gv[2], uu[2], qq[2], sa[2]; float rk[2];
#pragma unroll
                for (int r = 0; r < 2; ++r) { const int row = row0 + 2 * hf + r; const h16* prow = P16 + (size_t)row * PP;
                    ov[r] = *(const h16x8*)(A16 + (size_t)row * D + c0); gv[r] = *(const h16x8*)(EAG + (size_t)row * 6144 + 2 * D + c0);
                    uu[r] = *(const h16x8*)(prow + C_U + c0); qq[r] = *(const h16x8*)(prow + C_Q + c0); sa[r] = *(const h16x8*)(prow + C_SA + c0);
                    rk[r] = RK[(size_t)row * 32 + hd]; }
#pragma unroll
                for (int r = 0; r < 2; ++r) { const int row = row0 + 2 * hf + r, tt = tt0 + 2 * hf + r;
                    float of[8], s1 = 0.f;
#pragma unroll
                    for (int j = 0; j < 8; ++j) { of[j] = (float)ov[r][j]; s1 += of[j]; }
                    const float mean = row_allreduce8(s1) * (1.f / 64.f); float s2 = 0.f;
#pragma unroll
                    for (int j = 0; j < 8; ++j) { of[j] -= mean; s2 += of[j] * of[j]; }
                    const float rstd = rsqrtf(row_allreduce8(s2) * (1.f / 64.f) + 64e-5f);
                    float mg[8], u0[8];
#pragma unroll
                    for (int j = 0; j < 8; ++j) {
                        const float vs = (float)vt[j][2 * hf + r];
                        const float ya = (of[j] * rstd * lg[j] + lb[j] + rk[r] * vs) * (float)gv[r][j];
                        u0[j] = (float)uu[r][j];
                        const float cv = w0[j] * u2[j] + w1[j] * u1[j] + w2[j] * u0[j];
                        mg[j] = (float)sa[r][j] * ya + (float)qq[r][j] * cv; u2[j] = u1[j]; u1[j] = u0[j]; }
                    *(u32x4*)(A16 + (size_t)row * D + c0) = (u32x4){pk2h(mg[0], mg[1]), pk2h(mg[2], mg[3]), pk2h(mg[4], mg[5]), pk2h(mg[6], mg[7])};
                    if (tt >= T - 2) { float* q = a.out + (pr ? O_CVP : O_CVS) + (size_t)sq * 2 * D + (size_t)(tt - (T - 2)) * D + c0;
                        *(f32x4*)q = (f32x4){u0[0], u0[1], u0[2], u0[3]}; *(f32x4*)(q + 4) = (f32x4){u0[4], u0[5], u0[6], u0[7]}; }
                }
            }
        }
    }
    SEAM(PH_MERGE);
    if (IN(PH_WOUT)) {
        { pg8::Gemm g{A16, WOUT, MT, D, D}; pg8::Order S; S.init(MT, D, D, G, bx, 0, MP / 256); pg8::EpiRes<true, true> E{XH, XH, SLAB, 1.0f, 0}; pg8::gemm_phase(lds, g, S, E); }
    }
    SEAM(PH_WOUT);
    if (IN(PH_RMS2)) { for (int m = gw; m < MT; m += NGW) { if (m < MP) rms_row_h(XH + (size_t)m * D, a.in[24], A16 + (size_t)m * D, nullptr, lane);
            else rms_row_f16(Y + (size_t)m * D, a.in[24], A16 + (size_t)m * D, nullptr, lane, SLAB + (size_t)(m - MP) * D, 1.0f, Y + (size_t)m * D); } }
    SEAM(PH_RMS2);
    if (IN(PH_FFN2_GU)) { pg8::Gemm g{A16, W2GU, MT, 2 * FF, D}; pg8::Order S; S.init(MT, 2 * FF, D, G, bx, 0, -1); pg8::EpiSwiGLU E{HM, FF}; pg8::gemm_phase(lds, g, S, E); }
    SEAM(PH_FFN2_GU);
    if (IN(PH_FFN2_D)) { pg8::Gemm g{HM, W2D, MT, D, FF}; pg8::Order S; S.init(MT, D, FF, G, bx, 0, MP / 256); pg8::EpiRes<true, true> E{XH, A16, SLAB, 0.5f, 0}; pg8::gemm_phase(lds, g, S, E); }
    SEAM(PH_FFN2_D);
    if (IN(PH_FINAL)) { for (int m = gw; m < MT; m += NGW) { if (m < MP) rms_row_h(A16 + (size_t)m * D, a.in[28], nullptr, Y + (size_t)m * D, lane);
            else rms_row_f16(Y + (size_t)m * D, a.in[28], nullptr, Y + (size_t)m * D, lane, SLAB + (size_t)(m - MP) * D, 0.5f, nullptr); } }
    if (PROBE_MASK) {
        pr_t[PH_N] = __builtin_amdgcn_s_memrealtime();
        if (bx == 0 && tid == 0) { unsigned long long tot = 0;
#pragma unroll
            for (int k = 0; k < PH_N; ++k) if ((PROBE_MASK >> k) & 1u) tot += pr_t[k + 1] - pr_t[k];
            const unsigned long long t0 = __builtin_amdgcn_s_memrealtime();
            while (__builtin_amdgcn_s_memrealtime() - t0 < tot) __builtin_amdgcn_s_sleep(8);
        }
    }
#undef IN
#undef SEAM
}

extern "C" void kernel_launch(void* const* d_in, const int* in_sizes, int n_in, void* d_out, int out_size, void* d_ws, size_t ws_size, hipStream_t stream) {
    static int grid = 0;
    if (grid == 0) {
        if (n_in != 29 || (size_t)out_size != O_END || ws_size < WS_END) { fprintf(stderr, "kernel_launch: unexpected shapes (n_in %d out %d ws %zu need %zu)\n", n_in, out_size, ws_size, (size_t)WS_END); grid = -1; return; }
        int dev = 0, cus = 0, per_cu = 0;
        if (hipGetDevice(&dev) != hipSuccess || hipDeviceGetAttribute(&cus, hipDeviceAttributeMultiprocessorCount, dev) != hipSuccess) { grid = -1; return; }
        if (hipFuncSetAttribute((const void*)fwd_kernel, hipFuncAttributeMaxDynamicSharedMemorySize, LDS_BYTES) != hipSuccess) { grid = -1; return; }
        if (hipOccupancyMaxActiveBlocksPerMultiprocessor(&per_cu, (const void*)fwd_kernel, NTHR, LDS_BYTES) != hipSuccess || per_cu < 1) { fprintf(stderr, "kernel_launch: occupancy query failed (%d)\n", per_cu); grid = -1; return; }
        grid = cus;
    }
    if (grid < 0) return;
    if (hipMemsetAsync((char*)d_ws + WS_CTL, 0, XCD_BAR_WORDS * 4, stream) != hipSuccess) return;
    Args a{};
    for (int i = 0; i < 29; ++i) a.in[i] = (const float*)d_in[i];
    a.out = (float*)d_out; a.ws = (unsigned char*)d_ws; a.ph_lo = 0; a.ph_hi = PH_N;
    void* kargs[] = {&a};
    hipError_t e = hipLaunchCooperativeKernel((const void*)fwd_kernel, dim3(grid), dim3(NTHR), kargs, LDS_BYTES, stream);
    if (e != hipSuccess) fprintf(stderr, "kernel_launch: cooperative launch failed: %s (grid %d)\n", hipGetErrorString(e), grid);
}
```

```cpp
#include <hip/hip_runtime.h>
#include <hip/hip_cooperative_groups.h>
#include <cstdio>
namespace cg = cooperative_groups;

#define LAS __attribute__((address_space(3)))
typedef _Float16 h16;
typedef _Float16 h16x2 __attribute__((ext_vector_type(2)));
typedef _Float16 h16x4 __attribute__((ext_vector_type(4)));
typedef _Float16 h16x8 __attribute__((ext_vector_type(8)));
typedef short s16x4 __attribute__((ext_vector_type(4)));
typedef float f32x4 __attribute__((ext_vector_type(4)));
typedef float f32x2 __attribute__((ext_vector_type(2)));
typedef unsigned u32x4 __attribute__((ext_vector_type(4)));
typedef unsigned u32x2 __attribute__((ext_vector_type(2)));

constexpr int D = 2048, FF = 5632, NA = 6592, NIN = 16832;
constexpr int MP = 8192, MS = 2048, MT = MP + MS;
constexpr int MA = MT + 256;
constexpr int PP = 12800;
constexpr int NW = 16896;
constexpr int PFW = 6656;
constexpr int C_U = 6656, C_Q = 8704, C_SA = 10752;
constexpr int LK = 512;
constexpr int NCHUNK = MT / 64;
constexpr size_t O_Y = 0, O_SHP = 20971520, O_CVP = 20975616, O_WKP = 20983808, O_SHS = 21245952, O_CVS = 21311488, O_WKS = 21442560, O_END = 25636864;
constexpr size_t WS_CTL = 0;
constexpr size_t WS_W1GU = 1u << 20;
constexpr size_t WS_W1D = WS_W1GU + (size_t)2 * FF * D * 2;
constexpr size_t WS_WIN = WS_W1D + (size_t)D * FF * 2;
constexpr size_t WS_WOUT = WS_WIN + (size_t)NW * D * 2;
constexpr size_t WS_A16 = WS_WOUT + (size_t)D * D * 2;
constexpr size_t WS_P16 = WS_A16 + (size_t)MA * D * 2;
constexpr size_t WS_W2GU = WS_P16 + (size_t)MT * PP * 2;
constexpr size_t WS_W2D = WS_W2GU + (size_t)2 * FF * D * 2;
constexpr size_t WS_PF = WS_W2D + (size_t)D * FF * 2;
constexpr size_t WS_END = WS_PF + (size_t)256 * PFW * 2;
constexpr size_t WS_EAG = WS_W1GU;
constexpr size_t WS_HM = WS_P16;
constexpr size_t WS_SLAB = WS_HM + (size_t)MT * FF * 2;
static_assert((size_t)MT * 6144 * 2 <= WS_WOUT - WS_W1GU, "EAG overlay");
static_assert(WS_SLAB + (size_t)4 * MS * D * 4 <= WS_W2GU, "HM + slab overlay of P16");
constexpr size_t OB_WL = O_WKS * 4;
constexpr size_t OB_SIDE = OB_WL + (size_t)6144 * LK * 2;
static_assert(OB_SIDE + (size_t)(MT / 16) * 6144 * 2 <= O_END * 4, "d_out scratch");

constexpr size_t WS_RK = WS_EAG + (size_t)MT * 6144 * 2;
constexpr size_t WS_LM = WS_RK + (size_t)MT * 32 * 4;
static_assert(WS_LM + (size_t)(MT / 16) * 32 * 128 * 4 <= WS_WOUT, "RK + LM");
constexpr int SC_SLOT = 6 * 64, SC_BUF = 16 * SC_SLOT;
constexpr int NWAVES = 8, NTHR = 512;
constexpr int LDS_BYTES = 147456;

__device__ __forceinline__ unsigned pk2h(float a, float b) { h16x2 v = {(h16)a, (h16)b}; return __builtin_bit_cast(unsigned, v); }
__device__ __forceinline__ float wave_sum(float v) {
#pragma unroll
    for (int o = 1; o < 64; o <<= 1) v += __shfl_xor(v, o);
    return v;
}
template <int CTRL> __device__ __forceinline__ float dpp_f(float x) { return __builtin_bit_cast(float, __builtin_amdgcn_update_dpp(0, __builtin_bit_cast(int, x), CTRL, 0xF, 0xF, false)); }
__device__ __forceinline__ float row_allreduce8(float x) { x += dpp_f<0xB1>(x); x += dpp_f<0x4E>(x); x += dpp_f<0x141>(x); return x; }
__device__ __forceinline__ float row_allreduce16(float x) { x = row_allreduce8(x); x += dpp_f<0x140>(x); return x; }
__device__ __forceinline__ float rl_f(float x, int l) { return __builtin_bit_cast(float, __builtin_amdgcn_readlane(__builtin_bit_cast(int, x), l)); }
__device__ __forceinline__ float wave_sum_dpp(float x) { x = row_allreduce16(x); return (rl_f(x, 0) + rl_f(x, 16)) + (rl_f(x, 32) + rl_f(x, 48)); }
__device__ __forceinline__ float wave_sum_bc(float x) {
    x = row_allreduce16(x);
    x += __builtin_bit_cast(float, __builtin_amdgcn_update_dpp(0, __builtin_bit_cast(int, x), 0x142, 0xA, 0xF, false));
    x += __builtin_bit_cast(float, __builtin_amdgcn_update_dpp(0, __builtin_bit_cast(int, x), 0x143, 0xC, 0xF, false));
    return rl_f(x, 63); }
__device__ __forceinline__ float sigmoidf_(float x) { return __builtin_amdgcn_rcpf(1.0f + __expf(-x)); }
__device__ __forceinline__ float tanhf_(float x) { return 1.0f - 2.0f * __builtin_amdgcn_rcpf(1.0f + __expf(2.0f * x)); }

namespace pg8 {
constexpr int BM = 256, BK = 64, HALF = 128, HTB = HALF * BK * 2, STAGE_BYTES = 8 * HTB, NXCD = 8, WGM = 8;
__host__ __device__ __forceinline__ int lds_byte(int r, int c) { const int st = (r >> 4) * 2 + (c >> 5), rr = r & 15, cc = c & 31, ob = rr * 64 + cc * 2; return st * 1024 + (ob ^ (((ob >> 9) & 1) << 5)); }
__host__ __device__ __forceinline__ void stage_rc(int b, int& R, int& C) { const int st = b / 1024, sb = b % 1024, swz = sb ^ (((sb >> 9) & 1) << 5); R = (st >> 1) * 16 + swz / 64; C = (st & 1) * 32 + (swz % 64) / 2; }
__host__ __device__ __forceinline__ int perm32(int rho) { const int n = rho >> 4, i = rho & 15; return 8 * (i >> 2) + 4 * n + (i & 3); }
struct Unit { int pm, pn, kt0, nkt, sp; };
struct Gemm { const h16* A; const h16* Bt; int M, N, K; };
struct Order {
    int nM, nN, nwg, G, c, extra, nkt, nsplit;
    __device__ void init(int M, int N, int K, int G_, int c_, int extra_, int nMw) { nM = M / BM; nN = N / BM; nwg = (nMw < 0 ? nM : nMw) * nN; G = G_; c = c_; extra = extra_; nkt = K / BK; nsplit = nMw < 0 ? 0 : (nM - nMw) * nN * 4; }
    __device__ bool next(int i, Unit& u) const {
        const long L = (long)i * G + c; if (L >= nwg + extra + nsplit) return false;
        u.kt0 = 0; u.nkt = nkt; u.sp = -1;
        if (L >= nwg + extra) { const int j = (int)(L - nwg - extra), rows = nM - nwg / nN; u.nkt = nkt >> 2;
            if (rows == 8 && nN == 8) {
                const int xcd = j & 7, idx = j >> 3; u.sp = xcd >> 1; u.pn = 4 * (xcd & 1) + (idx >> 3); u.pm = nwg / nN + (idx & 7); }
            else { const int tile = j >> 2; u.sp = j & 3; u.pm = nwg / nN + tile % rows; u.pn = tile / rows; }
            u.kt0 = u.sp * u.nkt; return true; }
        if (L >= nwg) { u.pm = nM; u.pn = (int)(L - nwg); return true; }
        const int nMe = nwg / nN;
        int wgid = (int)L; { const int q = nwg / NXCD, r = nwg % NXCD, xcd = wgid % NXCD, off = wgid / NXCD; wgid = (xcd < r ? xcd * (q + 1) : r * (q + 1) + (xcd - r) * q) + off; }
        const int nig = WGM * nN, gid = wgid / nig, fm = gid * WGM, gsz = (nMe - fm) < WGM ? (nMe - fm) : WGM;
        u.pm = fm + ((wgid % nig) % gsz); u.pn = (wgid % nig) / gsz; return true;
    }
};

template <class Epi, bool SP2 = true, bool ALIGN_EPI = true>
__device__ __forceinline__ void gemm_phase(LAS unsigned char* lds, const Gemm g, const Order& S, const Epi& E) {
    const int tid = threadIdx.x, wid = __builtin_amdgcn_readfirstlane(tid >> 6), lane = tid & 63, wr = wid >> 2, wc = wid & 3, fr = lane & 15, fq = lane >> 4;
    const int K = g.K;
    unsigned voffA[2], voffB[2];
#pragma unroll
    for (int i = 0; i < 2; ++i) { int R, C; stage_rc(tid * 16 + i * 8192, R, C); const int Rb = Epi::PERM ? ((R & ~31) + perm32(R & 31)) : R;
        voffA[i] = (unsigned)(R * K + C) * 2u; voffB[i] = (unsigned)(Rb * K + C) * 2u; }
    const size_t kstep = (size_t)(BK * 2);
    const size_t hstep = (size_t)HALF * K * 2;
    const size_t tstep = 2 * hstep;
    const unsigned ldsw = (unsigned)wid * 1024u;
    const int aoff = lds_byte(wr * 64 + fr, fq * 8), boff = lds_byte(wc * 32 + fr, fq * 8);
#define PG8_SA(b, h) (((b) * 2 + (h)) * HTB)
#define PG8_SB(b, h) ((4 + (b) * 2 + (h)) * HTB)
#define PG8_STAGE(bufoff, gbase, voff) do { _Pragma("unroll") for (int _i = 0; _i < 2; ++_i) \
        __builtin_amdgcn_global_load_lds((const unsigned*)((const char*)(gbase) + (voff)[_i]), (LAS unsigned*)(lds + (bufoff) + ldsw + _i * 8192), 16, 0, 0); } while (0)
#define PG8_LDA(dst, b, h) do { _Pragma("unroll") for (int m = 0; m < 4; ++m) _Pragma("unroll") for (int k = 0; k < 2; ++k) dst[m][k] = *(const LAS h16x8*)(lds + PG8_SA(b, h) + aoff + m * 2048 + k * 1024); } while (0)
#define PG8_LDB(dst, b, h) do { _Pragma("unroll") for (int n = 0; n < 2; ++n) _Pragma("unroll") for (int k = 0; k < 2; ++k) dst[n][k] = *(const LAS h16x8*)(lds + PG8_SB(b, h) + boff + n * 2048 + k * 1024); } while (0)
#define PG8_MMA(ai, bj, At, Bt) do { __builtin_amdgcn_s_setprio(1); _Pragma("unroll") for (int m = 0; m < 4; ++m) _Pragma("unroll") for (int n = 0; n < 2; ++n) _Pragma("unroll") for (int k = 0; k < 2; ++k) \
        acc[ai][bj][m][n] = __builtin_amdgcn_mfma_f32_16x16x32_f16(Bt[n][k], At[m][k], acc[ai][bj][m][n], 0, 0, 0); __builtin_amdgcn_s_setprio(0); } while (0)
#define PG8_WAIT_V(n) asm volatile("s_waitcnt vmcnt(" #n ")" ::: "memory")
#define PG8_WAIT_L(n) asm volatile("s_waitcnt lgkmcnt(" #n ")" ::: "memory")
#define PG8_BAR __builtin_amdgcn_s_barrier()
#define PG8_SCHED __builtin_amdgcn_sched_barrier(0)
    Unit cur, nxt; int ui = 0;
    if (!S.next(0, cur)) return;
    f32x4 acc[2][2][4][2];
#pragma unroll
    for (int a = 0; a < 2; ++a)
#pragma unroll
        for (int b = 0; b < 2; ++b)
#pragma unroll
            for (int m = 0; m < 4; ++m)
#pragma unroll
                for (int n = 0; n < 2; ++n) acc[a][b][m][n] = (f32x4){0.f, 0.f, 0.f, 0.f};
    h16x8 At[4][2], B0[2][2], B1[2][2];
    const char* cA = (const char*)g.A + (size_t)cur.pm * tstep + (size_t)cur.kt0 * kstep; const char* cB = (const char*)g.Bt + (size_t)cur.pn * tstep + (size_t)cur.kt0 * kstep;
    if constexpr (SP2) {
        PG8_STAGE(PG8_SB(0, 0), cB, voffB); PG8_STAGE(PG8_SB(0, 1), cB + hstep, voffB); PG8_STAGE(PG8_SA(0, 0), cA, voffA); PG8_STAGE(PG8_SA(0, 1), cA + hstep, voffA);
        if (wr == 1) PG8_BAR;
        PG8_WAIT_V(2); PG8_BAR;
        PG8_STAGE(PG8_SB(1, 0), cB + kstep, voffB); PG8_STAGE(PG8_SA(1, 0), cA + kstep, voffA); PG8_STAGE(PG8_SB(1, 1), cB + hstep + kstep, voffB);
        PG8_WAIT_V(6); PG8_BAR;
    } else {
        PG8_STAGE(PG8_SB(0, 0), cB, voffB); PG8_STAGE(PG8_SA(0, 0), cA, voffA); PG8_STAGE(PG8_SB(0, 1), cB + hstep, voffB); PG8_STAGE(PG8_SA(0, 1), cA + hstep, voffA);
        if (wr == 1) PG8_BAR;
        PG8_WAIT_V(4); PG8_BAR;
        PG8_STAGE(PG8_SB(1, 0), cB + kstep, voffB); PG8_STAGE(PG8_SA(1, 0), cA + kstep, voffA); PG8_STAGE(PG8_SB(1, 1), cB + hstep + kstep, voffB);
        PG8_WAIT_V(6); PG8_BAR;
    }
    for (;;) {
        const bool has_next = S.next(ui + 1, nxt);
        const char* nA = has_next ? (const char*)g.A + (size_t)nxt.pm * tstep + (size_t)nxt.kt0 * kstep : cA; const char* nB = has_next ? (const char*)g.Bt + (size_t)nxt.pn * tstep + (size_t)nxt.kt0 * kstep : cB;
        const int nt = cur.nkt;
        for (int t = 0; t < nt; t += 2) {
            const bool last = (t == nt - 2);
            const char* a1 = cA + (size_t)(t + 1) * kstep;
            const char* a2 = last ? nA : cA + (size_t)(t + 2) * kstep; const char* b2 = last ? nB : cB + (size_t)(t + 2) * kstep;
            const char* a3 = a2 + kstep; const char* b3 = b2 + kstep;
            if constexpr (SP2) {
            PG8_LDB(B0, 0, 0); PG8_LDB(B1, 0, 1); PG8_SCHED; PG8_LDA(At, 0, 0); PG8_STAGE(PG8_SA(1, 1), a1 + hstep, voffA);
            PG8_WAIT_V(8); PG8_WAIT_L(0); PG8_BAR; PG8_MMA(0, 0, At, B0); PG8_MMA(0, 1, At, B1); PG8_BAR; PG8_SCHED;
            PG8_LDA(At, 0, 1); PG8_STAGE(PG8_SB(0, 0), b2, voffB); PG8_STAGE(PG8_SB(0, 1), b2 + hstep, voffB); PG8_STAGE(PG8_SA(0, 0), a2, voffA);
            PG8_WAIT_V(8); PG8_WAIT_L(0); PG8_BAR; PG8_MMA(1, 0, At, B0); PG8_MMA(1, 1, At, B1); PG8_BAR; PG8_SCHED;
            PG8_LDB(B0, 1, 0); PG8_LDB(B1, 1, 1); PG8_SCHED; PG8_LDA(At, 1, 0); PG8_STAGE(PG8_SA(0, 1), a2 + hstep, voffA);
            PG8_WAIT_V(8); PG8_WAIT_L(0); PG8_BAR; PG8_MMA(0, 0, At, B0); PG8_MMA(0, 1, At, B1); PG8_BAR; PG8_SCHED;
            PG8_LDA(At, 1, 1); PG8_STAGE(PG8_SB(1, 0), b3, voffB); PG8_STAGE(PG8_SB(1, 1), b3 + hstep, voffB); PG8_STAGE(PG8_SA(1, 0), a3, voffA);
            PG8_WAIT_V(8); PG8_WAIT_L(0); PG8_BAR; PG8_MMA(1, 0, At, B0); PG8_MMA(1, 1, At, B1); PG8_BAR; PG8_SCHED;
            } else {
            PG8_LDB(B0, 0, 0); PG8_SCHED; PG8_LDA(At, 0, 0); PG8_STAGE(PG8_SA(1, 1), a1 + hstep, voffA);
            PG8_WAIT_L(8); PG8_BAR; PG8_WAIT_L(0); PG8_MMA(0, 0, At, B0); PG8_BAR; PG8_SCHED;
            PG8_LDB(B1, 0, 1); PG8_STAGE(PG8_SB(0, 0), b2, voffB);
            PG8_BAR; PG8_WAIT_L(0); PG8_MMA(0, 1, At, B1); PG8_BAR;
            PG8_LDA(At, 0, 1); PG8_STAGE(PG8_SA(0, 0), a2, voffA);
            PG8_BAR; PG8_WAIT_L(0); PG8_MMA(1, 0, At, B0); PG8_BAR; PG8_SCHED;
            PG8_STAGE(PG8_SB(0, 1), b2 + hstep, voffB);
            PG8_WAIT_V(6); PG8_BAR; PG8_MMA(1, 1, At, B1); PG8_BAR;
            PG8_LDB(B0, 1, 0); PG8_SCHED; PG8_LDA(At, 1, 0); PG8_STAGE(PG8_SA(0, 1), a2 + hstep, voffA);
            PG8_WAIT_L(8); PG8_BAR; PG8_WAIT_L(0); PG8_MMA(0, 0, At, B0); PG8_BAR; PG8_SCHED;
            PG8_LDB(B1, 1, 1); PG8_STAGE(PG8_SB(1, 0), b3, voffB);
            PG8_BAR; PG8_WAIT_L(0); PG8_MMA(0, 1, At, B1); PG8_BAR;
            PG8_LDA(At, 1, 1); PG8_STAGE(PG8_SA(1, 0), a3, voffA);
            PG8_BAR; PG8_WAIT_L(0); PG8_MMA(1, 0, At, B0); PG8_BAR; PG8_SCHED;
            PG8_STAGE(PG8_SB(1, 1), b3 + hstep, voffB);
            PG8_WAIT_V(6); PG8_BAR; PG8_MMA(1, 1, At, B1); PG8_BAR;
                    }
        }
        if constexpr (ALIGN_EPI) { if (wr == 0) PG8_BAR; }
        E(acc, cur, wr, wc, fr, fq);
        if (!has_next) break;
#pragma unroll
        for (int a = 0; a < 2; ++a)
#pragma unroll
            for (int b = 0; b < 2; ++b)
#pragma unroll
                for (int m = 0; m < 4; ++m)
#pragma unroll
                    for (int n = 0; n < 2; ++n) acc[a][b][m][n] = (f32x4){0.f, 0.f, 0.f, 0.f};
        cur = nxt; cA = nA; cB = nB; ++ui;
        if constexpr (ALIGN_EPI) { if (wr == 1) PG8_BAR; }
    }
    PG8_WAIT_V(0);
    if constexpr (!ALIGN_EPI) { if (wr == 0) PG8_BAR; }
    PG8_BAR;
#undef PG8_SA
#undef PG8_SB
#undef PG8_STAGE
#undef PG8_LDA
#undef PG8_LDB
#undef PG8_MMA
#undef PG8_WAIT_V
#undef PG8_WAIT_L
#undef PG8_BAR
#undef PG8_SCHED
}

struct EpiSwiGLU {
    static constexpr bool PERM = false;
    h16* O; int ldo;
    __device__ __forceinline__ void operator()(const f32x4 (&acc)[2][2][4][2], const Unit& u, int wr, int wc, int fr, int fq) const {
        const int row0 = u.pm * BM + wr * 64 + fr;
#pragma unroll
        for (int ai = 0; ai < 2; ++ai)
#pragma unroll
            for (int m = 0; m < 4; ++m) { h16* rowp = O + (size_t)(row0 + ai * HALF + m * 16) * ldo;
#pragma unroll
                for (int bj = 0; bj < 2; ++bj) { const int oc = (u.pn * BM + bj * HALF + wc * 32) / 2 + 4 * fq;
                    const f32x4 gt = acc[ai][bj][m][0], up = acc[ai][bj][m][1]; float o[4];
#pragma unroll
                    for (int j = 0; j < 4; ++j) o[j] = gt[j] * sigmoidf_(gt[j]) * up[j];
                    u32x2 w; w.x = pk2h(o[0], o[1]); w.y = pk2h(o[2], o[3]);
                    *(u32x2*)(rowp + oc) = w; } }
    }
};
template <bool RES16, bool OUT16> struct EpiRes {
    static constexpr bool PERM = false;
    const void* res; void* out; float* slab; float scale; int pad;
    __device__ __forceinline__ void operator()(const f32x4 (&acc)[2][2][4][2], const Unit& u, int wr, int wc, int fr, int fq) const {
        const int row0 = u.pm * BM + wr * 64 + fr, col0 = u.pn * BM + wc * 32 + 4 * fq;
        if (u.sp >= 0) {
            float* sb = slab + ((size_t)u.sp * MS - MP) * D;
#pragma unroll
            for (int ai = 0; ai < 2; ++ai)
#pragma unroll
                for (int m = 0; m < 4; ++m) { const size_t off = (size_t)(row0 + ai * HALF + m * 16) * D + col0;
#pragma unroll
                    for (int bj = 0; bj < 2; ++bj)
#pragma unroll
                        for (int n = 0; n < 2; ++n) *(f32x4*)(sb + off + bj * HALF + n * 16) = acc[ai][bj][m][n]; }
            return;
        }
#pragma unroll
        for (int ai = 0; ai < 2; ++ai)
#pragma unroll
            for (int m = 0; m < 4; ++m) { const size_t off = (size_t)(row0 + ai * HALF + m * 16) * D + col0;
#pragma unroll
                for (int bj = 0; bj < 2; ++bj)
#pragma unroll
                    for (int n = 0; n < 2; ++n) { f32x4 rv; const size_t o_ = off + bj * HALF + n * 16;
                        if constexpr (RES16) { const h16x4 hv = *(const h16x4*)((const h16*)res + o_); rv = (f32x4){(float)hv[0], (float)hv[1], (float)hv[2], (float)hv[3]}; }
                        else rv = *(const f32x4*)((const float*)res + o_);
                        const f32x4 o = rv + scale * acc[ai][bj][m][n];
                        if constexpr (OUT16) { u32x2 w; w.x = pk2h(o[0], o[1]); w.y = pk2h(o[2], o[3]); *(u32x2*)((h16*)out + o_) = w; }
                        else *(f32x4*)((float*)out + o_) = o; } }
    }
};
struct EpiP16 {
    static constexpr bool PERM = true;
    h16* P; h16* PF;
    __device__ __forceinline__ void operator()(const f32x4 (&acc)[2][2][4][2], const Unit& u, int wr, int wc, int fr, int fq) const {
        const int row0 = u.pm * BM + wr * 64 + fr; const int kind = u.pn < 26 ? 0 : u.pn < 42 ? 1 : u.pn < 58 ? 2 : 3;
#pragma unroll
        for (int ai = 0; ai < 2; ++ai)
#pragma unroll
            for (int m = 0; m < 4; ++m) { const int row = row0 + ai * HALF + m * 16;
#pragma unroll
                for (int bj = 0; bj < 2; ++bj) { const int gcol = u.pn * BM + bj * HALF + wc * 32;
                    const f32x4 v0 = acc[ai][bj][m][0], v1 = acc[ai][bj][m][1];
                    if (kind == 0) { u32x4 w; w.x = pk2h(v0[0], v0[1]); w.y = pk2h(v0[2], v0[3]); w.z = pk2h(v1[0], v1[1]); w.w = pk2h(v1[2], v1[3]);
                        if (u.pm < MT / BM) *(u32x4*)(P + (size_t)row * PP + gcol + 8 * fq) = w;
                        else *(u32x4*)(PF + (size_t)(row - MT) * PFW + gcol + 8 * fq) = w; }
                    else if (kind == 3) { u32x4 w; w.x = pk2h(sigmoidf_(v0[0]), sigmoidf_(v0[1])); w.y = pk2h(sigmoidf_(v0[2]), sigmoidf_(v0[3])); w.z = pk2h(sigmoidf_(v1[0]), sigmoidf_(v1[1])); w.w = pk2h(sigmoidf_(v1[2]), sigmoidf_(v1[3]));
                        *(u32x4*)(P + (size_t)row * PP + C_SA + (gcol - (PFW + 8192)) + 8 * fq) = w; }
                    else { float o[4];
#pragma unroll
                        for (int j = 0; j < 4; ++j) o[j] = kind == 1 ? v0[j] * v1[j] : sigmoidf_(v1[j]) * v0[j];
                        u32x2 w; w.x = pk2h(o[0], o[1]); w.y = pk2h(o[2], o[3]);
                        *(u32x2*)(P + (size_t)row * PP + (kind == 1 ? C_U + ((gcol - PFW) >> 1) : C_Q + ((gcol - PFW - 4096) >> 1)) + 4 * fq) = w; } } }
    }
};
struct EpiEAG {
    static constexpr bool PERM = true;
    h16* O; const float* w0; const float* a0;
    __device__ __forceinline__ void operator()(const f32x4 (&acc)[2][2][4][2], const Unit& u, int wr, int wc, int fr, int fq) const {
        const int row0 = u.pm * BM + wr * 64 + fr; const int typ = u.pn >> 3;
#pragma unroll
        for (int bj = 0; bj < 2; ++bj) { const int col = u.pn * BM + bj * HALF + wc * 32 + 8 * fq;
            f32x4 b0 = (f32x4){0.f, 0.f, 0.f, 0.f}, b1 = b0;
            if (typ == 0) { b0 = *(const f32x4*)(w0 + col); b1 = *(const f32x4*)(w0 + col + 4); }
            if (typ == 1) { b0 = *(const f32x4*)(a0 + col - D); b1 = *(const f32x4*)(a0 + col - D + 4); }
#pragma unroll
            for (int ai = 0; ai < 2; ++ai)
#pragma unroll
                for (int m = 0; m < 4; ++m) { const int row = row0 + ai * HALF + m * 16;
                    f32x4 v0 = acc[ai][bj][m][0] + b0, v1 = acc[ai][bj][m][1] + b1;
                    if (typ < 2) { const float sc = typ == 0 ? 0.60653065971f : 1.0f;
#pragma unroll
                        for (int j = 0; j < 4; ++j) { v0[j] = sigmoidf_(v0[j]) * sc; v1[j] = sigmoidf_(v1[j]) * sc; } }
                    u32x4 w; w.x = pk2h(v0[0], v0[1]); w.y = pk2h(v0[2], v0[3]); w.z = pk2h(v1[0], v1[1]); w.w = pk2h(v1[2], v1[3]);
                    *(u32x4*)(O + (size_t)row * 6144 + col) = w; } }
    }
};
}


#define XB_TMO      128
#define XB_XCNT(j)  (256  + 64 * (j))
#define XB_XSUB(j)  (1280 + 64 * (j))
#define XB_XGEN(j)  (2304 + 64 * (j))
#define XB_TOP      3328
#define XB_TOPGEN   3392
#define XCD_BAR_WORDS 3456
#define XB_SPIN_CAP (1u << 22)
__device__ __forceinline__ unsigned xb_ld(unsigned* p)              { return __hip_atomic_load(p, __ATOMIC_RELAXED, __HIP_MEMORY_SCOPE_AGENT); }
__device__ __forceinline__ unsigned xb_add(unsigned* p, unsigned v) { return __hip_atomic_fetch_add(p, v, __ATOMIC_RELAXED, __HIP_MEMORY_SCOPE_AGENT); }
__device__ __forceinline__ unsigned xb_xcc_id() { return (unsigned)__builtin_amdgcn_s_getreg((3 << 11) | 20) & 0xFu; }
#define XB_SPIN(cond, bar) do { unsigned _sp = 0; while (cond) { __builtin_amdgcn_s_sleep(1); \
    if ((++_sp & 255u) == 0u) { if (xb_ld(&(bar)[XB_TMO])) break; if (_sp > XB_SPIN_CAP) { atomicAdd(&(bar)[XB_TMO], 1u); break; } } } } while (0)
struct XcdBarrier { unsigned* bar; unsigned x; volatile LAS unsigned* st; };
__device__ __forceinline__ XcdBarrier xcd_barrier_post(unsigned* bar, volatile LAS unsigned* st) {
    XcdBarrier b; b.bar = bar; b.x = xb_xcc_id(); b.st = st;
    if (threadIdx.x == 0) (void)xb_add(&bar[XB_XCNT(b.x)], 1u);
    return b;
}
__device__ __forceinline__ void xcd_barrier_complete(unsigned* bar, unsigned x, unsigned& nloc, unsigned& nx) {
    const unsigned G = gridDim.x * gridDim.y * gridDim.z;
    unsigned sum, cnt, mine, sp = 0u;
    for (;;) {
        sum = 0u; cnt = 0u; mine = 0u;
#pragma unroll
        for (unsigned j = 0; j < 16; ++j) { const unsigned c = xb_ld(&bar[XB_XCNT(j)]); sum += c; cnt += (c > 0u) ? 1u : 0u; mine = (j == x) ? c : mine; }
        if (sum == G) break;
        __builtin_amdgcn_s_sleep(1);
        if ((++sp & 255u) == 0u) { if (xb_ld(&bar[XB_TMO])) break; if (sp > XB_SPIN_CAP) { atomicAdd(&bar[XB_TMO], 1u); break; } }
    }
    nloc = mine > 0u ? mine : 1u; nx = cnt > 0u ? cnt : 1u;
}
__device__ __forceinline__ void xcd_barrier(const XcdBarrier& b) {
    asm volatile("s_waitcnt vmcnt(0)" ::: "memory");
    __syncthreads();
    if (threadIdx.x == 0) {
        unsigned* bar = b.bar;
        __builtin_amdgcn_s_waitcnt(0);
        unsigned nloc = b.st[0], nx = b.st[1];
        if (nloc == 0u) { xcd_barrier_complete(bar, b.x, nloc, nx); b.st[0] = nloc; b.st[1] = nx; }
        const unsigned old = xb_add(&bar[XB_XSUB(b.x)], 1u);
        const unsigned gen = old / nloc;
        if (old + 1u == (gen + 1u) * nloc) {
            __builtin_amdgcn_fence(__ATOMIC_RELEASE, "agent");
            asm volatile("s_waitcnt vmcnt(0)" ::: "memory");
            const unsigned og = xb_add(&bar[XB_TOP], 1u);
            const unsigned tg = og / nx;
            if (og + 1u == (tg + 1u) * nx) xb_add(&bar[XB_TOPGEN], 1u);
            else XB_SPIN(xb_ld(&bar[XB_TOPGEN]) == tg, bar);
            __builtin_amdgcn_fence(__ATOMIC_ACQUIRE, "agent");
            xb_add(&bar[XB_XGEN(b.x)], 1u);
            asm volatile("s_waitcnt vmcnt(0)" ::: "memory");
        } else {
            XB_SPIN(xb_ld(&bar[XB_XGEN(b.x)]) == gen, bar);
            __builtin_amdgcn_fence(__ATOMIC_ACQUIRE, "agent");
            asm volatile("s_waitcnt vmcnt(0)" ::: "memory");
        }
    }
    __syncthreads();
}

struct Args { const float* in[29]; float* out; unsigned char* ws; int ph_lo, ph_hi; };

__device__ __forceinline__ void cvt_item(int mode, const float* s0, const float* s1, int Nsrc, int K, h16* WT, LAS float* scr, int item, int nblk, int lane) {
    const int kb = item / nblk, nb = item % nblk, k0 = 64 * kb, n0 = 32 * nb;
    const int nn = lane & 31; const float* src = s0; int col = n0 + nn; bool zero = false;
    if (mode == 1) { src = (nn < 16) ? s0 : s1; col = (n0 >> 1) + (nn & 15); }
    if (mode == 2) { if (n0 >= NA && n0 < PFW) zero = true; else if (n0 >= PFW) col -= 64; }
#pragma unroll 8
    for (int i = 0; i < 32; ++i) { const int kk = 2 * i + (lane >> 5); scr[kk * 33 + nn] = zero ? 0.f : src[(size_t)(k0 + kk) * Nsrc + col]; }
    asm volatile("s_waitcnt lgkmcnt(0)" ::: "memory");
    const int c = lane & 7;
#pragma unroll
    for (int j = 0; j < 4; ++j) { const int n = (lane >> 3) + 8 * j; const LAS float* s = scr + (8 * c) * 33 + n;
        u32x4 o; o.x = pk2h(s[0 * 33], s[1 * 33]); o.y = pk2h(s[2 * 33], s[3 * 33]); o.z = pk2h(s[4 * 33], s[5 * 33]); o.w = pk2h(s[6 * 33], s[7 * 33]);
        *(u32x4*)(WT + (size_t)(n0 + n) * K + k0 + 8 * c) = o; }
    asm volatile("s_waitcnt lgkmcnt(0)" ::: "memory");
}
struct CvtIt { const float* p; h16* q; int Nsrc, K; bool zero; };
__device__ __forceinline__ CvtIt cvt_decode(int mode, const float* s0, const float* s1, int Nsrc, int K, h16* WT, int nblk, int item, int lane) {
    const int kb = item / nblk, nb = item % nblk, k0 = 64 * kb, n0 = 32 * nb, nn = lane & 31;
    const float* src = s0; int col = n0 + nn; bool zero = false;
    if (mode == 1) { src = (nn < 16) ? s0 : s1; col = (n0 >> 1) + (nn & 15); }
    if (mode == 2) {
        const int q = nn >> 3, sp = (nn >> 2) & 1, j = nn & 3;
        if (n0 >= NA && n0 < PFW) { zero = true; col = 0; }
        else if (n0 >= PFW && n0 < PFW + 4096) col = (sp ? NA + 2 * D : NA + D) + ((n0 - PFW) >> 1) + 4 * q + j;
        else if (n0 >= PFW + 4096 && n0 < PFW + 8192) col = (sp ? NA + 4 * D : NA) + ((n0 - PFW - 4096) >> 1) + 4 * q + j;
        else if (n0 >= PFW + 8192) col = NA + 3 * D + (n0 - PFW - 8192) + nn; }
    CvtIt r; r.p = src + (size_t)(k0 + (lane >> 5)) * Nsrc + col; r.q = WT + (size_t)(n0 + (lane >> 3)) * K + k0 + 8 * (lane & 7); r.Nsrc = Nsrc; r.K = K; r.zero = zero; return r;
}
__device__ __forceinline__ void cvt_load(const CvtIt& t, float (&v)[32]) {
#pragma unroll
    for (int i = 0; i < 32; ++i) v[i] = t.p[(size_t)(2 * i) * t.Nsrc];
}
__device__ __forceinline__ void cvt_finish(const CvtIt& t, const float (&v)[32], LAS float* scr, int lane) {
    const int nn = lane & 31;
#pragma unroll
    for (int i = 0; i < 32; ++i) scr[(2 * i + (lane >> 5)) * 33 + nn] = t.zero ? 0.f : v[i];
    asm volatile("s_waitcnt lgkmcnt(0)" ::: "memory");
    const int c = lane & 7;
#pragma unroll
    for (int j = 0; j < 4; ++j) { const int n = (lane >> 3) + 8 * j; const LAS float* s = scr + (8 * c) * 33 + n;
        u32x4 o; o.x = pk2h(s[0 * 33], s[1 * 33]); o.y = pk2h(s[2 * 33], s[3 * 33]); o.z = pk2h(s[4 * 33], s[5 * 33]); o.w = pk2h(s[6 * 33], s[7 * 33]);
        *(u32x4*)(t.q + (size_t)(8 * j) * t.K) = o; }
    asm volatile("s_waitcnt lgkmcnt(0)" ::: "memory");
}
#define CVT_RUN(total_, PICK) do { float va[32], vb[32]; CvtIt A_, B_; int it_ = gw; if (it_ < (total_)) { PICK(it_, A_); cvt_load(A_, va); \
        for (;;) { const int itb_ = it_ + NGW; const bool hb_ = itb_ < (total_); if (hb_) { PICK(itb_, B_); cvt_load(B_, vb); } cvt_finish(A_, va, scr, lane); if (!hb_) break; \
            it_ = itb_ + NGW; const bool ha_ = it_ < (total_); if (ha_) { PICK(it_, A_); cvt_load(A_, va); } cvt_finish(B_, vb, scr, lane); if (!ha_) break; } } } while (0)
__device__ __forceinline__ void cvt_lora_item(const float* wl, const float* al, const float* gl, h16* WT, int item, int lane) {
    const int n = item, typ = n >> 11, col = n & 2047; unsigned w[4];
#pragma unroll
    for (int j = 0; j < 4; ++j) { float v[2];
#pragma unroll
        for (int e = 0; e < 2; ++e) { const int k = lane * 8 + j * 2 + e; float x = 0.f;
            if (typ == 0 && k < 96) x = wl[(size_t)k * D + col];
            if (typ == 1 && k >= 96 && k < 192) x = al[(size_t)(k - 96) * D + col];
            if (typ == 2 && k >= 192 && k < 448) x = gl[(size_t)(k - 192) * D + col];
            v[e] = x; }
        w[j] = pk2h(v[0], v[1]); }
    *(u32x4*)(WT + (size_t)n * LK + lane * 8) = (u32x4){w[0], w[1], w[2], w[3]};
}

__device__ __forceinline__ void rms_row_f16(const float* xrow, const float* g, h16* orow, float* f32row, int lane, const float* part = nullptr, float pscale = 0.f, float* xout = nullptr) {
    const f32x4* xr = (const f32x4*)xrow + lane; const f32x4* gr = (const f32x4*)g + lane;
    f32x4 v[8]; float s = 0.f;
#pragma unroll
    for (int j = 0; j < 8; ++j) { v[j] = xr[64 * j];
        if (part) { const f32x4* pp = (const f32x4*)part + lane + 64 * j; const size_t st = (size_t)MS * D / 4;
            v[j] += pscale * ((pp[0] + pp[st]) + (pp[2 * st] + pp[3 * st])); if (xout) *((f32x4*)xout + lane + 64 * j) = v[j]; }
        s += (v[j].x * v[j].x + v[j].y * v[j].y) + (v[j].z * v[j].z + v[j].w * v[j].w); }
    const float rs = rsqrtf(wave_sum(s) * (1.f / D) + 1e-6f);
#pragma unroll
    for (int j = 0; j < 8; ++j) { const f32x4 gg = gr[64 * j]; const f32x4 o = v[j] * rs * gg;
        if (orow) { u32x2 w; w.x = pk2h(o.x, o.y); w.y = pk2h(o.z, o.w); *((u32x2*)orow + lane + 64 * j) = w; }
        if (f32row) *((f32x4*)f32row + lane + 64 * j) = o; }
}

__device__ __forceinline__ void rms_row_h(const h16* xrow, const float* g, h16* orow, float* f32row, int lane) {
    const f32x4* gr = (const f32x4*)g + lane;
    f32x4 v[8]; float s = 0.f;
#pragma unroll
    for (int j = 0; j < 8; ++j) { const h16x4 hv = *((const h16x4*)xrow + lane + 64 * j);
        v[j] = (f32x4){(float)hv[0], (float)hv[1], (float)hv[2], (float)hv[3]};
        s += (v[j].x * v[j].x + v[j].y * v[j].y) + (v[j].z * v[j].z + v[j].w * v[j].w); }
    const float rs = rsqrtf(wave_sum(s) * (1.f / D) + 1e-6f);
#pragma unroll
    for (int j = 0; j < 8; ++j) { const f32x4 gg = gr[64 * j]; const f32x4 o = v[j] * rs * gg;
        if (orow) { u32x2 w; w.x = pk2h(o.x, o.y); w.y = pk2h(o.z, o.w); *((u32x2*)orow + lane + 64 * j) = w; }
        if (f32row) *((f32x4*)f32row + lane + 64 * j) = o; }
}

enum { PH_CVT1 = 0, PH_FFN1_GU, PH_FFN1_D, PH_RMS_MIX, PH_WIN, PH_SHIFT, PH_LORA, PH_PREP, PH_SCAN, PH_MERGE, PH_WOUT, PH_RMS2, PH_FFN2_GU, PH_FFN2_D, PH_FINAL, PH_N };

__global__ void __launch_bounds__(NTHR, 2) fwd_kernel(Args a) {
    extern __shared__ __attribute__((aligned(16))) unsigned char lds_raw[];
    LAS unsigned char* lds = (LAS unsigned char*)lds_raw;
    const int tid = threadIdx.x, lane = tid & 63, wave = __builtin_amdgcn_readfirstlane(tid >> 6);
    const int G = gridDim.x, bx = blockIdx.x;
    const int gw = bx * NWAVES + wave, NGW = G * NWAVES;
    unsigned char* ws = a.ws; unsigned char* ob = (unsigned char*)a.out;
    h16* W1GU = (h16*)(ws + WS_W1GU); h16* W1D = (h16*)(ws + WS_W1D); h16* WIN = (h16*)(ws + WS_WIN); h16* WOUT = (h16*)(ws + WS_WOUT);
    h16* A16 = (h16*)(ws + WS_A16); h16* P16 = (h16*)(ws + WS_P16); h16* EAG = (h16*)(ws + WS_EAG); h16* HM = (h16*)(ws + WS_HM);
    h16* W2GU = (h16*)(ws + WS_W2GU); h16* W2D = (h16*)(ws + WS_W2D);
    h16* WL = (h16*)(ob + OB_WL); h16* PF = (h16*)(ws + WS_PF);
    float* Y = a.out + O_Y; float* SLAB = (float*)(ws + WS_SLAB);
    h16* XH = (h16*)(a.out + O_Y);
    const int lo = a.ph_lo, hi = a.ph_hi;
#define IN(k) (lo <= (k) && (k) < hi)
    cg::grid_group grid = cg::this_grid();
    volatile LAS unsigned* xst = (volatile LAS unsigned*)(lds + LDS_BYTES - 16);
    if (tid < 2) xst[tid] = 0u;
    __syncthreads();
    const XcdBarrier xbar = xcd_barrier_post((unsigned*)(ws + WS_CTL), xst);
#ifndef PROBE_MASK
#define PROBE_MASK 0u
#endif
    unsigned long long pr_t[PH_N + 1]; (void)pr_t;
    if (PROBE_MASK) pr_t[0] = __builtin_amdgcn_s_memrealtime();
#define SEAM(k) do { if (IN(k) && IN((k) + 1)) { if ((k) == PH_CVT1) grid.sync(); else xcd_barrier(xbar); } if (PROBE_MASK) pr_t[(k) + 1] = __builtin_amdgcn_s_memrealtime(); } while (0)

    if (IN(PH_CVT1)) {
        LAS float* scr = (LAS float*)(lds + wave * 16384);
        constexpr int I1 = (D / 64) * (2 * FF / 32), I2 = (FF / 64) * (D / 32), I3 = (D / 64) * (NW / 32), I4 = (D / 64) * (D / 32);
#define PICK1(it, out) do { int r_ = (it); if (r_ < I1) out = cvt_decode(1, a.in[6], a.in[7], FF, D, W1GU, 2 * FF / 32, r_, lane); else if ((r_ -= I1) < I2) out = cvt_decode(0, a.in[8], a.in[8], D, FF, W1D, D / 32, r_, lane); \
            else if ((r_ -= I2) < I3) out = cvt_decode(2, a.in[10], a.in[10], NIN, D, WIN, NW / 32, r_, lane); else out = cvt_decode(0, a.in[23], a.in[23], D, D, WOUT, D / 32, r_ - I3, lane); } while (0)
        CVT_RUN(I1 + I2 + I3 + I4, PICK1);
#undef PICK1
        for (int it = gw; it < 6144; it += NGW) cvt_lora_item(a.in[13], a.in[15], a.in[16], WL, it, lane);
        for (int r = gw; r < 256; r += NGW) { h16* orow = A16 + (size_t)(MT + r) * D;
#pragma unroll
            for (int j = 0; j < 8; ++j) { u32x2 w = (u32x2){0u, 0u};
                if (r < 32) { const f32x4 v = *((const f32x4*)(a.in[2] + (size_t)r * D) + lane + 64 * j); w.x = pk2h(v.x, v.y); w.y = pk2h(v.z, v.w); }
                *((u32x2*)orow + lane + 64 * j) = w; } }
        for (int m = gw; m < MT; m += NGW) { const float* xr = m < MP ? a.in[0] + (size_t)m * D : a.in[1] + (size_t)(m - MP) * D; rms_row_f16(xr, a.in[5], A16 + (size_t)m * D, nullptr, lane); }
    }
    SEAM(PH_CVT1);
    if (IN(PH_FFN1_GU)) { pg8::Gemm g{A16, W1GU, MT, 2 * FF, D}; pg8::Order S; S.init(MT, 2 * FF, D, G, bx, 0, -1); pg8::EpiSwiGLU E{HM, FF}; pg8::gemm_phase(lds, g, S, E); }
    SEAM(PH_FFN1_GU);
    if (IN(PH_FFN1_D)) { pg8::Gemm g{HM, W1D, MT, D, FF}; pg8::Order S; S.init(MT, D, FF, G, bx, 0, MP / 256); pg8::EpiRes<false, true> E{a.in[0], XH, SLAB, 0.5f, 0}; pg8::gemm_phase(lds, g, S, E); }
    SEAM(PH_FFN1_D);
    if (IN(PH_RMS_MIX)) {
        for (int m = gw; m < MT; m += NGW) { float* so = nullptr;
            if (m < MP) { if ((m & 4095) == 4095) so = a.out + O_SHP + (size_t)(m >> 12) * D; } else { if (((m - MP) & 63) == 63) so = a.out + O_SHS + (size_t)((m - MP) >> 6) * D; }
            if (m < MP) rms_row_h(XH + (size_t)m * D, a.in[9], A16 + (size_t)m * D, so, lane);
            else rms_row_f16(a.in[1] + (size_t)(m - MP) * D, a.in[9], A16 + (size_t)m * D, so, lane, SLAB + (size_t)(m - MP) * D, 0.5f, Y + (size_t)m * D); }
    }
    SEAM(PH_RMS_MIX);
    if (IN(PH_WIN)) { pg8::Gemm g{A16, WIN, MT, NW, D}; pg8::Order S; S.init(MT, NW, D, G, bx, PFW / 256, -1); pg8::EpiP16 E{P16, PF}; pg8::gemm_phase(lds, g, S, E); }
    SEAM(PH_WIN);
    if (IN(PH_SHIFT)) {
        for (int item = bx * NTHR + tid; item < (MT / 16) * 768; item += G * NTHR) { const int c = item / 768, o = item % 768;
            *(u32x4*)((h16*)(ob + OB_SIDE) + (size_t)c * 6144 + o * 8) = *(const u32x4*)(P16 + (size_t)(16 * c + 15) * PP + o * 8); }
    }
    if (IN(PH_SHIFT)) {
        h16* AIN = A16; const float* mu = a.in[11];
        for (int item = bx * NTHR + tid; item < MT * 64; item += G * NTHR) {
            const int row = item >> 6, o = item & 63;
            if (o >= 56) { *(u32x4*)(AIN + (size_t)row * LK + 448 + (o - 56) * 8) = (u32x4){0u, 0u, 0u, 0u}; continue; }
            const int c0 = 6144 + o * 8;
            const bool st = row < MP ? ((row & 4095) == 0) : (((row - MP) & 63) == 0);
            const h16* pp = st ? (row < MP ? PF + (size_t)32 * PFW : PF + (size_t)((row - MP) >> 6) * PFW) + c0 : P16 + (size_t)(row - 1) * PP + c0;
            const h16x8 cv = *(const h16x8*)(P16 + (size_t)row * PP + c0), pv = *(const h16x8*)pp;
            const f32x4 m0 = *(const f32x4*)(mu + c0), m1 = *(const f32x4*)(mu + c0 + 4);
            const float mu8[8] = {m0.x, m0.y, m0.z, m0.w, m1.x, m1.y, m1.z, m1.w}; float s[8];
#pragma unroll
            for (int j = 0; j < 8; ++j) { const float cu = (float)cv[j]; s[j] = cu + mu8[j] * ((float)pv[j] - cu); }
            if (o < 12) {
#pragma unroll
                for (int j = 0; j < 8; ++j) s[j] = tanhf_(s[j]);
            } else if (o >= 24) {
#pragma unroll
                for (int j = 0; j < 8; ++j) s[j] = sigmoidf_(s[j]);
            }
            *(u32x4*)(AIN + (size_t)row * LK + o * 8) = (u32x4){pk2h(s[0], s[1]), pk2h(s[2], s[3]), pk2h(s[4], s[5]), pk2h(s[6], s[7])};
        }
    }
    SEAM(PH_SHIFT);
    if (IN(PH_LORA)) { pg8::Gemm g{A16, WL, MT, 6144, LK}; pg8::Order S; S.init(MT, 6144, LK, G, bx, 0, -1); pg8::EpiEAG E{EAG, a.in[12], a.in[14]}; pg8::gemm_phase(lds, g, S, E); }
    SEAM(PH_LORA);
    if (IN(PH_PREP)) {
        LAS unsigned char* sc = lds + wave * 5120;
        float* RK = (float*)(ws + WS_RK); float* LM = (float*)(ws + WS_LM);
        const int cp = lane & 31, hs = lane >> 5;
#define H2LO(x) ((float)__builtin_bit_cast(h16, (unsigned short)((x) & 0xffffu)))
#define H2HI(x) ((float)__builtin_bit_cast(h16, (unsigned short)((x) >> 16)))
#define HSUM(x_, out_) do { float y_ = row_allreduce16(x_); y_ += __builtin_bit_cast(float, __builtin_amdgcn_update_dpp(0, __builtin_bit_cast(int, y_), 0x142, 0xA, 0xF, false)); \
            const float s31_ = rl_f(y_, 31), s63_ = rl_f(y_, 63); out_ = hs ? s63_ : s31_; } while (0)
        for (int item = gw; item < (MT / 16) * 32; item += NGW) {
            const int c = item >> 5, h = item & 31, row0 = 16 * c, hj2 = h * 64 + 2 * cp;
            const f32x2 c_kk = *(const f32x2*)(a.in[17] + hj2), c_ka = *(const f32x2*)(a.in[18] + hj2), c_rk = *(const f32x2*)(a.in[19] + hj2), c_mr = *(const f32x2*)(a.in[11] + hj2), c_mk = *(const f32x2*)(a.in[11] + D + hj2), c_mv = *(const f32x2*)(a.in[11] + 2 * D + hj2);
            const bool pr = row0 < MP; const bool st = pr ? ((row0 & 4095) == 0) : (((row0 - MP) & 63) == 0);
            const h16* pq = hs ? P16 + (size_t)(row0 + 7) * PP + hj2 : (st ? PF + (size_t)(pr ? 32 : ((row0 - MP) >> 6)) * PFW + hj2 : (const h16*)(ob + OB_SIDE) + (size_t)(c - 1) * 6144 + hj2);
            const h16* pp = P16 + (size_t)(row0 + 8 * hs) * PP + hj2; const h16* pe = EAG + (size_t)(row0 + 8 * hs) * 6144 + hj2;
            unsigned rr[9], kk[9], vv[9], ee[8], aa[8];
            rr[0] = *(const unsigned*)pq; kk[0] = *(const unsigned*)(pq + D); vv[0] = *(const unsigned*)(pq + 2 * D);
#pragma unroll
            for (int s_ = 0; s_ < 8; ++s_) { rr[s_ + 1] = *(const unsigned*)(pp + (size_t)s_ * PP); kk[s_ + 1] = *(const unsigned*)(pp + (size_t)s_ * PP + D); vv[s_ + 1] = *(const unsigned*)(pp + (size_t)s_ * PP + 2 * D);
                ee[s_] = *(const unsigned*)(pe + (size_t)s_ * 6144); aa[s_] = *(const unsigned*)(pe + (size_t)s_ * 6144 + D); }
            f32x2 Ll[8]; { f32x2 acc = (f32x2){0.f, 0.f};
#pragma unroll
                for (int s_ = 0; s_ < 8; ++s_) { acc -= (f32x2){H2LO(ee[s_]), H2HI(ee[s_])}; Ll[s_] = acc; } }
            const f32x2 oth = (f32x2){__shfl_xor(Ll[7].x, 32), __shfl_xor(Ll[7].y, 32)};
            const f32x2 M_ = hs ? oth : Ll[7]; const f32x2 L15 = M_ + (hs ? Ll[7] : oth);
            *(f32x2*)(LM + (size_t)item * 128 + 64 * hs + 2 * cp) = hs ? L15 : M_;
            const f32x2 off = hs ? (f32x2){0.f, 0.f} : M_;
            unsigned vpk[8];
            h16* eo = EAG + (size_t)(row0 + 8 * hs) * 6144 + hj2; h16* po = P16 + (size_t)(row0 + 8 * hs) * PP + hj2;
            f32x2 E3p = (f32x2){__expf(-off.x), __expf(-off.y)};
#pragma unroll
            for (int s_ = 0; s_ < 8; ++s_) { const int t = 8 * hs + s_;
                f32x2 r = (f32x2){H2LO(rr[s_ + 1]), H2HI(rr[s_ + 1])}, k = (f32x2){H2LO(kk[s_ + 1]), H2HI(kk[s_ + 1])}, v = (f32x2){H2LO(vv[s_ + 1]), H2HI(vv[s_ + 1])};
                r += c_mr * ((f32x2){H2LO(rr[s_]), H2HI(rr[s_])} - r); k += c_mk * ((f32x2){H2LO(kk[s_]), H2HI(kk[s_])} - k); v += c_mv * ((f32x2){H2LO(vv[s_]), H2HI(vv[s_])} - v);
                const f32x2 av = (f32x2){H2LO(aa[s_]), H2HI(aa[s_])};
                const f32x2 kkr = k * c_kk; float ss; HSUM(kkr.x * kkr.x + kkr.y * kkr.y, ss);
                const float rn = rsqrtf(fmaxf(ss, 1e-24f)); const f32x2 kap = kkr * rn;
                const f32x2 kmod = k * (1.f + (av - 1.f) * c_ka);
                const f32x2 Dm = Ll[s_] - off; const f32x2 E1 = E3p, E2 = (f32x2){__expf(-Dm.x), __expf(-Dm.y)}, E3 = (f32x2){__expf(Dm.x), __expf(Dm.y)}; E3p = E3;
                const f32x2 fat = kap * E1, frt = r * E3, fbb = kap * av * E2, fkb = kmod * E2;
                const unsigned hat = pk2h(fat.x, fat.y), hrt = pk2h(frt.x, frt.y), hbb = pk2h(fbb.x, fbb.y), hkb = pk2h(fkb.x, fkb.y);
                const f32x2 rkm = r * kmod * c_rk; float rk; HSUM(rkm.x + rkm.y, rk); if (cp == 0) RK[(size_t)(row0 + t) * 32 + h] = rk;
                *(unsigned*)(eo + (size_t)s_ * 6144) = hat; *(unsigned*)(eo + (size_t)s_ * 6144 + D) = hbb; *(unsigned*)(po + (size_t)s_ * PP) = hrt; *(unsigned*)(po + (size_t)s_ * PP + D) = hkb;
                ((LAS unsigned*)sc)[t * 32 + cp] = hat; ((LAS unsigned*)(sc + 2048))[t * 32 + cp] = hbb;
                vpk[s_] = pk2h(v.x, v.y);
            }
            { u32x4 lo, hi;
              lo.x = (vpk[0] & 0xffffu) | (vpk[1] << 16); lo.y = (vpk[2] & 0xffffu) | (vpk[3] << 16); lo.z = (vpk[4] & 0xffffu) | (vpk[5] << 16); lo.w = (vpk[6] & 0xffffu) | (vpk[7] << 16);
              hi.x = (vpk[0] >> 16) | (vpk[1] & 0xffff0000u); hi.y = (vpk[2] >> 16) | (vpk[3] & 0xffff0000u); hi.z = (vpk[4] >> 16) | (vpk[5] & 0xffff0000u); hi.w = (vpk[6] >> 16) | (vpk[7] & 0xffff0000u);
              const int i0 = 2 * cp;
              *(u32x4*)(P16 + (size_t)(row0 + (i0 >> 2)) * PP + 2 * D + h * 64 + (i0 & 3) * 16 + 8 * hs) = lo;
              *(u32x4*)(P16 + (size_t)(row0 + ((i0 + 1) >> 2)) * PP + 2 * D + h * 64 + ((i0 + 1) & 3) * 16 + 8 * hs) = hi; }
            asm volatile("s_waitcnt lgkmcnt(0)" ::: "memory");
            const int fr = lane & 15, fq = lane >> 4;
            f32x4 acc = (f32x4){0.f, 0.f, 0.f, 0.f};
#pragma unroll
            for (int kt = 0; kt < 4; ++kt) acc = __builtin_amdgcn_mfma_f32_16x16x16f16(*(const LAS h16x4*)(sc + (fr * 64 + 16 * kt + 4 * fq) * 2), *(const LAS h16x4*)(sc + 2048 + (fr * 64 + 16 * kt + 4 * fq) * 2), acc, 0, 0, 0);
            LAS float* Pm = (LAS float*)(sc + 4096);
#pragma unroll
            for (int g_ = 0; g_ < 4; ++g_) Pm[(4 * fq + g_) * 16 + fr] = (fr < 4 * fq + g_) ? acc[g_] : 0.f;
            asm volatile("s_waitcnt lgkmcnt(0)" ::: "memory");
            float Tc[16];
#pragma unroll
            for (int t = 0; t < 16; ++t) { float x = (t == fr) ? 1.f : 0.f;
#pragma unroll
                for (int j4 = 0; j4 < (t + 3) / 4; ++j4) { const f32x4 p4 = *(const LAS f32x4*)(Pm + t * 16 + 4 * j4);
                    if (4 * j4 + 0 < t) x -= p4.x * Tc[4 * j4 + 0]; if (4 * j4 + 1 < t) x -= p4.y * Tc[4 * j4 + 1]; if (4 * j4 + 2 < t) x -= p4.z * Tc[4 * j4 + 2]; if (4 * j4 + 3 < t) x -= p4.w * Tc[4 * j4 + 3]; }
                Tc[t] = x; }
            if (lane < 16) { h16* to = P16 + (size_t)row0 * PP + 6144 + h * 16 + fr;
#pragma unroll
                for (int t = 0; t < 16; ++t) to[(size_t)t * PP] = (h16)Tc[t]; }
            asm volatile("s_waitcnt lgkmcnt(0)" ::: "memory");
        }
#undef H2LO
#undef H2HI
#undef HSUM
    }
    SEAM(PH_PREP);
    if (IN(PH_SCAN)) {
        const int vcu = (G % 8 == 0) ? (bx % 8) * (G / 8) + bx / 8 : bx;
        constexpr int RAWB = 12288, NSL = 7, CSET = 2560, O_RAW = 0, O_CO = NSL * RAWB, O_YB = O_CO + 2 * CSET;
        static_assert(O_YB + 2 * 2048 <= LDS_BYTES - 16, "scan LDS map");
        h16* OUT16 = A16; const float* LM = (const float*)(ws + WS_LM);
        const bool pblk = vcu < 64;
        const int nitem = pblk ? 1 : (1024 - (vcu - 64) + 191) / 192;
        const int NCHB = pblk ? 256 : 4 * nitem;
#define SC_DESC(cc, prompt, sq, h, t0, first, last) \
        const bool prompt = pblk; bool first, last; int sq, h, t0; \
        if (prompt) { sq = vcu >> 5; h = vcu & 31; t0 = 16 * (cc); first = (cc) == 0; last = (cc) == 255; } \
        else { const int pair = (vcu - 64) + 192 * ((cc) >> 2); sq = pair >> 5; h = pair & 31; t0 = 16 * ((cc) & 3); first = ((cc) & 3) == 0; last = ((cc) & 3) == 3; }
#define SC_DMA(cc) do { if ((cc) < NCHB) { SC_DESC(cc, prompt_, sq_, h_, t0_, first_, last_); (void)last_; (void)first_; \
            const size_t rowb_ = (size_t)(prompt_ ? sq_ * 4096 : MP + sq_ * 64) + t0_; \
            LAS unsigned char* dst_ = lds + O_RAW + ((cc) % NSL) * RAWB; \
            const int sw_ = ((lane & 7) ^ (lane >> 3)) * 8;     \
            const h16* e0_ = EAG + (rowb_ + (lane >> 3)) * 6144 + h_ * 64 + sw_; const h16* p0_ = P16 + (rowb_ + (lane >> 3)) * PP + h_ * 64 + sw_; \
            __builtin_amdgcn_global_load_lds((const unsigned*)(e0_), (LAS unsigned*)(dst_), 16, 0, 0); \
            __builtin_amdgcn_global_load_lds((const unsigned*)(e0_ + 8 * 6144), (LAS unsigned*)(dst_ + 1024), 16, 0, 0); \
            __builtin_amdgcn_global_load_lds((const unsigned*)(p0_), (LAS unsigned*)(dst_ + 2048), 16, 0, 0); \
            __builtin_amdgcn_global_load_lds((const unsigned*)(p0_ + 8 * PP), (LAS unsigned*)(dst_ + 3072), 16, 0, 0); \
            __builtin_amdgcn_global_load_lds((const unsigned*)(e0_ + D), (LAS unsigned*)(dst_ + 4096), 16, 0, 0); \
            __builtin_amdgcn_global_load_lds((const unsigned*)(e0_ + D + 8 * 6144), (LAS unsigned*)(dst_ + 5120), 16, 0, 0); \
            __builtin_amdgcn_global_load_lds((const unsigned*)(p0_ + D), (LAS unsigned*)(dst_ + 6144), 16, 0, 0); \
            __builtin_amdgcn_global_load_lds((const unsigned*)(p0_ + D + 8 * PP), (LAS unsigned*)(dst_ + 7168), 16, 0, 0); \
            __builtin_amdgcn_global_load_lds((const unsigned*)(p0_ - sw_ + (lane & 7) * 8 + 2 * D), (LAS unsigned*)(dst_ + 8192), 16, 0, 0); \
            __builtin_amdgcn_global_load_lds((const unsigned*)(p0_ - sw_ + (lane & 7) * 8 + 2 * D + 8 * PP), (LAS unsigned*)(dst_ + 9216), 16, 0, 0); \
            __builtin_amdgcn_global_load_lds((const unsigned*)(P16 + (rowb_ + ((lane & 31) >> 1)) * PP + 6144 + h_ * 16 + (lane & 1) * 8), (LAS unsigned*)(dst_ + 10240), 16, 0, 0); \
            __builtin_amdgcn_global_load_lds((const unsigned*)(LM + ((rowb_ >> 4) * 32 + h_) * 128 + (lane & 31) * 4), (LAS unsigned*)(dst_ + 11264), 16, 0, 0); } } while (0)
#define MF(a_, b_, c_) __builtin_amdgcn_mfma_f32_16x16x32_f16(a_, b_, c_, 0, 0, 0)
#define CAT8(lo_, hi_) ((h16x8){(lo_)[0], (lo_)[1], (lo_)[2], (lo_)[3], (hi_)[0], (hi_)[1], (hi_)[2], (hi_)[3]})
#define SC_C(cc) do { if ((cc) >= 0 && (cc) < NCHB) { \
            const LAS unsigned char* rs = lds + O_RAW + ((cc) % NSL) * RAWB; LAS unsigned char* co = lds + O_CO + ((cc) & 1) * CSET; \
            const int fr = lane & 15, fq = lane >> 4; const int oa = wave == 4 ? 0 : 2048, ob_ = wave == 6 ? 4096 : 6144; \
            f32x4 acc = (f32x4){0.f, 0.f, 0.f, 0.f}; \
            _Pragma("unroll") for (int kb = 0; kb < 2; ++kb) { const int o_ = fr * 128 + (((4 * kb + fq) ^ (fr & 7)) << 4); acc = MF(*(const LAS h16x8*)(rs + oa + o_), *(const LAS h16x8*)(rs + ob_ + o_), acc); } \
            _Pragma("unroll") for (int g_ = 0; g_ < 4; ++g_) { const int t = 4 * fq + g_; const bool keep = wave == 4 ? (fr < t) : (fr <= t); ((LAS h16*)(co + (wave - 4) * 512))[t * 16 + fr] = (h16)(keep ? acc[g_] : 0.f); } \
            if (wave == 4) { const float M_ = ((const LAS float*)(rs + 11264))[lane], L15 = ((const LAS float*)(rs + 11264 + 256))[lane]; \
                ((LAS float*)(co + 1536))[lane] = __expf(M_); ((LAS float*)(co + 1792))[lane] = __expf(L15 - M_); ((LAS float*)(co + 2048))[lane] = __expf(L15); } } } while (0)
        f32x4 St[4];
#pragma unroll
        for (int n = 0; n < 4; ++n) St[n] = (f32x4){0.f, 0.f, 0.f, 0.f};
#define CVT4(x_) ((h16x4){(h16)(x_)[0], (h16)(x_)[1], (h16)(x_)[2], (h16)(x_)[3]})
#define TRR(p_) __builtin_bit_cast(h16x4, __builtin_amdgcn_ds_read_tr16_b64_v4i16((LAS s16x4*)(p_)))
#define SC_ROW(cc, PROMPT) do { if ((cc) >= 0 && (cc) < NCHB) { SC_DESC(cc, prompt, sq, h, t0, first, last); \
            const int fr = lane & 15, fq = lane >> 4; \
            float* sp = a.out + (prompt ? O_WKP : O_WKS) + ((size_t)(sq * 32 + h) * 64 + 16 * wave + fr) * 64 + 4 * fq; \
            if (first) { _Pragma("unroll") for (int n = 0; n < 4; ++n) { St[n] = (f32x4){0.f, 0.f, 0.f, 0.f}; if (!(PROMPT)) St[n] = *(const f32x4*)(a.in[4] + ((size_t)(sq * 32 + h) * 64 + 16 * wave + fr) * 64 + 16 * n + 4 * fq); } } \
            LAS unsigned char* rs = lds + O_RAW + ((cc) % NSL) * RAWB; const LAS unsigned char* co = lds + O_CO + ((cc) & 1) * CSET; \
              \
            f32x4 em[4], gm[4], e4[4]; h16x4 atl[2][2], rtl[2][2], kbt[4], bbt[4]; \
            _Pragma("unroll") for (int n = 0; n < 4; ++n) { em[n] = *(const LAS f32x4*)(co + 1536 + (16 * n + 4 * fq) * 4); gm[n] = *(const LAS f32x4*)(co + 2048 + (16 * n + 4 * fq) * 4); e4[n] = *(const LAS f32x4*)(co + 1792 + (16 * n + 4 * fq) * 4); } \
            _Pragma("unroll") for (int b = 0; b < 2; ++b) { \
                const int o0_ = fr * 128 + (((4 * b + (fq >> 1)) ^ (fr & 7)) << 4) + 8 * (fq & 1), o1_ = fr * 128 + (((4 * b + 2 + (fq >> 1)) ^ (fr & 7)) << 4) + 8 * (fq & 1); \
                atl[b][0] = *(const LAS h16x4*)(rs + o0_); atl[b][1] = *(const LAS h16x4*)(rs + o1_); rtl[b][0] = *(const LAS h16x4*)(rs + 2048 + o0_); rtl[b][1] = *(const LAS h16x4*)(rs + 2048 + o1_); } \
            const h16x4 vm = *(const LAS h16x4*)(rs + 8192 + ((16 * wave + fr) * 16 + 4 * fq) * 2), aak = *(const LAS h16x4*)(co + (fr * 16 + 4 * fq) * 2), tA = *(const LAS h16x4*)(rs + 10240 + (fr * 16 + 4 * fq) * 2), \
                        ark = *(const LAS h16x4*)(co + 512 + (fr * 16 + 4 * fq) * 2), arb = *(const LAS h16x4*)(co + 1024 + (fr * 16 + 4 * fq) * 2); \
            _Pragma("unroll") for (int n = 0; n < 4; ++n) { const int tr_ = 4 * fq + (fr >> 2); const int o_ = tr_ * 128 + (((2 * n + ((fr & 3) >> 1)) ^ (tr_ & 7)) << 4) + 8 * (fr & 1); kbt[n] = TRR(rs + 6144 + o_); bbt[n] = TRR(rs + 4096 + o_); } \
            asm volatile("s_waitcnt lgkmcnt(0)" ::: "memory"); \
            const h16x4 z4 = (h16x4){(h16)0.f, (h16)0.f, (h16)0.f, (h16)0.f}; \
            h16x4 sh[4]; \
            _Pragma("unroll") for (int n = 0; n < 4; ++n) { const f32x4 x = St[n] * em[n]; sh[n] = CVT4(x); } \
            f32x4 W1 = (f32x4){0.f, 0.f, 0.f, 0.f}, Yt = W1; \
              \
            _Pragma("unroll") for (int b = 0; b < 2; ++b) { const h16x8 sb = CAT8(sh[2 * b], sh[2 * b + 1]); \
                W1 = MF(CAT8(atl[b][0], atl[b][1]), sb, W1); Yt = MF(CAT8(rtl[b][0], rtl[b][1]), sb, Yt); } \
            W1 = MF(CAT8(aak, z4), CAT8(vm, z4), W1); \
            const h16x4 w1h = CVT4(W1); \
            f32x4 U = MF(CAT8(tA, z4), CAT8(w1h, z4), ((f32x4){0.f, 0.f, 0.f, 0.f})); \
            const f32x4 nU = -U; const h16x4 uh = CVT4(nU); const h16x8 vu = CAT8(vm, uh);     \
            Yt = MF(CAT8(ark, arb), vu, Yt); \
            _Pragma("unroll") for (int n = 0; n < 4; ++n) { const f32x4 tmp = MF(CAT8(kbt[n], bbt[n]), vu, ((f32x4){0.f, 0.f, 0.f, 0.f})); St[n] = gm[n] * St[n] + e4[n] * tmp; } \
            { LAS h16* yb = (LAS h16*)(lds + O_YB + ((cc) & 1) * 2048) + (4 * fq) * 64 + 16 * wave + fr; (void)t0; \
              yb[0] = (h16)Yt[0]; yb[64] = (h16)Yt[1]; yb[128] = (h16)Yt[2]; yb[192] = (h16)Yt[3]; } \
            if (last) { _Pragma("unroll") for (int n = 0; n < 4; ++n) *(f32x4*)(sp + 16 * n) = St[n]; } } } while (0)
#define SC_YOUT(cc) do { if ((cc) >= 0 && (cc) < NCHB && wave >= 5) { SC_DESC(cc, prompt, sq, h, t0, first, last); (void)first; (void)last; \
            const int L_ = (wave - 5) * 64 + lane, t_ = L_ >> 3, part_ = L_ & 7; \
            *(u32x4*)(OUT16 + ((size_t)(prompt ? sq * 4096 : MP + sq * 64) + t0 + t_) * D + h * 64 + part_ * 8) = *(const LAS u32x4*)(lds + O_YB + ((cc) & 1) * 2048 + t_ * 128 + part_ * 16); } } while (0)
#define SC_BARRIER() do { asm volatile("s_waitcnt lgkmcnt(0)" ::: "memory"); __builtin_amdgcn_s_barrier(); asm volatile("" ::: "memory"); } while (0)
        if (wave < 4) {
            SC_BARRIER();
            if (pblk) { for (int it = -1; it <= NCHB; ++it) { SC_ROW(it, true); SC_BARRIER(); } }
            else { for (int it = -1; it <= NCHB; ++it) { SC_ROW(it, false); SC_BARRIER(); } }
        } else if (wave == 7) {
            SC_DMA(0); SC_DMA(1); SC_DMA(2); SC_DMA(3); SC_DMA(4);
            asm volatile("s_waitcnt vmcnt(48)" ::: "memory");
            SC_BARRIER();
            for (int it = -1; it <= NCHB; ++it) {
                SC_DMA(it + 6);
                if (it + 6 < NCHB) asm volatile("s_waitcnt vmcnt(48)" ::: "memory");
                else asm volatile("s_waitcnt vmcnt(0)" ::: "memory");
                SC_BARRIER();
            }
        } else {
            SC_BARRIER();
            for (int it = -1; it <= NCHB; ++it) { SC_C(it + 1); SC_YOUT(it - 1); SC_BARRIER(); }
        }
        if (!pblk) {
            __syncthreads();
            LAS float* scr = (LAS float*)(lds + wave * 16384);
            constexpr int I1 = (D / 64) * (2 * FF / 32), I2 = (FF / 64) * (D / 32);
            const int gw = (vcu - 64) * NWAVES + wave, NGW = (G - 64) * NWAVES;
#define PICK2(it, out) do { int r_ = (it); if (r_ < I1) out = cvt_decode(1, a.in[25], a.in[26], FF, D, W2GU, 2 * FF / 32, r_, lane); else out = cvt_decode(0, a.in[27], a.in[27], D, FF, W2D, D / 32, r_ - I1, lane); } while (0)
            CVT_RUN(I1 + I2, PICK2);
#undef PICK2
        }
#undef SC_DESC
#undef SC_DMA
#undef MF
#undef CAT8
#undef SC_C
#undef CVT4
#undef TRR
#undef SC_ROW
#undef SC_BARRIER
#undef SC_YOUT
    }
    SEAM(PH_SCAN);
    if (IN(PH_MERGE)) {
        const float* RK = (const float*)(ws + WS_RK);
        const int o8 = tid & 255, c0 = o8 * 8, hd = o8 >> 3, rg = tid >> 8;
        float w0[8], w1[8], w2[8], lg[8], lb[8];
#pragma unroll
        for (int j = 0; j < 8; ++j) { w0[j] = a.in[22][c0 + j]; w1[j] = a.in[22][D + c0 + j]; w2[j] = a.in[22][2 * D + c0 + j]; lg[j] = a.in[20][c0 + j]; lb[j] = a.in[21][c0 + j]; }
        for (int c = bx; c < MT / 16; c += G) {
            const int row0 = 16 * c + 8 * rg;
            const bool pr = row0 < MP; const int tt0 = pr ? (row0 & 4095) : ((row0 - MP) & 63), sq = pr ? (row0 >> 12) : ((row0 - MP) >> 6), T = pr ? 4096 : 64;
            h16x8 vt[8];
            { const h16* vb = P16 + (size_t)(16 * c + ((c0 & 63) >> 2)) * PP + 2 * D + (c0 & ~63) + 8 * rg;
#pragma unroll
              for (int j = 0; j < 8; ++j) vt[j] = *(const h16x8*)(vb + (size_t)(j >> 2) * PP + (j & 3) * 16); }
            float u1[8], u2[8];
            { const h16* prow = P16 + (size_t)row0 * PP;
              if (tt0 >= 2) { const h16x8 p1 = *(const h16x8*)(prow - PP + C_U + c0), p2 = *(const h16x8*)(prow - 2 * PP + C_U + c0);
#pragma unroll
                  for (int j = 0; j < 8; ++j) { u1[j] = (float)p1[j]; u2[j] = (float)p2[j]; }
              } else {
#pragma unroll
                  for (int j = 0; j < 8; ++j) { u2[j] = pr ? 0.f : a.in[3][(size_t)sq * 2 * D + c0 + j]; u1[j] = pr ? 0.f : a.in[3][(size_t)sq * 2 * D + D + c0 + j]; } } }
#pragma unroll
            for (int hf = 0; hf < 4; ++hf) {
                h16x8 ov[2], gv[2], uu[2], qq[2], sa[2]; float rk[2];
#pragma unroll
                for (int r = 0; r < 2; ++r) { const int row = row0 + 2 * hf + r; const h16* prow = P16 + (size_t)row * PP;
                    ov[r] = *(const h16x8*)(A16 + (size_t)row * D + c0); gv[r] = *(const h16x8*)(EAG + (size_t)row * 6144 + 2 * D + c0);
                    uu[r] = *(const h16x8*)(prow + C_U + c0); qq[r] = *(const h16x8*)(prow + C_Q + c0); sa[r] = *(const h16x8*)(prow + C_SA + c0);
                    rk[r] = RK[(size_t)row * 32 + hd]; }
#pragma unroll
                for (int r = 0; r < 2; ++r) { const int row = row0 + 2 * hf + r, tt = tt0 + 2 * hf + r;
                    float of[8], s1 = 0.f;
#pragma unroll
                    for (int j = 0; j < 8; ++j) { of[j] = (float)ov[r][j]; s1 += of[j]; }
                    const float mean = row_allreduce8(s1) * (1.f / 64.f); float s2 = 0.f;
#pragma unroll
                    for (int j = 0; j < 8; ++j) { of[j] -= mean; s2 += of[j] * of[j]; }
                    const float rstd = rsqrtf(row_allreduce8(s2) * (1.f / 64.f) + 64e-5f);
                    float mg[8], u0[8];
#pragma unroll
                    for (int j = 0; j < 8; ++j) {
                        const float vs = (float)vt[j][2 * hf + r];
                        const float ya = (of[j] * rstd * lg[j] + lb[j] + rk[r] * vs) * (float)gv[r][j];
                        u0[j] = (float)uu[r][j];
                        const float cv = w0[j] * u2[j] + w1[j] * u1[j] + w2[j] * u0[j];
                        mg[j] = (float)sa[r][j] * ya + (float)qq[r][j] * cv; u2[j] = u1[j]; u1[j] = u0[j]; }
                    *(u32x4*)(A16 + (size_t)row * D + c0) = (u32x4){pk2h(mg[0], mg[1]), pk2h(mg[2], mg[3]), pk2h(mg[4], mg[5]), pk2h(mg[6], mg[7])};
                    if (tt >= T - 2) { float* q = a.out + (pr ? O_CVP : O_CVS) + (size_t)sq * 2 * D + (size_t)(tt - (T - 2)) * D + c0;
                        *(f32x4*)q = (f32x4){u0[0], u0[1], u0[2], u0[3]}; *(f32x4*)(q + 4) = (f32x4){u0[4], u0[5], u0[6], u0[7]}; }
                }
            }
        }
    }
    SEAM(PH_MERGE);
    if (IN(PH_WOUT)) {
        { pg8::Gemm g{A16, WOUT, MT, D, D}; pg8::Order S; S.init(MT, D, D, G, bx, 0, MP / 256); pg8::EpiRes<true, true> E{XH, XH, SLAB, 1.0f, 0}; pg8::gemm_phase(lds, g, S, E); }
    }
    SEAM(PH_WOUT);
    if (IN(PH_RMS2)) { for (int m = gw; m < MT; m += NGW) { if (m < MP) rms_row_h(XH + (size_t)m * D, a.in[24], A16 + (size_t)m * D, nullptr, lane);
            else rms_row_f16(Y + (size_t)m * D, a.in[24], A16 + (size_t)m * D, nullptr, lane, SLAB + (size_t)(m - MP) * D, 1.0f, Y + (size_t)m * D); } }
    SEAM(PH_RMS2);
    if (IN(PH_FFN2_GU)) { pg8::Gemm g{A16, W2GU, MT, 2 * FF, D}; pg8::Order S; S.init(MT, 2 * FF, D, G, bx, 0, -1); pg8::EpiSwiGLU E{HM, FF}; pg8::gemm_phase(lds, g, S, E); }
    SEAM(PH_FFN2_GU);
    if (IN(PH_FFN2_D)) { pg8::Gemm g{HM, W2D, MT, D, FF}; pg8::Order S; S.init(MT, D, FF, G, bx, 0, MP / 256); pg8::EpiRes<true, true> E{XH, A16, SLAB, 0.5f, 0}; pg8::gemm_phase(lds, g, S, E); }
    SEAM(PH_FFN2_D);
    if (IN(PH_FINAL)) { for (int m = gw; m < MT; m += NGW) { if (m < MP) rms_row_h(A16 + (size_t)m * D, a.in[28], nullptr, Y + (size_t)m * D, lane);
            else rms_row_f16(Y + (size_t)m * D, a.in[28], nullptr, Y + (size_t)m * D, lane, SLAB + (size_t)(m - MP) * D, 0.5f, nullptr); } }
    if (PROBE_MASK) {
        pr_t[PH_N] = __builtin_amdgcn_s_memrealtime();
        if (bx == 0 && tid == 0) { unsigned long long tot = 0;
#pragma unroll
            for (int k = 0; k < PH_N; ++k) if ((PROBE_MASK >> k) & 1u) tot += pr_t[k + 1] - pr_t[k];
            const unsigned long long t0 = __builtin_amdgcn_s_memrealtime();
            while (__builtin_amdgcn_s_memrealtime() - t0 < tot) __builtin_amdgcn_s_sleep(8);
        }
    }
#undef IN
#undef SEAM
}

extern "C" void kernel_launch(void* const* d_in, const int* in_sizes, int n_in, void* d_out, int out_size, void* d_ws, size_t ws_size, hipStream_t stream) {
    static int grid = 0;
    if (grid == 0) {
        if (n_in != 29 || (size_t)out_size != O_END || ws_size < WS_END) { fprintf(stderr, "kernel_launch: unexpected shapes (n_in %d out %d ws %zu need %zu)\n", n_in, out_size, ws_size, (size_t)WS_END); grid = -1; return; }
        int dev = 0, cus = 0, per_cu = 0;
        if (hipGetDevice(&dev) != hipSuccess || hipDeviceGetAttribute(&cus, hipDeviceAttributeMultiprocessorCount, dev) != hipSuccess) { grid = -1; return; }
        if (hipFuncSetAttribute((const void*)fwd_kernel, hipFuncAttributeMaxDynamicSharedMemorySize, LDS_BYTES) != hipSuccess) { grid = -1; return; }
        if (hipOccupancyMaxActiveBlocksPerMultiprocessor(&per_cu, (const void*)fwd_kernel, NTHR, LDS_BYTES) != hipSuccess || per_cu < 1) { fprintf(stderr, "kernel_launch: occupancy query failed (%d)\n", per_cu); grid = -1; return; }
        grid = cus;
    }
    if (grid < 0) return;
    if (hipMemsetAsync((char*)d_ws + WS_CTL, 0, XCD_BAR_WORDS * 4, stream) != hipSuccess) return;
    Args a{};
    for (int i = 0; i < 29; ++i) a.in[i] = (const float*)d_in[i];
    a.out = (float*)d_out; a.ws = (unsigned char*)d_ws; a.ph_lo = 0; a.ph_hi = PH_N;
    void* kargs[] = {&a};
    hipError_t e = hipLaunchCooperativeKernel((const void*)fwd_kernel, dim3(grid), dim3(NTHR), kargs, LDS_BYTES, stream);
    if (e != hipSuccess) fprintf(stderr, "kernel_launch: cooperative launch failed: %s (grid %d)\n", hipGetErrorString(e), grid);
}
```

```cpp
#include <hip/hip_runtime.h>
#include <hip/hip_cooperative_groups.h>
#include <cstdio>
namespace cg = cooperative_groups;

#define LAS __attribute__((address_space(3)))
typedef _Float16 h16;
typedef _Float16 h16x2 __attribute__((ext_vector_type(2)));
typedef _Float16 h16x4 __attribute__((ext_vector_type(4)));
typedef _Float16 h16x8 __attribute__((ext_vector_type(8)));
typedef short s16x4 __attribute__((ext_vector_type(4)));
typedef float f32x4 __attribute__((ext_vector_type(4)));
typedef float f32x2 __attribute__((ext_vector_type(2)));
typedef unsigned u32x4 __attribute__((ext_vector_type(4)));
typedef unsigned u32x2 __attribute__((ext_vector_type(2)));

constexpr int D = 2048, FF = 5632, NA = 6592, NIN = 16832;
constexpr int MP = 8192, MS = 2048, MT = MP + MS;
constexpr int MA = MT + 256;
constexpr int PP = 12800;
constexpr int NW = 16896;
constexpr int PFW = 6656;
constexpr int C_U = 6656, C_Q = 8704, C_SA = 10752;
constexpr int LK = 512;
constexpr int NCHUNK = MT / 64;
constexpr size_t O_Y = 0, O_SHP = 20971520, O_CVP = 20975616, O_WKP = 20983808, O_SHS = 21245952, O_CVS = 21311488, O_WKS = 21442560, O_END = 25636864;
constexpr size_t WS_CTL = 0;
constexpr size_t WS_W1GU = 1u << 20;
constexpr size_t WS_W1D = WS_W1GU + (size_t)2 * FF * D * 2;
constexpr size_t WS_WIN = WS_W1D + (size_t)D * FF * 2;
constexpr size_t WS_WOUT = WS_WIN + (size_t)NW * D * 2;
constexpr size_t WS_A16 = WS_WOUT + (size_t)D * D * 2;
constexpr size_t WS_P16 = WS_A16 + (size_t)MA * D * 2;
constexpr size_t WS_W2GU = WS_P16 + (size_t)MT * PP * 2;
constexpr size_t WS_W2D = WS_W2GU + (size_t)2 * FF * D * 2;
constexpr size_t WS_PF = WS_W2D + (size_t)D * FF * 2;
constexpr size_t WS_END = WS_PF + (size_t)256 * PFW * 2;
constexpr size_t WS_EAG = WS_W1GU;
constexpr size_t WS_HM = WS_P16;
constexpr size_t WS_SLAB = WS_HM + (size_t)MT * FF * 2;
static_assert((size_t)MT * 6144 * 2 <= WS_WOUT - WS_W1GU, "EAG overlay");
static_assert(WS_SLAB + (size_t)4 * MS * D * 4 <= WS_W2GU, "HM + slab overlay of P16");
constexpr size_t OB_WL = O_WKS * 4;
constexpr size_t OB_SIDE = OB_WL + (size_t)6144 * LK * 2;
static_assert(OB_SIDE + (size_t)(MT / 16) * 6144 * 2 <= O_END * 4, "d_out scratch");

constexpr size_t WS_RK = WS_EAG + (size_t)MT * 6144 * 2;
constexpr size_t WS_LM = WS_RK + (size_t)MT * 32 * 4;
static_assert(WS_LM + (size_t)(MT / 16) * 32 * 128 * 4 <= WS_WOUT, "RK + LM");
constexpr int SC_SLOT = 6 * 64, SC_BUF = 16 * SC_SLOT;
constexpr int NWAVES = 8, NTHR = 512;
constexpr int LDS_BYTES = 147456;

__device__ __forceinline__ unsigned pk2h(float a, float b) { h16x2 v = {(h16)a, (h16)b}; return __builtin_bit_cast(unsigned, v); }
__device__ __forceinline__ float wave_sum(float v) {
#pragma unroll
    for (int o = 1; o < 64; o <<= 1) v += __shfl_xor(v, o);
    return v;
}
template <int CTRL> __device__ __forceinline__ float dpp_f(float x) { return __builtin_bit_cast(float, __builtin_amdgcn_update_dpp(0, __builtin_bit_cast(int, x), CTRL, 0xF, 0xF, false)); }
__device__ __forceinline__ float row_allreduce8(float x) { x += dpp_f<0xB1>(x); x += dpp_f<0x4E>(x); x += dpp_f<0x141>(x); return x; }
__device__ __forceinline__ float row_allreduce16(float x) { x = row_allreduce8(x); x += dpp_f<0x140>(x); return x; }
__device__ __forceinline__ float rl_f(float x, int l) { return __builtin_bit_cast(float, __builtin_amdgcn_readlane(__builtin_bit_cast(int, x), l)); }
__device__ __forceinline__ float wave_sum_dpp(float x) { x = row_allreduce16(x); return (rl_f(x, 0) + rl_f(x, 16)) + (rl_f(x, 32) + rl_f(x, 48)); }
__device__ __forceinline__ float wave_sum_bc(float x) {
    x = row_allreduce16(x);
    x += __builtin_bit_cast(float, __builtin_amdgcn_update_dpp(0, __builtin_bit_cast(int, x), 0x142, 0xA, 0xF, false));
    x += __builtin_bit_cast(float, __builtin_amdgcn_update_dpp(0, __builtin_bit_cast(int, x), 0x143, 0xC, 0xF, false));
    return rl_f(x, 63); }
__device__ __forceinline__ float sigmoidf_(float x) { return __builtin_amdgcn_rcpf(1.0f + __expf(-x)); }
__device__ __forceinline__ float tanhf_(float x) { return 1.0f - 2.0f * __builtin_amdgcn_rcpf(1.0f + __expf(2.0f * x)); }

namespace pg8 {
constexpr int BM = 256, BK = 64, HALF = 128, HTB = HALF * BK * 2, STAGE_BYTES = 8 * HTB, NXCD = 8, WGM = 8;
__host__ __device__ __forceinline__ int lds_byte(int r, int c) { const int st = (r >> 4) * 2 + (c >> 5), rr = r & 15, cc = c & 31, ob = rr * 64 + cc * 2; return st * 1024 + (ob ^ (((ob >> 9) & 1) << 5)); }
__host__ __device__ __forceinline__ void stage_rc(int b, int& R, int& C) { const int st = b / 1024, sb = b % 1024, swz = sb ^ (((sb >> 9) & 1) << 5); R = (st >> 1) * 16 + swz / 64; C = (st & 1) * 32 + (swz % 64) / 2; }
__host__ __device__ __forceinline__ int perm32(int rho) { const int n = rho >> 4, i = rho & 15; return 8 * (i >> 2) + 4 * n + (i & 3); }
struct Unit { int pm, pn, kt0, nkt, sp; };
struct Gemm { const h16* A; const h16* Bt; int M, N, K; };
struct Order {
    int nM, nN, nwg, G, c, extra, nkt, nsplit;
    __device__ void init(int M, int N, int K, int G_, int c_, int extra_, int nMw) { nM = M / BM; nN = N / BM; nwg = (nMw < 0 ? nM : nMw) * nN; G = G_; c = c_; extra = extra_; nkt = K / BK; nsplit = nMw < 0 ? 0 : (nM - nMw) * nN * 4; }
    __device__ bool next(int i, Unit& u) const {
        const long L = (long)i * G + c; if (L >= nwg + extra + nsplit) return false;
        u.kt0 = 0; u.nkt = nkt; u.sp = -1;
        if (L >= nwg + extra) { const int j = (int)(L - nwg - extra), rows = nM - nwg / nN; u.nkt = nkt >> 2;
            if (rows == 8 && nN == 8) {
                const int xcd = j & 7, idx = j >> 3; u.sp = xcd >> 1; u.pn = 4 * (xcd & 1) + (idx >> 3); u.pm = nwg / nN + (idx & 7); }
            else { const int tile = j >> 2; u.sp = j & 3; u.pm = nwg / nN + tile % rows; u.pn = tile / rows; }
            u.kt0 = u.sp * u.nkt; return true; }
        if (L >= nwg) { u.pm = nM; u.pn = (int)(L - nwg); return true; }
        const int nMe = nwg / nN;
        int wgid = (int)L; { const int q = nwg / NXCD, r = nwg % NXCD, xcd = wgid % NXCD, off = wgid / NXCD; wgid = (xcd < r ? xcd * (q + 1) : r * (q + 1) + (xcd - r) * q) + off; }
        const int nig = WGM * nN, gid = wgid / nig, fm = gid * WGM, gsz = (nMe - fm) < WGM ? (nMe - fm) : WGM;
        u.pm = fm + ((wgid % nig) % gsz); u.pn = (wgid % nig) / gsz; return true;
    }
};

__device__ __forceinline__ void lora_k(Unit& u) { const int typ = u.pn >> 3; u.kt0 = typ == 0 ? 0 : typ == 1 ? 1 : 3; u.nkt = typ == 2 ? 4 : 2; }
template <class Epi, bool LORAK = false, bool SP2 = true, bool ALIGN_EPI = true>
__device__ __forceinline__ void gemm_phase(LAS unsigned char* lds, const Gemm g, const Order& S, const Epi& E) {
    const int tid = threadIdx.x, wid = __builtin_amdgcn_readfirstlane(tid >> 6), lane = tid & 63, wr = wid >> 2, wc = wid & 3, fr = lane & 15, fq = lane >> 4;
    const int K = g.K;
    unsigned voffA[2], voffB[2];
#pragma unroll
    for (int i = 0; i < 2; ++i) { int R, C; stage_rc(tid * 16 + i * 8192, R, C); const int Rb = Epi::PERM ? ((R & ~31) + perm32(R & 31)) : R;
        voffA[i] = (unsigned)(R * K + C) * 2u; voffB[i] = (unsigned)(Rb * K + C) * 2u; }
    const size_t kstep = (size_t)(BK * 2);
    const size_t hstep = (size_t)HALF * K * 2;
    const size_t tstep = 2 * hstep;
    const unsigned ldsw = (unsigned)wid * 1024u;
    const int aoff = lds_byte(wr * 64 + fr, fq * 8), boff = lds_byte(wc * 32 + fr, fq * 8);
#define PG8_SA(b, h) (((b) * 2 + (h)) * HTB)
#define PG8_SB(b, h) ((4 + (b) * 2 + (h)) * HTB)
#define PG8_STAGE(bufoff, gbase, voff) do { _Pragma("unroll") for (int _i = 0; _i < 2; ++_i) \
        __builtin_amdgcn_global_load_lds((const unsigned*)((const char*)(gbase) + (voff)[_i]), (LAS unsigned*)(lds + (bufoff) + ldsw + _i * 8192), 16, 0, 0); } while (0)
#define PG8_LDA(dst, b, h) do { _Pragma("unroll") for (int m = 0; m < 4; ++m) _Pragma("unroll") for (int k = 0; k < 2; ++k) dst[m][k] = *(const LAS h16x8*)(lds + PG8_SA(b, h) + aoff + m * 2048 + k * 1024); } while (0)
#define PG8_LDB(dst, b, h) do { _Pragma("unroll") for (int n = 0; n < 2; ++n) _Pragma("unroll") for (int k = 0; k < 2; ++k) dst[n][k] = *(const LAS h16x8*)(lds + PG8_SB(b, h) + boff + n * 2048 + k * 1024); } while (0)
#define PG8_MMA(ai, bj, At, Bt) do { __builtin_amdgcn_s_setprio(1); _Pragma("unroll") for (int m = 0; m < 4; ++m) _Pragma("unroll") for (int n = 0; n < 2; ++n) _Pragma("unroll") for (int k = 0; k < 2; ++k) \
        acc[ai][bj][m][n] = __builtin_amdgcn_mfma_f32_16x16x32_f16(Bt[n][k], At[m][k], acc[ai][bj][m][n], 0, 0, 0); __builtin_amdgcn_s_setprio(0); } while (0)
#define PG8_WAIT_V(n) asm volatile("s_waitcnt vmcnt(" #n ")" ::: "memory")
#define PG8_WAIT_L(n) asm volatile("s_waitcnt lgkmcnt(" #n ")" ::: "memory")
#define PG8_BAR __builtin_amdgcn_s_barrier()
#define PG8_SCHED __builtin_amdgcn_sched_barrier(0)
    Unit cur, nxt; int ui = 0;
    if (!S.next(0, cur)) return;
    if constexpr (LORAK) lora_k(cur);
    f32x4 acc[2][2][4][2];
#pragma unroll
    for (int a = 0; a < 2; ++a)
#pragma unroll
        for (int b = 0; b < 2; ++b)
#pragma unroll
            for (int m = 0; m < 4; ++m)
#pragma unroll
                for (int n = 0; n < 2; ++n) acc[a][b][m][n] = (f32x4){0.f, 0.f, 0.f, 0.f};
    h16x8 At[4][2], B0[2][2], B1[2][2];
    const char* cA = (const char*)g.A + (size_t)cur.pm * tstep + (size_t)cur.kt0 * kstep; const char* cB = (const char*)g.Bt + (size_t)cur.pn * tstep + (size_t)cur.kt0 * kstep;
    if constexpr (SP2) {
        PG8_STAGE(PG8_SB(0, 0), cB, voffB); PG8_STAGE(PG8_SB(0, 1), cB + hstep, voffB); PG8_STAGE(PG8_SA(0, 0), cA, voffA); PG8_STAGE(PG8_SA(0, 1), cA + hstep, voffA);
        if (wr == 1) PG8_BAR;
        PG8_WAIT_V(2); PG8_BAR;
        PG8_STAGE(PG8_SB(1, 0), cB + kstep, voffB); PG8_STAGE(PG8_SA(1, 0), cA + kstep, voffA); PG8_STAGE(PG8_SB(1, 1), cB + hstep + kstep, voffB);
        PG8_WAIT_V(6); PG8_BAR;
    } else {
        PG8_STAGE(PG8_SB(0, 0), cB, voffB); PG8_STAGE(PG8_SA(0, 0), cA, voffA); PG8_STAGE(PG8_SB(0, 1), cB + hstep, voffB); PG8_STAGE(PG8_SA(0, 1), cA + hstep, voffA);
        if (wr == 1) PG8_BAR;
        PG8_WAIT_V(4); PG8_BAR;
        PG8_STAGE(PG8_SB(1, 0), cB + kstep, voffB); PG8_STAGE(PG8_SA(1, 0), cA + kstep, voffA); PG8_STAGE(PG8_SB(1, 1), cB + hstep + kstep, voffB);
        PG8_WAIT_V(6); PG8_BAR;
    }
    for (;;) {
        const bool has_next = S.next(ui + 1, nxt);
        if constexpr (LORAK) { if (has_next) lora_k(nxt); }
        const char* nA = has_next ? (const char*)g.A + (size_t)nxt.pm * tstep + (size_t)nxt.kt0 * kstep : cA; const char* nB = has_next ? (const char*)g.Bt + (size_t)nxt.pn * tstep + (size_t)nxt.kt0 * kstep : cB;
        const int nt = cur.nkt;
        for (int t = 0; t < nt; t += 2) {
            const bool last = (t == nt - 2);
            const char* a1 = cA + (size_t)(t + 1) * kstep;
            const char* a2 = last ? nA : cA + (size_t)(t + 2) * kstep; const char* b2 = last ? nB : cB + (size_t)(t + 2) * kstep;
            const char* a3 = a2 + kstep; const char* b3 = b2 + kstep;
            if constexpr (SP2) {
            PG8_LDB(B0, 0, 0); PG8_LDB(B1, 0, 1); PG8_SCHED; PG8_LDA(At, 0, 0); PG8_STAGE(PG8_SA(1, 1), a1 + hstep, voffA);
            PG8_WAIT_V(8); PG8_WAIT_L(0); PG8_BAR; PG8_MMA(0, 0, At, B0); PG8_MMA(0, 1, At, B1); PG8_BAR; PG8_SCHED;
            PG8_LDA(At, 0, 1); PG8_STAGE(PG8_SB(0, 0), b2, voffB); PG8_STAGE(PG8_SB(0, 1), b2 + hstep, voffB); PG8_STAGE(PG8_SA(0, 0), a2, voffA);
            PG8_WAIT_V(8); PG8_WAIT_L(0); PG8_BAR; PG8_MMA(1, 0, At, B0); PG8_MMA(1, 1, At, B1); PG8_BAR; PG8_SCHED;
            PG8_LDB(B0, 1, 0); PG8_LDB(B1, 1, 1); PG8_SCHED; PG8_LDA(At, 1, 0); PG8_STAGE(PG8_SA(0, 1), a2 + hstep, voffA);
            PG8_WAIT_V(8); PG8_WAIT_L(0); PG8_BAR; PG8_MMA(0, 0, At, B0); PG8_MMA(0, 1, At, B1); PG8_BAR; PG8_SCHED;
            PG8_LDA(At, 1, 1); PG8_STAGE(PG8_SB(1, 0), b3, voffB); PG8_STAGE(PG8_SB(1, 1), b3 + hstep, voffB); PG8_STAGE(PG8_SA(1, 0), a3, voffA);
            PG8_WAIT_V(8); PG8_WAIT_L(0); PG8_BAR; PG8_MMA(1, 0, At, B0); PG8_MMA(1, 1, At, B1); PG8_BAR; PG8_SCHED;
            } else {
            PG8_LDB(B0, 0, 0); PG8_SCHED; PG8_LDA(At, 0, 0); PG8_STAGE(PG8_SA(1, 1), a1 + hstep, voffA);
            PG8_WAIT_L(8); PG8_BAR; PG8_WAIT_L(0); PG8_MMA(0, 0, At, B0); PG8_BAR; PG8_SCHED;
            PG8_LDB(B1, 0, 1); PG8_STAGE(PG8_SB(0, 0), b2, voffB);
            PG8_BAR; PG8_WAIT_L(0); PG8_MMA(0, 1, At, B1); PG8_BAR;
            PG8_LDA(At, 0, 1); PG8_STAGE(PG8_SA(0, 0), a2, voffA);
            PG8_BAR; PG8_WAIT_L(0); PG8_MMA(1, 0, At, B0); PG8_BAR; PG8_SCHED;
            PG8_STAGE(PG8_SB(0, 1), b2 + hstep, voffB);
            PG8_WAIT_V(6); PG8_BAR; PG8_MMA(1, 1, At, B1); PG8_BAR;
            PG8_LDB(B0, 1, 0); PG8_SCHED; PG8_LDA(At, 1, 0); PG8_STAGE(PG8_SA(0, 1), a2 + hstep, voffA);
            PG8_WAIT_L(8); PG8_BAR; PG8_WAIT_L(0); PG8_MMA(0, 0, At, B0); PG8_BAR; PG8_SCHED;
            PG8_LDB(B1, 1, 1); PG8_STAGE(PG8_SB(1, 0), b3, voffB);
            PG8_BAR; PG8_WAIT_L(0); PG8_MMA(0, 1, At, B1); PG8_BAR;
            PG8_LDA(At, 1, 1); PG8_STAGE(PG8_SA(1, 0), a3, voffA);
            PG8_BAR; PG8_WAIT_L(0); PG8_MMA(1, 0, At, B0); PG8_BAR; PG8_SCHED;
            PG8_STAGE(PG8_SB(1, 1), b3 + hstep, voffB);
            PG8_WAIT_V(6); PG8_BAR; PG8_MMA(1, 1, At, B1); PG8_BAR;
                    }
        }
        if constexpr (ALIGN_EPI) { if (wr == 0) PG8_BAR; }
        E(acc, cur, wr, wc, fr, fq);
        if (!has_next) break;
#pragma unroll
        for (int a = 0; a < 2; ++a)
#pragma unroll
            for (int b = 0; b < 2; ++b)
#pragma unroll
                for (int m = 0; m < 4; ++m)
#pragma unroll
                    for (int n = 0; n < 2; ++n) acc[a][b][m][n] = (f32x4){0.f, 0.f, 0.f, 0.f};
        cur = nxt; cA = nA; cB = nB; ++ui;
        if constexpr (ALIGN_EPI) { if (wr == 1) PG8_BAR; }
    }
    PG8_WAIT_V(0);
    if constexpr (!ALIGN_EPI) { if (wr == 0) PG8_BAR; }
    PG8_BAR;
#undef PG8_SA
#undef PG8_SB
#undef PG8_STAGE
#undef PG8_LDA
#undef PG8_LDB
#undef PG8_MMA
#undef PG8_WAIT_V
#undef PG8_WAIT_L
#undef PG8_BAR
#undef PG8_SCHED
}

struct EpiSwiGLU {
    static constexpr bool PERM = false;
    h16* O; int ldo;
    __device__ __forceinline__ void operator()(const f32x4 (&acc)[2][2][4][2], const Unit& u, int wr, int wc, int fr, int fq) const {
        const int row0 = u.pm * BM + wr * 64 + fr;
#pragma unroll
        for (int ai = 0; ai < 2; ++ai)
#pragma unroll
            for (int m = 0; m < 4; ++m) { h16* rowp = O + (size_t)(row0 + ai * HALF + m * 16) * ldo;
#pragma unroll
                for (int bj = 0; bj < 2; ++bj) { const int oc = (u.pn * BM + bj * HALF + wc * 32) / 2 + 4 * fq;
                    const f32x4 gt = acc[ai][bj][m][0], up = acc[ai][bj][m][1]; float o[4];
#pragma unroll
                    for (int j = 0; j < 4; ++j) o[j] = gt[j] * sigmoidf_(gt[j]) * up[j];
                    u32x2 w; w.x = pk2h(o[0], o[1]); w.y = pk2h(o[2], o[3]);
                    *(u32x2*)(rowp + oc) = w; } }
    }
};
template <bool RES16, bool OUT16> struct EpiRes {
    static constexpr bool PERM = false;
    const void* res; void* out; float* slab; float scale; int pad;
    __device__ __forceinline__ void operator()(const f32x4 (&acc)[2][2][4][2], const Unit& u, int wr, int wc, int fr, int fq) const {
        const int row0 = u.pm * BM + wr * 64 + fr, col0 = u.pn * BM + wc * 32 + 4 * fq;
        if (u.sp >= 0) {
            float* sb = slab + ((size_t)u.sp * MS - MP) * D;
#pragma unroll
            for (int ai = 0; ai < 2; ++ai)
#pragma unroll
                for (int m = 0; m < 4; ++m) { const size_t off = (size_t)(row0 + ai * HALF + m * 16) * D + col0;
#pragma unroll
                    for (int bj = 0; bj < 2; ++bj)
#pragma unroll
                        for (int n = 0; n < 2; ++n) *(f32x4*)(sb + off + bj * HALF + n * 16) = acc[ai][bj][m][n]; }
            return;
        }
#pragma unroll
        for (int ai = 0; ai < 2; ++ai)
#pragma unroll
            for (int m = 0; m < 4; ++m) { const size_t off = (size_t)(row0 + ai * HALF + m * 16) * D + col0;
#pragma unroll
                for (int bj = 0; bj < 2; ++bj)
#pragma unroll
                    for (int n = 0; n < 2; ++n) { f32x4 rv; const size_t o_ = off + bj * HALF + n * 16;
                        if constexpr (RES16) { const h16x4 hv = *(const h16x4*)((const h16*)res + o_); rv = (f32x4){(float)hv[0], (float)hv[1], (float)hv[2], (float)hv[3]}; }
                        else rv = *(const f32x4*)((const float*)res + o_);
                        const f32x4 o = rv + scale * acc[ai][bj][m][n];
                        if constexpr (OUT16) { u32x2 w; w.x = pk2h(o[0], o[1]); w.y = pk2h(o[2], o[3]); *(u32x2*)((h16*)out + o_) = w; }
                        else *(f32x4*)((float*)out + o_) = o; } }
    }
};
struct EpiP16 {
    static constexpr bool PERM = true;
    h16* P; h16* PF;
    __device__ __forceinline__ void operator()(const f32x4 (&acc)[2][2][4][2], const Unit& u, int wr, int wc, int fr, int fq) const {
        const int row0 = u.pm * BM + wr * 64 + fr; const int kind = u.pn < 26 ? 0 : u.pn < 42 ? 1 : u.pn < 58 ? 2 : 3;
#pragma unroll
        for (int ai = 0; ai < 2; ++ai)
#pragma unroll
            for (int m = 0; m < 4; ++m) { const int row = row0 + ai * HALF + m * 16;
#pragma unroll
                for (int bj = 0; bj < 2; ++bj) { const int gcol = u.pn * BM + bj * HALF + wc * 32;
                    const f32x4 v0 = acc[ai][bj][m][0], v1 = acc[ai][bj][m][1];
                    if (kind == 0) { u32x4 w; w.x = pk2h(v0[0], v0[1]); w.y = pk2h(v0[2], v0[3]); w.z = pk2h(v1[0], v1[1]); w.w = pk2h(v1[2], v1[3]);
                        if (u.pm < MT / BM) *(u32x4*)(P + (size_t)row * PP + gcol + 8 * fq) = w;
                        else *(u32x4*)(PF + (size_t)(row - MT) * PFW + gcol + 8 * fq) = w; }
                    else if (kind == 3) { u32x4 w; w.x = pk2h(sigmoidf_(v0[0]), sigmoidf_(v0[1])); w.y = pk2h(sigmoidf_(v0[2]), sigmoidf_(v0[3])); w.z = pk2h(sigmoidf_(v1[0]), sigmoidf_(v1[1])); w.w = pk2h(sigmoidf_(v1[2]), sigmoidf_(v1[3]));
                        *(u32x4*)(P + (size_t)row * PP + C_SA + (gcol - (PFW + 8192)) + 8 * fq) = w; }
                    else { float o[4];
#pragma unroll
                        for (int j = 0; j < 4; ++j) o[j] = kind == 1 ? v0[j] * v1[j] : sigmoidf_(v1[j]) * v0[j];
                        u32x2 w; w.x = pk2h(o[0], o[1]); w.y = pk2h(o[2], o[3]);
                        *(u32x2*)(P + (size_t)row * PP + (kind == 1 ? C_U + ((gcol - PFW) >> 1) : C_Q + ((gcol - PFW - 4096) >> 1)) + 4 * fq) = w; } } }
    }
};
struct EpiEAG {
    static constexpr bool PERM = true;
    h16* O; const float* w0; const float* a0;
    __device__ __forceinline__ void operator()(const f32x4 (&acc)[2][2][4][2], const Unit& u, int wr, int wc, int fr, int fq) const {
        const int row0 = u.pm * BM + wr * 64 + fr; const int typ = u.pn >> 3;
#pragma unroll
        for (int bj = 0; bj < 2; ++bj) { const int col = u.pn * BM + bj * HALF + wc * 32 + 8 * fq;
            f32x4 b0 = (f32x4){0.f, 0.f, 0.f, 0.f}, b1 = b0;
            if (typ == 0) { b0 = *(const f32x4*)(w0 + col); b1 = *(const f32x4*)(w0 + col + 4); }
            if (typ == 1) { b0 = *(const f32x4*)(a0 + col - D); b1 = *(const f32x4*)(a0 + col - D + 4); }
#pragma unroll
            for (int ai = 0; ai < 2; ++ai)
#pragma unroll
                for (int m = 0; m < 4; ++m) { const int row = row0 + ai * HALF + m * 16;
                    f32x4 v0 = acc[ai][bj][m][0] + b0, v1 = acc[ai][bj][m][1] + b1;
                    if (typ < 2) { const float sc = typ == 0 ? 0.60653065971f : 1.0f;
#pragma unroll
                        for (int j = 0; j < 4; ++j) { v0[j] = sigmoidf_(v0[j]) * sc; v1[j] = sigmoidf_(v1[j]) * sc; } }
                    u32x4 w; w.x = pk2h(v0[0], v0[1]); w.y = pk2h(v0[2], v0[3]); w.z = pk2h(v1[0], v1[1]); w.w = pk2h(v1[2], v1[3]);
                    *(u32x4*)(O + (size_t)row * 6144 + col) = w; } }
    }
};
}


#define XB_TMO      128
#define XB_XCNT(j)  (256  + 64 * (j))
#define XB_XSUB(j)  (1280 + 64 * (j))
#define XB_XGEN(j)  (2304 + 64 * (j))
#define XB_TOP      3328
#define XB_TOPGEN   3392
#define XCD_BAR_WORDS 3456
#define XB_SPIN_CAP (1u << 22)
__device__ __forceinline__ unsigned xb_ld(unsigned* p)              { return __hip_atomic_load(p, __ATOMIC_RELAXED, __HIP_MEMORY_SCOPE_AGENT); }
__device__ __forceinline__ unsigned xb_add(unsigned* p, unsigned v) { return __hip_atomic_fetch_add(p, v, __ATOMIC_RELAXED, __HIP_MEMORY_SCOPE_AGENT); }
__device__ __forceinline__ unsigned xb_xcc_id() { return (unsigned)__builtin_amdgcn_s_getreg((3 << 11) | 20) & 0xFu; }
#define XB_SPIN(cond, bar) do { unsigned _sp = 0; while (cond) { __builtin_amdgcn_s_sleep(1); \
    if ((++_sp & 255u) == 0u) { if (xb_ld(&(bar)[XB_TMO])) break; if (_sp > XB_SPIN_CAP) { atomicAdd(&(bar)[XB_TMO], 1u); break; } } } } while (0)
struct XcdBarrier { unsigned* bar; unsigned x; volatile LAS unsigned* st; };
__device__ __forceinline__ XcdBarrier xcd_barrier_post(unsigned* bar, volatile LAS unsigned* st) {
    XcdBarrier b; b.bar = bar; b.x = xb_xcc_id(); b.st = st;
    if (threadIdx.x == 0) (void)xb_add(&bar[XB_XCNT(b.x)], 1u);
    return b;
}
__device__ __forceinline__ void xcd_barrier_complete(unsigned* bar, unsigned x, unsigned& nloc, unsigned& nx) {
    const unsigned G = gridDim.x * gridDim.y * gridDim.z;
    unsigned sum, cnt, mine, sp = 0u;
    for (;;) {
        sum = 0u; cnt = 0u; mine = 0u;
#pragma unroll
        for (unsigned j = 0; j < 16; ++j) { const unsigned c = xb_ld(&bar[XB_XCNT(j)]); sum += c; cnt += (c > 0u) ? 1u : 0u; mine = (j == x) ? c : mine; }
        if (sum == G) break;
        __builtin_amdgcn_s_sleep(1);
        if ((++sp & 255u) == 0u) { if (xb_ld(&bar[XB_TMO])) break; if (sp > XB_SPIN_CAP) { atomicAdd(&bar[XB_TMO], 1u); break; } }
    }
    nloc = mine > 0u ? mine : 1u; nx = cnt > 0u ? cnt : 1u;
}
__device__ __forceinline__ void xcd_barrier(const XcdBarrier& b) {
    asm volatile("s_waitcnt vmcnt(0)" ::: "memory");
    __syncthreads();
    if (threadIdx.x == 0) {
        unsigned* bar = b.bar;
        __builtin_amdgcn_s_waitcnt(0);
        unsigned nloc = b.st[0], nx = b.st[1];
        if (nloc == 0u) { xcd_barrier_complete(bar, b.x, nloc, nx); b.st[0] = nloc; b.st[1] = nx; }
        const unsigned old = xb_add(&bar[XB_XSUB(b.x)], 1u);
        const unsigned gen = old / nloc;
        if (old + 1u == (gen + 1u) * nloc) {
            __builtin_amdgcn_fence(__ATOMIC_RELEASE, "agent");
            asm volatile("s_waitcnt vmcnt(0)" ::: "memory");
            const unsigned og = xb_add(&bar[XB_TOP], 1u);
            const unsigned tg = og / nx;
            if (og + 1u == (tg + 1u) * nx) xb_add(&bar[XB_TOPGEN], 1u);
            else XB_SPIN(xb_ld(&bar[XB_TOPGEN]) == tg, bar);
            __builtin_amdgcn_fence(__ATOMIC_ACQUIRE, "agent");
            xb_add(&bar[XB_XGEN(b.x)], 1u);
            asm volatile("s_waitcnt vmcnt(0)" ::: "memory");
        } else {
            XB_SPIN(xb_ld(&bar[XB_XGEN(b.x)]) == gen, bar);
            __builtin_amdgcn_fence(__ATOMIC_ACQUIRE, "agent");
            asm volatile("s_waitcnt vmcnt(0)" ::: "memory");
        }
    }
    __syncthreads();
}

struct Args { const float* in[29]; float* out; unsigned char* ws; int ph_lo, ph_hi; };

__device__ __forceinline__ void cvt_item(int mode, const float* s0, const float* s1, int Nsrc, int K, h16* WT, LAS float* scr, int item, int nblk, int lane) {
    const int kb = item / nblk, nb = item % nblk, k0 = 64 * kb, n0 = 32 * nb;
    const int nn = lane & 31; const float* src = s0; int col = n0 + nn; bool zero = false;
    if (mode == 1) { src = (nn < 16) ? s0 : s1; col = (n0 >> 1) + (nn & 15); }
    if (mode == 2) { if (n0 >= NA && n0 < PFW) zero = true; else if (n0 >= PFW) col -= 64; }
#pragma unroll 8
    for (int i = 0; i < 32; ++i) { const int kk = 2 * i + (lane >> 5); scr[kk * 33 + nn] = zero ? 0.f : src[(size_t)(k0 + kk) * Nsrc + col]; }
    asm volatile("s_waitcnt lgkmcnt(0)" ::: "memory");
    const int c = lane & 7;
#pragma unroll
    for (int j = 0; j < 4; ++j) { const int n = (lane >> 3) + 8 * j; const LAS float* s = scr + (8 * c) * 33 + n;
        u32x4 o; o.x = pk2h(s[0 * 33], s[1 * 33]); o.y = pk2h(s[2 * 33], s[3 * 33]); o.z = pk2h(s[4 * 33], s[5 * 33]); o.w = pk2h(s[6 * 33], s[7 * 33]);
        *(u32x4*)(WT + (size_t)(n0 + n) * K + k0 + 8 * c) = o; }
    asm volatile("s_waitcnt lgkmcnt(0)" ::: "memory");
}
struct CvtIt { const float* p; h16* q; int Nsrc, K; bool zero; };
__device__ __forceinline__ CvtIt cvt_decode(int mode, const float* s0, const float* s1, int Nsrc, int K, h16* WT, int nblk, int item, int lane) {
    const int kb = item / nblk, nb = item % nblk, k0 = 64 * kb, n0 = 32 * nb, nn = lane & 31;
    const float* src = s0; int col = n0 + nn; bool zero = false;
    if (mode == 1) { src = (nn < 16) ? s0 : s1; col = (n0 >> 1) + (nn & 15); }
    if (mode == 2) {
        const int q = nn >> 3, sp = (nn >> 2) & 1, j = nn & 3;
        if (n0 >= NA && n0 < PFW) { zero = true; col = 0; }
        else if (n0 >= PFW && n0 < PFW + 4096) col = (sp ? NA + 2 * D : NA + D) + ((n0 - PFW) >> 1) + 4 * q + j;
        else if (n0 >= PFW + 4096 && n0 < PFW + 8192) col = (sp ? NA + 4 * D : NA) + ((n0 - PFW - 4096) >> 1) + 4 * q + j;
        else if (n0 >= PFW + 8192) col = NA + 3 * D + (n0 - PFW - 8192) + nn; }
    CvtIt r; r.p = src + (size_t)(k0 + (lane >> 5)) * Nsrc + col; r.q = WT + (size_t)(n0 + (lane >> 3)) * K + k0 + 8 * (lane & 7); r.Nsrc = Nsrc; r.K = K; r.zero = zero; return r;
}
__device__ __forceinline__ void cvt_load(const CvtIt& t, float (&v)[32]) {
#pragma unroll
    for (int i = 0; i < 32; ++i) v[i] = t.p[(size_t)(2 * i) * t.Nsrc];
}
__device__ __forceinline__ void cvt_finish(const CvtIt& t, const float (&v)[32], LAS float* scr, int lane) {
    const int nn = lane & 31;
#pragma unroll
    for (int i = 0; i < 32; ++i) scr[(2 * i + (lane >> 5)) * 33 + nn] = t.zero ? 0.f : v[i];
    asm volatile("s_waitcnt lgkmcnt(0)" ::: "memory");
    const int c = lane & 7;
#pragma unroll
    for (int j = 0; j < 4; ++j) { const int n = (lane >> 3) + 8 * j; const LAS float* s = scr + (8 * c) * 33 + n;
        u32x4 o; o.x = pk2h(s[0 * 33], s[1 * 33]); o.y = pk2h(s[2 * 33], s[3 * 33]); o.z = pk2h(s[4 * 33], s[5 * 33]); o.w = pk2h(s[6 * 33], s[7 * 33]);
        *(u32x4*)(t.q + (size_t)(8 * j) * t.K) = o; }
    asm volatile("s_waitcnt lgkmcnt(0)" ::: "memory");
}
#define CVT_RUN(total_, PICK) do { float va[32], vb[32]; CvtIt A_, B_; int it_ = gw; if (it_ < (total_)) { PICK(it_, A_); cvt_load(A_, va); \
        for (;;) { const int itb_ = it_ + NGW; const bool hb_ = itb_ < (total_); if (hb_) { PICK(itb_, B_); cvt_load(B_, vb); } cvt_finish(A_, va, scr, lane); if (!hb_) break; \
            it_ = itb_ + NGW; const bool ha_ = it_ < (total_); if (ha_) { PICK(it_, A_); cvt_load(A_, va); } cvt_finish(B_, vb, scr, lane); if (!ha_) break; } } } while (0)
__device__ __forceinline__ void cvt_lora_item(const float* wl, const float* al, const float* gl, h16* WT, int item, int lane) {
    const int n = item, typ = n >> 11, col = n & 2047; unsigned w[4];
#pragma unroll
    for (int j = 0; j < 4; ++j) { float v[2];
#pragma unroll
        for (int e = 0; e < 2; ++e) { const int k = lane * 8 + j * 2 + e; float x = 0.f;
            if (typ == 0 && k < 96) x = wl[(size_t)k * D + col];
            if (typ == 1 && k >= 96 && k < 192) x = al[(size_t)(k - 96) * D + col];
            if (typ == 2 && k >= 192 && k < 448) x = gl[(size_t)(k - 192) * D + col];
            v[e] = x; }
        w[j] = pk2h(v[0], v[1]); }
    *(u32x4*)(WT + (size_t)n * LK + lane * 8) = (u32x4){w[0], w[1], w[2], w[3]};
}

__device__ __forceinline__ void rms_row_f16(const float* xrow, const float* g, h16* orow, float* f32row, int lane, const float* part = nullptr, float pscale = 0.f, float* xout = nullptr) {
    const f32x4* xr = (const f32x4*)xrow + lane; const f32x4* gr = (const f32x4*)g + lane;
    f32x4 v[8]; float s = 0.f;
#pragma unroll
    for (int j = 0; j < 8; ++j) { v[j] = xr[64 * j];
        if (part) { const f32x4* pp = (const f32x4*)part + lane + 64 * j; const size_t st = (size_t)MS * D / 4;
            v[j] += pscale * ((pp[0] + pp[st]) + (pp[2 * st] + pp[3 * st])); if (xout) *((f32x4*)xout + lane + 64 * j) = v[j]; }
        s += (v[j].x * v[j].x + v[j].y * v[j].y) + (v[j].z * v[j].z + v[j].w * v[j].w); }
    const float rs = rsqrtf(wave_sum(s) * (1.f / D) + 1e-6f);
#pragma unroll
    for (int j = 0; j < 8; ++j) { const f32x4 gg = gr[64 * j]; const f32x4 o = v[j] * rs * gg;
        if (orow) { u32x2 w; w.x = pk2h(o.x, o.y); w.y = pk2h(o.z, o.w); *((u32x2*)orow + lane + 64 * j) = w; }
        if (f32row) *((f32x4*)f32row + lane + 64 * j) = o; }
}

__device__ __forceinline__ void rms_row_h(const h16* xrow, const float* g, h16* orow, float* f32row, int lane) {
    const f32x4* gr = (const f32x4*)g + lane;
    f32x4 v[8]; float s = 0.f;
#pragma unroll
    for (int j = 0; j < 8; ++j) { const h16x4 hv = *((const h16x4*)xrow + lane + 64 * j);
        v[j] = (f32x4){(float)hv[0], (float)hv[1], (float)hv[2], (float)hv[3]};
        s += (v[j].x * v[j].x + v[j].y * v[j].y) + (v[j].z * v[j].z + v[j].w * v[j].w); }
    const float rs = rsqrtf(wave_sum(s) * (1.f / D) + 1e-6f);
#pragma unroll
    for (int j = 0; j < 8; ++j) { const f32x4 gg = gr[64 * j]; const f32x4 o = v[j] * rs * gg;
        if (orow) { u32x2 w; w.x = pk2h(o.x, o.y); w.y = pk2h(o.z, o.w); *((u32x2*)orow + lane + 64 * j) = w; }
        if (f32row) *((f32x4*)f32row + lane + 64 * j) = o; }
}

enum { PH_CVT1 = 0, PH_FFN1_GU, PH_FFN1_D, PH_RMS_MIX, PH_WIN, PH_SHIFT, PH_LORA, PH_PREP, PH_SCAN, PH_MERGE, PH_WOUT, PH_RMS2, PH_FFN2_GU, PH_FFN2_D, PH_FINAL, PH_N };

__global__ void __launch_bounds__(NTHR, 2) fwd_kernel(Args a) {
    extern __shared__ __attribute__((aligned(16))) unsigned char lds_raw[];
    LAS unsigned char* lds = (LAS unsigned char*)lds_raw;
    const int tid = threadIdx.x, lane = tid & 63, wave = __builtin_amdgcn_readfirstlane(tid >> 6);
    const int G = gridDim.x, bx = blockIdx.x;
    const int gw = bx * NWAVES + wave, NGW = G * NWAVES;
    unsigned char* ws = a.ws; unsigned char* ob = (unsigned char*)a.out;
    h16* W1GU = (h16*)(ws + WS_W1GU); h16* W1D = (h16*)(ws + WS_W1D); h16* WIN = (h16*)(ws + WS_WIN); h16* WOUT = (h16*)(ws + WS_WOUT);
    h16* A16 = (h16*)(ws + WS_A16); h16* P16 = (h16*)(ws + WS_P16); h16* EAG = (h16*)(ws + WS_EAG); h16* HM = (h16*)(ws + WS_HM);
    h16* W2GU = (h16*)(ws + WS_W2GU); h16* W2D = (h16*)(ws + WS_W2D);
    h16* WL = (h16*)(ob + OB_WL); h16* PF = (h16*)(ws + WS_PF);
    float* Y = a.out + O_Y; float* SLAB = (float*)(ws + WS_SLAB);
    h16* XH = (h16*)(a.out + O_Y);
    const int lo = a.ph_lo, hi = a.ph_hi;
#define IN(k) (lo <= (k) && (k) < hi)
    cg::grid_group grid = cg::this_grid();
    volatile LAS unsigned* xst = (volatile LAS unsigned*)(lds + LDS_BYTES - 16);
    if (tid < 2) xst[tid] = 0u;
    __syncthreads();
    const XcdBarrier xbar = xcd_barrier_post((unsigned*)(ws + WS_CTL), xst);
#ifndef PROBE_MASK
#define PROBE_MASK 0u
#endif
#ifndef PROBE_MUL
#define PROBE_MUL 1u
#endif
    unsigned long long pr_t[PH_N + 1]; (void)pr_t;
    if (PROBE_MASK) pr_t[0] = __builtin_amdgcn_s_memrealtime();
#define SEAM(k) do { if (IN(k) && IN((k) + 1)) { if ((k) == PH_CVT1) grid.sync(); else xcd_barrier(xbar); } if (PROBE_MASK) pr_t[(k) + 1] = __builtin_amdgcn_s_memrealtime(); } while (0)

    if (IN(PH_CVT1)) {
        LAS float* scr = (LAS float*)(lds + wave * 16384);
        constexpr int I1 = (D / 64) * (2 * FF / 32), I2 = (FF / 64) * (D / 32), I3 = (D / 64) * (NW / 32), I4 = (D / 64) * (D / 32);
#define PICK1(it, out) do { int r_ = (it); if (r_ < I1) out = cvt_decode(1, a.in[6], a.in[7], FF, D, W1GU, 2 * FF / 32, r_, lane); else if ((r_ -= I1) < I2) out = cvt_decode(0, a.in[8], a.in[8], D, FF, W1D, D / 32, r_, lane); \
            else if ((r_ -= I2) < I3) out = cvt_decode(2, a.in[10], a.in[10], NIN, D, WIN, NW / 32, r_, lane); else out = cvt_decode(0, a.in[23], a.in[23], D, D, WOUT, D / 32, r_ - I3, lane); } while (0)
        CVT_RUN(I1 + I2 + I3 + I4, PICK1);
#undef PICK1
        for (int it = gw; it < 6144; it += NGW) cvt_lora_item(a.in[13], a.in[15], a.in[16], WL, it, lane);
        for (int r = gw; r < 256; r += NGW) { h16* orow = A16 + (size_t)(MT + r) * D;
#pragma unroll
            for (int j = 0; j < 8; ++j) { u32x2 w = (u32x2){0u, 0u};
                if (r < 32) { const f32x4 v = *((const f32x4*)(a.in[2] + (size_t)r * D) + lane + 64 * j); w.x = pk2h(v.x, v.y); w.y = pk2h(v.z, v.w); }
                *((u32x2*)orow + lane + 64 * j) = w; } }
        for (int m = gw; m < MT; m += NGW) { const float* xr = m < MP ? a.in[0] + (size_t)m * D : a.in[1] + (size_t)(m - MP) * D; rms_row_f16(xr, a.in[5], A16 + (size_t)m * D, nullptr, lane); }
    }
    SEAM(PH_CVT1);
    if (IN(PH_FFN1_GU)) { pg8::Gemm g{A16, W1GU, MT, 2 * FF, D}; pg8::Order S; S.init(MT, 2 * FF, D, G, bx, 0, -1); pg8::EpiSwiGLU E{HM, FF}; pg8::gemm_phase(lds, g, S, E); }
    SEAM(PH_FFN1_GU);
    if (IN(PH_FFN1_D)) { pg8::Gemm g{HM, W1D, MT, D, FF}; pg8::Order S; S.init(MT, D, FF, G, bx, 0, MP / 256); pg8::EpiRes<false, true> E{a.in[0], XH, SLAB, 0.5f, 0}; pg8::gemm_phase(lds, g, S, E); }
    SEAM(PH_FFN1_D);
    if (IN(PH_RMS_MIX)) {
        for (int m = gw; m < MT; m += NGW) { float* so = nullptr;
            if (m < MP) { if ((m & 4095) == 4095) so = a.out + O_SHP + (size_t)(m >> 12) * D; } else { if (((m - MP) & 63) == 63) so = a.out + O_SHS + (size_t)((m - MP) >> 6) * D; }
            if (m < MP) rms_row_h(XH + (size_t)m * D, a.in[9], A16 + (size_t)m * D, so, lane);
            else rms_row_f16(a.in[1] + (size_t)(m - MP) * D, a.in[9], A16 + (size_t)m * D, so, lane, SLAB + (size_t)(m - MP) * D, 0.5f, Y + (size_t)m * D); }
    }
    SEAM(PH_RMS_MIX);
    if (IN(PH_WIN)) { pg8::Gemm g{A16, WIN, MT, NW, D}; pg8::Order S; S.init(MT, NW, D, G, bx, PFW / 256, -1); pg8::EpiP16 E{P16, PF}; pg8::gemm_phase(lds, g, S, E); }
    SEAM(PH_WIN);
    if (IN(PH_SHIFT)) {
        for (int item = bx * NTHR + tid; item < (MT / 16) * 768; item += G * NTHR) { const int c = item / 768, o = item % 768;
            *(u32x4*)((h16*)(ob + OB_SIDE) + (size_t)c * 6144 + o * 8) = *(const u32x4*)(P16 + (size_t)(16 * c + 15) * PP + o * 8); }
    }
    if (IN(PH_SHIFT)) {
        h16* AIN = A16; const float* mu = a.in[11];
        for (int item = bx * NTHR + tid; item < MT * 64; item += G * NTHR) {
            const int row = item >> 6, o = item & 63;
            if (o >= 56) { *(u32x4*)(AIN + (size_t)row * LK + 448 + (o - 56) * 8) = (u32x4){0u, 0u, 0u, 0u}; continue; }
            const int c0 = 6144 + o * 8;
            const bool st = row < MP ? ((row & 4095) == 0) : (((row - MP) & 63) == 0);
            const h16* pp = st ? (row < MP ? PF + (size_t)32 * PFW : PF + (size_t)((row - MP) >> 6) * PFW) + c0 : P16 + (size_t)(row - 1) * PP + c0;
            const h16x8 cv = *(const h16x8*)(P16 + (size_t)row * PP + c0), pv = *(const h16x8*)pp;
            const f32x4 m0 = *(const f32x4*)(mu + c0), m1 = *(const f32x4*)(mu + c0 + 4);
            const float mu8[8] = {m0.x, m0.y, m0.z, m0.w, m1.x, m1.y, m1.z, m1.w}; float s[8];
#pragma unroll
            for (int j = 0; j < 8; ++j) { const float cu = (float)cv[j]; s[j] = cu + mu8[j] * ((float)pv[j] - cu); }
            if (o < 12) {
#pragma unroll
                for (int j = 0; j < 8; ++j) s[j] = tanhf_(s[j]);
            } else if (o >= 24) {
#pragma unroll
                for (int j = 0; j < 8; ++j) s[j] = sigmoidf_(s[j]);
            }
            *(u32x4*)(AIN + (size_t)row * LK + o * 8) = (u32x4){pk2h(s[0], s[1]), pk2h(s[2], s[3]), pk2h(s[4], s[5]), pk2h(s[6], s[7])};
        }
    }
    SEAM(PH_SHIFT);
    if (IN(PH_LORA)) { pg8::Gemm g{A16, WL, MT, 6144, LK}; pg8::Order S; S.init(MT, 6144, LK, G, bx, 0, -1); pg8::EpiEAG E{EAG, a.in[12], a.in[14]}; pg8::gemm_phase<pg8::EpiEAG, true>(lds, g, S, E); }
    SEAM(PH_LORA);
    if (IN(PH_PREP)) {
        LAS unsigned char* sc = lds + wave * 5120;
        float* RK = (float*)(ws + WS_RK); float* LM = (float*)(ws + WS_LM);
        const int cp = lane & 31, hs = lane >> 5;
#define H2LO(x) ((float)__builtin_bit_cast(h16, (unsigned short)((x) & 0xffffu)))
#define H2HI(x) ((float)__builtin_bit_cast(h16, (unsigned short)((x) >> 16)))
#define HSUM(x_, out_) do { float y_ = row_allreduce16(x_); y_ += __builtin_bit_cast(float, __builtin_amdgcn_update_dpp(0, __builtin_bit_cast(int, y_), 0x142, 0xA, 0xF, false)); \
            const float s31_ = rl_f(y_, 31), s63_ = rl_f(y_, 63); out_ = hs ? s63_ : s31_; } while (0)
#define PREP_LOAD(item_, RR, KK, VV, EE, AA) do { const int c_ = (item_) >> 5, h_ = (item_) & 31, r0_ = 16 * c_, j2_ = h_ * 64 + 2 * cp; \
            const bool pr_ = r0_ < MP; const bool st_ = pr_ ? ((r0_ & 4095) == 0) : (((r0_ - MP) & 63) == 0); \
            const h16* pq_ = hs ? P16 + (size_t)(r0_ + 7) * PP + j2_ : (st_ ? PF + (size_t)(pr_ ? 32 : ((r0_ - MP) >> 6)) * PFW + j2_ : (const h16*)(ob + OB_SIDE) + (size_t)(c_ - 1) * 6144 + j2_); \
            const h16* pp_ = P16 + (size_t)(r0_ + 8 * hs) * PP + j2_; const h16* pe_ = EAG + (size_t)(r0_ + 8 * hs) * 6144 + j2_; \
            RR[0] = *(const unsigned*)pq_; KK[0] = *(const unsigned*)(pq_ + D); VV[0] = *(const unsigned*)(pq_ + 2 * D); \
            _Pragma("unroll") for (int s_ = 0; s_ < 8; ++s_) { RR[s_ + 1] = *(const unsigned*)(pp_ + (size_t)s_ * PP); KK[s_ + 1] = *(const unsigned*)(pp_ + (size_t)s_ * PP + D); VV[s_ + 1] = *(const unsigned*)(pp_ + (size_t)s_ * PP + 2 * D); \
                EE[s_] = *(const unsigned*)(pe_ + (size_t)s_ * 6144); AA[s_] = *(const unsigned*)(pe_ + (size_t)s_ * 6144 + D); } } while (0)
        unsigned rr[9], kk[9], vv[9], ee[8], aa[8], rrn[9], kkn[9], vvn[9], een[8], aan[8];
        if (gw < (MT / 16) * 32) PREP_LOAD(gw, rr, kk, vv, ee, aa);
        for (int item = gw; item < (MT / 16) * 32; item += NGW) {
            const int c = item >> 5, h = item & 31, row0 = 16 * c, hj2 = h * 64 + 2 * cp;
            const f32x2 c_kk = *(const f32x2*)(a.in[17] + hj2), c_ka = *(const f32x2*)(a.in[18] + hj2), c_rk = *(const f32x2*)(a.in[19] + hj2), c_mr = *(const f32x2*)(a.in[11] + hj2), c_mk = *(const f32x2*)(a.in[11] + D + hj2), c_mv = *(const f32x2*)(a.in[11] + 2 * D + hj2);
            if (item + NGW < (MT / 16) * 32) PREP_LOAD(item + NGW, rrn, kkn, vvn, een, aan);
            f32x2 Ll[8]; { f32x2 acc = (f32x2){0.f, 0.f};
#pragma unroll
                for (int s_ = 0; s_ < 8; ++s_) { acc -= (f32x2){H2LO(ee[s_]), H2HI(ee[s_])}; Ll[s_] = acc; } }
            const f32x2 oth = (f32x2){__shfl_xor(Ll[7].x, 32), __shfl_xor(Ll[7].y, 32)};
            const f32x2 M_ = hs ? oth : Ll[7]; const f32x2 L15 = M_ + (hs ? Ll[7] : oth);
            *(f32x2*)(LM + (size_t)item * 128 + 64 * hs + 2 * cp) = hs ? L15 : M_;
            const f32x2 off = hs ? (f32x2){0.f, 0.f} : M_;
            unsigned vpk[8];
            h16* eo = EAG + (size_t)(row0 + 8 * hs) * 6144 + hj2; h16* po = P16 + (size_t)(row0 + 8 * hs) * PP + hj2;
            f32x2 E3p = (f32x2){__expf(-off.x), __expf(-off.y)};
#pragma unroll
            for (int s_ = 0; s_ < 8; ++s_) { const int t = 8 * hs + s_;
                f32x2 r = (f32x2){H2LO(rr[s_ + 1]), H2HI(rr[s_ + 1])}, k = (f32x2){H2LO(kk[s_ + 1]), H2HI(kk[s_ + 1])}, v = (f32x2){H2LO(vv[s_ + 1]), H2HI(vv[s_ + 1])};
                r += c_mr * ((f32x2){H2LO(rr[s_]), H2HI(rr[s_])} - r); k += c_mk * ((f32x2){H2LO(kk[s_]), H2HI(kk[s_])} - k); v += c_mv * ((f32x2){H2LO(vv[s_]), H2HI(vv[s_])} - v);
                const f32x2 av = (f32x2){H2LO(aa[s_]), H2HI(aa[s_])};
                const f32x2 kkr = k * c_kk; float ss; HSUM(kkr.x * kkr.x + kkr.y * kkr.y, ss);
                const float rn = rsqrtf(fmaxf(ss, 1e-24f)); const f32x2 kap = kkr * rn;
                const f32x2 kmod = k * (1.f + (av - 1.f) * c_ka);
                const f32x2 Dm = Ll[s_] - off; const f32x2 E1 = E3p, E2 = (f32x2){__expf(-Dm.x), __expf(-Dm.y)}, E3 = (f32x2){__expf(Dm.x), __expf(Dm.y)}; E3p = E3;
                const f32x2 fat = kap * E1, frt = r * E3, fbb = kap * av * E2, fkb = kmod * E2;
                const unsigned hat = pk2h(fat.x, fat.y), hrt = pk2h(frt.x, frt.y), hbb = pk2h(fbb.x, fbb.y), hkb = pk2h(fkb.x, fkb.y);
                const f32x2 rkm = r * kmod * c_rk; float rk; HSUM(rkm.x + rkm.y, rk); if (cp == 0) RK[(size_t)(row0 + t) * 32 + h] = rk;
                *(unsigned*)(eo + (size_t)s_ * 6144) = hat; *(unsigned*)(eo + (size_t)s_ * 6144 + D) = hbb; *(unsigned*)(po + (size_t)s_ * PP) = hrt; *(unsigned*)(po + (size_t)s_ * PP + D) = hkb;
                ((LAS unsigned*)sc)[t * 32 + cp] = hat; ((LAS unsigned*)(sc + 2048))[t * 32 + cp] = hbb;
                vpk[s_] = pk2h(v.x, v.y);
            }
            { u32x4 lo, hi;
              lo.x = (vpk[0] & 0xffffu) | (vpk[1] << 16); lo.y = (vpk[2] & 0xffffu) | (vpk[3] << 16); lo.z = (vpk[4] & 0xffffu) | (vpk[5] << 16); lo.w = (vpk[6] & 0xffffu) | (vpk[7] << 16);
              hi.x = (vpk[0] >> 16) | (vpk[1] & 0xffff0000u); hi.y = (vpk[2] >> 16) | (vpk[3] & 0xffff0000u); hi.z = (vpk[4] >> 16) | (vpk[5] & 0xffff0000u); hi.w = (vpk[6] >> 16) | (vpk[7] & 0xffff0000u);
              const int i0 = 2 * cp;
              *(u32x4*)(P16 + (size_t)(row0 + (i0 >> 2)) * PP + 2 * D + h * 64 + (i0 & 3) * 16 + 8 * hs) = lo;
              *(u32x4*)(P16 + (size_t)(row0 + ((i0 + 1) >> 2)) * PP + 2 * D + h * 64 + ((i0 + 1) & 3) * 16 + 8 * hs) = hi; }
            asm volatile("s_waitcnt lgkmcnt(0)" ::: "memory");
            const int fr = lane & 15, fq = lane >> 4;
            f32x4 acc = (f32x4){0.f, 0.f, 0.f, 0.f};
#pragma unroll
            for (int kt = 0; kt < 4; ++kt) acc = __builtin_amdgcn_mfma_f32_16x16x16f16(*(const LAS h16x4*)(sc + (fr * 64 + 16 * kt + 4 * fq) * 2), *(const LAS h16x4*)(sc + 2048 + (fr * 64 + 16 * kt + 4 * fq) * 2), acc, 0, 0, 0);
            LAS float* Pm = (LAS float*)(sc + 4096);
#pragma unroll
            for (int g_ = 0; g_ < 4; ++g_) Pm[(4 * fq + g_) * 16 + fr] = (fr < 4 * fq + g_) ? acc[g_] : 0.f;
            asm volatile("s_waitcnt lgkmcnt(0)" ::: "memory");
            float Tc[16];
#pragma unroll
            for (int t = 0; t < 16; ++t) { float x = (t == fr) ? 1.f : 0.f;
#pragma unroll
                for (int j4 = 0; j4 < (t + 3) / 4; ++j4) { const f32x4 p4 = *(const LAS f32x4*)(Pm + t * 16 + 4 * j4);
                    if (4 * j4 + 0 < t) x -= p4.x * Tc[4 * j4 + 0]; if (4 * j4 + 1 < t) x -= p4.y * Tc[4 * j4 + 1]; if (4 * j4 + 2 < t) x -= p4.z * Tc[4 * j4 + 2]; if (4 * j4 + 3 < t) x -= p4.w * Tc[4 * j4 + 3]; }
                Tc[t] = x; }
            if (lane < 16) { h16* to = P16 + (size_t)row0 * PP + 6144 + h * 16 + fr;
#pragma unroll
                for (int t = 0; t < 16; ++t) to[(size_t)t * PP] = (h16)Tc[t]; }
            asm volatile("s_waitcnt lgkmcnt(0)" ::: "memory");
#pragma unroll
            for (int q_ = 0; q_ < 9; ++q_) { rr[q_] = rrn[q_]; kk[q_] = kkn[q_]; vv[q_] = vvn[q_]; }
#pragma unroll
            for (int q_ = 0; q_ < 8; ++q_) { ee[q_] = een[q_]; aa[q_] = aan[q_]; }
        }
#undef PREP_LOAD
#undef H2LO
#undef H2HI
#undef HSUM
    }
    SEAM(PH_PREP);
    if (IN(PH_SCAN)) {
        const int vcu = (G % 8 == 0) ? (bx % 8) * (G / 8) + bx / 8 : bx;
        constexpr int RAWB = 12288, NSL = 7, CSET = 2560, O_RAW = 0, O_CO = NSL * RAWB, O_YB = O_CO + 2 * CSET;
        static_assert(O_YB + 2 * 2048 <= LDS_BYTES - 16, "scan LDS map");
        h16* OUT16 = A16; const float* LM = (const float*)(ws + WS_LM);
        const bool pblk = vcu < 64;
        const int nitem = pblk ? 1 : (1024 - (vcu - 64) + 191) / 192;
        const int NCHB = pblk ? 256 : 4 * nitem;
#define SC_DESC(cc, prompt, sq, h, t0, first, last) \
        const bool prompt = pblk; bool first, last; int sq, h, t0; \
        if (prompt) { sq = vcu >> 5; h = vcu & 31; t0 = 16 * (cc); first = (cc) == 0; last = (cc) == 255; } \
        else { const int pair = (vcu - 64) + 192 * ((cc) >> 2); sq = pair >> 5; h = pair & 31; t0 = 16 * ((cc) & 3); first = ((cc) & 3) == 0; last = ((cc) & 3) == 3; }
#define SC_DMA(cc) do { if ((cc) < NCHB) { SC_DESC(cc, prompt_, sq_, h_, t0_, first_, last_); (void)last_; (void)first_; \
            const size_t rowb_ = (size_t)(prompt_ ? sq_ * 4096 : MP + sq_ * 64) + t0_; \
            LAS unsigned char* dst_ = lds + O_RAW + ((cc) % NSL) * RAWB; \
            const int sw_ = ((lane & 7) ^ (lane >> 3)) * 8;     \
            const h16* e0_ = EAG + (rowb_ + (lane >> 3)) * 6144 + h_ * 64 + sw_; const h16* p0_ = P16 + (rowb_ + (lane >> 3)) * PP + h_ * 64 + sw_; \
            __builtin_amdgcn_global_load_lds((const unsigned*)(e0_), (LAS unsigned*)(dst_), 16, 0, 0); \
            __builtin_amdgcn_global_load_lds((const unsigned*)(e0_ + 8 * 6144), (LAS unsigned*)(dst_ + 1024), 16, 0, 0); \
            __builtin_amdgcn_global_load_lds((const unsigned*)(p0_), (LAS unsigned*)(dst_ + 2048), 16, 0, 0); \
            __builtin_amdgcn_global_load_lds((const unsigned*)(p0_ + 8 * PP), (LAS unsigned*)(dst_ + 3072), 16, 0, 0); \
            __builtin_amdgcn_global_load_lds((const unsigned*)(e0_ + D), (LAS unsigned*)(dst_ + 4096), 16, 0, 0); \
            __builtin_amdgcn_global_load_lds((const unsigned*)(e0_ + D + 8 * 6144), (LAS unsigned*)(dst_ + 5120), 16, 0, 0); \
            __builtin_amdgcn_global_load_lds((const unsigned*)(p0_ + D), (LAS unsigned*)(dst_ + 6144), 16, 0, 0); \
            __builtin_amdgcn_global_load_lds((const unsigned*)(p0_ + D + 8 * PP), (LAS unsigned*)(dst_ + 7168), 16, 0, 0); \
            __builtin_amdgcn_global_load_lds((const unsigned*)(p0_ - sw_ + (lane & 7) * 8 + 2 * D), (LAS unsigned*)(dst_ + 8192), 16, 0, 0); \
            __builtin_amdgcn_global_load_lds((const unsigned*)(p0_ - sw_ + (lane & 7) * 8 + 2 * D + 8 * PP), (LAS unsigned*)(dst_ + 9216), 16, 0, 0); \
            __builtin_amdgcn_global_load_lds((const unsigned*)(P16 + (rowb_ + ((lane & 31) >> 1)) * PP + 6144 + h_ * 16 + (lane & 1) * 8), (LAS unsigned*)(dst_ + 10240), 16, 0, 0); \
            __builtin_amdgcn_global_load_lds((const unsigned*)(LM + ((rowb_ >> 4) * 32 + h_) * 128 + (lane & 31) * 4), (LAS unsigned*)(dst_ + 11264), 16, 0, 0); } } while (0)
#define MF(a_, b_, c_) __builtin_amdgcn_mfma_f32_16x16x32_f16(a_, b_, c_, 0, 0, 0)
#define CAT8(lo_, hi_) ((h16x8){(lo_)[0], (lo_)[1], (lo_)[2], (lo_)[3], (hi_)[0], (hi_)[1], (hi_)[2], (hi_)[3]})
#define SC_C(cc) do { if ((cc) >= 0 && (cc) < NCHB) { \
            const LAS unsigned char* rs = lds + O_RAW + ((cc) % NSL) * RAWB; LAS unsigned char* co = lds + O_CO + ((cc) & 1) * CSET; \
            const int fr = lane & 15, fq = lane >> 4; const int oa = wave == 4 ? 0 : 2048, ob_ = wave == 6 ? 4096 : 6144; \
            f32x4 acc = (f32x4){0.f, 0.f, 0.f, 0.f}; \
            _Pragma("unroll") for (int kb = 0; kb < 2; ++kb) { const int o_ = fr * 128 + (((4 * kb + fq) ^ (fr & 7)) << 4); acc = MF(*(const LAS h16x8*)(rs + oa + o_), *(const LAS h16x8*)(rs + ob_ + o_), acc); } \
            _Pragma("unroll") for (int g_ = 0; g_ < 4; ++g_) { const int t = 4 * fq + g_; const bool keep = wave == 4 ? (fr < t) : (fr <= t); ((LAS h16*)(co + (wave - 4) * 512))[t * 16 + fr] = (h16)(keep ? acc[g_] : 0.f); } \
            if (wave == 4) { const float M_ = ((const LAS float*)(rs + 11264))[lane], L15 = ((const LAS float*)(rs + 11264 + 256))[lane]; \
                ((LAS float*)(co + 1536))[lane] = __expf(M_); ((LAS float*)(co + 1792))[lane] = __expf(L15 - M_); ((LAS float*)(co + 2048))[lane] = __expf(L15); } } } while (0)
        f32x4 St[4];
#pragma unroll
        for (int n = 0; n < 4; ++n) St[n] = (f32x4){0.f, 0.f, 0.f, 0.f};
#define CVT4(x_) ((h16x4){(h16)(x_)[0], (h16)(x_)[1], (h16)(x_)[2], (h16)(x_)[3]})
#define TRR(p_) __builtin_bit_cast(h16x4, __builtin_amdgcn_ds_read_tr16_b64_v4i16((LAS s16x4*)(p_)))
#define SC_ROW(cc, PROMPT) do { if ((cc) >= 0 && (cc) < NCHB) { SC_DESC(cc, prompt, sq, h, t0, first, last); \
            const int fr = lane & 15, fq = lane >> 4; \
            float* sp = a.out + (prompt ? O_WKP : O_WKS) + ((size_t)(sq * 32 + h) * 64 + 16 * wave + fr) * 64 + 4 * fq; \
            if (first) { _Pragma("unroll") for (int n = 0; n < 4; ++n) { St[n] = (f32x4){0.f, 0.f, 0.f, 0.f}; if (!(PROMPT)) St[n] = *(const f32x4*)(a.in[4] + ((size_t)(sq * 32 + h) * 64 + 16 * wave + fr) * 64 + 16 * n + 4 * fq); } } \
            LAS unsigned char* rs = lds + O_RAW + ((cc) % NSL) * RAWB; const LAS unsigned char* co = lds + O_CO + ((cc) & 1) * CSET; \
              \
            f32x4 em[4], gm[4], e4[4]; h16x4 atl[2][2], rtl[2][2], kbt[4], bbt[4]; \
            _Pragma("unroll") for (int n = 0; n < 4; ++n) { em[n] = *(const LAS f32x4*)(co + 1536 + (16 * n + 4 * fq) * 4); gm[n] = *(const LAS f32x4*)(co + 2048 + (16 * n + 4 * fq) * 4); e4[n] = *(const LAS f32x4*)(co + 1792 + (16 * n + 4 * fq) * 4); } \
            _Pragma("unroll") for (int b = 0; b < 2; ++b) { \
                const int o0_ = fr * 128 + (((4 * b + (fq >> 1)) ^ (fr & 7)) << 4) + 8 * (fq & 1), o1_ = fr * 128 + (((4 * b + 2 + (fq >> 1)) ^ (fr & 7)) << 4) + 8 * (fq & 1); \
                atl[b][0] = *(const LAS h16x4*)(rs + o0_); atl[b][1] = *(const LAS h16x4*)(rs + o1_); rtl[b][0] = *(const LAS h16x4*)(rs + 2048 + o0_); rtl[b][1] = *(const LAS h16x4*)(rs + 2048 + o1_); } \
            const h16x4 vm = *(const LAS h16x4*)(rs + 8192 + ((16 * wave + fr) * 16 + 4 * fq) * 2), aak = *(const LAS h16x4*)(co + (fr * 16 + 4 * fq) * 2), tA = *(const LAS h16x4*)(rs + 10240 + (fr * 16 + 4 * fq) * 2), \
                        ark = *(const LAS h16x4*)(co + 512 + (fr * 16 + 4 * fq) * 2), arb = *(const LAS h16x4*)(co + 1024 + (fr * 16 + 4 * fq) * 2); \
            _Pragma("unroll") for (int n = 0; n < 4; ++n) { const int tr_ = 4 * fq + (fr >> 2); const int o_ = tr_ * 128 + (((2 * n + ((fr & 3) >> 1)) ^ (tr_ & 7)) << 4) + 8 * (fr & 1); kbt[n] = TRR(rs + 6144 + o_); bbt[n] = TRR(rs + 4096 + o_); } \
            asm volatile("s_waitcnt lgkmcnt(0)" ::: "memory"); \
            const h16x4 z4 = (h16x4){(h16)0.f, (h16)0.f, (h16)0.f, (h16)0.f}; \
            h16x4 sh[4]; \
            _Pragma("unroll") for (int n = 0; n < 4; ++n) { const f32x4 x = St[n] * em[n]; sh[n] = CVT4(x); } \
            f32x4 W1 = (f32x4){0.f, 0.f, 0.f, 0.f}, Yt = W1; \
              \
            _Pragma("unroll") for (int b = 0; b < 2; ++b) { const h16x8 sb = CAT8(sh[2 * b], sh[2 * b + 1]); \
                W1 = MF(CAT8(atl[b][0], atl[b][1]), sb, W1); Yt = MF(CAT8(rtl[b][0], rtl[b][1]), sb, Yt); } \
            W1 = MF(CAT8(aak, z4), CAT8(vm, z4), W1); \
            const h16x4 w1h = CVT4(W1); \
            f32x4 U = MF(CAT8(tA, z4), CAT8(w1h, z4), ((f32x4){0.f, 0.f, 0.f, 0.f})); \
            const f32x4 nU = -U; const h16x4 uh = CVT4(nU); const h16x8 vu = CAT8(vm, uh);     \
            Yt = MF(CAT8(ark, arb), vu, Yt); \
            _Pragma("unroll") for (int n = 0; n < 4; ++n) { const f32x4 tmp = MF(CAT8(kbt[n], bbt[n]), vu, ((f32x4){0.f, 0.f, 0.f, 0.f})); St[n] = gm[n] * St[n] + e4[n] * tmp; } \
            { LAS h16* yb = (LAS h16*)(lds + O_YB + ((cc) & 1) * 2048) + (4 * fq) * 64 + 16 * wave + fr; (void)t0; \
              yb[0] = (h16)Yt[0]; yb[64] = (h16)Yt[1]; yb[128] = (h16)Yt[2]; yb[192] = (h16)Yt[3]; } \
            if (last) { _Pragma("unroll") for (int n = 0; n < 4; ++n) *(f32x4*)(sp + 16 * n) = St[n]; } } } while (0)
#define SC_YOUT(cc) do { if ((cc) >= 0 && (cc) < NCHB && wave >= 5) { SC_DESC(cc, prompt, sq, h, t0, first, last); (void)first; (void)last; \
            const int L_ = (wave - 5) * 64 + lane, t_ = L_ >> 3, part_ = L_ & 7; \
            *(u32x4*)(OUT16 + ((size_t)(prompt ? sq * 4096 : MP + sq * 64) + t0 + t_) * D + h * 64 + part_ * 8) = *(const LAS u32x4*)(lds + O_YB + ((cc) & 1) * 2048 + t_ * 128 + part_ * 16); } } while (0)
#define SC_BARRIER() do { asm volatile("s_waitcnt lgkmcnt(0)" ::: "memory"); __builtin_amdgcn_s_barrier(); asm volatile("" ::: "memory"); } while (0)
        if (wave < 4) {
            SC_BARRIER();
            if (pblk) { for (int it = -1; it <= NCHB; ++it) { SC_ROW(it, true); SC_BARRIER(); } }
            else { for (int it = -1; it <= NCHB; ++it) { SC_ROW(it, false); SC_BARRIER(); } }
        } else if (wave == 7) {
            SC_DMA(0); SC_DMA(1); SC_DMA(2); SC_DMA(3); SC_DMA(4);
            asm volatile("s_waitcnt vmcnt(48)" ::: "memory");
            SC_BARRIER();
            for (int it = -1; it <= NCHB; ++it) {
                SC_DMA(it + 6);
                if (it + 6 < NCHB) asm volatile("s_waitcnt vmcnt(48)" ::: "memory");
                else asm volatile("s_waitcnt vmcnt(0)" ::: "memory");
                SC_BARRIER();
            }
        } else {
            SC_BARRIER();
            for (int it = -1; it <= NCHB; ++it) { SC_C(it + 1); SC_YOUT(it - 1); SC_BARRIER(); }
        }
        if (!pblk) {
            __syncthreads();
            LAS float* scr = (LAS float*)(lds + wave * 16384);
            constexpr int I1 = (D / 64) * (2 * FF / 32), I2 = (FF / 64) * (D / 32);
            const int gw = (vcu - 64) * NWAVES + wave, NGW = (G - 64) * NWAVES;
#define PICK2(it, out) do { int r_ = (it); if (r_ < I1) out = cvt_decode(1, a.in[25], a.in[26], FF, D, W2GU, 2 * FF / 32, r_, lane); else out = cvt_decode(0, a.in[27], a.in[27], D, FF, W2D, D / 32, r_ - I1, lane); } while (0)
            CVT_RUN(I1 + I2, PICK2);
#undef PICK2
        }
#undef SC_DESC
#undef SC_DMA
#undef MF
#undef CAT8
#undef SC_C
#undef CVT4
#undef TRR
#undef SC_ROW
#undef SC_BARRIER
#undef SC_YOUT
    }
    SEAM(PH_SCAN);
    if (IN(PH_MERGE)) {
        const float* RK = (const float*)(ws + WS_RK);
        const int o8 = tid & 255, c0 = o8 * 8, hd = o8 >> 3, rg = tid >> 8;
        float w0[8], w1[8], w2[8], lg[8], lb[8];
#pragma unroll
        for (int j = 0; j < 8; ++j) { w0[j] = a.in[22][c0 + j]; w1[j] = a.in[22][D + c0 + j]; w2[j] = a.in[22][2 * D + c0 + j]; lg[j] = a.in[20][c0 + j]; lb[j] = a.in[21][c0 + j]; }
        for (int c = bx; c < MT / 16; c += G) {
            const int row0 = 16 * c + 8 * rg;
            const bool pr = row0 < MP; const int tt0 = pr ? (row0 & 4095) : ((row0 - MP) & 63), sq = pr ? (row0 >> 12) : ((row0 - MP) >> 6), T = pr ? 4096 : 64;
            h16x8 vt[8];
            { const h16* vb = P16 + (size_t)(16 * c + ((c0 & 63) >> 2)) * PP + 2 * D + (c0 & ~63) + 8 * rg;
#pragma unroll
              for (int j = 0; j < 8; ++j) vt[j] = *(const h16x8*)(vb + (size_t)(j >> 2) * PP + (j & 3) * 16); }
            float u1[8], u2[8];
            { const h16* prow = P16 + (size_t)row0 * PP;
              if (tt0 >= 2) { const h16x8 p1 = *(const h16x8*)(prow - PP + C_U + c0), p2 = *(const h16x8*)(prow - 2 * PP + C_U + c0);
#pragma unroll
                  for (int j = 0; j < 8; ++j) { u1[j] = (float)p1[j]; u2[j] = (float)p2[j]; }
              } else {
#pragma unroll
                  for (int j = 0; j < 8; ++j) { u2[j] = pr ? 0.f : a.in[3][(size_t)sq * 2 * D + c0 + j]; u1[j] = pr ? 0.f : a.in[3][(size_t)sq * 2 * D + D + c0 + j]; } } }
#pragma unroll
            for (int hf = 0; hf < 4; ++hf) {
                h16x8 ov[2], gv[2], uu[2], qq[2], sa[2]; float rk[2];
#pragma unroll
                for (int r = 0; r < 2; ++r) { const int row = row0 + 2 * hf + r; const h16* prow = P16 + (size_t)row * PP;
                    ov[r] = *(const h16x8*)(A16 + (size_t)row * D + c0); gv[r] = *(const h16x8*)(EAG + (size_t)row * 6144 + 2 * D + c0);
                    uu[r] = *(const h16x8*)(prow + C_U + c0); qq[r] = *(const h16x8*)(prow + C_Q + c0); sa[r] = *(const h16x8*)(prow + C_SA + c0);
                    rk[r] = RK[(size_t)row * 32 + hd]; }
#pragma unroll
                for (int r = 0; r < 2; ++r) { const int row = row0 + 2 * hf + r, tt = tt0 + 2 * hf + r;
                    float of[8], s1 = 0.f;
#pragma unroll
                    for (int j = 0; j < 8; ++j) { of[j] = (float)ov[r][j]; s1 += of[j]; }
                    const float mean = row_allreduce8(s1) * (1.f / 64.f); float s2 = 0.f;
#pragma unroll
                    for (int j = 0; j < 8; ++j) { of[j] -= mean; s2 += of[j] * of[j]; }
                    const float rstd = rsqrtf(row_allreduce8(s2) * (1.f / 64.f) + 64e-5f);
                    float mg[8], u0[8];
#pragma unroll
                    for (int j = 0; j < 8; ++j) {
                        const float vs = (float)vt[j][2 * hf + r];
                        const float ya = (of[j] * rstd * lg[j] + lb[j] + rk[r] * vs) * (float)gv[r][j];
                        u0[j] = (float)uu[r][j];
                        const float cv = w0[j] * u2[j] + w1[j] * u1[j] + w2[j] * u0[j];
                        mg[j] = (float)sa[r][j] * ya + (float)qq[r][j] * cv; u2[j] = u1[j]; u1[j] = u0[j]; }
                    *(u32x4*)(A16 + (size_t)row * D + c0) = (u32x4){pk2h(mg[0], mg[1]), pk2h(mg[2], mg[3]), pk2h(mg[4], mg[5]), pk2h(mg[6], mg[7])};
                    if (tt >= T - 2) { float* q = a.out + (pr ? O_CVP : O_CVS) + (size_t)sq * 2 * D + (size_t)(tt - (T - 2)) * D + c0;
                        *(f32x4*)q = (f32x4){u0[0], u0[1], u0[2], u0[3]}; *(f32x4*)(q + 4) = (f32x4){u0[4], u0[5], u0[6], u0[7]}; }
                }
            }
        }
    }
    SEAM(PH_MERGE);
    if (IN(PH_WOUT)) {
        { pg8::Gemm g{A16, WOUT, MT, D, D}; pg8::Order S; S.init(MT, D, D, G, bx, 0, MP / 256); pg8::EpiRes<true, true> E{XH, XH, SLAB, 1.0f, 0}; pg8::gemm_phase(lds, g, S, E); }
    }
    SEAM(PH_WOUT);
    if (IN(PH_RMS2)) { for (int m = gw; m < MT; m += NGW) { if (m < MP) rms_row_h(XH + (size_t)m * D, a.in[24], A16 + (size_t)m * D, nullptr, lane);
            else rms_row_f16(Y + (size_t)m * D, a.in[24], A16 + (size_t)m * D, nullptr, lane, SLAB + (size_t)(m - MP) * D, 1.0f, Y + (size_t)m * D); } }
    SEAM(PH_RMS2);
    if (IN(PH_FFN2_GU)) { pg8::Gemm g{A16, W2GU, MT, 2 * FF, D}; pg8::Order S; S.init(MT, 2 * FF, D, G, bx, 0, -1); pg8::EpiSwiGLU E{HM, FF}; pg8::gemm_phase(lds, g, S, E); }
    SEAM(PH_FFN2_GU);
    if (IN(PH_FFN2_D)) { pg8::Gemm g{HM, W2D, MT, D, FF}; pg8::Order S; S.init(MT, D, FF, G, bx, 0, MP / 256); pg8::EpiRes<true, true> E{XH, A16, SLAB, 0.5f, 0}; pg8::gemm_phase(lds, g, S, E); }
    SEAM(PH_FFN2_D);
    if (IN(PH_FINAL)) { for (int m = gw; m < MT; m += NGW) { if (m < MP) rms_row_h(A16 + (size_t)m * D, a.in[28], nullptr, Y + (size_t)m * D, lane);
            else rms_row_f16(Y + (size_t)m * D, a.in[28], nullptr, Y + (size_t)m * D, lane, SLAB + (size_t)(m - MP) * D, 0.5f, nullptr); } }
    if (PROBE_MASK) {
        pr_t[PH_N] = __builtin_amdgcn_s_memrealtime();
        if (bx == 0 && tid == 0) { unsigned long long tot = 0;
#pragma unroll
            for (int k = 0; k < PH_N; ++k) if ((PROBE_MASK >> k) & 1u) tot += pr_t[k + 1] - pr_t[k];
            const unsigned long long t0 = __builtin_amdgcn_s_memrealtime();
            while (__builtin_amdgcn_s_memrealtime() - t0 < tot * PROBE_MUL) __builtin_amdgcn_s_sleep(8);
        }
    }
#undef IN
#undef SEAM
}

extern "C" void kernel_launch(void* const* d_in, const int* in_sizes, int n_in, void* d_out, int out_size, void* d_ws, size_t ws_size, hipStream_t stream) {
    static int grid = 0;
    if (grid == 0) {
        if (n_in != 29 || (size_t)out_size != O_END || ws_size < WS_END) { fprintf(stderr, "kernel_launch: unexpected shapes (n_in %d out %d ws %zu need %zu)\n", n_in, out_size, ws_size, (size_t)WS_END); grid = -1; return; }
        int dev = 0, cus = 0, per_cu = 0;
        if (hipGetDevice(&dev) != hipSuccess || hipDeviceGetAttribute(&cus, hipDeviceAttributeMultiprocessorCount, dev) != hipSuccess) { grid = -1; return; }
        if (hipFuncSetAttribute((const void*)fwd_kernel, hipFuncAttributeMaxDynamicSharedMemorySize, LDS_BYTES) != hipSuccess) { grid = -1; return; }
        if (hipOccupancyMaxActiveBlocksPerMultiprocessor(&per_cu, (const void*)fwd_kernel, NTHR, LDS_BYTES) != hipSuccess || per_cu < 1) { fprintf(stderr, "kernel_launch: occupancy query failed (%d)\n", per_cu); grid = -1; return; }
        grid = cus;
    }
    if (grid < 0) return;
    if (hipMemsetAsync((char*)d_ws + WS_CTL, 0, XCD_BAR_WORDS * 4, stream) != hipSuccess) return;
    Args a{};
    for (int i = 0; i < 29; ++i) a.in[i] = (const float*)d_in[i];
    a.out = (float*)d_out; a.ws = (unsigned char*)d_ws; a.ph_lo = 0; a.ph_hi = PH_N;
    void* kargs[] = {&a};
    hipError_t e = hipLaunchCooperativeKernel((const void*)fwd_kernel, dim3(grid), dim3(NTHR), kargs, LDS_BYTES, stream);
    if (e != hipSuccess) fprintf(stderr, "kernel_launch: cooperative launch failed: %s (grid %d)\n", hipGetErrorString(e), grid);
}
```

```cpp
#include <hip/hip_runtime.h>
#include <hip/hip_cooperative_groups.h>
#include <cstdio>
namespace cg = cooperative_groups;

#define LAS __attribute__((address_space(3)))
typedef _Float16 h16;
typedef _Float16 h16x2 __attribute__((ext_vector_type(2)));
typedef _Float16 h16x4 __attribute__((ext_vector_type(4)));
typedef _Float16 h16x8 __attribute__((ext_vector_type(8)));
typedef short s16x4 __attribute__((ext_vector_type(4)));
typedef float f32x4 __attribute__((ext_vector_type(4)));
typedef float f32x2 __attribute__((ext_vector_type(2)));
typedef unsigned u32x4 __attribute__((ext_vector_type(4)));
typedef unsigned u32x2 __attribute__((ext_vector_type(2)));

constexpr int D = 2048, FF = 5632, NA = 6592, NIN = 16832;
constexpr int MP = 8192, MS = 2048, MT = MP + MS;
constexpr int MA = MT + 256;
constexpr int PP = 12800;
constexpr int NW = 16896;
constexpr int PFW = 6656;
constexpr int C_U = 6656, C_Q = 8704, C_SA = 10752;
constexpr int LK = 512;
constexpr int NCHUNK = MT / 64;
constexpr size_t O_Y = 0, O_SHP = 20971520, O_CVP = 20975616, O_WKP = 20983808, O_SHS = 21245952, O_CVS = 21311488, O_WKS = 21442560, O_END = 25636864;
constexpr size_t WS_CTL = 0;
constexpr size_t WS_W1GU = 1u << 20;
constexpr size_t WS_W1D = WS_W1GU + (size_t)2 * FF * D * 2;
constexpr size_t WS_WIN = WS_W1D + (size_t)D * FF * 2;
constexpr size_t WS_WOUT = WS_WIN + (size_t)NW * D * 2;
constexpr size_t WS_A16 = WS_WOUT + (size_t)D * D * 2;
constexpr size_t WS_P16 = WS_A16 + (size_t)MA * D * 2;
constexpr size_t WS_W2GU = WS_P16 + (size_t)MT * PP * 2;
constexpr size_t WS_W2D = WS_W2GU + (size_t)2 * FF * D * 2;
constexpr size_t WS_PF = WS_W2D + (size_t)D * FF * 2;
constexpr size_t WS_END = WS_PF + (size_t)256 * PFW * 2;
constexpr size_t WS_EAG = WS_W1GU;
constexpr size_t WS_HM = WS_P16;
constexpr size_t WS_SLAB = WS_HM + (size_t)MT * FF * 2;
static_assert((size_t)MT * 6144 * 2 <= WS_WOUT - WS_W1GU, "EAG overlay");
static_assert(WS_SLAB + (size_t)4 * MS * D * 4 <= WS_W2GU, "HM + slab overlay of P16");
constexpr size_t OB_WL = O_WKS * 4;
constexpr size_t OB_SIDE = OB_WL + (size_t)6144 * LK * 2;
static_assert(OB_SIDE + (size_t)(MT / 16) * 6144 * 2 <= O_END * 4, "d_out scratch");

constexpr size_t WS_RK = WS_EAG + (size_t)MT * 6144 * 2;
constexpr size_t WS_LM = WS_RK + (size_t)MT * 32 * 4;
static_assert(WS_LM + (size_t)(MT / 16) * 32 * 128 * 4 <= WS_WOUT, "RK + LM");
constexpr int SC_SLOT = 6 * 64, SC_BUF = 16 * SC_SLOT;
constexpr int NWAVES = 8, NTHR = 512;
constexpr int LDS_BYTES = 147456;

__device__ __forceinline__ unsigned pk2h(float a, float b) { h16x2 v = {(h16)a, (h16)b}; return __builtin_bit_cast(unsigned, v); }
__device__ __forceinline__ float wave_sum(float v) {
#pragma unroll
    for (int o = 1; o < 64; o <<= 1) v += __shfl_xor(v, o);
    return v;
}
template <int CTRL> __device__ __forceinline__ float dpp_f(float x) { return __builtin_bit_cast(float, __builtin_amdgcn_update_dpp(0, __builtin_bit_cast(int, x), CTRL, 0xF, 0xF, false)); }
__device__ __forceinline__ float row_allreduce8(float x) { x += dpp_f<0xB1>(x); x += dpp_f<0x4E>(x); x += dpp_f<0x141>(x); return x; }
__device__ __forceinline__ float row_allreduce16(float x) { x = row_allreduce8(x); x += dpp_f<0x140>(x); return x; }
__device__ __forceinline__ float rl_f(float x, int l) { return __builtin_bit_cast(float, __builtin_amdgcn_readlane(__builtin_bit_cast(int, x), l)); }
__device__ __forceinline__ float wave_sum_dpp(float x) { x = row_allreduce16(x); return (rl_f(x, 0) + rl_f(x, 16)) + (rl_f(x, 32) + rl_f(x, 48)); }
__device__ __forceinline__ float wave_sum_bc(float x) {
    x = row_allreduce16(x);
    x += __builtin_bit_cast(float, __builtin_amdgcn_update_dpp(0, __builtin_bit_cast(int, x), 0x142, 0xA, 0xF, false));
    x += __builtin_bit_cast(float, __builtin_amdgcn_update_dpp(0, __builtin_bit_cast(int, x), 0x143, 0xC, 0xF, false));
    return rl_f(x, 63); }
__device__ __forceinline__ float sigmoidf_(float x) { return __builtin_amdgcn_rcpf(1.0f + __expf(-x)); }
__device__ __forceinline__ float tanhf_(float x) { return 1.0f - 2.0f * __builtin_amdgcn_rcpf(1.0f + __expf(2.0f * x)); }

namespace pg8 {
constexpr int BM = 256, BK = 64, HALF = 128, HTB = HALF * BK * 2, STAGE_BYTES = 8 * HTB, NXCD = 8, WGM = 8;
__host__ __device__ __forceinline__ int lds_byte(int r, int c) { const int st = (r >> 4) * 2 + (c >> 5), rr = r & 15, cc = c & 31, ob = rr * 64 + cc * 2; return st * 1024 + (ob ^ (((ob >> 9) & 1) << 5)); }
__host__ __device__ __forceinline__ void stage_rc(int b, int& R, int& C) { const int st = b / 1024, sb = b % 1024, swz = sb ^ (((sb >> 9) & 1) << 5); R = (st >> 1) * 16 + swz / 64; C = (st & 1) * 32 + (swz % 64) / 2; }
__host__ __device__ __forceinline__ int perm32(int rho) { const int n = rho >> 4, i = rho & 15; return 8 * (i >> 2) + 4 * n + (i & 3); }
struct Unit { int pm, pn, kt0, nkt, sp; };
struct Gemm { const h16* A; const h16* Bt; int M, N, K; };
struct Order {
    int nM, nN, nwg, G, c, extra, nkt, nsplit;
    __device__ void init(int M, int N, int K, int G_, int c_, int extra_, int nMw) { nM = M / BM; nN = N / BM; nwg = (nMw < 0 ? nM : nMw) * nN; G = G_; c = c_; extra = extra_; nkt = K / BK; nsplit = nMw < 0 ? 0 : (nM - nMw) * nN * 4; }
    __device__ bool next(int i, Unit& u) const {
        const long L = (long)i * G + c; if (L >= nwg + extra + nsplit) return false;
        u.kt0 = 0; u.nkt = nkt; u.sp = -1;
        if (L >= nwg + extra) { const int j = (int)(L - nwg - extra), rows = nM - nwg / nN; u.nkt = nkt >> 2;
            if (rows == 8 && nN == 8) {
                const int xcd = j & 7, idx = j >> 3; u.sp = xcd >> 1; u.pn = 4 * (xcd & 1) + (idx >> 3); u.pm = nwg / nN + (idx & 7); }
            else { const int tile = j >> 2; u.sp = j & 3; u.pm = nwg / nN + tile % rows; u.pn = tile / rows; }
            u.kt0 = u.sp * u.nkt; return true; }
        if (L >= nwg) { u.pm = nM; u.pn = (int)(L - nwg); return true; }
        const int nMe = nwg / nN;
        int wgid = (int)L; { const int q = nwg / NXCD, r = nwg % NXCD, xcd = wgid % NXCD, off = wgid / NXCD; wgid = (xcd < r ? xcd * (q + 1) : r * (q + 1) + (xcd - r) * q) + off; }
        const int nig = WGM * nN, gid = wgid / nig, fm = gid * WGM, gsz = (nMe - fm) < WGM ? (nMe - fm) : WGM;
        u.pm = fm + ((wgid % nig) % gsz); u.pn = (wgid % nig) / gsz; return true;
    }
};

__device__ __forceinline__ void lora_k(Unit& u) { const int typ = u.pn >> 3; u.kt0 = typ == 0 ? 0 : typ == 1 ? 1 : 3; u.nkt = typ == 2 ? 4 : 2; }
template <class Epi, bool LORAK = false, bool SP2 = true, bool ALIGN_EPI = true>
__device__ __forceinline__ void gemm_phase(LAS unsigned char* lds, const Gemm g, const Order& S, const Epi& E) {
    const int tid = threadIdx.x, wid = __builtin_amdgcn_readfirstlane(tid >> 6), lane = tid & 63, wr = wid >> 2, wc = wid & 3, fr = lane & 15, fq = lane >> 4;
    const int K = g.K;
    unsigned voffA[2], voffB[2];
#pragma unroll
    for (int i = 0; i < 2; ++i) { int R, C; stage_rc(tid * 16 + i * 8192, R, C); const int Rb = Epi::PERM ? ((R & ~31) + perm32(R & 31)) : R;
        voffA[i] = (unsigned)(R * K + C) * 2u; voffB[i] = (unsigned)(Rb * K + C) * 2u; }
    const size_t kstep = (size_t)(BK * 2);
    const size_t hstep = (size_t)HALF * K * 2;
    const size_t tstep = 2 * hstep;
    const unsigned ldsw = (unsigned)wid * 1024u;
    const int aoff = lds_byte(wr * 64 + fr, fq * 8), boff = lds_byte(wc * 32 + fr, fq * 8);
#define PG8_SA(b, h) (((b) * 2 + (h)) * HTB)
#define PG8_SB(b, h) ((4 + (b) * 2 + (h)) * HTB)
#define PG8_STAGE(bufoff, gbase, voff) do { _Pragma("unroll") for (int _i = 0; _i < 2; ++_i) \
        __builtin_amdgcn_global_load_lds((const unsigned*)((const char*)(gbase) + (voff)[_i]), (LAS unsigned*)(lds + (bufoff) + ldsw + _i * 8192), 16, 0, 0); } while (0)
#define PG8_LDA(dst, b, h) do { _Pragma("unroll") for (int m = 0; m < 4; ++m) _Pragma("unroll") for (int k = 0; k < 2; ++k) dst[m][k] = *(const LAS h16x8*)(lds + PG8_SA(b, h) + aoff + m * 2048 + k * 1024); } while (0)
#define PG8_LDB(dst, b, h) do { _Pragma("unroll") for (int n = 0; n < 2; ++n) _Pragma("unroll") for (int k = 0; k < 2; ++k) dst[n][k] = *(const LAS h16x8*)(lds + PG8_SB(b, h) + boff + n * 2048 + k * 1024); } while (0)
#define PG8_MMA(ai, bj, At, Bt) do { __builtin_amdgcn_s_setprio(1); _Pragma("unroll") for (int m = 0; m < 4; ++m) _Pragma("unroll") for (int n = 0; n < 2; ++n) _Pragma("unroll") for (int k = 0; k < 2; ++k) \
        acc[ai][bj][m][n] = __builtin_amdgcn_mfma_f32_16x16x32_f16(Bt[n][k], At[m][k], acc[ai][bj][m][n], 0, 0, 0); __builtin_amdgcn_s_setprio(0); } while (0)
#define PG8_WAIT_V(n) asm volatile("s_waitcnt vmcnt(" #n ")" ::: "memory")
#define PG8_WAIT_L(n) asm volatile("s_waitcnt lgkmcnt(" #n ")" ::: "memory")
#define PG8_BAR __builtin_amdgcn_s_barrier()
#define PG8_SCHED __builtin_amdgcn_sched_barrier(0)
    Unit cur, nxt; int ui = 0;
    if (!S.next(0, cur)) return;
    if constexpr (LORAK) lora_k(cur);
    f32x4 acc[2][2][4][2];
#pragma unroll
    for (int a = 0; a < 2; ++a)
#pragma unroll
        for (int b = 0; b < 2; ++b)
#pragma unroll
            for (int m = 0; m < 4; ++m)
#pragma unroll
                for (int n = 0; n < 2; ++n) acc[a][b][m][n] = (f32x4){0.f, 0.f, 0.f, 0.f};
    h16x8 At[4][2], B0[2][2], B1[2][2];
    const char* cA = (const char*)g.A + (size_t)cur.pm * tstep + (size_t)cur.kt0 * kstep; const char* cB = (const char*)g.Bt + (size_t)cur.pn * tstep + (size_t)cur.kt0 * kstep;
    if constexpr (SP2) {
        PG8_STAGE(PG8_SB(0, 0), cB, voffB); PG8_STAGE(PG8_SB(0, 1), cB + hstep, voffB); PG8_STAGE(PG8_SA(0, 0), cA, voffA); PG8_STAGE(PG8_SA(0, 1), cA + hstep, voffA);
        if (wr == 1) PG8_BAR;
        PG8_WAIT_V(2); PG8_BAR;
        PG8_STAGE(PG8_SB(1, 0), cB + kstep, voffB); PG8_STAGE(PG8_SA(1, 0), cA + kstep, voffA); PG8_STAGE(PG8_SB(1, 1), cB + hstep + kstep, voffB);
        PG8_WAIT_V(6); PG8_BAR;
    } else {
        PG8_STAGE(PG8_SB(0, 0), cB, voffB); PG8_STAGE(PG8_SA(0, 0), cA, voffA); PG8_STAGE(PG8_SB(0, 1), cB + hstep, voffB); PG8_STAGE(PG8_SA(0, 1), cA + hstep, voffA);
        if (wr == 1) PG8_BAR;
        PG8_WAIT_V(4); PG8_BAR;
        PG8_STAGE(PG8_SB(1, 0), cB + kstep, voffB); PG8_STAGE(PG8_SA(1, 0), cA + kstep, voffA); PG8_STAGE(PG8_SB(1, 1), cB + hstep + kstep, voffB);
        PG8_WAIT_V(6); PG8_BAR;
    }
    for (;;) {
        const bool has_next = S.next(ui + 1, nxt);
        if constexpr (LORAK) { if (has_next) lora_k(nxt); }
        const char* nA = has_next ? (const char*)g.A + (size_t)nxt.pm * tstep + (size_t)nxt.kt0 * kstep : cA; const char* nB = has_next ? (const char*)g.Bt + (size_t)nxt.pn * tstep + (size_t)nxt.kt0 * kstep : cB;
        const int nt = cur.nkt;
        for (int t = 0; t < nt; t += 2) {
            const bool last = (t == nt - 2);
            const char* a1 = cA + (size_t)(t + 1) * kstep;
            const char* a2 = last ? nA : cA + (size_t)(t + 2) * kstep; const char* b2 = last ? nB : cB + (size_t)(t + 2) * kstep;
            const char* a3 = a2 + kstep; const char* b3 = b2 + kstep;
            if constexpr (SP2) {
            PG8_LDB(B0, 0, 0); PG8_LDB(B1, 0, 1); PG8_SCHED; PG8_LDA(At, 0, 0); PG8_STAGE(PG8_SA(1, 1), a1 + hstep, voffA);
            PG8_WAIT_V(8); PG8_WAIT_L(0); PG8_BAR; PG8_MMA(0, 0, At, B0); PG8_MMA(0, 1, At, B1); PG8_BAR; PG8_SCHED;
            PG8_LDA(At, 0, 1); PG8_STAGE(PG8_SB(0, 0), b2, voffB); PG8_STAGE(PG8_SB(0, 1), b2 + hstep, voffB); PG8_STAGE(PG8_SA(0, 0), a2, voffA);
            PG8_WAIT_V(8); PG8_WAIT_L(0); PG8_BAR; PG8_MMA(1, 0, At, B0); PG8_MMA(1, 1, At, B1); PG8_BAR; PG8_SCHED;
            PG8_LDB(B0, 1, 0); PG8_LDB(B1, 1, 1); PG8_SCHED; PG8_LDA(At, 1, 0); PG8_STAGE(PG8_SA(0, 1), a2 + hstep, voffA);
            PG8_WAIT_V(8); PG8_WAIT_L(0); PG8_BAR; PG8_MMA(0, 0, At, B0); PG8_MMA(0, 1, At, B1); PG8_BAR; PG8_SCHED;
            PG8_LDA(At, 1, 1); PG8_STAGE(PG8_SB(1, 0), b3, voffB); PG8_STAGE(PG8_SB(1, 1), b3 + hstep, voffB); PG8_STAGE(PG8_SA(1, 0), a3, voffA);
            PG8_WAIT_V(8); PG8_WAIT_L(0); PG8_BAR; PG8_MMA(1, 0, At, B0); PG8_MMA(1, 1, At, B1); PG8_BAR; PG8_SCHED;
            } else {
            PG8_LDB(B0, 0, 0); PG8_SCHED; PG8_LDA(At, 0, 0); PG8_STAGE(PG8_SA(1, 1), a1 + hstep, voffA);
            PG8_WAIT_L(8); PG8_BAR; PG8_WAIT_L(0); PG8_MMA(0, 0, At, B0); PG8_BAR; PG8_SCHED;
            PG8_LDB(B1, 0, 1); PG8_STAGE(PG8_SB(0, 0), b2, voffB);
            PG8_BAR; PG8_WAIT_L(0); PG8_MMA(0, 1, At, B1); PG8_BAR;
            PG8_LDA(At, 0, 1); PG8_STAGE(PG8_SA(0, 0), a2, voffA);
            PG8_BAR; PG8_WAIT_L(0); PG8_MMA(1, 0, At, B0); PG8_BAR; PG8_SCHED;
            PG8_STAGE(PG8_SB(0, 1), b2 + hstep, voffB);
            PG8_WAIT_V(6); PG8_BAR; PG8_MMA(1, 1, At, B1); PG8_BAR;
            PG8_LDB(B0, 1, 0); PG8_SCHED; PG8_LDA(At, 1, 0); PG8_STAGE(PG8_SA(0, 1), a2 + hstep, voffA);
            PG8_WAIT_L(8); PG8_BAR; PG8_WAIT_L(0); PG8_MMA(0, 0, At, B0); PG8_BAR; PG8_SCHED;
            PG8_LDB(B1, 1, 1); PG8_STAGE(PG8_SB(1, 0), b3, voffB);
            PG8_BAR; PG8_WAIT_L(0); PG8_MMA(0, 1, At, B1); PG8_BAR;
            PG8_LDA(At, 1, 1); PG8_STAGE(PG8_SA(1, 0), a3, voffA);
            PG8_BAR; PG8_WAIT_L(0); PG8_MMA(1, 0, At, B0); PG8_BAR; PG8_SCHED;
            PG8_STAGE(PG8_SB(1, 1), b3 + hstep, voffB);
            PG8_WAIT_V(6); PG8_BAR; PG8_MMA(1, 1, At, B1); PG8_BAR;
                    }
        }
        if constexpr (ALIGN_EPI) { if (wr == 0) PG8_BAR; }
        E(acc, cur, wr, wc, fr, fq);
        if (!has_next) break;
#pragma unroll
        for (int a = 0; a < 2; ++a)
#pragma unroll
            for (int b = 0; b < 2; ++b)
#pragma unroll
                for (int m = 0; m < 4; ++m)
#pragma unroll
                    for (int n = 0; n < 2; ++n) acc[a][b][m][n] = (f32x4){0.f, 0.f, 0.f, 0.f};
        cur = nxt; cA = nA; cB = nB; ++ui;
        if constexpr (ALIGN_EPI) { if (wr == 1) PG8_BAR; }
    }
    PG8_WAIT_V(0);
    if constexpr (!ALIGN_EPI) { if (wr == 0) PG8_BAR; }
    PG8_BAR;
#undef PG8_SA
#undef PG8_SB
#undef PG8_STAGE
#undef PG8_LDA
#undef PG8_LDB
#undef PG8_MMA
#undef PG8_WAIT_V
#undef PG8_WAIT_L
#undef PG8_BAR
#undef PG8_SCHED
}

struct EpiSwiGLU {
    static constexpr bool PERM = false;
    h16* O; int ldo;
    __device__ __forceinline__ void operator()(const f32x4 (&acc)[2][2][4][2], const Unit& u, int wr, int wc, int fr, int fq) const {
        const int row0 = u.pm * BM + wr * 64 + fr;
#pragma unroll
        for (int ai = 0; ai < 2; ++ai)
#pragma unroll
            for (int m = 0; m < 4; ++m) { h16* rowp = O + (size_t)(row0 + ai * HALF + m * 16) * ldo;
#pragma unroll
                for (int bj = 0; bj < 2; ++bj) { const int oc = (u.pn * BM + bj * HALF + wc * 32) / 2 + 4 * fq;
                    const f32x4 gt = acc[ai][bj][m][0], up = acc[ai][bj][m][1]; float o[4];
#pragma unroll
                    for (int j = 0; j < 4; ++j) o[j] = gt[j] * sigmoidf_(gt[j]) * up[j];
                    u32x2 w; w.x = pk2h(o[0], o[1]); w.y = pk2h(o[2], o[3]);
                    *(u32x2*)(rowp + oc) = w; } }
    }
};
template <bool RES16, bool OUT16> struct EpiRes {
    static constexpr bool PERM = false;
    const void* res; void* out; float* slab; float scale; int pad;
    __device__ __forceinline__ void operator()(const f32x4 (&acc)[2][2][4][2], const Unit& u, int wr, int wc, int fr, int fq) const {
        const int row0 = u.pm * BM + wr * 64 + fr, col0 = u.pn * BM + wc * 32 + 4 * fq;
        if (u.sp >= 0) {
            h16* sb = (h16*)slab + ((size_t)u.sp * MS - MP) * D;
#pragma unroll
            for (int ai = 0; ai < 2; ++ai)
#pragma unroll
                for (int m = 0; m < 4; ++m) { const size_t off = (size_t)(row0 + ai * HALF + m * 16) * D + col0;
#pragma unroll
                    for (int bj = 0; bj < 2; ++bj)
#pragma unroll
                        for (int n = 0; n < 2; ++n) { const f32x4 v = acc[ai][bj][m][n]; u32x2 w; w.x = pk2h(v[0], v[1]); w.y = pk2h(v[2], v[3]); *(u32x2*)(sb + off + bj * HALF + n * 16) = w; } }
            return;
        }
#pragma unroll
        for (int ai = 0; ai < 2; ++ai)
#pragma unroll
            for (int m = 0; m < 4; ++m) { const size_t off = (size_t)(row0 + ai * HALF + m * 16) * D + col0;
#pragma unroll
                for (int bj = 0; bj < 2; ++bj)
#pragma unroll
                    for (int n = 0; n < 2; ++n) { f32x4 rv; const size_t o_ = off + bj * HALF + n * 16;
                        if constexpr (RES16) { const h16x4 hv = *(const h16x4*)((const h16*)res + o_); rv = (f32x4){(float)hv[0], (float)hv[1], (float)hv[2], (float)hv[3]}; }
                        else rv = *(const f32x4*)((const float*)res + o_);
                        const f32x4 o = rv + scale * acc[ai][bj][m][n];
                        if constexpr (OUT16) { u32x2 w; w.x = pk2h(o[0], o[1]); w.y = pk2h(o[2], o[3]); *(u32x2*)((h16*)out + o_) = w; }
                        else *(f32x4*)((float*)out + o_) = o; } }
    }
};
struct EpiP16 {
    static constexpr bool PERM = true;
    h16* P; h16* PF;
    __device__ __forceinline__ void operator()(const f32x4 (&acc)[2][2][4][2], const Unit& u, int wr, int wc, int fr, int fq) const {
        const int row0 = u.pm * BM + wr * 64 + fr; const int kind = u.pn < 26 ? 0 : u.pn < 42 ? 1 : u.pn < 58 ? 2 : 3;
#pragma unroll
        for (int ai = 0; ai < 2; ++ai)
#pragma unroll
            for (int m = 0; m < 4; ++m) { const int row = row0 + ai * HALF + m * 16;
#pragma unroll
                for (int bj = 0; bj < 2; ++bj) { const int gcol = u.pn * BM + bj * HALF + wc * 32;
                    const f32x4 v0 = acc[ai][bj][m][0], v1 = acc[ai][bj][m][1];
                    if (kind == 0) { u32x4 w; w.x = pk2h(v0[0], v0[1]); w.y = pk2h(v0[2], v0[3]); w.z = pk2h(v1[0], v1[1]); w.w = pk2h(v1[2], v1[3]);
                        if (u.pm < MT / BM) *(u32x4*)(P + (size_t)row * PP + gcol + 8 * fq) = w;
                        else *(u32x4*)(PF + (size_t)(row - MT) * PFW + gcol + 8 * fq) = w; }
                    else if (kind == 3) { u32x4 w; w.x = pk2h(sigmoidf_(v0[0]), sigmoidf_(v0[1])); w.y = pk2h(sigmoidf_(v0[2]), sigmoidf_(v0[3])); w.z = pk2h(sigmoidf_(v1[0]), sigmoidf_(v1[1])); w.w = pk2h(sigmoidf_(v1[2]), sigmoidf_(v1[3]));
                        *(u32x4*)(P + (size_t)row * PP + C_SA + (gcol - (PFW + 8192)) + 8 * fq) = w; }
                    else { float o[4];
#pragma unroll
                        for (int j = 0; j < 4; ++j) o[j] = kind == 1 ? v0[j] * v1[j] : sigmoidf_(v1[j]) * v0[j];
                        u32x2 w; w.x = pk2h(o[0], o[1]); w.y = pk2h(o[2], o[3]);
                        *(u32x2*)(P + (size_t)row * PP + (kind == 1 ? C_U + ((gcol - PFW) >> 1) : C_Q + ((gcol - PFW - 4096) >> 1)) + 4 * fq) = w; } } }
    }
};
struct EpiEAG {
    static constexpr bool PERM = true;
    h16* O; const float* w0; const float* a0;
    __device__ __forceinline__ void operator()(const f32x4 (&acc)[2][2][4][2], const Unit& u, int wr, int wc, int fr, int fq) const {
        const int row0 = u.pm * BM + wr * 64 + fr; const int typ = u.pn >> 3;
#pragma unroll
        for (int bj = 0; bj < 2; ++bj) { const int col = u.pn * BM + bj * HALF + wc * 32 + 8 * fq;
            f32x4 b0 = (f32x4){0.f, 0.f, 0.f, 0.f}, b1 = b0;
            if (typ == 0) { b0 = *(const f32x4*)(w0 + col); b1 = *(const f32x4*)(w0 + col + 4); }
            if (typ == 1) { b0 = *(const f32x4*)(a0 + col - D); b1 = *(const f32x4*)(a0 + col - D + 4); }
#pragma unroll
            for (int ai = 0; ai < 2; ++ai)
#pragma unroll
                for (int m = 0; m < 4; ++m) { const int row = row0 + ai * HALF + m * 16;
                    f32x4 v0 = acc[ai][bj][m][0] + b0, v1 = acc[ai][bj][m][1] + b1;
                    if (typ < 2) { const float sc = typ == 0 ? 0.60653065971f : 1.0f;
#pragma unroll
                        for (int j = 0; j < 4; ++j) { v0[j] = sigmoidf_(v0[j]) * sc; v1[j] = sigmoidf_(v1[j]) * sc; } }
                    u32x4 w; w.x = pk2h(v0[0], v0[1]); w.y = pk2h(v0[2], v0[3]); w.z = pk2h(v1[0], v1[1]); w.w = pk2h(v1[2], v1[3]);
                    *(u32x4*)(O + (size_t)row * 6144 + col) = w; } }
    }
};
}


#define XB_TMO      128
#define XB_XCNT(j)  (256  + 64 * (j))
#define XB_XSUB(j)  (1280 + 64 * (j))
#define XB_XGEN(j)  (2304 + 64 * (j))
#define XB_TOP      3328
#define XB_TOPGEN   3392
#define XCD_BAR_WORDS 3456
#define XB_SPIN_CAP (1u << 22)
__device__ __forceinline__ unsigned xb_ld(unsigned* p)              { return __hip_atomic_load(p, __ATOMIC_RELAXED, __HIP_MEMORY_SCOPE_AGENT); }
__device__ __forceinline__ unsigned xb_add(unsigned* p, unsigned v) { return __hip_atomic_fetch_add(p, v, __ATOMIC_RELAXED, __HIP_MEMORY_SCOPE_AGENT); }
__device__ __forceinline__ unsigned xb_xcc_id() { return (unsigned)__builtin_amdgcn_s_getreg((3 << 11) | 20) & 0xFu; }
#define XB_SPIN(cond, bar) do { unsigned _sp = 0; while (cond) { __builtin_amdgcn_s_sleep(1); \
    if ((++_sp & 255u) == 0u) { if (xb_ld(&(bar)[XB_TMO])) break; if (_sp > XB_SPIN_CAP) { atomicAdd(&(bar)[XB_TMO], 1u); break; } } } } while (0)
struct XcdBarrier { unsigned* bar; unsigned x; volatile LAS unsigned* st; };
__device__ __forceinline__ XcdBarrier xcd_barrier_post(unsigned* bar, volatile LAS unsigned* st) {
    XcdBarrier b; b.bar = bar; b.x = xb_xcc_id(); b.st = st;
    if (threadIdx.x == 0) (void)xb_add(&bar[XB_XCNT(b.x)], 1u);
    return b;
}
__device__ __forceinline__ void xcd_barrier_complete(unsigned* bar, unsigned x, unsigned& nloc, unsigned& nx) {
    const unsigned G = gridDim.x * gridDim.y * gridDim.z;
    unsigned sum, cnt, mine, sp = 0u;
    for (;;) {
        sum = 0u; cnt = 0u; mine = 0u;
#pragma unroll
        for (unsigned j = 0; j < 16; ++j) { const unsigned c = xb_ld(&bar[XB_XCNT(j)]); sum += c; cnt += (c > 0u) ? 1u : 0u; mine = (j == x) ? c : mine; }
        if (sum == G) break;
        __builtin_amdgcn_s_sleep(1);
        if ((++sp & 255u) == 0u) { if (xb_ld(&bar[XB_TMO])) break; if (sp > XB_SPIN_CAP) { atomicAdd(&bar[XB_TMO], 1u); break; } }
    }
    nloc = mine > 0u ? mine : 1u; nx = cnt > 0u ? cnt : 1u;
}
__device__ __forceinline__ void xcd_barrier(const XcdBarrier& b) {
    asm volatile("s_waitcnt vmcnt(0)" ::: "memory");
    __syncthreads();
    if (threadIdx.x == 0) {
        unsigned* bar = b.bar;
        __builtin_amdgcn_s_waitcnt(0);
        unsigned nloc = b.st[0], nx = b.st[1];
        if (nloc == 0u) { xcd_barrier_complete(bar, b.x, nloc, nx); b.st[0] = nloc; b.st[1] = nx; }
        const unsigned old = xb_add(&bar[XB_XSUB(b.x)], 1u);
        const unsigned gen = old / nloc;
        if (old + 1u == (gen + 1u) * nloc) {
            __builtin_amdgcn_fence(__ATOMIC_RELEASE, "agent");
            asm volatile("s_waitcnt vmcnt(0)" ::: "memory");
            const unsigned og = xb_add(&bar[XB_TOP], 1u);
            const unsigned tg = og / nx;
            if (og + 1u == (tg + 1u) * nx) xb_add(&bar[XB_TOPGEN], 1u);
            else XB_SPIN(xb_ld(&bar[XB_TOPGEN]) == tg, bar);
            __builtin_amdgcn_fence(__ATOMIC_ACQUIRE, "agent");
            xb_add(&bar[XB_XGEN(b.x)], 1u);
            asm volatile("s_waitcnt vmcnt(0)" ::: "memory");
        } else {
            XB_SPIN(xb_ld(&bar[XB_XGEN(b.x)]) == gen, bar);
            __builtin_amdgcn_fence(__ATOMIC_ACQUIRE, "agent");
            asm volatile("s_waitcnt vmcnt(0)" ::: "memory");
        }
    }
    __syncthreads();
}

struct Args { const float* in[29]; float* out; unsigned char* ws; int ph_lo, ph_hi; };

__device__ __forceinline__ void cvt_item(int mode, const float* s0, const float* s1, int Nsrc, int K, h16* WT, LAS float* scr, int item, int nblk, int lane) {
    const int kb = item / nblk, nb = item % nblk, k0 = 64 * kb, n0 = 32 * nb;
    const int nn = lane & 31; const float* src = s0; int col = n0 + nn; bool zero = false;
    if (mode == 1) { src = (nn < 16) ? s0 : s1; col = (n0 >> 1) + (nn & 15); }
    if (mode == 2) { if (n0 >= NA && n0 < PFW) zero = true; else if (n0 >= PFW) col -= 64; }
#pragma unroll 8
    for (int i = 0; i < 32; ++i) { const int kk = 2 * i + (lane >> 5); scr[kk * 33 + nn] = zero ? 0.f : src[(size_t)(k0 + kk) * Nsrc + col]; }
    asm volatile("s_waitcnt lgkmcnt(0)" ::: "memory");
    const int c = lane & 7;
#pragma unroll
    for (int j = 0; j < 4; ++j) { const int n = (lane >> 3) + 8 * j; const LAS float* s = scr + (8 * c) * 33 + n;
        u32x4 o; o.x = pk2h(s[0 * 33], s[1 * 33]); o.y = pk2h(s[2 * 33], s[3 * 33]); o.z = pk2h(s[4 * 33], s[5 * 33]); o.w = pk2h(s[6 * 33], s[7 * 33]);
        *(u32x4*)(WT + (size_t)(n0 + n) * K + k0 + 8 * c) = o; }
    asm volatile("s_waitcnt lgkmcnt(0)" ::: "memory");
}
struct CvtIt { const float* p; h16* q; int Nsrc, K; bool zero; };
__device__ __forceinline__ CvtIt cvt_decode(int mode, const float* s0, const float* s1, int Nsrc, int K, h16* WT, int nblk, int item, int lane) {
    const int kb = item / nblk, nb = item % nblk, k0 = 64 * kb, n0 = 32 * nb, nn = lane & 31;
    const float* src = s0; int col = n0 + nn; bool zero = false;
    if (mode == 1) { src = (nn < 16) ? s0 : s1; col = (n0 >> 1) + (nn & 15); }
    if (mode == 2) {
        const int q = nn >> 3, sp = (nn >> 2) & 1, j = nn & 3;
        if (n0 >= NA && n0 < PFW) { zero = true; col = 0; }
        else if (n0 >= PFW && n0 < PFW + 4096) col = (sp ? NA + 2 * D : NA + D) + ((n0 - PFW) >> 1) + 4 * q + j;
        else if (n0 >= PFW + 4096 && n0 < PFW + 8192) col = (sp ? NA + 4 * D : NA) + ((n0 - PFW - 4096) >> 1) + 4 * q + j;
        else if (n0 >= PFW + 8192) col = NA + 3 * D + (n0 - PFW - 8192) + nn; }
    CvtIt r; r.p = src + (size_t)(k0 + (lane >> 5)) * Nsrc + col; r.q = WT + (size_t)(n0 + (lane >> 3)) * K + k0 + 8 * (lane & 7); r.Nsrc = Nsrc; r.K = K; r.zero = zero; return r;
}
__device__ __forceinline__ void cvt_load(const CvtIt& t, float (&v)[32]) {
#pragma unroll
    for (int i = 0; i < 32; ++i) v[i] = t.p[(size_t)(2 * i) * t.Nsrc];
}
__device__ __forceinline__ void cvt_finish(const CvtIt& t, const float (&v)[32], LAS float* scr, int lane) {
    const int nn = lane & 31;
#pragma unroll
    for (int i = 0; i < 32; ++i) scr[(2 * i + (lane >> 5)) * 33 + nn] = t.zero ? 0.f : v[i];
    asm volatile("s_waitcnt lgkmcnt(0)" ::: "memory");
    const int c = lane & 7;
#pragma unroll
    for (int j = 0; j < 4; ++j) { const int n = (lane >> 3) + 8 * j; const LAS float* s = scr + (8 * c) * 33 + n;
        u32x4 o; o.x = pk2h(s[0 * 33], s[1 * 33]); o.y = pk2h(s[2 * 33], s[3 * 33]); o.z = pk2h(s[4 * 33], s[5 * 33]); o.w = pk2h(s[6 * 33], s[7 * 33]);
        *(u32x4*)(t.q + (size_t)(8 * j) * t.K) = o; }
    asm volatile("s_waitcnt lgkmcnt(0)" ::: "memory");
}
#define CVT_RUN(total_, PICK) do { float va[32], vb[32]; CvtIt A_, B_; int it_ = gw; if (it_ < (total_)) { PICK(it_, A_); cvt_load(A_, va); \
        for (;;) { const int itb_ = it_ + NGW; const bool hb_ = itb_ < (total_); if (hb_) { PICK(itb_, B_); cvt_load(B_, vb); } cvt_finish(A_, va, scr, lane); if (!hb_) break; \
            it_ = itb_ + NGW; const bool ha_ = it_ < (total_); if (ha_) { PICK(it_, A_); cvt_load(A_, va); } cvt_finish(B_, vb, scr, lane); if (!ha_) break; } } } while (0)
__device__ __forceinline__ void cvt_lora_item(const float* wl, const float* al, const float* gl, h16* WT, int item, int lane) {
    const int n = item, typ = n >> 11, col = n & 2047; unsigned w[4];
#pragma unroll
    for (int j = 0; j < 4; ++j) { float v[2];
#pragma unroll
        for (int e = 0; e < 2; ++e) { const int k = lane * 8 + j * 2 + e; float x = 0.f;
            if (typ == 0 && k < 96) x = wl[(size_t)k * D + col];
            if (typ == 1 && k >= 96 && k < 192) x = al[(size_t)(k - 96) * D + col];
            if (typ == 2 && k >= 192 && k < 448) x = gl[(size_t)(k - 192) * D + col];
            v[e] = x; }
        w[j] = pk2h(v[0], v[1]); }
    *(u32x4*)(WT + (size_t)n * LK + lane * 8) = (u32x4){w[0], w[1], w[2], w[3]};
}

__device__ __forceinline__ void rms_row_f16(const float* xrow, const float* g, h16* orow, float* f32row, int lane, const h16* part = nullptr, float pscale = 0.f, float* xout = nullptr) {
    const f32x4* xr = (const f32x4*)xrow + lane; const f32x4* gr = (const f32x4*)g + lane;
    f32x4 v[8]; float s = 0.f;
#pragma unroll
    for (int j = 0; j < 8; ++j) { v[j] = xr[64 * j];
        if (part) { const h16x4* pp = (const h16x4*)part + lane + 64 * j; const size_t st = (size_t)MS * D / 4;
            const h16x4 p0 = pp[0], p1 = pp[st], p2 = pp[2 * st], p3 = pp[3 * st];
            v[j] += pscale * (((f32x4){(float)p0[0], (float)p0[1], (float)p0[2], (float)p0[3]} + (f32x4){(float)p1[0], (float)p1[1], (float)p1[2], (float)p1[3]}) + ((f32x4){(float)p2[0], (float)p2[1], (float)p2[2], (float)p2[3]} + (f32x4){(float)p3[0], (float)p3[1], (float)p3[2], (float)p3[3]}));
            if (xout) *((f32x4*)xout + lane + 64 * j) = v[j]; }
        s += (v[j].x * v[j].x + v[j].y * v[j].y) + (v[j].z * v[j].z + v[j].w * v[j].w); }
    const float rs = rsqrtf(wave_sum(s) * (1.f / D) + 1e-6f);
#pragma unroll
    for (int j = 0; j < 8; ++j) { const f32x4 gg = gr[64 * j]; const f32x4 o = v[j] * rs * gg;
        if (orow) { u32x2 w; w.x = pk2h(o.x, o.y); w.y = pk2h(o.z, o.w); *((u32x2*)orow + lane + 64 * j) = w; }
        if (f32row) *((f32x4*)f32row + lane + 64 * j) = o; }
}

__device__ __forceinline__ void rms_row_h(const h16* xrow, const float* g, h16* orow, float* f32row, int lane) {
    const f32x4* gr = (const f32x4*)g + lane;
    f32x4 v[8]; float s = 0.f;
#pragma unroll
    for (int j = 0; j < 8; ++j) { const h16x4 hv = *((const h16x4*)xrow + lane + 64 * j);
        v[j] = (f32x4){(float)hv[0], (float)hv[1], (float)hv[2], (float)hv[3]};
        s += (v[j].x * v[j].x + v[j].y * v[j].y) + (v[j].z * v[j].z + v[j].w * v[j].w); }
    const float rs = rsqrtf(wave_sum(s) * (1.f / D) + 1e-6f);
#pragma unroll
    for (int j = 0; j < 8; ++j) { const f32x4 gg = gr[64 * j]; const f32x4 o = v[j] * rs * gg;
        if (orow) { u32x2 w; w.x = pk2h(o.x, o.y); w.y = pk2h(o.z, o.w); *((u32x2*)orow + lane + 64 * j) = w; }
        if (f32row) *((f32x4*)f32row + lane + 64 * j) = o; }
}

enum { PH_CVT1 = 0, PH_FFN1_GU, PH_FFN1_D, PH_RMS_MIX, PH_WIN, PH_SHIFT, PH_LORA, PH_PREP, PH_SCAN, PH_MERGE, PH_WOUT, PH_RMS2, PH_FFN2_GU, PH_FFN2_D, PH_FINAL, PH_N };

__global__ void __launch_bounds__(NTHR, 2) fwd_kernel(Args a) {
    extern __shared__ __attribute__((aligned(16))) unsigned char lds_raw[];
    LAS unsigned char* lds = (LAS unsigned char*)lds_raw;
    const int tid = threadIdx.x, lane = tid & 63, wave = __builtin_amdgcn_readfirstlane(tid >> 6);
    const int G = gridDim.x, bx = blockIdx.x;
    const int gw = bx * NWAVES + wave, NGW = G * NWAVES;
    unsigned char* ws = a.ws; unsigned char* ob = (unsigned char*)a.out;
    h16* W1GU = (h16*)(ws + WS_W1GU); h16* W1D = (h16*)(ws + WS_W1D); h16* WIN = (h16*)(ws + WS_WIN); h16* WOUT = (h16*)(ws + WS_WOUT);
    h16* A16 = (h16*)(ws + WS_A16); h16* P16 = (h16*)(ws + WS_P16); h16* EAG = (h16*)(ws + WS_EAG); h16* HM = (h16*)(ws + WS_HM);
    h16* W2GU = (h16*)(ws + WS_W2GU); h16* W2D = (h16*)(ws + WS_W2D);
    h16* WL = (h16*)(ob + OB_WL); h16* PF = (h16*)(ws + WS_PF);
    float* Y = a.out + O_Y; float* SLAB = (float*)(ws + WS_SLAB);
    h16* XH = (h16*)(a.out + O_Y);
    const int lo = a.ph_lo, hi = a.ph_hi;
#define IN(k) (lo <= (k) && (k) < hi)
    cg::grid_group grid = cg::this_grid();
    volatile LAS unsigned* xst = (volatile LAS unsigned*)(lds + LDS_BYTES - 16);
    if (tid < 2) xst[tid] = 0u;
    if (bx == 0) { for (int i = tid; i < XCD_BAR_WORDS; i += NTHR) ((unsigned*)(ws + WS_CTL))[i] = 0u; }
    __syncthreads();
    XcdBarrier xbar; xbar.bar = (unsigned*)(ws + WS_CTL); xbar.x = xb_xcc_id(); xbar.st = xst;
#ifndef PROBE_MASK
#define PROBE_MASK 0u
#endif
#ifndef PROBE_MUL
#define PROBE_MUL 1u
#endif
    unsigned long long pr_t[PH_N + 1]; (void)pr_t;
    if (PROBE_MASK) pr_t[0] = __builtin_amdgcn_s_memrealtime();
#define SEAM(k) do { if (IN(k) && IN((k) + 1)) { if ((k) == PH_CVT1) grid.sync(); else xcd_barrier(xbar); } if (PROBE_MASK) pr_t[(k) + 1] = __builtin_amdgcn_s_memrealtime(); } while (0)

    if (IN(PH_CVT1)) {
        LAS float* scr = (LAS float*)(lds + wave * 16384);
        constexpr int I1 = (D / 64) * (2 * FF / 32), I2 = (FF / 64) * (D / 32), I3 = (D / 64) * (NW / 32), I4 = (D / 64) * (D / 32);
#define PICK1(it, out) do { int r_ = (it); if (r_ < I1) out = cvt_decode(1, a.in[6], a.in[7], FF, D, W1GU, 2 * FF / 32, r_, lane); else if ((r_ -= I1) < I2) out = cvt_decode(0, a.in[8], a.in[8], D, FF, W1D, D / 32, r_, lane); \
            else if ((r_ -= I2) < I3) out = cvt_decode(2, a.in[10], a.in[10], NIN, D, WIN, NW / 32, r_, lane); else out = cvt_decode(0, a.in[23], a.in[23], D, D, WOUT, D / 32, r_ - I3, lane); } while (0)
        CVT_RUN(I1 + I2 + I3 + I4, PICK1);
#undef PICK1
        for (int it = gw; it < 6144; it += NGW) cvt_lora_item(a.in[13], a.in[15], a.in[16], WL, it, lane);
        for (int r = gw; r < 256; r += NGW) { h16* orow = A16 + (size_t)(MT + r) * D;
#pragma unroll
            for (int j = 0; j < 8; ++j) { u32x2 w = (u32x2){0u, 0u};
                if (r < 32) { const f32x4 v = *((const f32x4*)(a.in[2] + (size_t)r * D) + lane + 64 * j); w.x = pk2h(v.x, v.y); w.y = pk2h(v.z, v.w); }
                *((u32x2*)orow + lane + 64 * j) = w; } }
        for (int m = gw; m < MT; m += NGW) { const float* xr = m < MP ? a.in[0] + (size_t)m * D : a.in[1] + (size_t)(m - MP) * D; rms_row_f16(xr, a.in[5], A16 + (size_t)m * D, nullptr, lane); }
    }
    SEAM(PH_CVT1);
    if (tid == 0) (void)xb_add(&xbar.bar[XB_XCNT(xbar.x)], 1u);
    if (IN(PH_FFN1_GU)) { pg8::Gemm g{A16, W1GU, MT, 2 * FF, D}; pg8::Order S; S.init(MT, 2 * FF, D, G, bx, 0, -1); pg8::EpiSwiGLU E{HM, FF}; pg8::gemm_phase(lds, g, S, E); }
    SEAM(PH_FFN1_GU);
    if (IN(PH_FFN1_D)) { pg8::Gemm g{HM, W1D, MT, D, FF}; pg8::Order S; S.init(MT, D, FF, G, bx, 0, MP / 256); pg8::EpiRes<false, true> E{a.in[0], XH, SLAB, 0.5f, 0}; pg8::gemm_phase(lds, g, S, E); }
    SEAM(PH_FFN1_D);
    if (IN(PH_RMS_MIX)) {
        for (int m = gw; m < MT; m += NGW) { float* so = nullptr;
            if (m < MP) { if ((m & 4095) == 4095) so = a.out + O_SHP + (size_t)(m >> 12) * D; } else { if (((m - MP) & 63) == 63) so = a.out + O_SHS + (size_t)((m - MP) >> 6) * D; }
            if (m < MP) rms_row_h(XH + (size_t)m * D, a.in[9], A16 + (size_t)m * D, so, lane);
            else rms_row_f16(a.in[1] + (size_t)(m - MP) * D, a.in[9], A16 + (size_t)m * D, so, lane, (const h16*)SLAB + (size_t)(m - MP) * D, 0.5f, Y + (size_t)m * D); }
    }
    SEAM(PH_RMS_MIX);
    if (IN(PH_WIN)) { pg8::Gemm g{A16, WIN, MT, NW, D}; pg8::Order S; S.init(MT, NW, D, G, bx, PFW / 256, -1); pg8::EpiP16 E{P16, PF}; pg8::gemm_phase(lds, g, S, E); }
    SEAM(PH_WIN);
    if (IN(PH_SHIFT)) {
        for (int item = bx * NTHR + tid; item < (MT / 16) * 768; item += G * NTHR) { const int c = item / 768, o = item % 768;
            *(u32x4*)((h16*)(ob + OB_SIDE) + (size_t)c * 6144 + o * 8) = *(const u32x4*)(P16 + (size_t)(16 * c + 15) * PP + o * 8); }
    }
    if (IN(PH_SHIFT)) {
        h16* AIN = A16; const float* mu = a.in[11];
        for (int item = bx * NTHR + tid; item < MT * 64; item += G * NTHR) {
            const int row = item >> 6, o = item & 63;
            if (o >= 56) { *(u32x4*)(AIN + (size_t)row * LK + 448 + (o - 56) * 8) = (u32x4){0u, 0u, 0u, 0u}; continue; }
            const int c0 = 6144 + o * 8;
            const bool st = row < MP ? ((row & 4095) == 0) : (((row - MP) & 63) == 0);
            const h16* pp = st ? (row < MP ? PF + (size_t)32 * PFW : PF + (size_t)((row - MP) >> 6) * PFW) + c0 : P16 + (size_t)(row - 1) * PP + c0;
            const h16x8 cv = *(const h16x8*)(P16 + (size_t)row * PP + c0), pv = *(const h16x8*)pp;
            const f32x4 m0 = *(const f32x4*)(mu + c0), m1 = *(const f32x4*)(mu + c0 + 4);
            const float mu8[8] = {m0.x, m0.y, m0.z, m0.w, m1.x, m1.y, m1.z, m1.w}; float s[8];
#pragma unroll
            for (int j = 0; j < 8; ++j) { const float cu = (float)cv[j]; s[j] = cu + mu8[j] * ((float)pv[j] - cu); }
            if (o < 12) {
#pragma unroll
                for (int j = 0; j < 8; ++j) s[j] = tanhf_(s[j]);
            } else if (o >= 24) {
#pragma unroll
                for (int j = 0; j < 8; ++j) s[j] = sigmoidf_(s[j]);
            }
            *(u32x4*)(AIN + (size_t)row * LK + o * 8) = (u32x4){pk2h(s[0], s[1]), pk2h(s[2], s[3]), pk2h(s[4], s[5]), pk2h(s[6], s[7])};
        }
    }
    SEAM(PH_SHIFT);
    if (IN(PH_LORA)) { pg8::Gemm g{A16, WL, MT, 6144, LK}; pg8::Order S; S.init(MT, 6144, LK, G, bx, 0, -1); pg8::EpiEAG E{EAG, a.in[12], a.in[14]}; pg8::gemm_phase<pg8::EpiEAG, true>(lds, g, S, E); }
    SEAM(PH_LORA);
    if (IN(PH_PREP)) {
        LAS unsigned char* sc = lds + wave * 5120;
        float* RK = (float*)(ws + WS_RK); float* LM = (float*)(ws + WS_LM);
        const int cp = lane & 31, hs = lane >> 5;
#define H2LO(x) ((float)__builtin_bit_cast(h16, (unsigned short)((x) & 0xffffu)))
#define H2HI(x) ((float)__builtin_bit_cast(h16, (unsigned short)((x) >> 16)))
#define HSUM(x_, out_) do { float y_ = row_allreduce16(x_); y_ += __builtin_bit_cast(float, __builtin_amdgcn_update_dpp(0, __builtin_bit_cast(int, y_), 0x142, 0xA, 0xF, false)); \
            const float s31_ = rl_f(y_, 31), s63_ = rl_f(y_, 63); out_ = hs ? s63_ : s31_; } while (0)
#define PREP_LOAD(item_, RR, KK, VV, EE, AA) do { const int c_ = (item_) >> 5, h_ = (item_) & 31, r0_ = 16 * c_, j2_ = h_ * 64 + 2 * cp; \
            const bool pr_ = r0_ < MP; const bool st_ = pr_ ? ((r0_ & 4095) == 0) : (((r0_ - MP) & 63) == 0); \
            const h16* pq_ = hs ? P16 + (size_t)(r0_ + 7) * PP + j2_ : (st_ ? PF + (size_t)(pr_ ? 32 : ((r0_ - MP) >> 6)) * PFW + j2_ : (const h16*)(ob + OB_SIDE) + (size_t)(c_ - 1) * 6144 + j2_); \
            const h16* pp_ = P16 + (size_t)(r0_ + 8 * hs) * PP + j2_; const h16* pe_ = EAG + (size_t)(r0_ + 8 * hs) * 6144 + j2_; \
            RR[0] = *(const unsigned*)pq_; KK[0] = *(const unsigned*)(pq_ + D); VV[0] = *(const unsigned*)(pq_ + 2 * D); \
            _Pragma("unroll") for (int s_ = 0; s_ < 8; ++s_) { RR[s_ + 1] = *(const unsigned*)(pp_ + (size_t)s_ * PP); KK[s_ + 1] = *(const unsigned*)(pp_ + (size_t)s_ * PP + D); VV[s_ + 1] = *(const unsigned*)(pp_ + (size_t)s_ * PP + 2 * D); \
                EE[s_] = *(const unsigned*)(pe_ + (size_t)s_ * 6144); AA[s_] = *(const unsigned*)(pe_ + (size_t)s_ * 6144 + D); } } while (0)
        unsigned rr[9], kk[9], vv[9], ee[8], aa[8], rrn[9], kkn[9], vvn[9], een[8], aan[8];
        if (gw < (MT / 16) * 32) PREP_LOAD(gw, rr, kk, vv, ee, aa);
        for (int item = gw; item < (MT / 16) * 32; item += NGW) {
            const int c = item >> 5, h = item & 31, row0 = 16 * c, hj2 = h * 64 + 2 * cp;
            const f32x2 c_kk = *(const f32x2*)(a.in[17] + hj2), c_ka = *(const f32x2*)(a.in[18] + hj2), c_rk = *(const f32x2*)(a.in[19] + hj2), c_mr = *(const f32x2*)(a.in[11] + hj2), c_mk = *(const f32x2*)(a.in[11] + D + hj2), c_mv = *(const f32x2*)(a.in[11] + 2 * D + hj2);
            if (item + NGW < (MT / 16) * 32) PREP_LOAD(item + NGW, rrn, kkn, vvn, een, aan);
            f32x2 Ll[8]; { f32x2 acc = (f32x2){0.f, 0.f};
#pragma unroll
                for (int s_ = 0; s_ < 8; ++s_) { acc -= (f32x2){H2LO(ee[s_]), H2HI(ee[s_])}; Ll[s_] = acc; } }
            const f32x2 oth = (f32x2){__shfl_xor(Ll[7].x, 32), __shfl_xor(Ll[7].y, 32)};
            const f32x2 M_ = hs ? oth : Ll[7]; const f32x2 L15 = M_ + (hs ? Ll[7] : oth);
            *(f32x2*)(LM + (size_t)item * 128 + 64 * hs + 2 * cp) = hs ? L15 : M_;
            const f32x2 off = hs ? (f32x2){0.f, 0.f} : M_;
            unsigned vpk[8];
            h16* eo = EAG + (size_t)(row0 + 8 * hs) * 6144 + hj2; h16* po = P16 + (size_t)(row0 + 8 * hs) * PP + hj2;
            f32x2 E3p = (f32x2){__expf(-off.x), __expf(-off.y)};
#pragma unroll
            for (int s_ = 0; s_ < 8; ++s_) { const int t = 8 * hs + s_;
                f32x2 r = (f32x2){H2LO(rr[s_ + 1]), H2HI(rr[s_ + 1])}, k = (f32x2){H2LO(kk[s_ + 1]), H2HI(kk[s_ + 1])}, v = (f32x2){H2LO(vv[s_ + 1]), H2HI(vv[s_ + 1])};
                r += c_mr * ((f32x2){H2LO(rr[s_]), H2HI(rr[s_])} - r); k += c_mk * ((f32x2){H2LO(kk[s_]), H2HI(kk[s_])} - k); v += c_mv * ((f32x2){H2LO(vv[s_]), H2HI(vv[s_])} - v);
                const f32x2 av = (f32x2){H2LO(aa[s_]), H2HI(aa[s_])};
                const f32x2 kkr = k * c_kk; float ss; HSUM(kkr.x * kkr.x + kkr.y * kkr.y, ss);
                const float rn = rsqrtf(fmaxf(ss, 1e-24f)); const f32x2 kap = kkr * rn;
                const f32x2 kmod = k * (1.f + (av - 1.f) * c_ka);
                const f32x2 Dm = Ll[s_] - off; const f32x2 E1 = E3p, E2 = (f32x2){__expf(-Dm.x), __expf(-Dm.y)}, E3 = (f32x2){__expf(Dm.x), __expf(Dm.y)}; E3p = E3;
                const f32x2 fat = kap * E1, frt = r * E3, fbb = kap * av * E2, fkb = kmod * E2;
                const unsigned hat = pk2h(fat.x, fat.y), hrt = pk2h(frt.x, frt.y), hbb = pk2h(fbb.x, fbb.y), hkb = pk2h(fkb.x, fkb.y);
                const f32x2 rkm = r * kmod * c_rk; float rk; HSUM(rkm.x + rkm.y, rk); if (cp == 0) RK[(size_t)(row0 + t) * 32 + h] = rk;
                *(unsigned*)(eo + (size_t)s_ * 6144) = hat; *(unsigned*)(eo + (size_t)s_ * 6144 + D) = hbb; *(unsigned*)(po + (size_t)s_ * PP) = hrt; *(unsigned*)(po + (size_t)s_ * PP + D) = hkb;
                ((LAS unsigned*)sc)[t * 32 + cp] = hat; ((LAS unsigned*)(sc + 2048))[t * 32 + cp] = hbb;
                vpk[s_] = pk2h(v.x, v.y);
            }
            { u32x4 lo, hi;
              lo.x = (vpk[0] & 0xffffu) | (vpk[1] << 16); lo.y = (vpk[2] & 0xffffu) | (vpk[3] << 16); lo.z = (vpk[4] & 0xffffu) | (vpk[5] << 16); lo.w = (vpk[6] & 0xffffu) | (vpk[7] << 16);
              hi.x = (vpk[0] >> 16) | (vpk[1] & 0xffff0000u); hi.y = (vpk[2] >> 16) | (vpk[3] & 0xffff0000u); hi.z = (vpk[4] >> 16) | (vpk[5] & 0xffff0000u); hi.w = (vpk[6] >> 16) | (vpk[7] & 0xffff0000u);
              const int i0 = 2 * cp;
              *(u32x4*)(P16 + (size_t)(row0 + (i0 >> 2)) * PP + 2 * D + h * 64 + (i0 & 3) * 16 + 8 * hs) = lo;
              *(u32x4*)(P16 + (size_t)(row0 + ((i0 + 1) >> 2)) * PP + 2 * D + h * 64 + ((i0 + 1) & 3) * 16 + 8 * hs) = hi; }
            asm volatile("s_waitcnt lgkmcnt(0)" ::: "memory");
            const int fr = lane & 15, fq = lane >> 4;
            f32x4 acc = (f32x4){0.f, 0.f, 0.f, 0.f};
#pragma unroll
            for (int kt = 0; kt < 4; ++kt) acc = __builtin_amdgcn_mfma_f32_16x16x16f16(*(const LAS h16x4*)(sc + (fr * 64 + 16 * kt + 4 * fq) * 2), *(const LAS h16x4*)(sc + 2048 + (fr * 64 + 16 * kt + 4 * fq) * 2), acc, 0, 0, 0);
            LAS float* Pm = (LAS float*)(sc + 4096);
#pragma unroll
            for (int g_ = 0; g_ < 4; ++g_) Pm[(4 * fq + g_) * 16 + fr] = (fr < 4 * fq + g_) ? acc[g_] : 0.f;
            asm volatile("s_waitcnt lgkmcnt(0)" ::: "memory");
            float Tc[16];
#pragma unroll
            for (int t = 0; t < 16; ++t) { float x = (t == fr) ? 1.f : 0.f;
#pragma unroll
                for (int j4 = 0; j4 < (t + 3) / 4; ++j4) { const f32x4 p4 = *(const LAS f32x4*)(Pm + t * 16 + 4 * j4);
                    if (4 * j4 + 0 < t) x -= p4.x * Tc[4 * j4 + 0]; if (4 * j4 + 1 < t) x -= p4.y * Tc[4 * j4 + 1]; if (4 * j4 + 2 < t) x -= p4.z * Tc[4 * j4 + 2]; if (4 * j4 + 3 < t) x -= p4.w * Tc[4 * j4 + 3]; }
                Tc[t] = x; }
            if (lane < 16) { h16* to = P16 + (size_t)row0 * PP + 6144 + h * 16 + fr;
#pragma unroll
                for (int t = 0; t < 16; ++t) to[(size_t)t * PP] = (h16)Tc[t]; }
            asm volatile("s_waitcnt lgkmcnt(0)" ::: "memory");
#pragma unroll
            for (int q_ = 0; q_ < 9; ++q_) { rr[q_] = rrn[q_]; kk[q_] = kkn[q_]; vv[q_] = vvn[q_]; }
#pragma unroll
            for (int q_ = 0; q_ < 8; ++q_) { ee[q_] = een[q_]; aa[q_] = aan[q_]; }
        }
#undef PREP_LOAD
#undef H2LO
#undef H2HI
#undef HSUM
    }
    SEAM(PH_PREP);
    if (IN(PH_SCAN)) {
        const int vcu = (G % 8 == 0) ? (bx % 8) * (G / 8) + bx / 8 : bx;
        constexpr int RAWB = 12288, NSL = 7, CSET = 2560, O_RAW = 0, O_CO = NSL * RAWB, O_YB = O_CO + 2 * CSET;
        static_assert(O_YB + 2 * 2048 <= LDS_BYTES - 16, "scan LDS map");
        h16* OUT16 = A16; const float* LM = (const float*)(ws + WS_LM);
        const bool pblk = vcu < 64;
        const int nitem = pblk ? 1 : (1024 - (vcu - 64) + 191) / 192;
        const int NCHB = pblk ? 256 : 4 * nitem;
#define SC_DESC(cc, prompt, sq, h, t0, first, last) \
        const bool prompt = pblk; bool first, last; int sq, h, t0; \
        if (prompt) { sq = vcu >> 5; h = vcu & 31; t0 = 16 * (cc); first = (cc) == 0; last = (cc) == 255; } \
        else { const int pair = (vcu - 64) + 192 * ((cc) >> 2); sq = pair >> 5; h = pair & 31; t0 = 16 * ((cc) & 3); first = ((cc) & 3) == 0; last = ((cc) & 3) == 3; }
#define SC_DMA(cc) do { if ((cc) < NCHB) { SC_DESC(cc, prompt_, sq_, h_, t0_, first_, last_); (void)last_; (void)first_; \
            const size_t rowb_ = (size_t)(prompt_ ? sq_ * 4096 : MP + sq_ * 64) + t0_; \
            LAS unsigned char* dst_ = lds + O_RAW + ((cc) % NSL) * RAWB; \
            const int sw_ = ((lane & 7) ^ (lane >> 3)) * 8;     \
            const h16* e0_ = EAG + (rowb_ + (lane >> 3)) * 6144 + h_ * 64 + sw_; const h16* p0_ = P16 + (rowb_ + (lane >> 3)) * PP + h_ * 64 + sw_; \
            __builtin_amdgcn_global_load_lds((const unsigned*)(e0_), (LAS unsigned*)(dst_), 16, 0, 0); \
            __builtin_amdgcn_global_load_lds((const unsigned*)(e0_ + 8 * 6144), (LAS unsigned*)(dst_ + 1024), 16, 0, 0); \
            __builtin_amdgcn_global_load_lds((const unsigned*)(p0_), (LAS unsigned*)(dst_ + 2048), 16, 0, 0); \
            __builtin_amdgcn_global_load_lds((const unsigned*)(p0_ + 8 * PP), (LAS unsigned*)(dst_ + 3072), 16, 0, 0); \
            __builtin_amdgcn_global_load_lds((const unsigned*)(e0_ + D), (LAS unsigned*)(dst_ + 4096), 16, 0, 0); \
            __builtin_amdgcn_global_load_lds((const unsigned*)(e0_ + D + 8 * 6144), (LAS unsigned*)(dst_ + 5120), 16, 0, 0); \
            __builtin_amdgcn_global_load_lds((const unsigned*)(p0_ + D), (LAS unsigned*)(dst_ + 6144), 16, 0, 0); \
            __builtin_amdgcn_global_load_lds((const unsigned*)(p0_ + D + 8 * PP), (LAS unsigned*)(dst_ + 7168), 16, 0, 0); \
            __builtin_amdgcn_global_load_lds((const unsigned*)(p0_ - sw_ + (lane & 7) * 8 + 2 * D), (LAS unsigned*)(dst_ + 8192), 16, 0, 0); \
            __builtin_amdgcn_global_load_lds((const unsigned*)(p0_ - sw_ + (lane & 7) * 8 + 2 * D + 8 * PP), (LAS unsigned*)(dst_ + 9216), 16, 0, 0); \
            __builtin_amdgcn_global_load_lds((const unsigned*)(P16 + (rowb_ + ((lane & 31) >> 1)) * PP + 6144 + h_ * 16 + (lane & 1) * 8), (LAS unsigned*)(dst_ + 10240), 16, 0, 0); \
            __builtin_amdgcn_global_load_lds((const unsigned*)(LM + ((rowb_ >> 4) * 32 + h_) * 128 + (lane & 31) * 4), (LAS unsigned*)(dst_ + 11264), 16, 0, 0); } } while (0)
#define MF(a_, b_, c_) __builtin_amdgcn_mfma_f32_16x16x32_f16(a_, b_, c_, 0, 0, 0)
#define CAT8(lo_, hi_) ((h16x8){(lo_)[0], (lo_)[1], (lo_)[2], (lo_)[3], (hi_)[0], (hi_)[1], (hi_)[2], (hi_)[3]})
#define SC_C(cc) do { if ((cc) >= 0 && (cc) < NCHB) { \
            const LAS unsigned char* rs = lds + O_RAW + ((cc) % NSL) * RAWB; LAS unsigned char* co = lds + O_CO + ((cc) & 1) * CSET; \
            const int fr = lane & 15, fq = lane >> 4; const int oa = wave == 4 ? 0 : 2048, ob_ = wave == 6 ? 4096 : 6144; \
            f32x4 acc = (f32x4){0.f, 0.f, 0.f, 0.f}; \
            _Pragma("unroll") for (int kb = 0; kb < 2; ++kb) { const int o_ = fr * 128 + (((4 * kb + fq) ^ (fr & 7)) << 4); acc = MF(*(const LAS h16x8*)(rs + oa + o_), *(const LAS h16x8*)(rs + ob_ + o_), acc); } \
            _Pragma("unroll") for (int g_ = 0; g_ < 4; ++g_) { const int t = 4 * fq + g_; const bool keep = wave == 4 ? (fr < t) : (fr <= t); ((LAS h16*)(co + (wave - 4) * 512))[t * 16 + fr] = (h16)(keep ? acc[g_] : 0.f); } \
            if (wave == 4) { const float M_ = ((const LAS float*)(rs + 11264))[lane], L15 = ((const LAS float*)(rs + 11264 + 256))[lane]; \
                ((LAS float*)(co + 1536))[lane] = __expf(M_); ((LAS float*)(co + 1792))[lane] = __expf(L15 - M_); ((LAS float*)(co + 2048))[lane] = __expf(L15); } } } while (0)
        f32x4 St[4];
#pragma unroll
        for (int n = 0; n < 4; ++n) St[n] = (f32x4){0.f, 0.f, 0.f, 0.f};
#define CVT4(x_) ((h16x4){(h16)(x_)[0], (h16)(x_)[1], (h16)(x_)[2], (h16)(x_)[3]})
#define TRR(p_) __builtin_bit_cast(h16x4, __builtin_amdgcn_ds_read_tr16_b64_v4i16((LAS s16x4*)(p_)))
#define SC_ROW(cc, PROMPT) do { if ((cc) >= 0 && (cc) < NCHB) { SC_DESC(cc, prompt, sq, h, t0, first, last); \
            const int fr = lane & 15, fq = lane >> 4; \
            float* sp = a.out + (prompt ? O_WKP : O_WKS) + ((size_t)(sq * 32 + h) * 64 + 16 * wave + fr) * 64 + 4 * fq; \
            if (first) { _Pragma("unroll") for (int n = 0; n < 4; ++n) { St[n] = (f32x4){0.f, 0.f, 0.f, 0.f}; if (!(PROMPT)) St[n] = *(const f32x4*)(a.in[4] + ((size_t)(sq * 32 + h) * 64 + 16 * wave + fr) * 64 + 16 * n + 4 * fq); } } \
            LAS unsigned char* rs = lds + O_RAW + ((cc) % NSL) * RAWB; const LAS unsigned char* co = lds + O_CO + ((cc) & 1) * CSET; \
              \
            f32x4 em[4], gm[4], e4[4]; h16x4 atl[2][2], rtl[2][2], kbt[4], bbt[4]; \
            _Pragma("unroll") for (int n = 0; n < 4; ++n) { em[n] = *(const LAS f32x4*)(co + 1536 + (16 * n + 4 * fq) * 4); gm[n] = *(const LAS f32x4*)(co + 2048 + (16 * n + 4 * fq) * 4); e4[n] = *(const LAS f32x4*)(co + 1792 + (16 * n + 4 * fq) * 4); } \
            _Pragma("unroll") for (int b = 0; b < 2; ++b) { \
                const int o0_ = fr * 128 + (((4 * b + (fq >> 1)) ^ (fr & 7)) << 4) + 8 * (fq & 1), o1_ = fr * 128 + (((4 * b + 2 + (fq >> 1)) ^ (fr & 7)) << 4) + 8 * (fq & 1); \
                atl[b][0] = *(const LAS h16x4*)(rs + o0_); atl[b][1] = *(const LAS h16x4*)(rs + o1_); rtl[b][0] = *(const LAS h16x4*)(rs + 2048 + o0_); rtl[b][1] = *(const LAS h16x4*)(rs + 2048 + o1_); } \
            const h16x4 vm = *(const LAS h16x4*)(rs + 8192 + ((16 * wave + fr) * 16 + 4 * fq) * 2), aak = *(const LAS h16x4*)(co + (fr * 16 + 4 * fq) * 2), tA = *(const LAS h16x4*)(rs + 10240 + (fr * 16 + 4 * fq) * 2), \
                        ark = *(const LAS h16x4*)(co + 512 + (fr * 16 + 4 * fq) * 2), arb = *(const LAS h16x4*)(co + 1024 + (fr * 16 + 4 * fq) * 2); \
            _Pragma("unroll") for (int n = 0; n < 4; ++n) { const int tr_ = 4 * fq + (fr >> 2); const int o_ = tr_ * 128 + (((2 * n + ((fr & 3) >> 1)) ^ (tr_ & 7)) << 4) + 8 * (fr & 1); kbt[n] = TRR(rs + 6144 + o_); bbt[n] = TRR(rs + 4096 + o_); } \
            asm volatile("s_waitcnt lgkmcnt(0)" ::: "memory"); \
            const h16x4 z4 = (h16x4){(h16)0.f, (h16)0.f, (h16)0.f, (h16)0.f}; \
            h16x4 sh[4]; \
            _Pragma("unroll") for (int n = 0; n < 4; ++n) { const f32x4 x = St[n] * em[n]; sh[n] = CVT4(x); } \
            f32x4 W1 = (f32x4){0.f, 0.f, 0.f, 0.f}, Yt = W1; \
              \
            _Pragma("unroll") for (int b = 0; b < 2; ++b) { const h16x8 sb = CAT8(sh[2 * b], sh[2 * b + 1]); \
                W1 = MF(CAT8(atl[b][0], atl[b][1]), sb, W1); Yt = MF(CAT8(rtl[b][0], rtl[b][1]), sb, Yt); } \
            W1 = MF(CAT8(aak, z4), CAT8(vm, z4), W1); \
            const h16x4 w1h = CVT4(W1); \
            f32x4 U = MF(CAT8(tA, z4), CAT8(w1h, z4), ((f32x4){0.f, 0.f, 0.f, 0.f})); \
            const f32x4 nU = -U; const h16x4 uh = CVT4(nU); const h16x8 vu = CAT8(vm, uh);     \
            Yt = MF(CAT8(ark, arb), vu, Yt); \
            _Pragma("unroll") for (int n = 0; n < 4; ++n) { const f32x4 tmp = MF(CAT8(kbt[n], bbt[n]), vu, ((f32x4){0.f, 0.f, 0.f, 0.f})); St[n] = gm[n] * St[n] + e4[n] * tmp; } \
            { LAS h16* yb = (LAS h16*)(lds + O_YB + ((cc) & 1) * 2048) + (4 * fq) * 64 + 16 * wave + fr; (void)t0; \
              yb[0] = (h16)Yt[0]; yb[64] = (h16)Yt[1]; yb[128] = (h16)Yt[2]; yb[192] = (h16)Yt[3]; } \
            if (last) { _Pragma("unroll") for (int n = 0; n < 4; ++n) *(f32x4*)(sp + 16 * n) = St[n]; } } } while (0)
#define SC_YOUT(cc) do { if ((cc) >= 0 && (cc) < NCHB && wave >= 5) { SC_DESC(cc, prompt, sq, h, t0, first, last); (void)first; (void)last; \
            const int L_ = (wave - 5) * 64 + lane, t_ = L_ >> 3, part_ = L_ & 7; \
            *(u32x4*)(OUT16 + ((size_t)(prompt ? sq * 4096 : MP + sq * 64) + t0 + t_) * D + h * 64 + part_ * 8) = *(const LAS u32x4*)(lds + O_YB + ((cc) & 1) * 2048 + t_ * 128 + part_ * 16); } } while (0)
#define SC_BARRIER() do { asm volatile("s_waitcnt lgkmcnt(0)" ::: "memory"); __builtin_amdgcn_s_barrier(); asm volatile("" ::: "memory"); } while (0)
        if (wave < 4) {
            SC_BARRIER();
            if (pblk) { for (int it = -1; it <= NCHB; ++it) { SC_ROW(it, true); SC_BARRIER(); } }
            else { for (int it = -1; it <= NCHB; ++it) { SC_ROW(it, false); SC_BARRIER(); } }
        } else if (wave == 7) {
            SC_DMA(0); SC_DMA(1); SC_DMA(2); SC_DMA(3); SC_DMA(4);
            asm volatile("s_waitcnt vmcnt(48)" ::: "memory");
            SC_BARRIER();
            for (int it = -1; it <= NCHB; ++it) {
                SC_DMA(it + 6);
                if (it + 6 < NCHB) asm volatile("s_waitcnt vmcnt(48)" ::: "memory");
                else asm volatile("s_waitcnt vmcnt(0)" ::: "memory");
                SC_BARRIER();
            }
        } else {
            SC_BARRIER();
            for (int it = -1; it <= NCHB; ++it) { SC_C(it + 1); SC_YOUT(it - 1); SC_BARRIER(); }
        }
        if (!pblk) {
            __syncthreads();
            LAS float* scr = (LAS float*)(lds + wave * 16384);
            constexpr int I1 = (D / 64) * (2 * FF / 32), I2 = (FF / 64) * (D / 32);
            const int gw = (vcu - 64) * NWAVES + wave, NGW = (G - 64) * NWAVES;
#define PICK2(it, out) do { int r_ = (it); if (r_ < I1) out = cvt_decode(1, a.in[25], a.in[26], FF, D, W2GU, 2 * FF / 32, r_, lane); else out = cvt_decode(0, a.in[27], a.in[27], D, FF, W2D, D / 32, r_ - I1, lane); } while (0)
            CVT_RUN(I1 + I2, PICK2);
#undef PICK2
        }
#undef SC_DESC
#undef SC_DMA
#undef MF
#undef CAT8
#undef SC_C
#undef CVT4
#undef TRR
#undef SC_ROW
#undef SC_BARRIER
#undef SC_YOUT
    }
    SEAM(PH_SCAN);
    if (IN(PH_MERGE)) {
        const float* RK = (const float*)(ws + WS_RK);
        const int o8 = tid & 255, c0 = o8 * 8, hd = o8 >> 3, rg = tid >> 8;
        float w0[8], w1[8], w2[8], lg[8], lb[8];
#pragma unroll
        for (int j = 0; j < 8; ++j) { w0[j] = a.in[22][c0 + j]; w1[j] = a.in[22][D + c0 + j]; w2[j] = a.in[22][2 * D + c0 + j]; lg[j] = a.in[20][c0 + j]; lb[j] = a.in[21][c0 + j]; }
        for (int c = bx; c < MT / 16; c += G) {
            const int row0 = 16 * c + 8 * rg;
            const bool pr = row0 < MP; const int tt0 = pr ? (row0 & 4095) : ((row0 - MP) & 63), sq = pr ? (row0 >> 12) : ((row0 - MP) >> 6), T = pr ? 4096 : 64;
            h16x8 vt[8];
            { const h16* vb = P16 + (size_t)(16 * c + ((c0 & 63) >> 2)) * PP + 2 * D + (c0 & ~63) + 8 * rg;
#pragma unroll
              for (int j = 0; j < 8; ++j) vt[j] = *(const h16x8*)(vb + (size_t)(j >> 2) * PP + (j & 3) * 16); }
            float u1[8], u2[8];
            { const h16* prow = P16 + (size_t)row0 * PP;
              if (tt0 >= 2) { const h16x8 p1 = *(const h16x8*)(prow - PP + C_U + c0), p2 = *(const h16x8*)(prow - 2 * PP + C_U + c0);
#pragma unroll
                  for (int j = 0; j < 8; ++j) { u1[j] = (float)p1[j]; u2[j] = (float)p2[j]; }
              } else {
#pragma unroll
                  for (int j = 0; j < 8; ++j) { u2[j] = pr ? 0.f : a.in[3][(size_t)sq * 2 * D + c0 + j]; u1[j] = pr ? 0.f : a.in[3][(size_t)sq * 2 * D + D + c0 + j]; } } }
#pragma unroll
            for (int hf = 0; hf < 4; ++hf) {
                h16x8 ov[2], gv[2], uu[2], qq[2], sa[2]; float rk[2];
#pragma unroll
                for (int r = 0; r < 2; ++r) { const int row = row0 + 2 * hf + r; const h16* prow = P16 + (size_t)row * PP;
                    ov[r] = *(const h16x8*)(A16 + (size_t)row * D + c0); gv[r] = *(const h16x8*)(EAG + (size_t)row * 6144 + 2 * D + c0);
                    uu[r] = *(const h16x8*)(prow + C_U + c0); qq[r] = *(const h16x8*)(prow + C_Q + c0); sa[r] = *(const h16x8*)(prow + C_SA + c0);
                    rk[r] = RK[(size_t)row * 32 + hd]; }
#pragma unroll
                for (int r = 0; r < 2; ++r) { const int row = row0 + 2 * hf + r, tt = tt0 + 2 * hf + r;
                    float of[8], s1 = 0.f;
#pragma unroll
                    for (int j = 0; j < 8; ++j) { of[j] = (float)ov[r][j]; s1 += of[j]; }
                    const float mean = row_allreduce8(s1) * (1.f / 64.f); float s2 = 0.f;
#pragma unroll
                    for (int j = 0; j < 8; ++j) { of[j] -= mean; s2 += of[j] * of[j]; }
                    const float rstd = rsqrtf(row_allreduce8(s2) * (1.f / 64.f) + 64e-5f);
                    float mg[8], u0[8];
#pragma unroll
                    for (int j = 0; j < 8; ++j) {
                        const float vs = (float)vt[j][2 * hf + r];
                        const float ya = (of[j] * rstd * lg[j] + lb[j] + rk[r] * vs) * (float)gv[r][j];
                        u0[j] = (float)uu[r][j];
                        const float cv = w0[j] * u2[j] + w1[j] * u1[j] + w2[j] * u0[j];
                        mg[j] = (float)sa[r][j] * ya + (float)qq[r][j] * cv; u2[j] = u1[j]; u1[j] = u0[j]; }
                    *(u32x4*)(A16 + (size_t)row * D + c0) = (u32x4){pk2h(mg[0], mg[1]), pk2h(mg[2], mg[3]), pk2h(mg[4], mg[5]), pk2h(mg[6], mg[7])};
                    if (tt >= T - 2) { float* q = a.out + (pr ? O_CVP : O_CVS) + (size_t)sq * 2 * D + (size_t)(tt - (T - 2)) * D + c0;
                        *(f32x4*)q = (f32x4){u0[0], u0[1], u0[2], u0[3]}; *(f32x4*)(q + 4) = (f32x4){u0[4], u0[5], u0[6], u0[7]}; }
                }
            }
        }
    }
    SEAM(PH_MERGE);
    if (IN(PH_WOUT)) {
        { pg8::Gemm g{A16, WOUT, MT, D, D}; pg8::Order S; S.init(MT, D, D, G, bx, 0, MP / 256); pg8::EpiRes<true, true> E{XH, XH, SLAB, 1.0f, 0}; pg8::gemm_phase(lds, g, S, E); }
    }
    SEAM(PH_WOUT);
    if (IN(PH_RMS2)) { for (int m = gw; m < MT; m += NGW) { if (m < MP) rms_row_h(XH + (size_t)m * D, a.in[24], A16 + (size_t)m * D, nullptr, lane);
            else rms_row_f16(Y + (size_t)m * D, a.in[24], A16 + (size_t)m * D, nullptr, lane, (const h16*)SLAB + (size_t)(m - MP) * D, 1.0f, Y + (size_t)m * D); } }
    SEAM(PH_RMS2);
    if (IN(PH_FFN2_GU)) { pg8::Gemm g{A16, W2GU, MT, 2 * FF, D}; pg8::Order S; S.init(MT, 2 * FF, D, G, bx, 0, -1); pg8::EpiSwiGLU E{HM, FF}; pg8::gemm_phase(lds, g, S, E); }
    SEAM(PH_FFN2_GU);
    if (IN(PH_FFN2_D)) { pg8::Gemm g{HM, W2D, MT, D, FF}; pg8::Order S; S.init(MT, D, FF, G, bx, 0, MP / 256); pg8::EpiRes<true, true> E{XH, A16, SLAB, 0.5f, 0}; pg8::gemm_phase(lds, g, S, E); }
    SEAM(PH_FFN2_D);
    if (IN(PH_FINAL)) { for (int m = gw; m < MT; m += NGW) { if (m < MP) rms_row_h(A16 + (size_t)m * D, a.in[28], nullptr, Y + (size_t)m * D, lane);
            else rms_row_f16(Y + (size_t)m * D, a.in[28], nullptr, Y + (size_t)m * D, lane, (const h16*)SLAB + (size_t)(m - MP) * D, 0.5f, nullptr); } }
    if (PROBE_MASK) {
        pr_t[PH_N] = __builtin_amdgcn_s_memrealtime();
        if (bx == 0 && tid == 0) { unsigned long long tot = 0;
#pragma unroll
            for (int k = 0; k < PH_N; ++k) if ((PROBE_MASK >> k) & 1u) tot += pr_t[k + 1] - pr_t[k];
            const unsigned long long t0 = __builtin_amdgcn_s_memrealtime();
            while (__builtin_amdgcn_s_memrealtime() - t0 < tot * PROBE_MUL) __builtin_amdgcn_s_sleep(8);
        }
    }
#undef IN
#undef SEAM
}

extern "C" void kernel_launch(void* const* d_in, const int* in_sizes, int n_in, void* d_out, int out_size, void* d_ws, size_t ws_size, hipStream_t stream) {
    static int grid = 0;
    if (grid == 0) {
        if (n_in != 29 || (size_t)out_size != O_END || ws_size < WS_END) { fprintf(stderr, "kernel_launch: unexpected shapes (n_in %d out %d ws %zu need %zu)\n", n_in, out_size, ws_size, (size_t)WS_END); grid = -1; return; }
        int dev = 0, cus = 0, per_cu = 0;
        if (hipGetDevice(&dev) != hipSuccess || hipDeviceGetAttribute(&cus, hipDeviceAttributeMultiprocessorCount, dev) != hipSuccess) { grid = -1; return; }
        if (hipFuncSetAttribute((const void*)fwd_kernel, hipFuncAttributeMaxDynamicSharedMemorySize, LDS_BYTES) != hipSuccess) { grid = -1; return; }
        if (hipOccupancyMaxActiveBlocksPerMultiprocessor(&per_cu, (const void*)fwd_kernel, NTHR, LDS_BYTES) != hipSuccess || per_cu < 1) { fprintf(stderr, "kernel_launch: occupancy query failed (%d)\n", per_cu); grid = -1; return; }
        grid = cus;
    }
    if (grid < 0) return;
    Args a{};
    for (int i = 0; i < 29; ++i) a.in[i] = (const float*)d_in[i];
    a.out = (float*)d_out; a.ws = (unsigned char*)d_ws; a.ph_lo = 0; a.ph_hi = PH_N;
    void* kargs[] = {&a};
    hipError_t e = hipLaunchCooperativeKernel((const void*)fwd_kernel, dim3(grid), dim3(NTHR), kargs, LDS_BYTES, stream);
    if (e != hipSuccess) fprintf(stderr, "kernel_launch: cooperative launch failed: %s (grid %d)\n", hipGetErrorString(e), grid);
}
```

```cpp
#include <hip/hip_runtime.h>
#include <hip/hip_cooperative_groups.h>
#include <cstdio>
namespace cg = cooperative_groups;

#define LAS __attribute__((address_space(3)))
typedef _Float16 h16;
typedef _Float16 h16x2 __attribute__((ext_vector_type(2)));
typedef _Float16 h16x4 __attribute__((ext_vector_type(4)));
typedef _Float16 h16x8 __attribute__((ext_vector_type(8)));
typedef short s16x4 __attribute__((ext_vector_type(4)));
typedef float f32x4 __attribute__((ext_vector_type(4)));
typedef float f32x2 __attribute__((ext_vector_type(2)));
typedef unsigned u32x4 __attribute__((ext_vector_type(4)));
typedef unsigned u32x2 __attribute__((ext_vector_type(2)));

constexpr int D = 2048, FF = 5632, NA = 6592, NIN = 16832;
constexpr int MP = 8192, MS = 2048, MT = MP + MS;
constexpr int MA = MT + 256;
constexpr int PP = 12800;
constexpr int NW = 16896;
constexpr int PFW = 6656;
constexpr int C_U = 6656, C_Q = 8704, C_SA = 10752;
constexpr int LK = 512;
constexpr int NCHUNK = MT / 64;
constexpr size_t O_Y = 0, O_SHP = 20971520, O_CVP = 20975616, O_WKP = 20983808, O_SHS = 21245952, O_CVS = 21311488, O_WKS = 21442560, O_END = 25636864;
constexpr size_t WS_CTL = 0;
constexpr size_t WS_W1GU = 1u << 20;
constexpr size_t WS_W1D = WS_W1GU + (size_t)2 * FF * D * 2;
constexpr size_t WS_WIN = WS_W1D + (size_t)D * FF * 2;
constexpr size_t WS_WOUT = WS_WIN + (size_t)NW * D * 2;
constexpr size_t WS_A16 = WS_WOUT + (size_t)D * D * 2;
constexpr size_t WS_P16 = WS_A16 + (size_t)MA * D * 2;
constexpr size_t WS_W2GU = WS_P16 + (size_t)MT * PP * 2;
constexpr size_t WS_W2D = WS_W2GU + (size_t)2 * FF * D * 2;
constexpr size_t WS_PF = WS_W2D + (size_t)D * FF * 2;
constexpr size_t WS_END = WS_PF + (size_t)256 * PFW * 2;
constexpr size_t WS_EAG = WS_W1GU;
constexpr size_t WS_HM = WS_P16;
constexpr size_t WS_SLAB = WS_HM + (size_t)MT * FF * 2;
static_assert((size_t)MT * 6144 * 2 <= WS_WOUT - WS_W1GU, "EAG overlay");
static_assert(WS_SLAB + (size_t)4 * MS * D * 4 <= WS_W2GU, "HM + slab overlay of P16");
constexpr size_t OB_WL = O_WKS * 4;
constexpr size_t OB_SIDE = OB_WL + (size_t)6144 * LK * 2;
static_assert(OB_SIDE + (size_t)(MT / 16) * 6144 * 2 <= O_END * 4, "d_out scratch");

constexpr size_t WS_RK = WS_EAG + (size_t)MT * 6144 * 2;
constexpr size_t WS_LM = WS_RK + (size_t)MT * 32 * 4;
static_assert(WS_LM + (size_t)(MT / 16) * 32 * 128 * 4 <= WS_WOUT, "RK + LM");
constexpr int SC_SLOT = 6 * 64, SC_BUF = 16 * SC_SLOT;
constexpr int NWAVES = 8, NTHR = 512;
constexpr int LDS_BYTES = 147456;

__device__ __forceinline__ unsigned pk2h(float a, float b) { h16x2 v = {(h16)a, (h16)b}; return __builtin_bit_cast(unsigned, v); }
__device__ __forceinline__ float wave_sum(float v) {
#pragma unroll
    for (int o = 1; o < 64; o <<= 1) v += __shfl_xor(v, o);
    return v;
}
template <int CTRL> __device__ __forceinline__ float dpp_f(float x) { return __builtin_bit_cast(float, __builtin_amdgcn_update_dpp(0, __builtin_bit_cast(int, x), CTRL, 0xF, 0xF, false)); }
__device__ __forceinline__ float row_allreduce8(float x) { x += dpp_f<0xB1>(x); x += dpp_f<0x4E>(x); x += dpp_f<0x141>(x); return x; }
__device__ __forceinline__ float row_allreduce16(float x) { x = row_allreduce8(x); x += dpp_f<0x140>(x); return x; }
__device__ __forceinline__ float rl_f(float x, int l) { return __builtin_bit_cast(float, __builtin_amdgcn_readlane(__builtin_bit_cast(int, x), l)); }
__device__ __forceinline__ float wave_sum_dpp(float x) { x = row_allreduce16(x); return (rl_f(x, 0) + rl_f(x, 16)) + (rl_f(x, 32) + rl_f(x, 48)); }
__device__ __forceinline__ float wave_sum_bc(float x) {
    x = row_allreduce16(x);
    x += __builtin_bit_cast(float, __builtin_amdgcn_update_dpp(0, __builtin_bit_cast(int, x), 0x142, 0xA, 0xF, false));
    x += __builtin_bit_cast(float, __builtin_amdgcn_update_dpp(0, __builtin_bit_cast(int, x), 0x143, 0xC, 0xF, false));
    return rl_f(x, 63); }
__device__ __forceinline__ float sigmoidf_(float x) { return __builtin_amdgcn_rcpf(1.0f + __expf(-x)); }
__device__ __forceinline__ float tanhf_(float x) { return 1.0f - 2.0f * __builtin_amdgcn_rcpf(1.0f + __expf(2.0f * x)); }

namespace pg8 {
constexpr int BM = 256, BK = 64, HALF = 128, HTB = HALF * BK * 2, STAGE_BYTES = 8 * HTB, NXCD = 8, WGM = 8;
__host__ __device__ __forceinline__ int lds_byte(int r, int c) { const int st = (r >> 4) * 2 + (c >> 5), rr = r & 15, cc = c & 31, ob = rr * 64 + cc * 2; return st * 1024 + (ob ^ (((ob >> 9) & 1) << 5)); }
__host__ __device__ __forceinline__ void stage_rc(int b, int& R, int& C) { const int st = b / 1024, sb = b % 1024, swz = sb ^ (((sb >> 9) & 1) << 5); R = (st >> 1) * 16 + swz / 64; C = (st & 1) * 32 + (swz % 64) / 2; }
__host__ __device__ __forceinline__ int perm32(int rho) { const int n = rho >> 4, i = rho & 15; return 8 * (i >> 2) + 4 * n + (i & 3); }
struct Unit { int pm, pn, kt0, nkt, sp; };
struct Gemm { const h16* A; const h16* Bt; int M, N, K; };
struct Order {
    int nM, nN, nwg, G, c, extra, nkt, nsplit;
    __device__ void init(int M, int N, int K, int G_, int c_, int extra_, int nMw) { nM = M / BM; nN = N / BM; nwg = (nMw < 0 ? nM : nMw) * nN; G = G_; c = c_; extra = extra_; nkt = K / BK; nsplit = nMw < 0 ? 0 : (nM - nMw) * nN * 4; }
    __device__ bool next(int i, Unit& u) const {
        const long L = (long)i * G + c; if (L >= nwg + extra + nsplit) return false;
        u.kt0 = 0; u.nkt = nkt; u.sp = -1;
        if (L >= nwg + extra) { const int j = (int)(L - nwg - extra), rows = nM - nwg / nN; u.nkt = nkt >> 2;
            if (rows == 8 && nN == 8) {
                const int xcd = j & 7, idx = j >> 3; u.sp = xcd >> 1; u.pn = 4 * (xcd & 1) + (idx >> 3); u.pm = nwg / nN + (idx & 7); }
            else { const int tile = j >> 2; u.sp = j & 3; u.pm = nwg / nN + tile % rows; u.pn = tile / rows; }
            u.kt0 = u.sp * u.nkt; return true; }
        if (L >= nwg) { u.pm = nM; u.pn = (int)(L - nwg); return true; }
        const int nMe = nwg / nN;
        int wgid = (int)L; { const int q = nwg / NXCD, r = nwg % NXCD, xcd = wgid % NXCD, off = wgid / NXCD; wgid = (xcd < r ? xcd * (q + 1) : r * (q + 1) + (xcd - r) * q) + off; }
        const int nig = WGM * nN, gid = wgid / nig, fm = gid * WGM, gsz = (nMe - fm) < WGM ? (nMe - fm) : WGM;
        u.pm = fm + ((wgid % nig) % gsz); u.pn = (wgid % nig) / gsz; return true;
    }
};

__device__ __forceinline__ void lora_k(Unit& u) { const int typ = u.pn >> 3; u.kt0 = typ == 0 ? 0 : typ == 1 ? 1 : 3; u.nkt = typ == 2 ? 4 : 2; }
template <class Epi, bool LORAK = false, bool SP2 = true, bool ALIGN_EPI = true>
__device__ __forceinline__ void gemm_phase(LAS unsigned char* lds, const Gemm g, const Order& S, const Epi& E) {
    const int tid = threadIdx.x, wid = __builtin_amdgcn_readfirstlane(tid >> 6), lane = tid & 63, wr = wid >> 2, wc = wid & 3, fr = lane & 15, fq = lane >> 4;
    const int K = g.K;
    unsigned voffA[2], voffB[2];
#pragma unroll
    for (int i = 0; i < 2; ++i) { int R, C; stage_rc(tid * 16 + i * 8192, R, C); const int Rb = Epi::PERM ? ((R & ~31) + perm32(R & 31)) : R;
        voffA[i] = (unsigned)(R * K + C) * 2u; voffB[i] = (unsigned)(Rb * K + C) * 2u; }
    const size_t kstep = (size_t)(BK * 2);
    const size_t hstep = (size_t)HALF * K * 2;
    const size_t tstep = 2 * hstep;
    const unsigned ldsw = (unsigned)wid * 1024u;
    const int aoff = lds_byte(wr * 64 + fr, fq * 8), boff = lds_byte(wc * 32 + fr, fq * 8);
#define PG8_SA(b, h) (((b) * 2 + (h)) * HTB)
#define PG8_SB(b, h) ((4 + (b) * 2 + (h)) * HTB)
#define PG8_STAGE(bufoff, gbase, voff) do { _Pragma("unroll") for (int _i = 0; _i < 2; ++_i) \
        __builtin_amdgcn_global_load_lds((const unsigned*)((const char*)(gbase) + (voff)[_i]), (LAS unsigned*)(lds + (bufoff) + ldsw + _i * 8192), 16, 0, 0); } while (0)
#define PG8_LDA(dst, b, h) do { _Pragma("unroll") for (int m = 0; m < 4; ++m) _Pragma("unroll") for (int k = 0; k < 2; ++k) dst[m][k] = *(const LAS h16x8*)(lds + PG8_SA(b, h) + aoff + m * 2048 + k * 1024); } while (0)
#define PG8_LDB(dst, b, h) do { _Pragma("unroll") for (int n = 0; n < 2; ++n) _Pragma("unroll") for (int k = 0; k < 2; ++k) dst[n][k] = *(const LAS h16x8*)(lds + PG8_SB(b, h) + boff + n * 2048 + k * 1024); } while (0)
#define PG8_MMA(ai, bj, At, Bt) do { __builtin_amdgcn_s_setprio(1); _Pragma("unroll") for (int m = 0; m < 4; ++m) _Pragma("unroll") for (int n = 0; n < 2; ++n) _Pragma("unroll") for (int k = 0; k < 2; ++k) \
        acc[ai][bj][m][n] = __builtin_amdgcn_mfma_f32_16x16x32_f16(Bt[n][k], At[m][k], acc[ai][bj][m][n], 0, 0, 0); __builtin_amdgcn_s_setprio(0); } while (0)
#define PG8_WAIT_V(n) asm volatile("s_waitcnt vmcnt(" #n ")" ::: "memory")
#define PG8_WAIT_L(n) asm volatile("s_waitcnt lgkmcnt(" #n ")" ::: "memory")
#define PG8_BAR __builtin_amdgcn_s_barrier()
#define PG8_SCHED __builtin_amdgcn_sched_barrier(0)
    Unit cur, nxt; int ui = 0;
    if (!S.next(0, cur)) return;
    if constexpr (LORAK) lora_k(cur);
    f32x4 acc[2][2][4][2];
#pragma unroll
    for (int a = 0; a < 2; ++a)
#pragma unroll
        for (int b = 0; b < 2; ++b)
#pragma unroll
            for (int m = 0; m < 4; ++m)
#pragma unroll
                for (int n = 0; n < 2; ++n) acc[a][b][m][n] = (f32x4){0.f, 0.f, 0.f, 0.f};
    h16x8 At[4][2], B0[2][2], B1[2][2];
    const char* cA = (const char*)g.A + (size_t)cur.pm * tstep + (size_t)cur.kt0 * kstep; const char* cB = (const char*)g.Bt + (size_t)cur.pn * tstep + (size_t)cur.kt0 * kstep;
    if constexpr (SP2) {
        PG8_STAGE(PG8_SB(0, 0), cB, voffB); PG8_STAGE(PG8_SB(0, 1), cB + hstep, voffB); PG8_STAGE(PG8_SA(0, 0), cA, voffA); PG8_STAGE(PG8_SA(0, 1), cA + hstep, voffA);
        if (wr == 1) PG8_BAR;
        PG8_WAIT_V(2); PG8_BAR;
        PG8_STAGE(PG8_SB(1, 0), cB + kstep, voffB); PG8_STAGE(PG8_SA(1, 0), cA + kstep, voffA); PG8_STAGE(PG8_SB(1, 1), cB + hstep + kstep, voffB);
        PG8_WAIT_V(6); PG8_BAR;
    } else {
        PG8_STAGE(PG8_SB(0, 0), cB, voffB); PG8_STAGE(PG8_SA(0, 0), cA, voffA); PG8_STAGE(PG8_SB(0, 1), cB + hstep, voffB); PG8_STAGE(PG8_SA(0, 1), cA + hstep, voffA);
        if (wr == 1) PG8_BAR;
        PG8_WAIT_V(4); PG8_BAR;
        PG8_STAGE(PG8_SB(1, 0), cB + kstep, voffB); PG8_STAGE(PG8_SA(1, 0), cA + kstep, voffA); PG8_STAGE(PG8_SB(1, 1), cB + hstep + kstep, voffB);
        PG8_WAIT_V(6); PG8_BAR;
    }
    for (;;) {
        const bool has_next = S.next(ui + 1, nxt);
        if constexpr (LORAK) { if (has_next) lora_k(nxt); }
        const char* nA = has_next ? (const char*)g.A + (size_t)nxt.pm * tstep + (size_t)nxt.kt0 * kstep : cA; const char* nB = has_next ? (const char*)g.Bt + (size_t)nxt.pn * tstep + (size_t)nxt.kt0 * kstep : cB;
        const int nt = cur.nkt;
        for (int t = 0; t < nt; t += 2) {
            const bool last = (t == nt - 2);
            const char* a1 = cA + (size_t)(t + 1) * kstep;
            const char* a2 = last ? nA : cA + (size_t)(t + 2) * kstep; const char* b2 = last ? nB : cB + (size_t)(t + 2) * kstep;
            const char* a3 = a2 + kstep; const char* b3 = b2 + kstep;
            if constexpr (SP2) {
            PG8_LDB(B0, 0, 0); PG8_LDB(B1, 0, 1); PG8_SCHED; PG8_LDA(At, 0, 0); PG8_STAGE(PG8_SA(1, 1), a1 + hstep, voffA);
            PG8_WAIT_V(8); PG8_WAIT_L(0); PG8_BAR; PG8_MMA(0, 0, At, B0); PG8_MMA(0, 1, At, B1); PG8_BAR; PG8_SCHED;
            PG8_LDA(At, 0, 1); PG8_STAGE(PG8_SB(0, 0), b2, voffB); PG8_STAGE(PG8_SB(0, 1), b2 + hstep, voffB); PG8_STAGE(PG8_SA(0, 0), a2, voffA);
            PG8_WAIT_V(8); PG8_WAIT_L(0); PG8_BAR; PG8_MMA(1, 0, At, B0); PG8_MMA(1, 1, At, B1); PG8_BAR; PG8_SCHED;
            PG8_LDB(B0, 1, 0); PG8_LDB(B1, 1, 1); PG8_SCHED; PG8_LDA(At, 1, 0); PG8_STAGE(PG8_SA(0, 1), a2 + hstep, voffA);
            PG8_WAIT_V(8); PG8_WAIT_L(0); PG8_BAR; PG8_MMA(0, 0, At, B0); PG8_MMA(0, 1, At, B1); PG8_BAR; PG8_SCHED;
            PG8_LDA(At, 1, 1); PG8_STAGE(PG8_SB(1, 0), b3, voffB); PG8_STAGE(PG8_SB(1, 1), b3 + hstep, voffB); PG8_STAGE(PG8_SA(1, 0), a3, voffA);
            PG8_WAIT_V(8); PG8_WAIT_L(0); PG8_BAR; PG8_MMA(1, 0, At, B0); PG8_MMA(1, 1, At, B1); PG8_BAR; PG8_SCHED;
            } else {
            PG8_LDB(B0, 0, 0); PG8_SCHED; PG8_LDA(At, 0, 0); PG8_STAGE(PG8_SA(1, 1), a1 + hstep, voffA);
            PG8_WAIT_L(8); PG8_BAR; PG8_WAIT_L(0); PG8_MMA(0, 0, At, B0); PG8_BAR; PG8_SCHED;
            PG8_LDB(B1, 0, 1); PG8_STAGE(PG8_SB(0, 0), b2, voffB);
            PG8_BAR; PG8_WAIT_L(0); PG8_MMA(0, 1, At, B1); PG8_BAR;
            PG8_LDA(At, 0, 1); PG8_STAGE(PG8_SA(0, 0), a2, voffA);
            PG8_BAR; PG8_WAIT_L(0); PG8_MMA(1, 0, At, B0); PG8_BAR; PG8_SCHED;
            PG8_STAGE(PG8_SB(0, 1), b2 + hstep, voffB);
            PG8_WAIT_V(6); PG8_BAR; PG8_MMA(1, 1, At, B1); PG8_BAR;
            PG8_LDB(B0, 1, 0); PG8_SCHED; PG8_LDA(At, 1, 0); PG8_STAGE(PG8_SA(0, 1), a2 + hstep, voffA);
            PG8_WAIT_L(8); PG8_BAR; PG8_WAIT_L(0); PG8_MMA(0, 0, At, B0); PG8_BAR; PG8_SCHED;
            PG8_LDB(B1, 1, 1); PG8_STAGE(PG8_SB(1, 0), b3, voffB);
            PG8_BAR; PG8_WAIT_L(0); PG8_MMA(0, 1, At, B1); PG8_BAR;
            PG8_LDA(At, 1, 1); PG8_STAGE(PG8_SA(1, 0), a3, voffA);
            PG8_BAR; PG8_WAIT_L(0); PG8_MMA(1, 0, At, B0); PG8_BAR; PG8_SCHED;
            PG8_STAGE(PG8_SB(1, 1), b3 + hstep, voffB);
            PG8_WAIT_V(6); PG8_BAR; PG8_MMA(1, 1, At, B1); PG8_BAR;
                    }
        }
        if constexpr (ALIGN_EPI) { if (wr == 0) PG8_BAR; }
        E(acc, cur, wr, wc, fr, fq);
        if (!has_next) break;
#pragma unroll
        for (int a = 0; a < 2; ++a)
#pragma unroll
            for (int b = 0; b < 2; ++b)
#pragma unroll
                for (int m = 0; m < 4; ++m)
#pragma unroll
                    for (int n = 0; n < 2; ++n) acc[a][b][m][n] = (f32x4){0.f, 0.f, 0.f, 0.f};
        cur = nxt; cA = nA; cB = nB; ++ui;
        if constexpr (ALIGN_EPI) { if (wr == 1) PG8_BAR; }
    }
    PG8_WAIT_V(0);
    if constexpr (!ALIGN_EPI) { if (wr == 0) PG8_BAR; }
    PG8_BAR;
#undef PG8_SA
#undef PG8_SB
#undef PG8_STAGE
#undef PG8_LDA
#undef PG8_LDB
#undef PG8_MMA
#undef PG8_WAIT_V
#undef PG8_WAIT_L
#undef PG8_BAR
#undef PG8_SCHED
}

struct EpiSwiGLU {
    static constexpr bool PERM = false;
    h16* O; int ldo;
    __device__ __forceinline__ void operator()(const f32x4 (&acc)[2][2][4][2], const Unit& u, int wr, int wc, int fr, int fq) const {
        const int row0 = u.pm * BM + wr * 64 + fr;
#pragma unroll
        for (int ai = 0; ai < 2; ++ai)
#pragma unroll
            for (int m = 0; m < 4; ++m) { h16* rowp = O + (size_t)(row0 + ai * HALF + m * 16) * ldo;
#pragma unroll
                for (int bj = 0; bj < 2; ++bj) { const int oc = (u.pn * BM + bj * HALF + wc * 32) / 2 + 4 * fq;
                    const f32x4 gt = acc[ai][bj][m][0], up = acc[ai][bj][m][1]; float o[4];
#pragma unroll
                    for (int j = 0; j < 4; ++j) o[j] = gt[j] * sigmoidf_(gt[j]) * up[j];
                    u32x2 w; w.x = pk2h(o[0], o[1]); w.y = pk2h(o[2], o[3]);
                    *(u32x2*)(rowp + oc) = w; } }
    }
};
template <bool RES16, bool OUT16> struct EpiRes {
    static constexpr bool PERM = false;
    const void* res; void* out; float* slab; float scale; int pad;
    __device__ __forceinline__ void operator()(const f32x4 (&acc)[2][2][4][2], const Unit& u, int wr, int wc, int fr, int fq) const {
        const int row0 = u.pm * BM + wr * 64 + fr, col0 = u.pn * BM + wc * 32 + 4 * fq;
        if (u.sp >= 0) {
            h16* sb = (h16*)slab + ((size_t)u.sp * MS - MP) * D;
#pragma unroll
            for (int ai = 0; ai < 2; ++ai)
#pragma unroll
                for (int m = 0; m < 4; ++m) { const size_t off = (size_t)(row0 + ai * HALF + m * 16) * D + col0;
#pragma unroll
                    for (int bj = 0; bj < 2; ++bj)
#pragma unroll
                        for (int n = 0; n < 2; ++n) { const f32x4 v = acc[ai][bj][m][n]; u32x2 w; w.x = pk2h(v[0], v[1]); w.y = pk2h(v[2], v[3]); *(u32x2*)(sb + off + bj * HALF + n * 16) = w; } }
            return;
        }
#pragma unroll
        for (int ai = 0; ai < 2; ++ai)
#pragma unroll
            for (int m = 0; m < 4; ++m) { const size_t off = (size_t)(row0 + ai * HALF + m * 16) * D + col0;
#pragma unroll
                for (int bj = 0; bj < 2; ++bj)
#pragma unroll
                    for (int n = 0; n < 2; ++n) { f32x4 rv; const size_t o_ = off + bj * HALF + n * 16;
                        if constexpr (RES16) { const h16x4 hv = *(const h16x4*)((const h16*)res + o_); rv = (f32x4){(float)hv[0], (float)hv[1], (float)hv[2], (float)hv[3]}; }
                        else rv = *(const f32x4*)((const float*)res + o_);
                        const f32x4 o = rv + scale * acc[ai][bj][m][n];
                        if constexpr (OUT16) { u32x2 w; w.x = pk2h(o[0], o[1]); w.y = pk2h(o[2], o[3]); *(u32x2*)((h16*)out + o_) = w; }
                        else *(f32x4*)((float*)out + o_) = o; } }
    }
};
struct EpiP16 {
    static constexpr bool PERM = true;
    h16* P; h16* PF;
    __device__ __forceinline__ void operator()(const f32x4 (&acc)[2][2][4][2], const Unit& u, int wr, int wc, int fr, int fq) const {
        const int row0 = u.pm * BM + wr * 64 + fr; const int kind = u.pn < 26 ? 0 : u.pn < 42 ? 1 : u.pn < 58 ? 2 : 3;
#pragma unroll
        for (int ai = 0; ai < 2; ++ai)
#pragma unroll
            for (int m = 0; m < 4; ++m) { const int row = row0 + ai * HALF + m * 16;
#pragma unroll
                for (int bj = 0; bj < 2; ++bj) { const int gcol = u.pn * BM + bj * HALF + wc * 32;
                    const f32x4 v0 = acc[ai][bj][m][0], v1 = acc[ai][bj][m][1];
                    if (kind == 0) { u32x4 w; w.x = pk2h(v0[0], v0[1]); w.y = pk2h(v0[2], v0[3]); w.z = pk2h(v1[0], v1[1]); w.w = pk2h(v1[2], v1[3]);
                        if (u.pm < MT / BM) *(u32x4*)(P + (size_t)row * PP + gcol + 8 * fq) = w;
                        else *(u32x4*)(PF + (size_t)(row - MT) * PFW + gcol + 8 * fq) = w; }
                    else if (kind == 3) { u32x4 w; w.x = pk2h(sigmoidf_(v0[0]), sigmoidf_(v0[1])); w.y = pk2h(sigmoidf_(v0[2]), sigmoidf_(v0[3])); w.z = pk2h(sigmoidf_(v1[0]), sigmoidf_(v1[1])); w.w = pk2h(sigmoidf_(v1[2]), sigmoidf_(v1[3]));
                        *(u32x4*)(P + (size_t)row * PP + C_SA + (gcol - (PFW + 8192)) + 8 * fq) = w; }
                    else { float o[4];
#pragma unroll
                        for (int j = 0; j < 4; ++j) o[j] = kind == 1 ? v0[j] * v1[j] : sigmoidf_(v1[j]) * v0[j];
                        u32x2 w; w.x = pk2h(o[0], o[1]); w.y = pk2h(o[2], o[3]);
                        *(u32x2*)(P + (size_t)row * PP + (kind == 1 ? C_U + ((gcol - PFW) >> 1) : C_Q + ((gcol - PFW - 4096) >> 1)) + 4 * fq) = w; } } }
    }
};
struct EpiEAG {
    static constexpr bool PERM = true;
    h16* O; const float* w0; const float* a0;
    __device__ __forceinline__ void operator()(const f32x4 (&acc)[2][2][4][2], const Unit& u, int wr, int wc, int fr, int fq) const {
        const int row0 = u.pm * BM + wr * 64 + fr; const int typ = u.pn >> 3;
#pragma unroll
        for (int bj = 0; bj < 2; ++bj) { const int col = u.pn * BM + bj * HALF + wc * 32 + 8 * fq;
            f32x4 b0 = (f32x4){0.f, 0.f, 0.f, 0.f}, b1 = b0;
            if (typ == 0) { b0 = *(const f32x4*)(w0 + col); b1 = *(const f32x4*)(w0 + col + 4); }
            if (typ == 1) { b0 = *(const f32x4*)(a0 + col - D); b1 = *(const f32x4*)(a0 + col - D + 4); }
#pragma unroll
            for (int ai = 0; ai < 2; ++ai)
#pragma unroll
                for (int m = 0; m < 4; ++m) { const int row = row0 + ai * HALF + m * 16;
                    f32x4 v0 = acc[ai][bj][m][0] + b0, v1 = acc[ai][bj][m][1] + b1;
                    if (typ < 2) { const float sc = typ == 0 ? 0.60653065971f : 1.0f;
#pragma unroll
                        for (int j = 0; j < 4; ++j) { v0[j] = sigmoidf_(v0[j]) * sc; v1[j] = sigmoidf_(v1[j]) * sc; } }
                    u32x4 w; w.x = pk2h(v0[0], v0[1]); w.y = pk2h(v0[2], v0[3]); w.z = pk2h(v1[0], v1[1]); w.w = pk2h(v1[2], v1[3]);
                    *(u32x4*)(O + (size_t)row * 6144 + col) = w; } }
    }
};
}


#define XB_TMO      128
#define XB_XCNT(j)  (256  + 64 * (j))
#define XB_XSUB(j)  (1280 + 64 * (j))
#define XB_XGEN(j)  (2304 + 64 * (j))
#define XB_TOP      3328
#define XB_TOPGEN   3392
#define XCD_BAR_WORDS 3456
#define XB_SPIN_CAP (1u << 22)
__device__ __forceinline__ unsigned xb_ld(unsigned* p)              { return __hip_atomic_load(p, __ATOMIC_RELAXED, __HIP_MEMORY_SCOPE_AGENT); }
__device__ __forceinline__ unsigned xb_add(unsigned* p, unsigned v) { return __hip_atomic_fetch_add(p, v, __ATOMIC_RELAXED, __HIP_MEMORY_SCOPE_AGENT); }
__device__ __forceinline__ unsigned xb_xcc_id() { return (unsigned)__builtin_amdgcn_s_getreg((3 << 11) | 20) & 0xFu; }
#define XB_SPIN(cond, bar) do { unsigned _sp = 0; while (cond) { __builtin_amdgcn_s_sleep(1); \
    if ((++_sp & 255u) == 0u) { if (xb_ld(&(bar)[XB_TMO])) break; if (_sp > XB_SPIN_CAP) { atomicAdd(&(bar)[XB_TMO], 1u); break; } } } } while (0)
struct XcdBarrier { unsigned* bar; unsigned x; volatile LAS unsigned* st; };
__device__ __forceinline__ XcdBarrier xcd_barrier_post(unsigned* bar, volatile LAS unsigned* st) {
    XcdBarrier b; b.bar = bar; b.x = xb_xcc_id(); b.st = st;
    if (threadIdx.x == 0) (void)xb_add(&bar[XB_XCNT(b.x)], 1u);
    return b;
}
__device__ __forceinline__ void xcd_barrier_complete(unsigned* bar, unsigned x, unsigned& nloc, unsigned& nx) {
    const unsigned G = gridDim.x * gridDim.y * gridDim.z;
    unsigned sum, cnt, mine, sp = 0u;
    for (;;) {
        sum = 0u; cnt = 0u; mine = 0u;
#pragma unroll
        for (unsigned j = 0; j < 16; ++j) { const unsigned c = xb_ld(&bar[XB_XCNT(j)]); sum += c; cnt += (c > 0u) ? 1u : 0u; mine = (j == x) ? c : mine; }
        if (sum == G) break;
        __builtin_amdgcn_s_sleep(1);
        if ((++sp & 255u) == 0u) { if (xb_ld(&bar[XB_TMO])) break; if (sp > XB_SPIN_CAP) { atomicAdd(&bar[XB_TMO], 1u); break; } }
    }
    nloc = mine > 0u ? mine : 1u; nx = cnt > 0u ? cnt : 1u;
}
__device__ __forceinline__ void xcd_barrier(const XcdBarrier& b) {
    asm volatile("s_waitcnt vmcnt(0)" ::: "memory");
    __syncthreads();
    if (threadIdx.x == 0) {
        unsigned* bar = b.bar;
        __builtin_amdgcn_s_waitcnt(0);
        unsigned nloc = b.st[0], nx = b.st[1];
        if (nloc == 0u) { xcd_barrier_complete(bar, b.x, nloc, nx); b.st[0] = nloc; b.st[1] = nx; }
        const unsigned old = xb_add(&bar[XB_XSUB(b.x)], 1u);
        const unsigned gen = old / nloc;
        if (old + 1u == (gen + 1u) * nloc) {
            __builtin_amdgcn_fence(__ATOMIC_RELEASE, "agent");
            asm volatile("s_waitcnt vmcnt(0)" ::: "memory");
            const unsigned og = xb_add(&bar[XB_TOP], 1u);
            const unsigned tg = og / nx;
            if (og + 1u == (tg + 1u) * nx) xb_add(&bar[XB_TOPGEN], 1u);
            else XB_SPIN(xb_ld(&bar[XB_TOPGEN]) == tg, bar);
            __builtin_amdgcn_fence(__ATOMIC_ACQUIRE, "agent");
            xb_add(&bar[XB_XGEN(b.x)], 1u);
            asm volatile("s_waitcnt vmcnt(0)" ::: "memory");
        } else {
            XB_SPIN(xb_ld(&bar[XB_XGEN(b.x)]) == gen, bar);
            __builtin_amdgcn_fence(__ATOMIC_ACQUIRE, "agent");
            asm volatile("s_waitcnt vmcnt(0)" ::: "memory");
        }
    }
    __syncthreads();
}

struct Args { const float* in[29]; float* out; unsigned char* ws; int ph_lo, ph_hi; };

__device__ __forceinline__ void cvt_item(int mode, const float* s0, const float* s1, int Nsrc, int K, h16* WT, LAS float* scr, int item, int nblk, int lane) {
    const int kb = item / nblk, nb = item % nblk, k0 = 64 * kb, n0 = 32 * nb;
    const int nn = lane & 31; const float* src = s0; int col = n0 + nn; bool zero = false;
    if (mode == 1) { src = (nn < 16) ? s0 : s1; col = (n0 >> 1) + (nn & 15); }
    if (mode == 2) { if (n0 >= NA && n0 < PFW) zero = true; else if (n0 >= PFW) col -= 64; }
#pragma unroll 8
    for (int i = 0; i < 32; ++i) { const int kk = 2 * i + (lane >> 5); scr[kk * 33 + nn] = zero ? 0.f : src[(size_t)(k0 + kk) * Nsrc + col]; }
    asm volatile("s_waitcnt lgkmcnt(0)" ::: "memory");
    const int c = lane & 7;
#pragma unroll
    for (int j = 0; j < 4; ++j) { const int n = (lane >> 3) + 8 * j; const LAS float* s = scr + (8 * c) * 33 + n;
        u32x4 o; o.x = pk2h(s[0 * 33], s[1 * 33]); o.y = pk2h(s[2 * 33], s[3 * 33]); o.z = pk2h(s[4 * 33], s[5 * 33]); o.w = pk2h(s[6 * 33], s[7 * 33]);
        *(u32x4*)(WT + (size_t)(n0 + n) * K + k0 + 8 * c) = o; }
    asm volatile("s_waitcnt lgkmcnt(0)" ::: "memory");
}
struct CvtIt { const float* p; h16* q; int Nsrc, K; bool zero; };
__device__ __forceinline__ CvtIt cvt_decode(int mode, const float* s0, const float* s1, int Nsrc, int K, h16* WT, int nblk, int item, int lane) {
    const int kb = item / nblk, nb = item % nblk, k0 = 64 * kb, n0 = 32 * nb, nn = lane & 31;
    const float* src = s0; int col = n0 + nn; bool zero = false;
    if (mode == 1) { src = (nn < 16) ? s0 : s1; col = (n0 >> 1) + (nn & 15); }
    if (mode == 2) {
        const int q = nn >> 3, sp = (nn >> 2) & 1, j = nn & 3;
        if (n0 >= NA && n0 < PFW) { zero = true; col = 0; }
        else if (n0 >= PFW && n0 < PFW + 4096) col = (sp ? NA + 2 * D : NA + D) + ((n0 - PFW) >> 1) + 4 * q + j;
        else if (n0 >= PFW + 4096 && n0 < PFW + 8192) col = (sp ? NA + 4 * D : NA) + ((n0 - PFW - 4096) >> 1) + 4 * q + j;
        else if (n0 >= PFW + 8192) col = NA + 3 * D + (n0 - PFW - 8192) + nn; }
    CvtIt r; r.p = src + (size_t)(k0 + (lane >> 5)) * Nsrc + col; r.q = WT + (size_t)(n0 + (lane >> 3)) * K + k0 + 8 * (lane & 7); r.Nsrc = Nsrc; r.K = K; r.zero = zero; return r;
}
__device__ __forceinline__ void cvt_load(const CvtIt& t, float (&v)[32]) {
#pragma unroll
    for (int i = 0; i < 32; ++i) v[i] = t.p[(size_t)(2 * i) * t.Nsrc];
}
__device__ __forceinline__ void cvt_finish(const CvtIt& t, const float (&v)[32], LAS float* scr, int lane) {
    const int nn = lane & 31;
#pragma unroll
    for (int i = 0; i < 32; ++i) scr[(2 * i + (lane >> 5)) * 33 + nn] = t.zero ? 0.f : v[i];
    asm volatile("s_waitcnt lgkmcnt(0)" ::: "memory");
    const int c = lane & 7;
#pragma unroll
    for (int j = 0; j < 4; ++j) { const int n = (lane >> 3) + 8 * j; const LAS float* s = scr + (8 * c) * 33 + n;
        u32x4 o; o.x = pk2h(s[0 * 33], s[1 * 33]); o.y = pk2h(s[2 * 33], s[3 * 33]); o.z = pk2h(s[4 * 33], s[5 * 33]); o.w = pk2h(s[6 * 33], s[7 * 33]);
        *(u32x4*)(t.q + (size_t)(8 * j) * t.K) = o; }
    asm volatile("s_waitcnt lgkmcnt(0)" ::: "memory");
}
#define CVT_RUN(total_, PICK) do { float va[32], vb[32]; CvtIt A_, B_; int it_ = gw; if (it_ < (total_)) { PICK(it_, A_); cvt_load(A_, va); \
        for (;;) { const int itb_ = it_ + NGW; const bool hb_ = itb_ < (total_); if (hb_) { PICK(itb_, B_); cvt_load(B_, vb); } cvt_finish(A_, va, scr, lane); if (!hb_) break; \
            it_ = itb_ + NGW; const bool ha_ = it_ < (total_); if (ha_) { PICK(it_, A_); cvt_load(A_, va); } cvt_finish(B_, vb, scr, lane); if (!ha_) break; } } } while (0)
__device__ __forceinline__ void cvt_lora_item(const float* wl, const float* al, const float* gl, h16* WT, int item, int lane) {
    const int n = item, typ = n >> 11, col = n & 2047; unsigned w[4];
#pragma unroll
    for (int j = 0; j < 4; ++j) { float v[2];
#pragma unroll
        for (int e = 0; e < 2; ++e) { const int k = lane * 8 + j * 2 + e; float x = 0.f;
            if (typ == 0 && k < 96) x = wl[(size_t)k * D + col];
            if (typ == 1 && k >= 96 && k < 192) x = al[(size_t)(k - 96) * D + col];
            if (typ == 2 && k >= 192 && k < 448) x = gl[(size_t)(k - 192) * D + col];
            v[e] = x; }
        w[j] = pk2h(v[0], v[1]); }
    *(u32x4*)(WT + (size_t)n * LK + lane * 8) = (u32x4){w[0], w[1], w[2], w[3]};
}

__device__ __forceinline__ void rms_row_f16(const float* xrow, const float* g, h16* orow, float* f32row, int lane, const h16* part = nullptr, float pscale = 0.f, float* xout = nullptr) {
    const f32x4* xr = (const f32x4*)xrow + lane; const f32x4* gr = (const f32x4*)g + lane;
    f32x4 v[8]; float s = 0.f;
#pragma unroll
    for (int j = 0; j < 8; ++j) { v[j] = xr[64 * j];
        if (part) { const h16x4* pp = (const h16x4*)part + lane + 64 * j; const size_t st = (size_t)MS * D / 4;
            const h16x4 p0 = pp[0], p1 = pp[st], p2 = pp[2 * st], p3 = pp[3 * st];
            v[j] += pscale * (((f32x4){(float)p0[0], (float)p0[1], (float)p0[2], (float)p0[3]} + (f32x4){(float)p1[0], (float)p1[1], (float)p1[2], (float)p1[3]}) + ((f32x4){(float)p2[0], (float)p2[1], (float)p2[2], (float)p2[3]} + (f32x4){(float)p3[0], (float)p3[1], (float)p3[2], (float)p3[3]}));
            if (xout) *((f32x4*)xout + lane + 64 * j) = v[j]; }
        s += (v[j].x * v[j].x + v[j].y * v[j].y) + (v[j].z * v[j].z + v[j].w * v[j].w); }
    const float rs = rsqrtf(wave_sum(s) * (1.f / D) + 1e-6f);
#pragma unroll
    for (int j = 0; j < 8; ++j) { const f32x4 gg = gr[64 * j]; const f32x4 o = v[j] * rs * gg;
        if (orow) { u32x2 w; w.x = pk2h(o.x, o.y); w.y = pk2h(o.z, o.w); *((u32x2*)orow + lane + 64 * j) = w; }
        if (f32row) *((f32x4*)f32row + lane + 64 * j) = o; }
}

__device__ __forceinline__ void rms_row_h(const h16* xrow, const float* g, h16* orow, float* f32row, int lane) {
    const f32x4* gr = (const f32x4*)g + lane;
    f32x4 v[8]; float s = 0.f;
#pragma unroll
    for (int j = 0; j < 8; ++j) { const h16x4 hv = *((const h16x4*)xrow + lane + 64 * j);
        v[j] = (f32x4){(float)hv[0], (float)hv[1], (float)hv[2], (float)hv[3]};
        s += (v[j].x * v[j].x + v[j].y * v[j].y) + (v[j].z * v[j].z + v[j].w * v[j].w); }
    const float rs = rsqrtf(wave_sum(s) * (1.f / D) + 1e-6f);
#pragma unroll
    for (int j = 0; j < 8; ++j) { const f32x4 gg = gr[64 * j]; const f32x4 o = v[j] * rs * gg;
        if (orow) { u32x2 w; w.x = pk2h(o.x, o.y); w.y = pk2h(o.z, o.w); *((u32x2*)orow + lane + 64 * j) = w; }
        if (f32row) *((f32x4*)f32row + lane + 64 * j) = o; }
}

constexpr int PREP_CA = 96;
__device__ __forceinline__ int prep_map(int j, bool segB) {
    const int h = j & 31, q = j >> 5; int c;
    if (!segB) c = q < 2 * PREP_CA ? (q / PREP_CA) * 256 + q % PREP_CA : 512 + (q - 2 * PREP_CA);
    else { constexpr int nb = 256 - PREP_CA; c = (q / nb) * 256 + PREP_CA + q % nb; }
    return c * 32 + h;
}

enum { PH_CVT1 = 0, PH_FFN1_GU, PH_FFN1_D, PH_RMS_MIX, PH_WIN, PH_SHIFT, PH_LORA, PH_PREP, PH_SCAN, PH_MERGE, PH_WOUT, PH_RMS2, PH_FFN2_GU, PH_FFN2_D, PH_FINAL, PH_N };

__global__ void __launch_bounds__(NTHR, 2) fwd_kernel(Args a) {
    extern __shared__ __attribute__((aligned(16))) unsigned char lds_raw[];
    LAS unsigned char* lds = (LAS unsigned char*)lds_raw;
    const int tid = threadIdx.x, lane = tid & 63, wave = __builtin_amdgcn_readfirstlane(tid >> 6);
    const int G = gridDim.x, bx = blockIdx.x;
    const int gw = bx * NWAVES + wave, NGW = G * NWAVES;
    unsigned char* ws = a.ws; unsigned char* ob = (unsigned char*)a.out;
    h16* W1GU = (h16*)(ws + WS_W1GU); h16* W1D = (h16*)(ws + WS_W1D); h16* WIN = (h16*)(ws + WS_WIN); h16* WOUT = (h16*)(ws + WS_WOUT);
    h16* A16 = (h16*)(ws + WS_A16); h16* P16 = (h16*)(ws + WS_P16); h16* EAG = (h16*)(ws + WS_EAG); h16* HM = (h16*)(ws + WS_HM);
    h16* W2GU = (h16*)(ws + WS_W2GU); h16* W2D = (h16*)(ws + WS_W2D);
    h16* WL = (h16*)(ob + OB_WL); h16* PF = (h16*)(ws + WS_PF);
    float* Y = a.out + O_Y; float* SLAB = (float*)(ws + WS_SLAB);
    h16* XH = (h16*)(a.out + O_Y);
    const int lo = a.ph_lo, hi = a.ph_hi;
#define IN(k) (lo <= (k) && (k) < hi)
    cg::grid_group grid = cg::this_grid();
    volatile LAS unsigned* xst = (volatile LAS unsigned*)(lds + LDS_BYTES - 16);
    if (tid < 2) xst[tid] = 0u;
    if (bx == 0) { for (int i = tid; i < XCD_BAR_WORDS; i += NTHR) ((unsigned*)(ws + WS_CTL))[i] = 0u; }
    __syncthreads();
    XcdBarrier xbar; xbar.bar = (unsigned*)(ws + WS_CTL); xbar.x = xb_xcc_id(); xbar.st = xst;
#ifndef PROBE_MASK
#define PROBE_MASK 0u
#endif
#ifndef PROBE_MUL
#define PROBE_MUL 1u
#endif
    unsigned long long pr_t[PH_N + 1]; (void)pr_t;
    if (PROBE_MASK) pr_t[0] = __builtin_amdgcn_s_memrealtime();
#define SEAM(k) do { if (IN(k) && IN((k) + 1)) { if ((k) == PH_CVT1) grid.sync(); else xcd_barrier(xbar); } if (PROBE_MASK) pr_t[(k) + 1] = __builtin_amdgcn_s_memrealtime(); } while (0)

    if (IN(PH_CVT1)) {
        LAS float* scr = (LAS float*)(lds + wave * 16384);
        constexpr int I1 = (D / 64) * (2 * FF / 32), I2 = (FF / 64) * (D / 32), I3 = (D / 64) * (NW / 32), I4 = (D / 64) * (D / 32);
#define PICK1(it, out) do { int r_ = (it); if (r_ < I1) out = cvt_decode(1, a.in[6], a.in[7], FF, D, W1GU, 2 * FF / 32, r_, lane); else if ((r_ -= I1) < I2) out = cvt_decode(0, a.in[8], a.in[8], D, FF, W1D, D / 32, r_, lane); \
            else if ((r_ -= I2) < I3) out = cvt_decode(2, a.in[10], a.in[10], NIN, D, WIN, NW / 32, r_, lane); else out = cvt_decode(0, a.in[23], a.in[23], D, D, WOUT, D / 32, r_ - I3, lane); } while (0)
        CVT_RUN(I1 + I2 + I3 + I4, PICK1);
#undef PICK1
        for (int it = gw; it < 6144; it += NGW) cvt_lora_item(a.in[13], a.in[15], a.in[16], WL, it, lane);
        for (int r = gw; r < 256; r += NGW) { h16* orow = A16 + (size_t)(MT + r) * D;
#pragma unroll
            for (int j = 0; j < 8; ++j) { u32x2 w = (u32x2){0u, 0u};
                if (r < 32) { const f32x4 v = *((const f32x4*)(a.in[2] + (size_t)r * D) + lane + 64 * j); w.x = pk2h(v.x, v.y); w.y = pk2h(v.z, v.w); }
                *((u32x2*)orow + lane + 64 * j) = w; } }
        for (int m = gw; m < MT; m += NGW) { const float* xr = m < MP ? a.in[0] + (size_t)m * D : a.in[1] + (size_t)(m - MP) * D; rms_row_f16(xr, a.in[5], A16 + (size_t)m * D, nullptr, lane); }
    }
    SEAM(PH_CVT1);
    if (tid == 0) (void)xb_add(&xbar.bar[XB_XCNT(xbar.x)], 1u);
    if (IN(PH_FFN1_GU)) { pg8::Gemm g{A16, W1GU, MT, 2 * FF, D}; pg8::Order S; S.init(MT, 2 * FF, D, G, bx, 0, -1); pg8::EpiSwiGLU E{HM, FF}; pg8::gemm_phase(lds, g, S, E); }
    SEAM(PH_FFN1_GU);
    if (IN(PH_FFN1_D)) { pg8::Gemm g{HM, W1D, MT, D, FF}; pg8::Order S; S.init(MT, D, FF, G, bx, 0, MP / 256); pg8::EpiRes<false, true> E{a.in[0], XH, SLAB, 0.5f, 0}; pg8::gemm_phase(lds, g, S, E); }
    SEAM(PH_FFN1_D);
    if (IN(PH_RMS_MIX)) {
        for (int m = gw; m < MT; m += NGW) { float* so = nullptr;
            if (m < MP) { if ((m & 4095) == 4095) so = a.out + O_SHP + (size_t)(m >> 12) * D; } else { if (((m - MP) & 63) == 63) so = a.out + O_SHS + (size_t)((m - MP) >> 6) * D; }
            if (m < MP) rms_row_h(XH + (size_t)m * D, a.in[9], A16 + (size_t)m * D, so, lane);
            else rms_row_f16(a.in[1] + (size_t)(m - MP) * D, a.in[9], A16 + (size_t)m * D, so, lane, (const h16*)SLAB + (size_t)(m - MP) * D, 0.5f, Y + (size_t)m * D); }
    }
    SEAM(PH_RMS_MIX);
    if (IN(PH_WIN)) { pg8::Gemm g{A16, WIN, MT, NW, D}; pg8::Order S; S.init(MT, NW, D, G, bx, PFW / 256, -1); pg8::EpiP16 E{P16, PF}; pg8::gemm_phase(lds, g, S, E); }
    SEAM(PH_WIN);
    if (IN(PH_SHIFT)) {
        for (int item = bx * NTHR + tid; item < (MT / 16) * 768; item += G * NTHR) { const int c = item / 768, o = item % 768;
            *(u32x4*)((h16*)(ob + OB_SIDE) + (size_t)c * 6144 + o * 8) = *(const u32x4*)(P16 + (size_t)(16 * c + 15) * PP + o * 8); }
    }
    if (IN(PH_SHIFT)) {
        h16* AIN = A16; const float* mu = a.in[11];
        for (int item = bx * NTHR + tid; item < MT * 64; item += G * NTHR) {
            const int row = item >> 6, o = item & 63;
            if (o >= 56) { *(u32x4*)(AIN + (size_t)row * LK + 448 + (o - 56) * 8) = (u32x4){0u, 0u, 0u, 0u}; continue; }
            const int c0 = 6144 + o * 8;
            const bool st = row < MP ? ((row & 4095) == 0) : (((row - MP) & 63) == 0);
            const h16* pp = st ? (row < MP ? PF + (size_t)32 * PFW : PF + (size_t)((row - MP) >> 6) * PFW) + c0 : P16 + (size_t)(row - 1) * PP + c0;
            const h16x8 cv = *(const h16x8*)(P16 + (size_t)row * PP + c0), pv = *(const h16x8*)pp;
            const f32x4 m0 = *(const f32x4*)(mu + c0), m1 = *(const f32x4*)(mu + c0 + 4);
            const float mu8[8] = {m0.x, m0.y, m0.z, m0.w, m1.x, m1.y, m1.z, m1.w}; float s[8];
#pragma unroll
            for (int j = 0; j < 8; ++j) { const float cu = (float)cv[j]; s[j] = cu + mu8[j] * ((float)pv[j] - cu); }
            if (o < 12) {
#pragma unroll
                for (int j = 0; j < 8; ++j) s[j] = tanhf_(s[j]);
            } else if (o >= 24) {
#pragma unroll
                for (int j = 0; j < 8; ++j) s[j] = sigmoidf_(s[j]);
            }
            *(u32x4*)(AIN + (size_t)row * LK + o * 8) = (u32x4){pk2h(s[0], s[1]), pk2h(s[2], s[3]), pk2h(s[4], s[5]), pk2h(s[6], s[7])};
        }
    }
    SEAM(PH_SHIFT);
    if (IN(PH_LORA)) { pg8::Gemm g{A16, WL, MT, 6144, LK}; pg8::Order S; S.init(MT, 6144, LK, G, bx, 0, -1); pg8::EpiEAG E{EAG, a.in[12], a.in[14]}; pg8::gemm_phase<pg8::EpiEAG, true>(lds, g, S, E); }
    SEAM(PH_LORA);
    auto prep_run = [&](const int gw0, const int ngw, const int nitems, const bool segB) {
        LAS unsigned char* sc = lds + wave * 5120;
        float* RK = (float*)(ws + WS_RK); float* LM = (float*)(ws + WS_LM);
        const int cp = lane & 31, hs = lane >> 5;
#define H2LO(x) ((float)__builtin_bit_cast(h16, (unsigned short)((x) & 0xffffu)))
#define H2HI(x) ((float)__builtin_bit_cast(h16, (unsigned short)((x) >> 16)))
#define HSUM(x_, out_) do { float y_ = row_allreduce16(x_); y_ += __builtin_bit_cast(float, __builtin_amdgcn_update_dpp(0, __builtin_bit_cast(int, y_), 0x142, 0xA, 0xF, false)); \
            const float s31_ = rl_f(y_, 31), s63_ = rl_f(y_, 63); out_ = hs ? s63_ : s31_; } while (0)
#define PREP_LOAD(item_, RR, KK, VV, EE, AA) do { const int c_ = (item_) >> 5, h_ = (item_) & 31, r0_ = 16 * c_, j2_ = h_ * 64 + 2 * cp; \
            const bool pr_ = r0_ < MP; const bool st_ = pr_ ? ((r0_ & 4095) == 0) : (((r0_ - MP) & 63) == 0); \
            const h16* pq_ = hs ? P16 + (size_t)(r0_ + 7) * PP + j2_ : (st_ ? PF + (size_t)(pr_ ? 32 : ((r0_ - MP) >> 6)) * PFW + j2_ : (const h16*)(ob + OB_SIDE) + (size_t)(c_ - 1) * 6144 + j2_); \
            const h16* pp_ = P16 + (size_t)(r0_ + 8 * hs) * PP + j2_; const h16* pe_ = EAG + (size_t)(r0_ + 8 * hs) * 6144 + j2_; \
            RR[0] = *(const unsigned*)pq_; KK[0] = *(const unsigned*)(pq_ + D); VV[0] = *(const unsigned*)(pq_ + 2 * D); \
            _Pragma("unroll") for (int s_ = 0; s_ < 8; ++s_) { RR[s_ + 1] = *(const unsigned*)(pp_ + (size_t)s_ * PP); KK[s_ + 1] = *(const unsigned*)(pp_ + (size_t)s_ * PP + D); VV[s_ + 1] = *(const unsigned*)(pp_ + (size_t)s_ * PP + 2 * D); \
                EE[s_] = *(const unsigned*)(pe_ + (size_t)s_ * 6144); AA[s_] = *(const unsigned*)(pe_ + (size_t)s_ * 6144 + D); } } while (0)
        unsigned rr[9], kk[9], vv[9], ee[8], aa[8], rrn[9], kkn[9], vvn[9], een[8], aan[8];
        if (gw0 < nitems) { const int i0_ = prep_map(gw0, segB); PREP_LOAD(i0_, rr, kk, vv, ee, aa); }
        for (int j = gw0; j < nitems; j += ngw) { const int item = prep_map(j, segB);
            const int c = item >> 5, h = item & 31, row0 = 16 * c, hj2 = h * 64 + 2 * cp;
            const f32x2 c_kk = *(const f32x2*)(a.in[17] + hj2), c_ka = *(const f32x2*)(a.in[18] + hj2), c_rk = *(const f32x2*)(a.in[19] + hj2), c_mr = *(const f32x2*)(a.in[11] + hj2), c_mk = *(const f32x2*)(a.in[11] + D + hj2), c_mv = *(const f32x2*)(a.in[11] + 2 * D + hj2);
            if (j + ngw < nitems) { const int in_ = prep_map(j + ngw, segB); PREP_LOAD(in_, rrn, kkn, vvn, een, aan); }
            f32x2 Ll[8]; { f32x2 acc = (f32x2){0.f, 0.f};
#pragma unroll
                for (int s_ = 0; s_ < 8; ++s_) { acc -= (f32x2){H2LO(ee[s_]), H2HI(ee[s_])}; Ll[s_] = acc; } }
            const f32x2 oth = (f32x2){__shfl_xor(Ll[7].x, 32), __shfl_xor(Ll[7].y, 32)};
            const f32x2 M_ = hs ? oth : Ll[7]; const f32x2 L15 = M_ + (hs ? Ll[7] : oth);
            *(f32x2*)(LM + (size_t)item * 128 + 64 * hs + 2 * cp) = hs ? L15 : M_;
            const f32x2 off = hs ? (f32x2){0.f, 0.f} : M_;
            unsigned vpk[8];
            h16* eo = EAG + (size_t)(row0 + 8 * hs) * 6144 + hj2; h16* po = P16 + (size_t)(row0 + 8 * hs) * PP + hj2;
            f32x2 E3p = (f32x2){__expf(-off.x), __expf(-off.y)};
#pragma unroll
            for (int s_ = 0; s_ < 8; ++s_) { const int t = 8 * hs + s_;
                f32x2 r = (f32x2){H2LO(rr[s_ + 1]), H2HI(rr[s_ + 1])}, k = (f32x2){H2LO(kk[s_ + 1]), H2HI(kk[s_ + 1])}, v = (f32x2){H2LO(vv[s_ + 1]), H2HI(vv[s_ + 1])};
                r += c_mr * ((f32x2){H2LO(rr[s_]), H2HI(rr[s_])} - r); k += c_mk * ((f32x2){H2LO(kk[s_]), H2HI(kk[s_])} - k); v += c_mv * ((f32x2){H2LO(vv[s_]), H2HI(vv[s_])} - v);
                const f32x2 av = (f32x2){H2LO(aa[s_]), H2HI(aa[s_])};
                const f32x2 kkr = k * c_kk; float ss; HSUM(kkr.x * kkr.x + kkr.y * kkr.y, ss);
                const float rn = rsqrtf(fmaxf(ss, 1e-24f)); const f32x2 kap = kkr * rn;
                const f32x2 kmod = k * (1.f + (av - 1.f) * c_ka);
                const f32x2 Dm = Ll[s_] - off; const f32x2 E1 = E3p, E2 = (f32x2){__expf(-Dm.x), __expf(-Dm.y)}, E3 = (f32x2){__expf(Dm.x), __expf(Dm.y)}; E3p = E3;
                const f32x2 fat = kap * E1, frt = r * E3, fbb = kap * av * E2, fkb = kmod * E2;
                const unsigned hat = pk2h(fat.x, fat.y), hrt = pk2h(frt.x, frt.y), hbb = pk2h(fbb.x, fbb.y), hkb = pk2h(fkb.x, fkb.y);
                const f32x2 rkm = r * kmod * c_rk; float rk; HSUM(rkm.x + rkm.y, rk); if (cp == 0) RK[(size_t)(row0 + t) * 32 + h] = rk;
                *(unsigned*)(eo + (size_t)s_ * 6144) = hat; *(unsigned*)(eo + (size_t)s_ * 6144 + D) = hbb; *(unsigned*)(po + (size_t)s_ * PP) = hrt; *(unsigned*)(po + (size_t)s_ * PP + D) = hkb;
                ((LAS unsigned*)sc)[t * 32 + cp] = hat; ((LAS unsigned*)(sc + 2048))[t * 32 + cp] = hbb;
                vpk[s_] = pk2h(v.x, v.y);
            }
            { u32x4 lo, hi;
              lo.x = (vpk[0] & 0xffffu) | (vpk[1] << 16); lo.y = (vpk[2] & 0xffffu) | (vpk[3] << 16); lo.z = (vpk[4] & 0xffffu) | (vpk[5] << 16); lo.w = (vpk[6] & 0xffffu) | (vpk[7] << 16);
              hi.x = (vpk[0] >> 16) | (vpk[1] & 0xffff0000u); hi.y = (vpk[2] >> 16) | (vpk[3] & 0xffff0000u); hi.z = (vpk[4] >> 16) | (vpk[5] & 0xffff0000u); hi.w = (vpk[6] >> 16) | (vpk[7] & 0xffff0000u);
              const int i0 = 2 * cp;
              *(u32x4*)(P16 + (size_t)(row0 + (i0 >> 2)) * PP + 2 * D + h * 64 + (i0 & 3) * 16 + 8 * hs) = lo;
              *(u32x4*)(P16 + (size_t)(row0 + ((i0 + 1) >> 2)) * PP + 2 * D + h * 64 + ((i0 + 1) & 3) * 16 + 8 * hs) = hi; }
            asm volatile("s_waitcnt lgkmcnt(0)" ::: "memory");
            const int fr = lane & 15, fq = lane >> 4;
            f32x4 acc = (f32x4){0.f, 0.f, 0.f, 0.f};
#pragma unroll
            for (int kt = 0; kt < 4; ++kt) acc = __builtin_amdgcn_mfma_f32_16x16x16f16(*(const LAS h16x4*)(sc + (fr * 64 + 16 * kt + 4 * fq) * 2), *(const LAS h16x4*)(sc + 2048 + (fr * 64 + 16 * kt + 4 * fq) * 2), acc, 0, 0, 0);
            LAS float* Pm = (LAS float*)(sc + 4096);
#pragma unroll
            for (int g_ = 0; g_ < 4; ++g_) Pm[(4 * fq + g_) * 16 + fr] = (fr < 4 * fq + g_) ? acc[g_] : 0.f;
            asm volatile("s_waitcnt lgkmcnt(0)" ::: "memory");
            float Tc[16];
#pragma unroll
            for (int t = 0; t < 16; ++t) { float x = (t == fr) ? 1.f : 0.f;
#pragma unroll
                for (int j4 = 0; j4 < (t + 3) / 4; ++j4) { const f32x4 p4 = *(const LAS f32x4*)(Pm + t * 16 + 4 * j4);
                    if (4 * j4 + 0 < t) x -= p4.x * Tc[4 * j4 + 0]; if (4 * j4 + 1 < t) x -= p4.y * Tc[4 * j4 + 1]; if (4 * j4 + 2 < t) x -= p4.z * Tc[4 * j4 + 2]; if (4 * j4 + 3 < t) x -= p4.w * Tc[4 * j4 + 3]; }
                Tc[t] = x; }
            if (lane < 16) { h16* to = P16 + (size_t)row0 * PP + 6144 + h * 16 + fr;
#pragma unroll
                for (int t = 0; t < 16; ++t) to[(size_t)t * PP] = (h16)Tc[t]; }
            asm volatile("s_waitcnt lgkmcnt(0)" ::: "memory");
#pragma unroll
            for (int q_ = 0; q_ < 9; ++q_) { rr[q_] = rrn[q_]; kk[q_] = kkn[q_]; vv[q_] = vvn[q_]; }
#pragma unroll
            for (int q_ = 0; q_ < 8; ++q_) { ee[q_] = een[q_]; aa[q_] = aan[q_]; }
        }
#undef PREP_LOAD
#undef H2LO
#undef H2HI
#undef HSUM
        };
    if (IN(PH_PREP)) prep_run(gw, NGW, (2 * PREP_CA + MS / 16) * 32, false);
    SEAM(PH_PREP);
    if (IN(PH_SCAN)) {
        const int vcu = (G % 8 == 0) ? (bx % 8) * (G / 8) + bx / 8 : bx;
        constexpr int RAWB = 12288, NSL = 7, CSET = 2560, O_RAW = 0, O_CO = NSL * RAWB, O_YB = O_CO + 2 * CSET;
        static_assert(O_YB + 2 * 2048 <= LDS_BYTES - 16, "scan LDS map");
        h16* OUT16 = A16; const float* LM = (const float*)(ws + WS_LM);
        const bool pblk = vcu < 64;
        const int nitem = pblk ? 1 : (1024 - (vcu - 64) + 191) / 192;
        const int NCHB = pblk ? 256 : 4 * nitem;
#define SC_DESC(cc, prompt, sq, h, t0, first, last) \
        const bool prompt = pblk; bool first, last; int sq, h, t0; \
        if (prompt) { sq = vcu >> 5; h = vcu & 31; t0 = 16 * (cc); first = (cc) == 0; last = (cc) == 255; } \
        else { const int pair = (vcu - 64) + 192 * ((cc) >> 2); sq = pair >> 5; h = pair & 31; t0 = 16 * ((cc) & 3); first = ((cc) & 3) == 0; last = ((cc) & 3) == 3; }
#define SC_DMA(cc) do { if ((cc) < sc1) { SC_DESC(cc, prompt_, sq_, h_, t0_, first_, last_); (void)last_; (void)first_; \
            const size_t rowb_ = (size_t)(prompt_ ? sq_ * 4096 : MP + sq_ * 64) + t0_; \
            LAS unsigned char* dst_ = lds + O_RAW + ((cc) % NSL) * RAWB; \
            const int sw_ = ((lane & 7) ^ (lane >> 3)) * 8;     \
            const h16* e0_ = EAG + (rowb_ + (lane >> 3)) * 6144 + h_ * 64 + sw_; const h16* p0_ = P16 + (rowb_ + (lane >> 3)) * PP + h_ * 64 + sw_; \
            __builtin_amdgcn_global_load_lds((const unsigned*)(e0_), (LAS unsigned*)(dst_), 16, 0, 0); \
            __builtin_amdgcn_global_load_lds((const unsigned*)(e0_ + 8 * 6144), (LAS unsigned*)(dst_ + 1024), 16, 0, 0); \
            __builtin_amdgcn_global_load_lds((const unsigned*)(p0_), (LAS unsigned*)(dst_ + 2048), 16, 0, 0); \
            __builtin_amdgcn_global_load_lds((const unsigned*)(p0_ + 8 * PP), (LAS unsigned*)(dst_ + 3072), 16, 0, 0); \
            __builtin_amdgcn_global_load_lds((const unsigned*)(e0_ + D), (LAS unsigned*)(dst_ + 4096), 16, 0, 0); \
            __builtin_amdgcn_global_load_lds((const unsigned*)(e0_ + D + 8 * 6144), (LAS unsigned*)(dst_ + 5120), 16, 0, 0); \
            __builtin_amdgcn_global_load_lds((const unsigned*)(p0_ + D), (LAS unsigned*)(dst_ + 6144), 16, 0, 0); \
            __builtin_amdgcn_global_load_lds((const unsigned*)(p0_ + D + 8 * PP), (LAS unsigned*)(dst_ + 7168), 16, 0, 0); \
            __builtin_amdgcn_global_load_lds((const unsigned*)(p0_ - sw_ + (lane & 7) * 8 + 2 * D), (LAS unsigned*)(dst_ + 8192), 16, 0, 0); \
            __builtin_amdgcn_global_load_lds((const unsigned*)(p0_ - sw_ + (lane & 7) * 8 + 2 * D + 8 * PP), (LAS unsigned*)(dst_ + 9216), 16, 0, 0); \
            __builtin_amdgcn_global_load_lds((const unsigned*)(P16 + (rowb_ + ((lane & 31) >> 1)) * PP + 6144 + h_ * 16 + (lane & 1) * 8), (LAS unsigned*)(dst_ + 10240), 16, 0, 0); \
            __builtin_amdgcn_global_load_lds((const unsigned*)(LM + ((rowb_ >> 4) * 32 + h_) * 128 + (lane & 31) * 4), (LAS unsigned*)(dst_ + 11264), 16, 0, 0); } } while (0)
#define MF(a_, b_, c_) __builtin_amdgcn_mfma_f32_16x16x32_f16(a_, b_, c_, 0, 0, 0)
#define CAT8(lo_, hi_) ((h16x8){(lo_)[0], (lo_)[1], (lo_)[2], (lo_)[3], (hi_)[0], (hi_)[1], (hi_)[2], (hi_)[3]})
#define SC_C(cc) do { if ((cc) >= sc0 && (cc) < sc1) { \
            const LAS unsigned char* rs = lds + O_RAW + ((cc) % NSL) * RAWB; LAS unsigned char* co = lds + O_CO + ((cc) & 1) * CSET; \
            const int fr = lane & 15, fq = lane >> 4; const int oa = wave == 4 ? 0 : 2048, ob_ = wave == 6 ? 4096 : 6144; \
            f32x4 acc = (f32x4){0.f, 0.f, 0.f, 0.f}; \
            _Pragma("unroll") for (int kb = 0; kb < 2; ++kb) { const int o_ = fr * 128 + (((4 * kb + fq) ^ (fr & 7)) << 4); acc = MF(*(const LAS h16x8*)(rs + oa + o_), *(const LAS h16x8*)(rs + ob_ + o_), acc); } \
            _Pragma("unroll") for (int g_ = 0; g_ < 4; ++g_) { const int t = 4 * fq + g_; const bool keep = wave == 4 ? (fr < t) : (fr <= t); ((LAS h16*)(co + (wave - 4) * 512))[t * 16 + fr] = (h16)(keep ? acc[g_] : 0.f); } \
            if (wave == 4) { const float M_ = ((const LAS float*)(rs + 11264))[lane], L15 = ((const LAS float*)(rs + 11264 + 256))[lane]; \
                ((LAS float*)(co + 1536))[lane] = __expf(M_); ((LAS float*)(co + 1792))[lane] = __expf(L15 - M_); ((LAS float*)(co + 2048))[lane] = __expf(L15); } } } while (0)
        f32x4 St[4];
#pragma unroll
        for (int n = 0; n < 4; ++n) St[n] = (f32x4){0.f, 0.f, 0.f, 0.f};
#define CVT4(x_) ((h16x4){(h16)(x_)[0], (h16)(x_)[1], (h16)(x_)[2], (h16)(x_)[3]})
#define TRR(p_) __builtin_bit_cast(h16x4, __builtin_amdgcn_ds_read_tr16_b64_v4i16((LAS s16x4*)(p_)))
#define SC_ROW(cc, PROMPT) do { if ((cc) >= sc0 && (cc) < sc1) { SC_DESC(cc, prompt, sq, h, t0, first, last); \
            const int fr = lane & 15, fq = lane >> 4; \
            float* sp = a.out + (prompt ? O_WKP : O_WKS) + ((size_t)(sq * 32 + h) * 64 + 16 * wave + fr) * 64 + 4 * fq; \
            if (first) { _Pragma("unroll") for (int n = 0; n < 4; ++n) { St[n] = (f32x4){0.f, 0.f, 0.f, 0.f}; if (!(PROMPT)) St[n] = *(const f32x4*)(a.in[4] + ((size_t)(sq * 32 + h) * 64 + 16 * wave + fr) * 64 + 16 * n + 4 * fq); } } \
            LAS unsigned char* rs = lds + O_RAW + ((cc) % NSL) * RAWB; const LAS unsigned char* co = lds + O_CO + ((cc) & 1) * CSET; \
              \
            f32x4 em[4], gm[4], e4[4]; h16x4 atl[2][2], rtl[2][2], kbt[4], bbt[4]; \
            _Pragma("unroll") for (int n = 0; n < 4; ++n) { em[n] = *(const LAS f32x4*)(co + 1536 + (16 * n + 4 * fq) * 4); gm[n] = *(const LAS f32x4*)(co + 2048 + (16 * n + 4 * fq) * 4); e4[n] = *(const LAS f32x4*)(co + 1792 + (16 * n + 4 * fq) * 4); } \
            _Pragma("unroll") for (int b = 0; b < 2; ++b) { \
                const int o0_ = fr * 128 + (((4 * b + (fq >> 1)) ^ (fr & 7)) << 4) + 8 * (fq & 1), o1_ = fr * 128 + (((4 * b + 2 + (fq >> 1)) ^ (fr & 7)) << 4) + 8 * (fq & 1); \
                atl[b][0] = *(const LAS h16x4*)(rs + o0_); atl[b][1] = *(const LAS h16x4*)(rs + o1_); rtl[b][0] = *(const LAS h16x4*)(rs + 2048 + o0_); rtl[b][1] = *(const LAS h16x4*)(rs + 2048 + o1_); } \
            const h16x4 vm = *(const LAS h16x4*)(rs + 8192 + ((16 * wave + fr) * 16 + 4 * fq) * 2), aak = *(const LAS h16x4*)(co + (fr * 16 + 4 * fq) * 2), tA = *(const LAS h16x4*)(rs + 10240 + (fr * 16 + 4 * fq) * 2), \
                        ark = *(const LAS h16x4*)(co + 512 + (fr * 16 + 4 * fq) * 2), arb = *(const LAS h16x4*)(co + 1024 + (fr * 16 + 4 * fq) * 2); \
            _Pragma("unroll") for (int n = 0; n < 4; ++n) { const int tr_ = 4 * fq + (fr >> 2); const int o_ = tr_ * 128 + (((2 * n + ((fr & 3) >> 1)) ^ (tr_ & 7)) << 4) + 8 * (fr & 1); kbt[n] = TRR(rs + 6144 + o_); bbt[n] = TRR(rs + 4096 + o_); } \
            asm volatile("s_waitcnt lgkmcnt(0)" ::: "memory"); \
            const h16x4 z4 = (h16x4){(h16)0.f, (h16)0.f, (h16)0.f, (h16)0.f}; \
            h16x4 sh[4]; \
            _Pragma("unroll") for (int n = 0; n < 4; ++n) { const f32x4 x = St[n] * em[n]; sh[n] = CVT4(x); } \
            f32x4 W1 = (f32x4){0.f, 0.f, 0.f, 0.f}, Yt = W1; \
              \
            _Pragma("unroll") for (int b = 0; b < 2; ++b) { const h16x8 sb = CAT8(sh[2 * b], sh[2 * b + 1]); \
                W1 = MF(CAT8(atl[b][0], atl[b][1]), sb, W1); Yt = MF(CAT8(rtl[b][0], rtl[b][1]), sb, Yt); } \
            W1 = MF(CAT8(aak, z4), CAT8(vm, z4), W1); \
            const h16x4 w1h = CVT4(W1); \
            f32x4 U = MF(CAT8(tA, z4), CAT8(w1h, z4), ((f32x4){0.f, 0.f, 0.f, 0.f})); \
            const f32x4 nU = -U; const h16x4 uh = CVT4(nU); const h16x8 vu = CAT8(vm, uh);     \
            Yt = MF(CAT8(ark, arb), vu, Yt); \
            _Pragma("unroll") for (int n = 0; n < 4; ++n) { const f32x4 tmp = MF(CAT8(kbt[n], bbt[n]), vu, ((f32x4){0.f, 0.f, 0.f, 0.f})); St[n] = gm[n] * St[n] + e4[n] * tmp; } \
            { LAS h16* yb = (LAS h16*)(lds + O_YB + ((cc) & 1) * 2048) + (4 * fq) * 64 + 16 * wave + fr; (void)t0; \
              yb[0] = (h16)Yt[0]; yb[64] = (h16)Yt[1]; yb[128] = (h16)Yt[2]; yb[192] = (h16)Yt[3]; } \
            if (last) { _Pragma("unroll") for (int n = 0; n < 4; ++n) *(f32x4*)(sp + 16 * n) = St[n]; } } } while (0)
#define SC_YOUT(cc) do { if ((cc) >= sc0 && (cc) < sc1 && wave >= 5) { SC_DESC(cc, prompt, sq, h, t0, first, last); (void)first; (void)last; \
            const int L_ = (wave - 5) * 64 + lane, t_ = L_ >> 3, part_ = L_ & 7; \
            *(u32x4*)(OUT16 + ((size_t)(prompt ? sq * 4096 : MP + sq * 64) + t0 + t_) * D + h * 64 + part_ * 8) = *(const LAS u32x4*)(lds + O_YB + ((cc) & 1) * 2048 + t_ * 128 + part_ * 16); } } while (0)
#define SC_BARRIER() do { asm volatile("s_waitcnt lgkmcnt(0)" ::: "memory"); __builtin_amdgcn_s_barrier(); asm volatile("" ::: "memory"); } while (0)
        auto scan_run = [&](const int sc0, const int sc1) {
            if (wave < 4) {
                SC_BARRIER();
                if (pblk) { for (int it = sc0 - 1; it <= sc1; ++it) { SC_ROW(it, true); SC_BARRIER(); } }
                else { for (int it = sc0 - 1; it <= sc1; ++it) { SC_ROW(it, false); SC_BARRIER(); } }
            } else if (wave == 7) {
                SC_DMA(sc0); SC_DMA(sc0 + 1); SC_DMA(sc0 + 2); SC_DMA(sc0 + 3); SC_DMA(sc0 + 4);
                asm volatile("s_waitcnt vmcnt(48)" ::: "memory");
                SC_BARRIER();
                for (int it = sc0 - 1; it <= sc1; ++it) {
                    SC_DMA(it + 6);
                    if (it + 6 < sc1) asm volatile("s_waitcnt vmcnt(48)" ::: "memory");
                    else asm volatile("s_waitcnt vmcnt(0)" ::: "memory");
                    SC_BARRIER();
                }
            } else {
                SC_BARRIER();
                for (int it = sc0 - 1; it <= sc1; ++it) { SC_C(it + 1); SC_YOUT(it - 1); SC_BARRIER(); }
            }
        };
        if (pblk) scan_run(0, PREP_CA);
        else prep_run((vcu - 64) * NWAVES + wave, (G - 64) * NWAVES, 2 * (256 - PREP_CA) * 32, true);
        xcd_barrier(xbar);
        scan_run(pblk ? PREP_CA : 0, pblk ? 256 : NCHB);
        if (!pblk) {
            __syncthreads();
            LAS float* scr = (LAS float*)(lds + wave * 16384);
            constexpr int I1 = (D / 64) * (2 * FF / 32), I2 = (FF / 64) * (D / 32);
            const int gw = (vcu - 64) * NWAVES + wave, NGW = (G - 64) * NWAVES;
#define PICK2(it, out) do { int r_ = (it); if (r_ < I1) out = cvt_decode(1, a.in[25], a.in[26], FF, D, W2GU, 2 * FF / 32, r_, lane); else out = cvt_decode(0, a.in[27], a.in[27], D, FF, W2D, D / 32, r_ - I1, lane); } while (0)
            CVT_RUN(I1 + I2, PICK2);
#undef PICK2
        }
#undef SC_DESC
#undef SC_DMA
#undef MF
#undef CAT8
#undef SC_C
#undef CVT4
#undef TRR
#undef SC_ROW
#undef SC_BARRIER
#undef SC_YOUT
    }
    SEAM(PH_SCAN);
    if (IN(PH_MERGE)) {
        const float* RK = (const float*)(ws + WS_RK);
        const int o8 = tid & 255, c0 = o8 * 8, hd = o8 >> 3, rg = tid >> 8;
        float w0[8], w1[8], w2[8], lg[8], lb[8];
#pragma unroll
        for (int j = 0; j < 8; ++j) { w0[j] = a.in[22][c0 + j]; w1[j] = a.in[22][D + c0 + j]; w2[j] = a.in[22][2 * D + c0 + j]; lg[j] = a.in[20][c0 + j]; lb[j] = a.in[21][c0 + j]; }
        for (int c = bx; c < MT / 16; c += G) {
            const int row0 = 16 * c + 8 * rg;
            const bool pr = row0 < MP; const int tt0 = pr ? (row0 & 4095) : ((row0 - MP) & 63), sq = pr ? (row0 >> 12) : ((row0 - MP) >> 6), T = pr ? 4096 : 64;
            h16x8 vt[8];
            { const h16* vb = P16 + (size_t)(16 * c + ((c0 & 63) >> 2)) * PP + 2 * D + (c0 & ~63) + 8 * rg;
#pragma unroll
              for (int j = 0; j < 8; ++j) vt[j] = *(const h16x8*)(vb + (size_t)(j >> 2) * PP + (j & 3) * 16); }
            float u1[8], u2[8];
            { const h16* prow = P16 + (size_t)row0 * PP;
              if (tt0 >= 2) { const h16x8 p1 = *(const h16x8*)(prow - PP + C_U + c0), p2 = *(const h16x8*)(prow - 2 * PP + C_U + c0);
#pragma unroll
                  for (int j = 0; j < 8; ++j) { u1[j] = (float)p1[j]; u2[j] = (float)p2[j]; }
              } else {
#pragma unroll
                  for (int j = 0; j < 8; ++j) { u2[j] = pr ? 0.f : a.in[3][(size_t)sq * 2 * D + c0 + j]; u1[j] = pr ? 0.f : a.in[3][(size_t)sq * 2 * D + D + c0 + j]; } } }
#pragma unroll
            for (int hf = 0; hf < 4; ++hf) {
                h16x8 ov[2], gv[2], uu[2], qq[2], sa[2]; float rk[2];
#pragma unroll
                for (int r = 0; r < 2; ++r) { const int row = row0 + 2 * hf + r; const h16* prow = P16 + (size_t)row * PP;
                    ov[r] = *(const h16x8*)(A16 + (size_t)row * D + c0); gv[r] = *(const h16x8*)(EAG + (size_t)row * 6144 + 2 * D + c0);
                    uu[r] = *(const h16x8*)(prow + C_U + c0); qq[r] = *(const h16x8*)(prow + C_Q + c0); sa[r] = *(const h16x8*)(prow + C_SA + c0);
                    rk[r] = RK[(size_t)row * 32 + hd]; }
#pragma unroll
                for (int r = 0; r < 2; ++r) { const int row = row0 + 2 * hf + r, tt = tt0 + 2 * hf + r;
                    float of[8], s1 = 0.f;
#pragma unroll
                    for (int j = 0; j < 8; ++j) { of[j] = (float)ov[r][j]; s1 += of[j]; }
                    const float mean = row_allreduce8(s1) * (1.f / 64.f); float s2 = 0.f;
#pragma unroll
                    for (int j = 0; j < 8; ++j) { of[j] -= mean; s2 += of[j] * of[j]; }
                    const float rstd = rsqrtf(row_allreduce8(s2) * (1.f / 64.f) + 64e-5f);
                    float mg[8], u0[8];
#pragma unroll
                    for (int j = 0; j < 8; ++j) {
                        const float vs = (float)vt[j][2 * hf + r];
                        const float ya = (of[j] * rstd * lg[j] + lb[j] + rk[r] * vs) * (float)gv[r][j];
                        u0[j] = (float)uu[r][j];
                        const float cv = w0[j] * u2[j] + w1[j] * u1[j] + w2[j] * u0[j];
                        mg[j] = (float)sa[r][j] * ya + (float)qq[r][j] * cv; u2[j] = u1[j]; u1[j] = u0[j]; }
                    *(u32x4*)(A16 + (size_t)row * D + c0) = (u32x4){pk2h(mg[0], mg[1]), pk2h(mg[2], mg[3]), pk2h(mg[4], mg[5]), pk2h(mg[6], mg[7])};
                    if (tt >= T - 2) { float* q = a.out + (pr ? O_CVP : O_CVS) + (size_t)sq * 2 * D + (size_t)(tt - (T - 2)) * D + c0;
                        *(f32x4*)q = (f32x4){u0[0], u0[1], u0[2], u0[3]}; *(f32x4*)(q + 4) = (f32x4){u0[4], u0[5], u0[6], u0[7]}; }
                }
            }
        }
    }
    SEAM(PH_MERGE);
    if (IN(PH_WOUT)) {
        { pg8::Gemm g{A16, WOUT, MT, D, D}; pg8::Order S; S.init(MT, D, D, G, bx, 0, MP / 256); pg8::EpiRes<true, true> E{XH, XH, SLAB, 1.0f, 0}; pg8::gemm_phase(lds, g, S, E); }
    }
    SEAM(PH_WOUT);
    if (IN(PH_RMS2)) { for (int m = gw; m < MT; m += NGW) { if (m < MP) rms_row_h(XH + (size_t)m * D, a.in[24], A16 + (size_t)m * D, nullptr, lane);
            else rms_row_f16(Y + (size_t)m * D, a.in[24], A16 + (size_t)m * D, nullptr, lane, (const h16*)SLAB + (size_t)(m - MP) * D, 1.0f, Y + (size_t)m * D); } }
    SEAM(PH_RMS2);
    if (IN(PH_FFN2_GU)) { pg8::Gemm g{A16, W2GU, MT, 2 * FF, D}; pg8::Order S; S.init(MT, 2 * FF, D, G, bx, 0, -1); pg8::EpiSwiGLU E{HM, FF}; pg8::gemm_phase(lds, g, S, E); }
    SEAM(PH_FFN2_GU);
    if (IN(PH_FFN2_D)) { pg8::Gemm g{HM, W2D, MT, D, FF}; pg8::Order S; S.init(MT, D, FF, G, bx, 0, MP / 256); pg8::EpiRes<true, true> E{XH, A16, SLAB, 0.5f, 0}; pg8::gemm_phase(lds, g, S, E); }
    SEAM(PH_FFN2_D);
    if (IN(PH_FINAL)) { for (int m = gw; m < MT; m += NGW) { if (m < MP) rms_row_h(A16 + (size_t)m * D, a.in[28], nullptr, Y + (size_t)m * D, lane);
            else rms_row_f16(Y + (size_t)m * D, a.in[28], nullptr, Y + (size_t)m * D, lane, (const h16*)SLAB + (size_t)(m - MP) * D, 0.5f, nullptr); } }
    if (PROBE_MASK) {
        pr_t[PH_N] = __builtin_amdgcn_s_memrealtime();
        if (bx == 0 && tid == 0) { unsigned long long tot = 0;
#pragma unroll
            for (int k = 0; k < PH_N; ++k) if ((PROBE_MASK >> k) & 1u) tot += pr_t[k + 1] - pr_t[k];
            const unsigned long long t0 = __builtin_amdgcn_s_memrealtime();
            while (__builtin_amdgcn_s_memrealtime() - t0 < tot * PROBE_MUL) __builtin_amdgcn_s_sleep(8);
        }
    }
#undef IN
#undef SEAM
}

extern "C" void kernel_launch(void* const* d_in, const int* in_sizes, int n_in, void* d_out, int out_size, void* d_ws, size_t ws_size, hipStream_t stream) {
    static int grid = 0;
    if (grid == 0) {
        if (n_in != 29 || (size_t)out_size != O_END || ws_size < WS_END) { fprintf(stderr, "kernel_launch: unexpected shapes (n_in %d out %d ws %zu need %zu)\n", n_in, out_size, ws_size, (size_t)WS_END); grid = -1; return; }
        int dev = 0, cus = 0, per_cu = 0;
        if (hipGetDevice(&dev) != hipSuccess || hipDeviceGetAttribute(&cus, hipDeviceAttributeMultiprocessorCount, dev) != hipSuccess) { grid = -1; return; }
        if (hipFuncSetAttribute((const void*)fwd_kernel, hipFuncAttributeMaxDynamicSharedMemorySize, LDS_BYTES) != hipSuccess) { grid = -1; return; }
        if (hipOccupancyMaxActiveBlocksPerMultiprocessor(&per_cu, (const void*)fwd_kernel, NTHR, LDS_BYTES) != hipSuccess || per_cu < 1) { fprintf(stderr, "kernel_launch: occupancy query failed (%d)\n", per_cu); grid = -1; return; }
        grid = cus;
    }
    if (grid < 0) return;
    Args a{};
    for (int i = 0; i < 29; ++i) a.in[i] = (const float*)d_in[i];
    a.out = (float*)d_out; a.ws = (unsigned char*)d_ws; a.ph_lo = 0; a.ph_hi = PH_N;
    void* kargs[] = {&a};
    hipError_t e = hipLaunchCooperativeKernel((const void*)fwd_kernel, dim3(grid), dim3(NTHR), kargs, LDS_BYTES, stream);
    if (e != hipSuccess) fprintf(stderr, "kernel_launch: cooperative launch failed: %s (grid %d)\n", hipGetErrorString(e), grid);
}
```

```cpp
#include <hip/hip_runtime.h>
#include <hip/hip_cooperative_groups.h>
#include <cstdio>
namespace cg = cooperative_groups;

#define LAS __attribute__((address_space(3)))
typedef _Float16 h16;
typedef _Float16 h16x2 __attribute__((ext_vector_type(2)));
typedef _Float16 h16x4 __attribute__((ext_vector_type(4)));
typedef _Float16 h16x8 __attribute__((ext_vector_type(8)));
typedef short s16x4 __attribute__((ext_vector_type(4)));
typedef float f32x4 __attribute__((ext_vector_type(4)));
typedef float f32x2 __attribute__((ext_vector_type(2)));
typedef unsigned u32x4 __attribute__((ext_vector_type(4)));
typedef unsigned u32x2 __attribute__((ext_vector_type(2)));

constexpr int D = 2048, FF = 5632, NA = 6592, NIN = 16832;
constexpr int MP = 8192, MS = 2048, MT = MP + MS;
constexpr int MA = MT + 256;
constexpr int PP = 12800;
constexpr int NW = 16896;
constexpr int PFW = 6656;
constexpr int C_U = 6656, C_Q = 8704, C_SA = 10752;
constexpr int LK = 512;
constexpr int NCHUNK = MT / 64;
constexpr size_t O_Y = 0, O_SHP = 20971520, O_CVP = 20975616, O_WKP = 20983808, O_SHS = 21245952, O_CVS = 21311488, O_WKS = 21442560, O_END = 25636864;
constexpr size_t WS_CTL = 0;
constexpr size_t WS_W1GU = 1u << 20;
constexpr size_t WS_W1D = WS_W1GU + (size_t)2 * FF * D * 2;
constexpr size_t WS_WIN = WS_W1D + (size_t)D * FF * 2;
constexpr size_t WS_WOUT = WS_WIN + (size_t)NW * D * 2;
constexpr size_t WS_A16 = WS_WOUT + (size_t)D * D * 2;
constexpr size_t WS_P16 = WS_A16 + (size_t)MA * D * 2;
constexpr size_t WS_W2GU = WS_P16 + (size_t)MT * PP * 2;
constexpr size_t WS_W2D = WS_W2GU + (size_t)2 * FF * D * 2;
constexpr size_t WS_PF = WS_W2D + (size_t)D * FF * 2;
constexpr size_t WS_END = WS_PF + (size_t)256 * PFW * 2;
constexpr size_t WS_EAG = WS_W1GU;
constexpr size_t WS_HM = WS_P16;
constexpr size_t WS_SLAB = WS_HM + (size_t)MT * FF * 2;
static_assert((size_t)MT * 6144 * 2 <= WS_WOUT - WS_W1GU, "EAG overlay");
static_assert(WS_SLAB + (size_t)4 * MS * D * 4 <= WS_W2GU, "HM + slab overlay of P16");
constexpr size_t OB_WL = O_WKS * 4;
constexpr size_t OB_SIDE = OB_WL + (size_t)6144 * LK * 2;
static_assert(OB_SIDE + (size_t)(MT / 16) * 6144 * 2 <= O_END * 4, "d_out scratch");

constexpr size_t WS_RK = WS_EAG + (size_t)MT * 6144 * 2;
constexpr size_t WS_LM = WS_RK + (size_t)MT * 32 * 4;
static_assert(WS_LM + (size_t)(MT / 16) * 32 * 128 * 4 <= WS_WOUT, "RK + LM");
constexpr int SC_SLOT = 6 * 64, SC_BUF = 16 * SC_SLOT;
constexpr int NWAVES = 8, NTHR = 512;
constexpr int LDS_BYTES = 147456;

__device__ __forceinline__ unsigned pk2h(float a, float b) { h16x2 v = {(h16)a, (h16)b}; return __builtin_bit_cast(unsigned, v); }
__device__ __forceinline__ float wave_sum(float v) {
#pragma unroll
    for (int o = 1; o < 64; o <<= 1) v += __shfl_xor(v, o);
    return v;
}
template <int CTRL> __device__ __forceinline__ float dpp_f(float x) { return __builtin_bit_cast(float, __builtin_amdgcn_update_dpp(0, __builtin_bit_cast(int, x), CTRL, 0xF, 0xF, false)); }
__device__ __forceinline__ float row_allreduce8(float x) { x += dpp_f<0xB1>(x); x += dpp_f<0x4E>(x); x += dpp_f<0x141>(x); return x; }
__device__ __forceinline__ float row_allreduce16(float x) { x = row_allreduce8(x); x += dpp_f<0x140>(x); return x; }
__device__ __forceinline__ float rl_f(float x, int l) { return __builtin_bit_cast(float, __builtin_amdgcn_readlane(__builtin_bit_cast(int, x), l)); }
__device__ __forceinline__ float wave_sum_dpp(float x) { x = row_allreduce16(x); return (rl_f(x, 0) + rl_f(x, 16)) + (rl_f(x, 32) + rl_f(x, 48)); }
__device__ __forceinline__ float wave_sum_bc(float x) {
    x = row_allreduce16(x);
    x += __builtin_bit_cast(float, __builtin_amdgcn_update_dpp(0, __builtin_bit_cast(int, x), 0x142, 0xA, 0xF, false));
    x += __builtin_bit_cast(float, __builtin_amdgcn_update_dpp(0, __builtin_bit_cast(int, x), 0x143, 0xC, 0xF, false));
    return rl_f(x, 63); }
__device__ __forceinline__ float sigmoidf_(float x) { return __builtin_amdgcn_rcpf(1.0f + __expf(-x)); }
__device__ __forceinline__ float tanhf_(float x) { return 1.0f - 2.0f * __builtin_amdgcn_rcpf(1.0f + __expf(2.0f * x)); }

namespace pg8 {
constexpr int BM = 256, BK = 64, HALF = 128, HTB = HALF * BK * 2, STAGE_BYTES = 8 * HTB, NXCD = 8, WGM = 8;
__host__ __device__ __forceinline__ int lds_byte(int r, int c) { const int st = (r >> 4) * 2 + (c >> 5), rr = r & 15, cc = c & 31, ob = rr * 64 + cc * 2; return st * 1024 + (ob ^ (((ob >> 9) & 1) << 5)); }
__host__ __device__ __forceinline__ void stage_rc(int b, int& R, int& C) { const int st = b / 1024, sb = b % 1024, swz = sb ^ (((sb >> 9) & 1) << 5); R = (st >> 1) * 16 + swz / 64; C = (st & 1) * 32 + (swz % 64) / 2; }
__host__ __device__ __forceinline__ int perm32(int rho) { const int n = rho >> 4, i = rho & 15; return 8 * (i >> 2) + 4 * n + (i & 3); }
struct Unit { int pm, pn, kt0, nkt, sp; };
struct Gemm { const h16* A; const h16* Bt; int M, N, K; };
struct Order {
    int nM, nN, nwg, G, c, extra, nkt, nsplit;
    __device__ void init(int M, int N, int K, int G_, int c_, int extra_, int nMw) { nM = M / BM; nN = N / BM; nwg = (nMw < 0 ? nM : nMw) * nN; G = G_; c = c_; extra = extra_; nkt = K / BK; nsplit = nMw < 0 ? 0 : (nM - nMw) * nN * 4; }
    __device__ bool next(int i, Unit& u) const {
        const long L = (long)i * G + c; if (L >= nwg + extra + nsplit) return false;
        u.kt0 = 0; u.nkt = nkt; u.sp = -1;
        if (L >= nwg + extra) { const int j = (int)(L - nwg - extra), rows = nM - nwg / nN; u.nkt = nkt >> 2;
            if (rows == 8 && nN == 8) {
                const int xcd = j & 7, idx = j >> 3; u.sp = xcd >> 1; u.pn = 4 * (xcd & 1) + (idx >> 3); u.pm = nwg / nN + (idx & 7); }
            else { const int tile = j >> 2; u.sp = j & 3; u.pm = nwg / nN + tile % rows; u.pn = tile / rows; }
            u.kt0 = u.sp * u.nkt; return true; }
        if (L >= nwg) { u.pm = nM; u.pn = (int)(L - nwg); return true; }
        const int nMe = nwg / nN;
        int wgid = (int)L; { const int q = nwg / NXCD, r = nwg % NXCD, xcd = wgid % NXCD, off = wgid / NXCD; wgid = (xcd < r ? xcd * (q + 1) : r * (q + 1) + (xcd - r) * q) + off; }
        const int nig = WGM * nN, gid = wgid / nig, fm = gid * WGM, gsz = (nMe - fm) < WGM ? (nMe - fm) : WGM;
        u.pm = fm + ((wgid % nig) % gsz); u.pn = (wgid % nig) / gsz; return true;
    }
};

__device__ __forceinline__ void lora_k(Unit& u) { const int typ = u.pn >> 3; u.kt0 = typ == 0 ? 0 : typ == 1 ? 1 : 3; u.nkt = typ == 2 ? 4 : 2; }
template <class Epi, bool LORAK = false, bool SP2 = true, bool ALIGN_EPI = true>
__device__ __forceinline__ void gemm_phase(LAS unsigned char* lds, const Gemm g, const Order& S, const Epi& E) {
    const int tid = threadIdx.x, wid = __builtin_amdgcn_readfirstlane(tid >> 6), lane = tid & 63, wr = wid >> 2, wc = wid & 3, fr = lane & 15, fq = lane >> 4;
    const int K = g.K;
    unsigned voffA[2], voffB[2];
#pragma unroll
    for (int i = 0; i < 2; ++i) { int R, C; stage_rc(tid * 16 + i * 8192, R, C); const int Rb = Epi::PERM ? ((R & ~31) + perm32(R & 31)) : R;
        voffA[i] = (unsigned)(R * K + C) * 2u; voffB[i] = (unsigned)(Rb * K + C) * 2u; }
    const size_t kstep = (size_t)(BK * 2);
    const size_t hstep = (size_t)HALF * K * 2;
    const size_t tstep = 2 * hstep;
    const unsigned ldsw = (unsigned)wid * 1024u;
    const int aoff = lds_byte(wr * 64 + fr, fq * 8), boff = lds_byte(wc * 32 + fr, fq * 8);
#define PG8_SA(b, h) (((b) * 2 + (h)) * HTB)
#define PG8_SB(b, h) ((4 + (b) * 2 + (h)) * HTB)
#define PG8_STAGE(bufoff, gbase, voff) do { _Pragma("unroll") for (int _i = 0; _i < 2; ++_i) \
        __builtin_amdgcn_global_load_lds((const unsigned*)((const char*)(gbase) + (voff)[_i]), (LAS unsigned*)(lds + (bufoff) + ldsw + _i * 8192), 16, 0, 0); } while (0)
#define PG8_LDA(dst, b, h) do { _Pragma("unroll") for (int m = 0; m < 4; ++m) _Pragma("unroll") for (int k = 0; k < 2; ++k) dst[m][k] = *(const LAS h16x8*)(lds + PG8_SA(b, h) + aoff + m * 2048 + k * 1024); } while (0)
#define PG8_LDB(dst, b, h) do { _Pragma("unroll") for (int n = 0; n < 2; ++n) _Pragma("unroll") for (int k = 0; k < 2; ++k) dst[n][k] = *(const LAS h16x8*)(lds + PG8_SB(b, h) + boff + n * 2048 + k * 1024); } while (0)
#define PG8_MMA(ai, bj, At, Bt) do { __builtin_amdgcn_s_setprio(1); _Pragma("unroll") for (int m = 0; m < 4; ++m) _Pragma("unroll") for (int n = 0; n < 2; ++n) _Pragma("unroll") for (int k = 0; k < 2; ++k) \
        acc[ai][bj][m][n] = __builtin_amdgcn_mfma_f32_16x16x32_f16(Bt[n][k], At[m][k], acc[ai][bj][m][n], 0, 0, 0); __builtin_amdgcn_s_setprio(0); } while (0)
#define PG8_WAIT_V(n) asm volatile("s_waitcnt vmcnt(" #n ")" ::: "memory")
#define PG8_WAIT_L(n) asm volatile("s_waitcnt lgkmcnt(" #n ")" ::: "memory")
#define PG8_BAR __builtin_amdgcn_s_barrier()
#define PG8_SCHED __builtin_amdgcn_sched_barrier(0)
    Unit cur, nxt; int ui = 0;
    if (!S.next(0, cur)) return;
    if constexpr (LORAK) lora_k(cur);
    f32x4 acc[2][2][4][2];
#pragma unroll
    for (int a = 0; a < 2; ++a)
#pragma unroll
        for (int b = 0; b < 2; ++b)
#pragma unroll
            for (int m = 0; m < 4; ++m)
#pragma unroll
                for (int n = 0; n < 2; ++n) acc[a][b][m][n] = (f32x4){0.f, 0.f, 0.f, 0.f};
    h16x8 At[4][2], B0[2][2], B1[2][2];
    const char* cA = (const char*)g.A + (size_t)cur.pm * tstep + (size_t)cur.kt0 * kstep; const char* cB = (const char*)g.Bt + (size_t)cur.pn * tstep + (size_t)cur.kt0 * kstep;
    if constexpr (SP2) {
        PG8_STAGE(PG8_SB(0, 0), cB, voffB); PG8_STAGE(PG8_SB(0, 1), cB + hstep, voffB); PG8_STAGE(PG8_SA(0, 0), cA, voffA); PG8_STAGE(PG8_SA(0, 1), cA + hstep, voffA);
        if (wr == 1) PG8_BAR;
        PG8_WAIT_V(2); PG8_BAR;
        PG8_STAGE(PG8_SB(1, 0), cB + kstep, voffB); PG8_STAGE(PG8_SA(1, 0), cA + kstep, voffA); PG8_STAGE(PG8_SB(1, 1), cB + hstep + kstep, voffB);
        PG8_WAIT_V(6); PG8_BAR;
    } else {
        PG8_STAGE(PG8_SB(0, 0), cB, voffB); PG8_STAGE(PG8_SA(0, 0), cA, voffA); PG8_STAGE(PG8_SB(0, 1), cB + hstep, voffB); PG8_STAGE(PG8_SA(0, 1), cA + hstep, voffA);
        if (wr == 1) PG8_BAR;
        PG8_WAIT_V(4); PG8_BAR;
        PG8_STAGE(PG8_SB(1, 0), cB + kstep, voffB); PG8_STAGE(PG8_SA(1, 0), cA + kstep, voffA); PG8_STAGE(PG8_SB(1, 1), cB + hstep + kstep, voffB);
        PG8_WAIT_V(6); PG8_BAR;
    }
    for (;;) {
        const bool has_next = S.next(ui + 1, nxt);
        if constexpr (LORAK) { if (has_next) lora_k(nxt); }
        const char* nA = has_next ? (const char*)g.A + (size_t)nxt.pm * tstep + (size_t)nxt.kt0 * kstep : cA; const char* nB = has_next ? (const char*)g.Bt + (size_t)nxt.pn * tstep + (size_t)nxt.kt0 * kstep : cB;
        const int nt = cur.nkt;
        for (int t = 0; t < nt; t += 2) {
            const bool last = (t == nt - 2);
            const char* a1 = cA + (size_t)(t + 1) * kstep;
            const char* a2 = last ? nA : cA + (size_t)(t + 2) * kstep; const char* b2 = last ? nB : cB + (size_t)(t + 2) * kstep;
            const char* a3 = a2 + kstep; const char* b3 = b2 + kstep;
            if constexpr (SP2) {
            PG8_LDB(B0, 0, 0); PG8_LDB(B1, 0, 1); PG8_SCHED; PG8_LDA(At, 0, 0); PG8_STAGE(PG8_SA(1, 1), a1 + hstep, voffA);
            PG8_WAIT_V(8); PG8_WAIT_L(0); PG8_BAR; PG8_MMA(0, 0, At, B0); PG8_MMA(0, 1, At, B1); PG8_BAR; PG8_SCHED;
            PG8_LDA(At, 0, 1); PG8_STAGE(PG8_SB(0, 0), b2, voffB); PG8_STAGE(PG8_SB(0, 1), b2 + hstep, voffB); PG8_STAGE(PG8_SA(0, 0), a2, voffA);
            PG8_WAIT_V(8); PG8_WAIT_L(0); PG8_BAR; PG8_MMA(1, 0, At, B0); PG8_MMA(1, 1, At, B1); PG8_BAR; PG8_SCHED;
            PG8_LDB(B0, 1, 0); PG8_LDB(B1, 1, 1); PG8_SCHED; PG8_LDA(At, 1, 0); PG8_STAGE(PG8_SA(0, 1), a2 + hstep, voffA);
            PG8_WAIT_V(8); PG8_WAIT_L(0); PG8_BAR; PG8_MMA(0, 0, At, B0); PG8_MMA(0, 1, At, B1); PG8_BAR; PG8_SCHED;
            PG8_LDA(At, 1, 1); PG8_STAGE(PG8_SB(1, 0), b3, voffB); PG8_STAGE(PG8_SB(1, 1), b3 + hstep, voffB); PG8_STAGE(PG8_SA(1, 0), a3, voffA);
            PG8_WAIT_V(8); PG8_WAIT_L(0); PG8_BAR; PG8_MMA(1, 0, At, B0); PG8_MMA(1, 1, At, B1); PG8_BAR; PG8_SCHED;
            } else {
            PG8_LDB(B0, 0, 0); PG8_SCHED; PG8_LDA(At, 0, 0); PG8_STAGE(PG8_SA(1, 1), a1 + hstep, voffA);
            PG8_WAIT_L(8); PG8_BAR; PG8_WAIT_L(0); PG8_MMA(0, 0, At, B0); PG8_BAR; PG8_SCHED;
            PG8_LDB(B1, 0, 1); PG8_STAGE(PG8_SB(0, 0), b2, voffB);
            PG8_BAR; PG8_WAIT_L(0); PG8_MMA(0, 1, At, B1); PG8_BAR;
            PG8_LDA(At, 0, 1); PG8_STAGE(PG8_SA(0, 0), a2, voffA);
            PG8_BAR; PG8_WAIT_L(0); PG8_MMA(1, 0, At, B0); PG8_BAR; PG8_SCHED;
            PG8_STAGE(PG8_SB(0, 1), b2 + hstep, voffB);
            PG8_WAIT_V(6); PG8_BAR; PG8_MMA(1, 1, At, B1); PG8_BAR;
            PG8_LDB(B0, 1, 0); PG8_SCHED; PG8_LDA(At, 1, 0); PG8_STAGE(PG8_SA(0, 1), a2 + hstep, voffA);
            PG8_WAIT_L(8); PG8_BAR; PG8_WAIT_L(0); PG8_MMA(0, 0, At, B0); PG8_BAR; PG8_SCHED;
            PG8_LDB(B1, 1, 1); PG8_STAGE(PG8_SB(1, 0), b3, voffB);
            PG8_BAR; PG8_WAIT_L(0); PG8_MMA(0, 1, At, B1); PG8_BAR;
            PG8_LDA(At, 1, 1); PG8_STAGE(PG8_SA(1, 0), a3, voffA);
            PG8_BAR; PG8_WAIT_L(0); PG8_MMA(1, 0, At, B0); PG8_BAR; PG8_SCHED;
            PG8_STAGE(PG8_SB(1, 1), b3 + hstep, voffB);
            PG8_WAIT_V(6); PG8_BAR; PG8_MMA(1, 1, At, B1); PG8_BAR;
                    }
        }
        if constexpr (ALIGN_EPI) { if (wr == 0) PG8_BAR; }
        E(acc, cur, wr, wc, fr, fq);
        if (!has_next) break;
#pragma unroll
        for (int a = 0; a < 2; ++a)
#pragma unroll
            for (int b = 0; b < 2; ++b)
#pragma unroll
                for (int m = 0; m < 4; ++m)
#pragma unroll
                    for (int n = 0; n < 2; ++n) acc[a][b][m][n] = (f32x4){0.f, 0.f, 0.f, 0.f};
        cur = nxt; cA = nA; cB = nB; ++ui;
        if constexpr (ALIGN_EPI) { if (wr == 1) PG8_BAR; }
    }
    PG8_WAIT_V(0);
    if constexpr (!ALIGN_EPI) { if (wr == 0) PG8_BAR; }
    PG8_BAR;
#undef PG8_SA
#undef PG8_SB
#undef PG8_STAGE
#undef PG8_LDA
#undef PG8_LDB
#undef PG8_MMA
#undef PG8_WAIT_V
#undef PG8_WAIT_L
#undef PG8_BAR
#undef PG8_SCHED
}

struct EpiSwiGLU {
    static constexpr bool PERM = false;
    h16* O; int ldo;
    __device__ __forceinline__ void operator()(const f32x4 (&acc)[2][2][4][2], const Unit& u, int wr, int wc, int fr, int fq) const {
        const int row0 = u.pm * BM + wr * 64 + fr;
#pragma unroll
        for (int ai = 0; ai < 2; ++ai)
#pragma unroll
            for (int m = 0; m < 4; ++m) { h16* rowp = O + (size_t)(row0 + ai * HALF + m * 16) * ldo;
#pragma unroll
                for (int bj = 0; bj < 2; ++bj) { const int oc = (u.pn * BM + bj * HALF + wc * 32) / 2 + 4 * fq;
                    const f32x4 gt = acc[ai][bj][m][0], up = acc[ai][bj][m][1]; float o[4];
#pragma unroll
                    for (int j = 0; j < 4; ++j) o[j] = gt[j] * sigmoidf_(gt[j]) * up[j];
                    u32x2 w; w.x = pk2h(o[0], o[1]); w.y = pk2h(o[2], o[3]);
                    *(u32x2*)(rowp + oc) = w; } }
    }
};
template <bool RES16, bool OUT16> struct EpiRes {
    static constexpr bool PERM = false;
    const void* res; void* out; float* slab; float scale; int pad;
    __device__ __forceinline__ void operator()(const f32x4 (&acc)[2][2][4][2], const Unit& u, int wr, int wc, int fr, int fq) const {
        const int row0 = u.pm * BM + wr * 64 + fr, col0 = u.pn * BM + wc * 32 + 4 * fq;
        if (u.sp >= 0) {
            h16* sb = (h16*)slab + ((size_t)u.sp * MS - MP) * D;
#pragma unroll
            for (int ai = 0; ai < 2; ++ai)
#pragma unroll
                for (int m = 0; m < 4; ++m) { const size_t off = (size_t)(row0 + ai * HALF + m * 16) * D + col0;
#pragma unroll
                    for (int bj = 0; bj < 2; ++bj)
#pragma unroll
                        for (int n = 0; n < 2; ++n) { const f32x4 v = acc[ai][bj][m][n]; u32x2 w; w.x = pk2h(v[0], v[1]); w.y = pk2h(v[2], v[3]); *(u32x2*)(sb + off + bj * HALF + n * 16) = w; } }
            return;
        }
#pragma unroll
        for (int ai = 0; ai < 2; ++ai)
#pragma unroll
            for (int m = 0; m < 4; ++m) { const size_t off = (size_t)(row0 + ai * HALF + m * 16) * D + col0;
#pragma unroll
                for (int bj = 0; bj < 2; ++bj)
#pragma unroll
                    for (int n = 0; n < 2; ++n) { f32x4 rv; const size_t o_ = off + bj * HALF + n * 16;
                        if constexpr (RES16) { const h16x4 hv = *(const h16x4*)((const h16*)res + o_); rv = (f32x4){(float)hv[0], (float)hv[1], (float)hv[2], (float)hv[3]}; }
                        else rv = *(const f32x4*)((const float*)res + o_);
                        const f32x4 o = rv + scale * acc[ai][bj][m][n];
                        if constexpr (OUT16) { u32x2 w; w.x = pk2h(o[0], o[1]); w.y = pk2h(o[2], o[3]); *(u32x2*)((h16*)out + o_) = w; }
                        else *(f32x4*)((float*)out + o_) = o; } }
    }
};
struct EpiP16 {
    static constexpr bool PERM = true;
    h16* P; h16* PF;
    __device__ __forceinline__ void operator()(const f32x4 (&acc)[2][2][4][2], const Unit& u, int wr, int wc, int fr, int fq) const {
        const int row0 = u.pm * BM + wr * 64 + fr; const int kind = u.pn < 26 ? 0 : u.pn < 42 ? 1 : u.pn < 58 ? 2 : 3;
#pragma unroll
        for (int ai = 0; ai < 2; ++ai)
#pragma unroll
            for (int m = 0; m < 4; ++m) { const int row = row0 + ai * HALF + m * 16;
#pragma unroll
                for (int bj = 0; bj < 2; ++bj) { const int gcol = u.pn * BM + bj * HALF + wc * 32;
                    const f32x4 v0 = acc[ai][bj][m][0], v1 = acc[ai][bj][m][1];
                    if (kind == 0) { u32x4 w; w.x = pk2h(v0[0], v0[1]); w.y = pk2h(v0[2], v0[3]); w.z = pk2h(v1[0], v1[1]); w.w = pk2h(v1[2], v1[3]);
                        if (u.pm < MT / BM) *(u32x4*)(P + (size_t)row * PP + gcol + 8 * fq) = w;
                        else *(u32x4*)(PF + (size_t)(row - MT) * PFW + gcol + 8 * fq) = w; }
                    else if (kind == 3) { u32x4 w; w.x = pk2h(sigmoidf_(v0[0]), sigmoidf_(v0[1])); w.y = pk2h(sigmoidf_(v0[2]), sigmoidf_(v0[3])); w.z = pk2h(sigmoidf_(v1[0]), sigmoidf_(v1[1])); w.w = pk2h(sigmoidf_(v1[2]), sigmoidf_(v1[3]));
                        *(u32x4*)(P + (size_t)row * PP + C_SA + (gcol - (PFW + 8192)) + 8 * fq) = w; }
                    else { float o[4];
#pragma unroll
                        for (int j = 0; j < 4; ++j) o[j] = kind == 1 ? v0[j] * v1[j] : sigmoidf_(v1[j]) * v0[j];
                        u32x2 w; w.x = pk2h(o[0], o[1]); w.y = pk2h(o[2], o[3]);
                        *(u32x2*)(P + (size_t)row * PP + (kind == 1 ? C_U + ((gcol - PFW) >> 1) : C_Q + ((gcol - PFW - 4096) >> 1)) + 4 * fq) = w; } } }
    }
};
struct EpiEAG {
    static constexpr bool PERM = true;
    h16* O; const float* w0; const float* a0;
    __device__ __forceinline__ void operator()(const f32x4 (&acc)[2][2][4][2], const Unit& u, int wr, int wc, int fr, int fq) const {
        const int row0 = u.pm * BM + wr * 64 + fr; const int typ = u.pn >> 3;
#pragma unroll
        for (int bj = 0; bj < 2; ++bj) { const int col = u.pn * BM + bj * HALF + wc * 32 + 8 * fq;
            f32x4 b0 = (f32x4){0.f, 0.f, 0.f, 0.f}, b1 = b0;
            if (typ == 0) { b0 = *(const f32x4*)(w0 + col); b1 = *(const f32x4*)(w0 + col + 4); }
            if (typ == 1) { b0 = *(const f32x4*)(a0 + col - D); b1 = *(const f32x4*)(a0 + col - D + 4); }
#pragma unroll
            for (int ai = 0; ai < 2; ++ai)
#pragma unroll
                for (int m = 0; m < 4; ++m) { const int row = row0 + ai * HALF + m * 16;
                    f32x4 v0 = acc[ai][bj][m][0] + b0, v1 = acc[ai][bj][m][1] + b1;
                    if (typ < 2) { const float sc = typ == 0 ? 0.60653065971f : 1.0f;
#pragma unroll
                        for (int j = 0; j < 4; ++j) { v0[j] = sigmoidf_(v0[j]) * sc; v1[j] = sigmoidf_(v1[j]) * sc; } }
                    u32x4 w; w.x = pk2h(v0[0], v0[1]); w.y = pk2h(v0[2], v0[3]); w.z = pk2h(v1[0], v1[1]); w.w = pk2h(v1[2], v1[3]);
                    *(u32x4*)(O + (size_t)row * 6144 + col) = w; } }
    }
};
}


#define XB_TMO      128
#define XB_XCNT(j)  (256  + 64 * (j))
#define XB_XSUB(j)  (1280 + 64 * (j))
#define XB_XGEN(j)  (2304 + 64 * (j))
#define XB_TOP      3328
#define XB_TOPGEN   3392
#define XCD_BAR_WORDS 3456
#define XB_SPIN_CAP (1u << 22)
__device__ __forceinline__ unsigned xb_ld(unsigned* p)              { return __hip_atomic_load(p, __ATOMIC_RELAXED, __HIP_MEMORY_SCOPE_AGENT); }
__device__ __forceinline__ unsigned xb_add(unsigned* p, unsigned v) { return __hip_atomic_fetch_add(p, v, __ATOMIC_RELAXED, __HIP_MEMORY_SCOPE_AGENT); }
__device__ __forceinline__ unsigned xb_xcc_id() { return (unsigned)__builtin_amdgcn_s_getreg((3 << 11) | 20) & 0xFu; }
#define XB_SPIN(cond, bar) do { unsigned _sp = 0; while (cond) { __builtin_amdgcn_s_sleep(1); \
    if ((++_sp & 255u) == 0u) { if (xb_ld(&(bar)[XB_TMO])) break; if (_sp > XB_SPIN_CAP) { atomicAdd(&(bar)[XB_TMO], 1u); break; } } } } while (0)
struct XcdBarrier { unsigned* bar; unsigned x; volatile LAS unsigned* st; };
__device__ __forceinline__ XcdBarrier xcd_barrier_post(unsigned* bar, volatile LAS unsigned* st) {
    XcdBarrier b; b.bar = bar; b.x = xb_xcc_id(); b.st = st;
    if (threadIdx.x == 0) (void)xb_add(&bar[XB_XCNT(b.x)], 1u);
    return b;
}
__device__ __forceinline__ void xcd_barrier_complete(unsigned* bar, unsigned x, unsigned& nloc, unsigned& nx) {
    const unsigned G = gridDim.x * gridDim.y * gridDim.z;
    unsigned sum, cnt, mine, sp = 0u;
    for (;;) {
        sum = 0u; cnt = 0u; mine = 0u;
#pragma unroll
        for (unsigned j = 0; j < 16; ++j) { const unsigned c = xb_ld(&bar[XB_XCNT(j)]); sum += c; cnt += (c > 0u) ? 1u : 0u; mine = (j == x) ? c : mine; }
        if (sum == G) break;
        __builtin_amdgcn_s_sleep(1);
        if ((++sp & 255u) == 0u) { if (xb_ld(&bar[XB_TMO])) break; if (sp > XB_SPIN_CAP) { atomicAdd(&bar[XB_TMO], 1u); break; } }
    }
    nloc = mine > 0u ? mine : 1u; nx = cnt > 0u ? cnt : 1u;
}
__device__ __forceinline__ void xcd_barrier(const XcdBarrier& b) {
    asm volatile("s_waitcnt vmcnt(0)" ::: "memory");
    __syncthreads();
    if (threadIdx.x == 0) {
        unsigned* bar = b.bar;
        __builtin_amdgcn_s_waitcnt(0);
        unsigned nloc = b.st[0], nx = b.st[1];
        if (nloc == 0u) { xcd_barrier_complete(bar, b.x, nloc, nx); b.st[0] = nloc; b.st[1] = nx; }
        const unsigned old = xb_add(&bar[XB_XSUB(b.x)], 1u);
        const unsigned gen = old / nloc;
        if (old + 1u == (gen + 1u) * nloc) {
            __builtin_amdgcn_fence(__ATOMIC_RELEASE, "agent");
            asm volatile("s_waitcnt vmcnt(0)" ::: "memory");
            const unsigned og = xb_add(&bar[XB_TOP], 1u);
            const unsigned tg = og / nx;
            if (og + 1u == (tg + 1u) * nx) xb_add(&bar[XB_TOPGEN], 1u);
            else XB_SPIN(xb_ld(&bar[XB_TOPGEN]) == tg, bar);
            __builtin_amdgcn_fence(__ATOMIC_ACQUIRE, "agent");
            xb_add(&bar[XB_XGEN(b.x)], 1u);
            asm volatile("s_waitcnt vmcnt(0)" ::: "memory");
        } else {
            XB_SPIN(xb_ld(&bar[XB_XGEN(b.x)]) == gen, bar);
            __builtin_amdgcn_fence(__ATOMIC_ACQUIRE, "agent");
            asm volatile("s_waitcnt vmcnt(0)" ::: "memory");
        }
    }
    __syncthreads();
}

struct Args { const float* in[29]; float* out; unsigned char* ws; int ph_lo, ph_hi; };

__device__ __forceinline__ void cvt_item(int mode, const float* s0, const float* s1, int Nsrc, int K, h16* WT, LAS float* scr, int item, int nblk, int lane) {
    const int kb = item / nblk, nb = item % nblk, k0 = 64 * kb, n0 = 32 * nb;
    const int nn = lane & 31; const float* src = s0; int col = n0 + nn; bool zero = false;
    if (mode == 1) { src = (nn < 16) ? s0 : s1; col = (n0 >> 1) + (nn & 15); }
    if (mode == 2) { if (n0 >= NA && n0 < PFW) zero = true; else if (n0 >= PFW) col -= 64; }
#pragma unroll 8
    for (int i = 0; i < 32; ++i) { const int kk = 2 * i + (lane >> 5); scr[kk * 33 + nn] = zero ? 0.f : src[(size_t)(k0 + kk) * Nsrc + col]; }
    asm volatile("s_waitcnt lgkmcnt(0)" ::: "memory");
    const int c = lane & 7;
#pragma unroll
    for (int j = 0; j < 4; ++j) { const int n = (lane >> 3) + 8 * j; const LAS float* s = scr + (8 * c) * 33 + n;
        u32x4 o; o.x = pk2h(s[0 * 33], s[1 * 33]); o.y = pk2h(s[2 * 33], s[3 * 33]); o.z = pk2h(s[4 * 33], s[5 * 33]); o.w = pk2h(s[6 * 33], s[7 * 33]);
        *(u32x4*)(WT + (size_t)(n0 + n) * K + k0 + 8 * c) = o; }
    asm volatile("s_waitcnt lgkmcnt(0)" ::: "memory");
}
struct CvtIt { const float* p; h16* q; int Nsrc, K; bool zero; };
__device__ __forceinline__ CvtIt cvt_decode(int mode, const float* s0, const float* s1, int Nsrc, int K, h16* WT, int nblk, int item, int lane) {
    const int kb = item / nblk, nb = item % nblk, k0 = 64 * kb, n0 = 32 * nb, nn = lane & 31;
    const float* src = s0; int col = n0 + nn; bool zero = false;
    if (mode == 1) { src = (nn < 16) ? s0 : s1; col = (n0 >> 1) + (nn & 15); }
    if (mode == 2) {
        const int q = nn >> 3, sp = (nn >> 2) & 1, j = nn & 3;
        if (n0 >= NA && n0 < PFW) { zero = true; col = 0; }
        else if (n0 >= PFW && n0 < PFW + 4096) col = (sp ? NA + 2 * D : NA + D) + ((n0 - PFW) >> 1) + 4 * q + j;
        else if (n0 >= PFW + 4096 && n0 < PFW + 8192) col = (sp ? NA + 4 * D : NA) + ((n0 - PFW - 4096) >> 1) + 4 * q + j;
        else if (n0 >= PFW + 8192) col = NA + 3 * D + (n0 - PFW - 8192) + nn; }
    CvtIt r; r.p = src + (size_t)(k0 + (lane >> 5)) * Nsrc + col; r.q = WT + (size_t)(n0 + (lane >> 3)) * K + k0 + 8 * (lane & 7); r.Nsrc = Nsrc; r.K = K; r.zero = zero; return r;
}
__device__ __forceinline__ void cvt_load(const CvtIt& t, float (&v)[32]) {
#pragma unroll
    for (int i = 0; i < 32; ++i) v[i] = t.p[(size_t)(2 * i) * t.Nsrc];
}
__device__ __forceinline__ void cvt_finish(const CvtIt& t, const float (&v)[32], LAS float* scr, int lane) {
    const int nn = lane & 31;
#pragma unroll
    for (int i = 0; i < 32; ++i) scr[(2 * i + (lane >> 5)) * 33 + nn] = t.zero ? 0.f : v[i];
    asm volatile("s_waitcnt lgkmcnt(0)" ::: "memory");
    const int c = lane & 7;
#pragma unroll
    for (int j = 0; j < 4; ++j) { const int n = (lane >> 3) + 8 * j; const LAS float* s = scr + (8 * c) * 33 + n;
        u32x4 o; o.x = pk2h(s[0 * 33], s[1 * 33]); o.y = pk2h(s[2 * 33], s[3 * 33]); o.z = pk2h(s[4 * 33], s[5 * 33]); o.w = pk2h(s[6 * 33], s[7 * 33]);
        *(u32x4*)(t.q + (size_t)(8 * j) * t.K) = o; }
    asm volatile("s_waitcnt lgkmcnt(0)" ::: "memory");
}
#define CVT_RUN(total_, PICK) do { float va[32], vb[32]; CvtIt A_, B_; int it_ = gw; if (it_ < (total_)) { PICK(it_, A_); cvt_load(A_, va); \
        for (;;) { const int itb_ = it_ + NGW; const bool hb_ = itb_ < (total_); if (hb_) { PICK(itb_, B_); cvt_load(B_, vb); } cvt_finish(A_, va, scr, lane); if (!hb_) break; \
            it_ = itb_ + NGW; const bool ha_ = it_ < (total_); if (ha_) { PICK(it_, A_); cvt_load(A_, va); } cvt_finish(B_, vb, scr, lane); if (!ha_) break; } } } while (0)
__device__ __forceinline__ void cvt_lora_item(const float* wl, const float* al, const float* gl, h16* WT, int item, int lane) {
    const int n = item, typ = n >> 11, col = n & 2047; unsigned w[4];
#pragma unroll
    for (int j = 0; j < 4; ++j) { float v[2];
#pragma unroll
        for (int e = 0; e < 2; ++e) { const int k = lane * 8 + j * 2 + e; float x = 0.f;
            if (typ == 0 && k < 96) x = wl[(size_t)k * D + col];
            if (typ == 1 && k >= 96 && k < 192) x = al[(size_t)(k - 96) * D + col];
            if (typ == 2 && k >= 192 && k < 448) x = gl[(size_t)(k - 192) * D + col];
            v[e] = x; }
        w[j] = pk2h(v[0], v[1]); }
    *(u32x4*)(WT + (size_t)n * LK + lane * 8) = (u32x4){w[0], w[1], w[2], w[3]};
}

__device__ __forceinline__ void rms_row_f16(const float* xrow, const float* g, h16* orow, float* f32row, int lane, const h16* part = nullptr, float pscale = 0.f, float* xout = nullptr) {
    const f32x4* xr = (const f32x4*)xrow + lane; const f32x4* gr = (const f32x4*)g + lane;
    f32x4 v[8]; float s = 0.f;
#pragma unroll
    for (int j = 0; j < 8; ++j) { v[j] = xr[64 * j];
        if (part) { const h16x4* pp = (const h16x4*)part + lane + 64 * j; const size_t st = (size_t)MS * D / 4;
            const h16x4 p0 = pp[0], p1 = pp[st], p2 = pp[2 * st], p3 = pp[3 * st];
            v[j] += pscale * (((f32x4){(float)p0[0], (float)p0[1], (float)p0[2], (float)p0[3]} + (f32x4){(float)p1[0], (float)p1[1], (float)p1[2], (float)p1[3]}) + ((f32x4){(float)p2[0], (float)p2[1], (float)p2[2], (float)p2[3]} + (f32x4){(float)p3[0], (float)p3[1], (float)p3[2], (float)p3[3]}));
            if (xout) *((f32x4*)xout + lane + 64 * j) = v[j]; }
        s += (v[j].x * v[j].x + v[j].y * v[j].y) + (v[j].z * v[j].z + v[j].w * v[j].w); }
    const float rs = rsqrtf(wave_sum(s) * (1.f / D) + 1e-6f);
#pragma unroll
    for (int j = 0; j < 8; ++j) { const f32x4 gg = gr[64 * j]; const f32x4 o = v[j] * rs * gg;
        if (orow) { u32x2 w; w.x = pk2h(o.x, o.y); w.y = pk2h(o.z, o.w); *((u32x2*)orow + lane + 64 * j) = w; }
        if (f32row) *((f32x4*)f32row + lane + 64 * j) = o; }
}

__device__ __forceinline__ void rms_row_h(const h16* xrow, const float* g, h16* orow, float* f32row, int lane) {
    const f32x4* gr = (const f32x4*)g + lane;
    f32x4 v[8]; float s = 0.f;
#pragma unroll
    for (int j = 0; j < 8; ++j) { const h16x4 hv = *((const h16x4*)xrow + lane + 64 * j);
        v[j] = (f32x4){(float)hv[0], (float)hv[1], (float)hv[2], (float)hv[3]};
        s += (v[j].x * v[j].x + v[j].y * v[j].y) + (v[j].z * v[j].z + v[j].w * v[j].w); }
    const float rs = rsqrtf(wave_sum(s) * (1.f / D) + 1e-6f);
#pragma unroll
    for (int j = 0; j < 8; ++j) { const f32x4 gg = gr[64 * j]; const f32x4 o = v[j] * rs * gg;
        if (orow) { u32x2 w; w.x = pk2h(o.x, o.y); w.y = pk2h(o.z, o.w); *((u32x2*)orow + lane + 64 * j) = w; }
        if (f32row) *((f32x4*)f32row + lane + 64 * j) = o; }
}

constexpr int PREP_CA = 96;
__device__ __forceinline__ int prep_map(int j, bool segB) {
    const int h = j & 31, q = j >> 5; int c;
    if (!segB) c = q < 2 * PREP_CA ? (q / PREP_CA) * 256 + q % PREP_CA : 512 + (q - 2 * PREP_CA);
    else { constexpr int nb = 256 - PREP_CA; c = (q / nb) * 256 + PREP_CA + q % nb; }
    return c * 32 + h;
}

enum { PH_CVT1 = 0, PH_FFN1_GU, PH_FFN1_D, PH_RMS_MIX, PH_WIN, PH_SHIFT, PH_LORA, PH_PREP, PH_SCAN, PH_MERGE, PH_WOUT, PH_RMS2, PH_FFN2_GU, PH_FFN2_D, PH_FINAL, PH_N };

__global__ void __launch_bounds__(NTHR, 2) fwd_kernel(Args a) {
    extern __shared__ __attribute__((aligned(16))) unsigned char lds_raw[];
    LAS unsigned char* lds = (LAS unsigned char*)lds_raw;
    const int tid = threadIdx.x, lane = tid & 63, wave = __builtin_amdgcn_readfirstlane(tid >> 6);
    const int G = gridDim.x, bx = blockIdx.x;
    const int gw = bx * NWAVES + wave, NGW = G * NWAVES;
    unsigned char* ws = a.ws; unsigned char* ob = (unsigned char*)a.out;
    h16* W1GU = (h16*)(ws + WS_W1GU); h16* W1D = (h16*)(ws + WS_W1D); h16* WIN = (h16*)(ws + WS_WIN); h16* WOUT = (h16*)(ws + WS_WOUT);
    h16* A16 = (h16*)(ws + WS_A16); h16* P16 = (h16*)(ws + WS_P16); h16* EAG = (h16*)(ws + WS_EAG); h16* HM = (h16*)(ws + WS_HM);
    h16* W2GU = (h16*)(ws + WS_W2GU); h16* W2D = (h16*)(ws + WS_W2D);
    h16* WL = (h16*)(ob + OB_WL); h16* PF = (h16*)(ws + WS_PF);
    float* Y = a.out + O_Y; float* SLAB = (float*)(ws + WS_SLAB);
    h16* XH = (h16*)(a.out + O_Y);
    const int lo = a.ph_lo, hi = a.ph_hi;
#define IN(k) (lo <= (k) && (k) < hi)
    cg::grid_group grid = cg::this_grid();
    volatile LAS unsigned* xst = (volatile LAS unsigned*)(lds + LDS_BYTES - 16);
    if (tid < 2) xst[tid] = 0u;
    if (bx == 0) { for (int i = tid; i < XCD_BAR_WORDS; i += NTHR) ((unsigned*)(ws + WS_CTL))[i] = 0u; }
    __syncthreads();
    XcdBarrier xbar; xbar.bar = (unsigned*)(ws + WS_CTL); xbar.x = xb_xcc_id(); xbar.st = xst;
#ifndef PROBE_MASK
#define PROBE_MASK 0u
#endif
#ifndef PROBE_MUL
#define PROBE_MUL 1u
#endif
    unsigned long long pr_t[PH_N + 1]; (void)pr_t;
    if (PROBE_MASK) pr_t[0] = __builtin_amdgcn_s_memrealtime();
#define SEAM(k) do { if (IN(k) && IN((k) + 1)) { if ((k) == PH_CVT1) grid.sync(); else xcd_barrier(xbar); } if (PROBE_MASK) pr_t[(k) + 1] = __builtin_amdgcn_s_memrealtime(); } while (0)

    if (IN(PH_CVT1)) {
        LAS float* scr = (LAS float*)(lds + wave * 16384);
        constexpr int I1 = (D / 64) * (2 * FF / 32), I2 = (FF / 64) * (D / 32), I3 = (D / 64) * (NW / 32), I4 = (D / 64) * (D / 32);
#define PICK1(it, out) do { int r_ = (it); if (r_ < I1) out = cvt_decode(1, a.in[6], a.in[7], FF, D, W1GU, 2 * FF / 32, r_, lane); else if ((r_ -= I1) < I2) out = cvt_decode(0, a.in[8], a.in[8], D, FF, W1D, D / 32, r_, lane); \
            else if ((r_ -= I2) < I3) out = cvt_decode(2, a.in[10], a.in[10], NIN, D, WIN, NW / 32, r_, lane); else out = cvt_decode(0, a.in[23], a.in[23], D, D, WOUT, D / 32, r_ - I3, lane); } while (0)
        CVT_RUN(I1 + I2 + I3 + I4, PICK1);
#undef PICK1
        for (int it = gw; it < 6144; it += NGW) cvt_lora_item(a.in[13], a.in[15], a.in[16], WL, it, lane);
        for (int r = gw; r < 256; r += NGW) { h16* orow = A16 + (size_t)(MT + r) * D;
#pragma unroll
            for (int j = 0; j < 8; ++j) { u32x2 w = (u32x2){0u, 0u};
                if (r < 32) { const f32x4 v = *((const f32x4*)(a.in[2] + (size_t)r * D) + lane + 64 * j); w.x = pk2h(v.x, v.y); w.y = pk2h(v.z, v.w); }
                *((u32x2*)orow + lane + 64 * j) = w; } }
        for (int m = gw; m < MT; m += NGW) { const float* xr = m < MP ? a.in[0] + (size_t)m * D : a.in[1] + (size_t)(m - MP) * D; rms_row_f16(xr, a.in[5], A16 + (size_t)m * D, nullptr, lane); }
    }
    SEAM(PH_CVT1);
    if (tid == 0) (void)xb_add(&xbar.bar[XB_XCNT(xbar.x)], 1u);
    if (IN(PH_FFN1_GU)) { pg8::Gemm g{A16, W1GU, MT, 2 * FF, D}; pg8::Order S; S.init(MT, 2 * FF, D, G, bx, 0, -1); pg8::EpiSwiGLU E{HM, FF}; pg8::gemm_phase(lds, g, S, E); }
    SEAM(PH_FFN1_GU);
    if (IN(PH_FFN1_D)) { pg8::Gemm g{HM, W1D, MT, D, FF}; pg8::Order S; S.init(MT, D, FF, G, bx, 0, MP / 256); pg8::EpiRes<false, true> E{a.in[0], XH, SLAB, 0.5f, 0}; pg8::gemm_phase(lds, g, S, E); }
    SEAM(PH_FFN1_D);
    if (IN(PH_RMS_MIX)) {
        for (int m = gw; m < MT; m += NGW) { float* so = nullptr;
            if (m < MP) { if ((m & 4095) == 4095) so = a.out + O_SHP + (size_t)(m >> 12) * D; } else { if (((m - MP) & 63) == 63) so = a.out + O_SHS + (size_t)((m - MP) >> 6) * D; }
            if (m < MP) rms_row_h(XH + (size_t)m * D, a.in[9], A16 + (size_t)m * D, so, lane);
            else rms_row_f16(a.in[1] + (size_t)(m - MP) * D, a.in[9], A16 + (size_t)m * D, so, lane, (const h16*)SLAB + (size_t)(m - MP) * D, 0.5f, Y + (size_t)m * D); }
    }
    SEAM(PH_RMS_MIX);
    if (IN(PH_WIN)) { pg8::Gemm g{A16, WIN, MT, NW, D}; pg8::Order S; S.init(MT, NW, D, G, bx, PFW / 256, -1); pg8::EpiP16 E{P16, PF}; pg8::gemm_phase(lds, g, S, E); }
    SEAM(PH_WIN);
    if (IN(PH_SHIFT)) {
        for (int item = bx * NTHR + tid; item < (MT / 16) * 768; item += G * NTHR) { const int c = item / 768, o = item % 768;
            *(u32x4*)((h16*)(ob + OB_SIDE) + (size_t)c * 6144 + o * 8) = *(const u32x4*)(P16 + (size_t)(16 * c + 15) * PP + o * 8); }
    }
    if (IN(PH_SHIFT)) {
        h16* AIN = A16; const float* mu = a.in[11];
        for (int item = bx * NTHR + tid; item < MT * 64; item += G * NTHR) {
            const int row = item >> 6, o = item & 63;
            if (o >= 56) { *(u32x4*)(AIN + (size_t)row * LK + 448 + (o - 56) * 8) = (u32x4){0u, 0u, 0u, 0u}; continue; }
            const int c0 = 6144 + o * 8;
            const bool st = row < MP ? ((row & 4095) == 0) : (((row - MP) & 63) == 0);
            const h16* pp = st ? (row < MP ? PF + (size_t)32 * PFW : PF + (size_t)((row - MP) >> 6) * PFW) + c0 : P16 + (size_t)(row - 1) * PP + c0;
            const h16x8 cv = *(const h16x8*)(P16 + (size_t)row * PP + c0), pv = *(const h16x8*)pp;
            const f32x4 m0 = *(const f32x4*)(mu + c0), m1 = *(const f32x4*)(mu + c0 + 4);
            const float mu8[8] = {m0.x, m0.y, m0.z, m0.w, m1.x, m1.y, m1.z, m1.w}; float s[8];
#pragma unroll
            for (int j = 0; j < 8; ++j) { const float cu = (float)cv[j]; s[j] = cu + mu8[j] * ((float)pv[j] - cu); }
            if (o < 12) {
#pragma unroll
                for (int j = 0; j < 8; ++j) s[j] = tanhf_(s[j]);
            } else if (o >= 24) {
#pragma unroll
                for (int j = 0; j < 8; ++j) s[j] = sigmoidf_(s[j]);
            }
            *(u32x4*)(AIN + (size_t)row * LK + o * 8) = (u32x4){pk2h(s[0], s[1]), pk2h(s[2], s[3]), pk2h(s[4], s[5]), pk2h(s[6], s[7])};
        }
    }
    SEAM(PH_SHIFT);
    if (IN(PH_LORA)) { pg8::Gemm g{A16, WL, MT, 6144, LK}; pg8::Order S; S.init(MT, 6144, LK, G, bx, 0, -1); pg8::EpiEAG E{EAG, a.in[12], a.in[14]}; pg8::gemm_phase<pg8::EpiEAG, true>(lds, g, S, E); }
    SEAM(PH_LORA);
    auto prep_run = [&](const int gw0, const int ngw, const int nitems, const bool segB) {
        LAS unsigned char* sc = lds + wave * 5120;
        float* RK = (float*)(ws + WS_RK); float* LM = (float*)(ws + WS_LM);
        const int cp = lane & 31, hs = lane >> 5;
#define H2LO(x) ((float)__builtin_bit_cast(h16, (unsigned short)((x) & 0xffffu)))
#define H2HI(x) ((float)__builtin_bit_cast(h16, (unsigned short)((x) >> 16)))
#define HSUM(x_, out_) do { float y_ = row_allreduce16(x_); y_ += __builtin_bit_cast(float, __builtin_amdgcn_update_dpp(0, __builtin_bit_cast(int, y_), 0x142, 0xA, 0xF, false)); \
            const float s31_ = rl_f(y_, 31), s63_ = rl_f(y_, 63); out_ = hs ? s63_ : s31_; } while (0)
#define PREP_LOAD(item_, RR, KK, VV, EE, AA) do { const int c_ = (item_) >> 5, h_ = (item_) & 31, r0_ = 16 * c_, j2_ = h_ * 64 + 2 * cp; \
            const bool pr_ = r0_ < MP; const bool st_ = pr_ ? ((r0_ & 4095) == 0) : (((r0_ - MP) & 63) == 0); \
            const h16* pq_ = hs ? P16 + (size_t)(r0_ + 7) * PP + j2_ : (st_ ? PF + (size_t)(pr_ ? 32 : ((r0_ - MP) >> 6)) * PFW + j2_ : (const h16*)(ob + OB_SIDE) + (size_t)(c_ - 1) * 6144 + j2_); \
            const h16* pp_ = P16 + (size_t)(r0_ + 8 * hs) * PP + j2_; const h16* pe_ = EAG + (size_t)(r0_ + 8 * hs) * 6144 + j2_; \
            RR[0] = *(const unsigned*)pq_; KK[0] = *(const unsigned*)(pq_ + D); VV[0] = *(const unsigned*)(pq_ + 2 * D); \
            _Pragma("unroll") for (int s_ = 0; s_ < 8; ++s_) { RR[s_ + 1] = *(const unsigned*)(pp_ + (size_t)s_ * PP); KK[s_ + 1] = *(const unsigned*)(pp_ + (size_t)s_ * PP + D); VV[s_ + 1] = *(const unsigned*)(pp_ + (size_t)s_ * PP + 2 * D); \
                EE[s_] = *(const unsigned*)(pe_ + (size_t)s_ * 6144); AA[s_] = *(const unsigned*)(pe_ + (size_t)s_ * 6144 + D); } } while (0)
        unsigned rr[9], kk[9], vv[9], ee[8], aa[8], rrn[9], kkn[9], vvn[9], een[8], aan[8];
        if (gw0 < nitems) { const int i0_ = prep_map(gw0, segB); PREP_LOAD(i0_, rr, kk, vv, ee, aa); }
        for (int j = gw0; j < nitems; j += ngw) { const int item = prep_map(j, segB);
            const int c = item >> 5, h = item & 31, row0 = 16 * c, hj2 = h * 64 + 2 * cp;
            const f32x2 c_kk = *(const f32x2*)(a.in[17] + hj2), c_ka = *(const f32x2*)(a.in[18] + hj2), c_rk = *(const f32x2*)(a.in[19] + hj2), c_mr = *(const f32x2*)(a.in[11] + hj2), c_mk = *(const f32x2*)(a.in[11] + D + hj2), c_mv = *(const f32x2*)(a.in[11] + 2 * D + hj2);
            if (j + ngw < nitems) { const int in_ = prep_map(j + ngw, segB); PREP_LOAD(in_, rrn, kkn, vvn, een, aan); }
            f32x2 Ll[8]; { f32x2 acc = (f32x2){0.f, 0.f};
#pragma unroll
                for (int s_ = 0; s_ < 8; ++s_) { acc -= (f32x2){H2LO(ee[s_]), H2HI(ee[s_])}; Ll[s_] = acc; } }
            const f32x2 oth = (f32x2){__shfl_xor(Ll[7].x, 32), __shfl_xor(Ll[7].y, 32)};
            const f32x2 M_ = hs ? oth : Ll[7]; const f32x2 L15 = M_ + (hs ? Ll[7] : oth);
            *(f32x2*)(LM + (size_t)item * 128 + 64 * hs + 2 * cp) = hs ? L15 : M_;
            const f32x2 off = hs ? (f32x2){0.f, 0.f} : M_;
            unsigned vpk[8];
            h16* eo = EAG + (size_t)(row0 + 8 * hs) * 6144 + hj2; h16* po = P16 + (size_t)(row0 + 8 * hs) * PP + hj2;
            f32x2 E3p = (f32x2){__expf(-off.x), __expf(-off.y)};
#pragma unroll
            for (int s_ = 0; s_ < 8; ++s_) { const int t = 8 * hs + s_;
                f32x2 r = (f32x2){H2LO(rr[s_ + 1]), H2HI(rr[s_ + 1])}, k = (f32x2){H2LO(kk[s_ + 1]), H2HI(kk[s_ + 1])}, v = (f32x2){H2LO(vv[s_ + 1]), H2HI(vv[s_ + 1])};
                r += c_mr * ((f32x2){H2LO(rr[s_]), H2HI(rr[s_])} - r); k += c_mk * ((f32x2){H2LO(kk[s_]), H2HI(kk[s_])} - k); v += c_mv * ((f32x2){H2LO(vv[s_]), H2HI(vv[s_])} - v);
                const f32x2 av = (f32x2){H2LO(aa[s_]), H2HI(aa[s_])};
                const f32x2 kkr = k * c_kk; float ss; HSUM(kkr.x * kkr.x + kkr.y * kkr.y, ss);
                const float rn = rsqrtf(fmaxf(ss, 1e-24f)); const f32x2 kap = kkr * rn;
                const f32x2 kmod = k * (1.f + (av - 1.f) * c_ka);
                const f32x2 Dm = Ll[s_] - off; const f32x2 E1 = E3p, E2 = (f32x2){__expf(-Dm.x), __expf(-Dm.y)}, E3 = (f32x2){__expf(Dm.x), __expf(Dm.y)}; E3p = E3;
                const f32x2 fat = kap * E1, frt = r * E3, fbb = kap * av * E2, fkb = kmod * E2;
                const unsigned hat = pk2h(fat.x, fat.y), hrt = pk2h(frt.x, frt.y), hbb = pk2h(fbb.x, fbb.y), hkb = pk2h(fkb.x, fkb.y);
                const f32x2 rkm = r * kmod * c_rk; float rk; HSUM(rkm.x + rkm.y, rk); if (cp == 0) RK[(size_t)(row0 + t) * 32 + h] = rk;
                *(unsigned*)(eo + (size_t)s_ * 6144) = hat; *(unsigned*)(eo + (size_t)s_ * 6144 + D) = hbb; *(unsigned*)(po + (size_t)s_ * PP) = hrt; *(unsigned*)(po + (size_t)s_ * PP + D) = hkb;
                ((LAS unsigned*)sc)[t * 32 + cp] = hat; ((LAS unsigned*)(sc + 2048))[t * 32 + cp] = hbb;
                vpk[s_] = pk2h(v.x, v.y);
            }
            { u32x4 lo, hi;
              lo.x = (vpk[0] & 0xffffu) | (vpk[1] << 16); lo.y = (vpk[2] & 0xffffu) | (vpk[3] << 16); lo.z = (vpk[4] & 0xffffu) | (vpk[5] << 16); lo.w = (vpk[6] & 0xffffu) | (vpk[7] << 16);
              hi.x = (vpk[0] >> 16) | (vpk[1] & 0xffff0000u); hi.y = (vpk[2] >> 16) | (vpk[3] & 0xffff0000u); hi.z = (vpk[4] >> 16) | (vpk[5] & 0xffff0000u); hi.w = (vpk[6] >> 16) | (vpk[7] & 0xffff0000u);
              const int i0 = 2 * cp;
              *(u32x4*)(P16 + (size_t)(row0 + (i0 >> 2)) * PP + 2 * D + h * 64 + (i0 & 3) * 16 + 8 * hs) = lo;
              *(u32x4*)(P16 + (size_t)(row0 + ((i0 + 1) >> 2)) * PP + 2 * D + h * 64 + ((i0 + 1) & 3) * 16 + 8 * hs) = hi; }
            asm volatile("s_waitcnt lgkmcnt(0)" ::: "memory");
            const int fr = lane & 15, fq = lane >> 4;
            f32x4 acc = (f32x4){0.f, 0.f, 0.f, 0.f};
#pragma unroll
            for (int kt = 0; kt < 4; ++kt) acc = __builtin_amdgcn_mfma_f32_16x16x16f16(*(const LAS h16x4*)(sc + (fr * 64 + 16 * kt + 4 * fq) * 2), *(const LAS h16x4*)(sc + 2048 + (fr * 64 + 16 * kt + 4 * fq) * 2), acc, 0, 0, 0);
            LAS float* Pm = (LAS float*)(sc + 4096);
#pragma unroll
            for (int g_ = 0; g_ < 4; ++g_) Pm[(4 * fq + g_) * 16 + fr] = (fr < 4 * fq + g_) ? acc[g_] : 0.f;
            asm volatile("s_waitcnt lgkmcnt(0)" ::: "memory");
            float Tc[16];
#pragma unroll
            for (int t = 0; t < 16; ++t) { float x = (t == fr) ? 1.f : 0.f;
#pragma unroll
                for (int j4 = 0; j4 < (t + 3) / 4; ++j4) { const f32x4 p4 = *(const LAS f32x4*)(Pm + t * 16 + 4 * j4);
                    if (4 * j4 + 0 < t) x -= p4.x * Tc[4 * j4 + 0]; if (4 * j4 + 1 < t) x -= p4.y * Tc[4 * j4 + 1]; if (4 * j4 + 2 < t) x -= p4.z * Tc[4 * j4 + 2]; if (4 * j4 + 3 < t) x -= p4.w * Tc[4 * j4 + 3]; }
                Tc[t] = x; }
            if (lane < 16) { h16* to = P16 + (size_t)row0 * PP + 6144 + h * 16 + fr;
#pragma unroll
                for (int t = 0; t < 16; ++t) to[(size_t)t * PP] = (h16)Tc[t]; }
            asm volatile("s_waitcnt lgkmcnt(0)" ::: "memory");
#pragma unroll
            for (int q_ = 0; q_ < 9; ++q_) { rr[q_] = rrn[q_]; kk[q_] = kkn[q_]; vv[q_] = vvn[q_]; }
#pragma unroll
            for (int q_ = 0; q_ < 8; ++q_) { ee[q_] = een[q_]; aa[q_] = aan[q_]; }
        }
#undef PREP_LOAD
#undef H2LO
#undef H2HI
#undef HSUM
        };
    if (IN(PH_PREP)) prep_run(gw, NGW, (2 * PREP_CA + MS / 16) * 32, false);
    SEAM(PH_PREP);
    auto merge_run = [&](const int q0, const int qs, const int nq, const bool early) {
        const float* RK = (const float*)(ws + WS_RK);
        const int o8 = tid & 255, c0 = o8 * 8, hd = o8 >> 3, rg = tid >> 8;
        float w0[8], w1[8], w2[8], lg[8], lb[8];
#pragma unroll
        for (int j = 0; j < 8; ++j) { w0[j] = a.in[22][c0 + j]; w1[j] = a.in[22][D + c0 + j]; w2[j] = a.in[22][2 * D + c0 + j]; lg[j] = a.in[20][c0 + j]; lb[j] = a.in[21][c0 + j]; }
        for (int q = q0; q < nq; q += qs) { const int c = early ? (q / PREP_CA) * 256 + q % PREP_CA : (q < 2 * (256 - PREP_CA) ? (q / (256 - PREP_CA)) * 256 + PREP_CA + q % (256 - PREP_CA) : 512 + (q - 2 * (256 - PREP_CA)));
            const int row0 = 16 * c + 8 * rg;
            const bool pr = row0 < MP; const int tt0 = pr ? (row0 & 4095) : ((row0 - MP) & 63), sq = pr ? (row0 >> 12) : ((row0 - MP) >> 6), T = pr ? 4096 : 64;
            h16x8 vt[8];
            { const h16* vb = P16 + (size_t)(16 * c + ((c0 & 63) >> 2)) * PP + 2 * D + (c0 & ~63) + 8 * rg;
#pragma unroll
              for (int j = 0; j < 8; ++j) vt[j] = *(const h16x8*)(vb + (size_t)(j >> 2) * PP + (j & 3) * 16); }
            float u1[8], u2[8];
            { const h16* prow = P16 + (size_t)row0 * PP;
              if (tt0 >= 2) { const h16x8 p1 = *(const h16x8*)(prow - PP + C_U + c0), p2 = *(const h16x8*)(prow - 2 * PP + C_U + c0);
#pragma unroll
                  for (int j = 0; j < 8; ++j) { u1[j] = (float)p1[j]; u2[j] = (float)p2[j]; }
              } else {
#pragma unroll
                  for (int j = 0; j < 8; ++j) { u2[j] = pr ? 0.f : a.in[3][(size_t)sq * 2 * D + c0 + j]; u1[j] = pr ? 0.f : a.in[3][(size_t)sq * 2 * D + D + c0 + j]; } } }
#pragma unroll
            for (int hf = 0; hf < 4; ++hf) {
                h16x8 ov[2], gv[2], uu[2], qq[2], sa[2]; float rk[2];
#pragma unroll
                for (int r = 0; r < 2; ++r) { const int row = row0 + 2 * hf + r; const h16* prow = P16 + (size_t)row * PP;
                    ov[r] = *(const h16x8*)(A16 + (size_t)row * D + c0); gv[r] = *(const h16x8*)(EAG + (size_t)row * 6144 + 2 * D + c0);
                    uu[r] = *(const h16x8*)(prow + C_U + c0); qq[r] = *(const h16x8*)(prow + C_Q + c0); sa[r] = *(const h16x8*)(prow + C_SA + c0);
                    rk[r] = RK[(size_t)row * 32 + hd]; }
#pragma unroll
                for (int r = 0; r < 2; ++r) { const int row = row0 + 2 * hf + r, tt = tt0 + 2 * hf + r;
                    float of[8], s1 = 0.f;
#pragma unroll
                    for (int j = 0; j < 8; ++j) { of[j] = (float)ov[r][j]; s1 += of[j]; }
                    const float mean = row_allreduce8(s1) * (1.f / 64.f); float s2 = 0.f;
#pragma unroll
                    for (int j = 0; j < 8; ++j) { of[j] -= mean; s2 += of[j] * of[j]; }
                    const float rstd = rsqrtf(row_allreduce8(s2) * (1.f / 64.f) + 64e-5f);
                    float mg[8], u0[8];
#pragma unroll
                    for (int j = 0; j < 8; ++j) {
                        const float vs = (float)vt[j][2 * hf + r];
                        const float ya = (of[j] * rstd * lg[j] + lb[j] + rk[r] * vs) * (float)gv[r][j];
                        u0[j] = (float)uu[r][j];
                        const float cv = w0[j] * u2[j] + w1[j] * u1[j] + w2[j] * u0[j];
                        mg[j] = (float)sa[r][j] * ya + (float)qq[r][j] * cv; u2[j] = u1[j]; u1[j] = u0[j]; }
                    *(u32x4*)(A16 + (size_t)row * D + c0) = (u32x4){pk2h(mg[0], mg[1]), pk2h(mg[2], mg[3]), pk2h(mg[4], mg[5]), pk2h(mg[6], mg[7])};
                    if (tt >= T - 2) { float* q = a.out + (pr ? O_CVP : O_CVS) + (size_t)sq * 2 * D + (size_t)(tt - (T - 2)) * D + c0;
                        *(f32x4*)q = (f32x4){u0[0], u0[1], u0[2], u0[3]}; *(f32x4*)(q + 4) = (f32x4){u0[4], u0[5], u0[6], u0[7]}; }
                }
            }
        }
        };
    if (IN(PH_SCAN)) {
        const int vcu = (G % 8 == 0) ? (bx % 8) * (G / 8) + bx / 8 : bx;
        constexpr int RAWB = 12288, NSL = 7, CSET = 2560, O_RAW = 0, O_CO = NSL * RAWB, O_YB = O_CO + 2 * CSET;
        static_assert(O_YB + 2 * 2048 <= LDS_BYTES - 16, "scan LDS map");
        h16* OUT16 = A16; const float* LM = (const float*)(ws + WS_LM);
        const bool pblk = vcu < 64;
        const int nitem = pblk ? 1 : (1024 - (vcu - 64) + 191) / 192;
        const int NCHB = pblk ? 256 : 4 * nitem;
#define SC_DESC(cc, prompt, sq, h, t0, first, last) \
        const bool prompt = pblk; bool first, last; int sq, h, t0; \
        if (prompt) { sq = vcu >> 5; h = vcu & 31; t0 = 16 * (cc); first = (cc) == 0; last = (cc) == 255; } \
        else { const int pair = (vcu - 64) + 192 * ((cc) >> 2); sq = pair >> 5; h = pair & 31; t0 = 16 * ((cc) & 3); first = ((cc) & 3) == 0; last = ((cc) & 3) == 3; }
#define SC_DMA(cc) do { if ((cc) < sc1) { SC_DESC(cc, prompt_, sq_, h_, t0_, first_, last_); (void)last_; (void)first_; \
            const size_t rowb_ = (size_t)(prompt_ ? sq_ * 4096 : MP + sq_ * 64) + t0_; \
            LAS unsigned char* dst_ = lds + O_RAW + ((cc) % NSL) * RAWB; \
            const int sw_ = ((lane & 7) ^ (lane >> 3)) * 8;     \
            const h16* e0_ = EAG + (rowb_ + (lane >> 3)) * 6144 + h_ * 64 + sw_; const h16* p0_ = P16 + (rowb_ + (lane >> 3)) * PP + h_ * 64 + sw_; \
            __builtin_amdgcn_global_load_lds((const unsigned*)(e0_), (LAS unsigned*)(dst_), 16, 0, 0); \
            __builtin_amdgcn_global_load_lds((const unsigned*)(e0_ + 8 * 6144), (LAS unsigned*)(dst_ + 1024), 16, 0, 0); \
            __builtin_amdgcn_global_load_lds((const unsigned*)(p0_), (LAS unsigned*)(dst_ + 2048), 16, 0, 0); \
            __builtin_amdgcn_global_load_lds((const unsigned*)(p0_ + 8 * PP), (LAS unsigned*)(dst_ + 3072), 16, 0, 0); \
            __builtin_amdgcn_global_load_lds((const unsigned*)(e0_ + D), (LAS unsigned*)(dst_ + 4096), 16, 0, 0); \
            __builtin_amdgcn_global_load_lds((const unsigned*)(e0_ + D + 8 * 6144), (LAS unsigned*)(dst_ + 5120), 16, 0, 0); \
            __builtin_amdgcn_global_load_lds((const unsigned*)(p0_ + D), (LAS unsigned*)(dst_ + 6144), 16, 0, 0); \
            __builtin_amdgcn_global_load_lds((const unsigned*)(p0_ + D + 8 * PP), (LAS unsigned*)(dst_ + 7168), 16, 0, 0); \
            __builtin_amdgcn_global_load_lds((const unsigned*)(p0_ - sw_ + (lane & 7) * 8 + 2 * D), (LAS unsigned*)(dst_ + 8192), 16, 0, 0); \
            __builtin_amdgcn_global_load_lds((const unsigned*)(p0_ - sw_ + (lane & 7) * 8 + 2 * D + 8 * PP), (LAS unsigned*)(dst_ + 9216), 16, 0, 0); \
            __builtin_amdgcn_global_load_lds((const unsigned*)(P16 + (rowb_ + ((lane & 31) >> 1)) * PP + 6144 + h_ * 16 + (lane & 1) * 8), (LAS unsigned*)(dst_ + 10240), 16, 0, 0); \
            __builtin_amdgcn_global_load_lds((const unsigned*)(LM + ((rowb_ >> 4) * 32 + h_) * 128 + (lane & 31) * 4), (LAS unsigned*)(dst_ + 11264), 16, 0, 0); } } while (0)
#define MF(a_, b_, c_) __builtin_amdgcn_mfma_f32_16x16x32_f16(a_, b_, c_, 0, 0, 0)
#define CAT8(lo_, hi_) ((h16x8){(lo_)[0], (lo_)[1], (lo_)[2], (lo_)[3], (hi_)[0], (hi_)[1], (hi_)[2], (hi_)[3]})
#define SC_C(cc) do { if ((cc) >= sc0 && (cc) < sc1) { \
            const LAS unsigned char* rs = lds + O_RAW + ((cc) % NSL) * RAWB; LAS unsigned char* co = lds + O_CO + ((cc) & 1) * CSET; \
            const int fr = lane & 15, fq = lane >> 4; const int oa = wave == 4 ? 0 : 2048, ob_ = wave == 6 ? 4096 : 6144; \
            f32x4 acc = (f32x4){0.f, 0.f, 0.f, 0.f}; \
            _Pragma("unroll") for (int kb = 0; kb < 2; ++kb) { const int o_ = fr * 128 + (((4 * kb + fq) ^ (fr & 7)) << 4); acc = MF(*(const LAS h16x8*)(rs + oa + o_), *(const LAS h16x8*)(rs + ob_ + o_), acc); } \
            _Pragma("unroll") for (int g_ = 0; g_ < 4; ++g_) { const int t = 4 * fq + g_; const bool keep = wave == 4 ? (fr < t) : (fr <= t); ((LAS h16*)(co + (wave - 4) * 512))[t * 16 + fr] = (h16)(keep ? acc[g_] : 0.f); } \
            if (wave == 4) { const float M_ = ((const LAS float*)(rs + 11264))[lane], L15 = ((const LAS float*)(rs + 11264 + 256))[lane]; \
                ((LAS float*)(co + 1536))[lane] = __expf(M_); ((LAS float*)(co + 1792))[lane] = __expf(L15 - M_); ((LAS float*)(co + 2048))[lane] = __expf(L15); } } } while (0)
        f32x4 St[4];
#pragma unroll
        for (int n = 0; n < 4; ++n) St[n] = (f32x4){0.f, 0.f, 0.f, 0.f};
#define CVT4(x_) ((h16x4){(h16)(x_)[0], (h16)(x_)[1], (h16)(x_)[2], (h16)(x_)[3]})
#define TRR(p_) __builtin_bit_cast(h16x4, __builtin_amdgcn_ds_read_tr16_b64_v4i16((LAS s16x4*)(p_)))
#define SC_ROW(cc, PROMPT) do { if ((cc) >= sc0 && (cc) < sc1) { SC_DESC(cc, prompt, sq, h, t0, first, last); \
            const int fr = lane & 15, fq = lane >> 4; \
            float* sp = a.out + (prompt ? O_WKP : O_WKS) + ((size_t)(sq * 32 + h) * 64 + 16 * wave + fr) * 64 + 4 * fq; \
            if (first) { _Pragma("unroll") for (int n = 0; n < 4; ++n) { St[n] = (f32x4){0.f, 0.f, 0.f, 0.f}; if (!(PROMPT)) St[n] = *(const f32x4*)(a.in[4] + ((size_t)(sq * 32 + h) * 64 + 16 * wave + fr) * 64 + 16 * n + 4 * fq); } } \
            LAS unsigned char* rs = lds + O_RAW + ((cc) % NSL) * RAWB; const LAS unsigned char* co = lds + O_CO + ((cc) & 1) * CSET; \
              \
            f32x4 em[4], gm[4], e4[4]; h16x4 atl[2][2], rtl[2][2], kbt[4], bbt[4]; \
            _Pragma("unroll") for (int n = 0; n < 4; ++n) { em[n] = *(const LAS f32x4*)(co + 1536 + (16 * n + 4 * fq) * 4); gm[n] = *(const LAS f32x4*)(co + 2048 + (16 * n + 4 * fq) * 4); e4[n] = *(const LAS f32x4*)(co + 1792 + (16 * n + 4 * fq) * 4); } \
            _Pragma("unroll") for (int b = 0; b < 2; ++b) { \
                const int o0_ = fr * 128 + (((4 * b + (fq >> 1)) ^ (fr & 7)) << 4) + 8 * (fq & 1), o1_ = fr * 128 + (((4 * b + 2 + (fq >> 1)) ^ (fr & 7)) << 4) + 8 * (fq & 1); \
                atl[b][0] = *(const LAS h16x4*)(rs + o0_); atl[b][1] = *(const LAS h16x4*)(rs + o1_); rtl[b][0] = *(const LAS h16x4*)(rs + 2048 + o0_); rtl[b][1] = *(const LAS h16x4*)(rs + 2048 + o1_); } \
            const h16x4 vm = *(const LAS h16x4*)(rs + 8192 + ((16 * wave + fr) * 16 + 4 * fq) * 2), aak = *(const LAS h16x4*)(co + (fr * 16 + 4 * fq) * 2), tA = *(const LAS h16x4*)(rs + 10240 + (fr * 16 + 4 * fq) * 2), \
                        ark = *(const LAS h16x4*)(co + 512 + (fr * 16 + 4 * fq) * 2), arb = *(const LAS h16x4*)(co + 1024 + (fr * 16 + 4 * fq) * 2); \
            _Pragma("unroll") for (int n = 0; n < 4; ++n) { const int tr_ = 4 * fq + (fr >> 2); const int o_ = tr_ * 128 + (((2 * n + ((fr & 3) >> 1)) ^ (tr_ & 7)) << 4) + 8 * (fr & 1); kbt[n] = TRR(rs + 6144 + o_); bbt[n] = TRR(rs + 4096 + o_); } \
            asm volatile("s_waitcnt lgkmcnt(0)" ::: "memory"); \
            const h16x4 z4 = (h16x4){(h16)0.f, (h16)0.f, (h16)0.f, (h16)0.f}; \
            h16x4 sh[4]; \
            _Pragma("unroll") for (int n = 0; n < 4; ++n) { const f32x4 x = St[n] * em[n]; sh[n] = CVT4(x); } \
            f32x4 W1 = (f32x4){0.f, 0.f, 0.f, 0.f}, Yt = W1; \
              \
            _Pragma("unroll") for (int b = 0; b < 2; ++b) { const h16x8 sb = CAT8(sh[2 * b], sh[2 * b + 1]); \
                W1 = MF(CAT8(atl[b][0], atl[b][1]), sb, W1); Yt = MF(CAT8(rtl[b][0], rtl[b][1]), sb, Yt); } \
            W1 = MF(CAT8(aak, z4), CAT8(vm, z4), W1); \
            const h16x4 w1h = CVT4(W1); \
            f32x4 U = MF(CAT8(tA, z4), CAT8(w1h, z4), ((f32x4){0.f, 0.f, 0.f, 0.f})); \
            const f32x4 nU = -U; const h16x4 uh = CVT4(nU); const h16x8 vu = CAT8(vm, uh);     \
            Yt = MF(CAT8(ark, arb), vu, Yt); \
            _Pragma("unroll") for (int n = 0; n < 4; ++n) { const f32x4 tmp = MF(CAT8(kbt[n], bbt[n]), vu, ((f32x4){0.f, 0.f, 0.f, 0.f})); St[n] = gm[n] * St[n] + e4[n] * tmp; } \
            { LAS h16* yb = (LAS h16*)(lds + O_YB + ((cc) & 1) * 2048) + (4 * fq) * 64 + 16 * wave + fr; (void)t0; \
              yb[0] = (h16)Yt[0]; yb[64] = (h16)Yt[1]; yb[128] = (h16)Yt[2]; yb[192] = (h16)Yt[3]; } \
            if (last) { _Pragma("unroll") for (int n = 0; n < 4; ++n) *(f32x4*)(sp + 16 * n) = St[n]; } } } while (0)
#define SC_YOUT(cc) do { if ((cc) >= sc0 && (cc) < sc1 && wave >= 5) { SC_DESC(cc, prompt, sq, h, t0, first, last); (void)first; (void)last; \
            const int L_ = (wave - 5) * 64 + lane, t_ = L_ >> 3, part_ = L_ & 7; \
            *(u32x4*)(OUT16 + ((size_t)(prompt ? sq * 4096 : MP + sq * 64) + t0 + t_) * D + h * 64 + part_ * 8) = *(const LAS u32x4*)(lds + O_YB + ((cc) & 1) * 2048 + t_ * 128 + part_ * 16); } } while (0)
#define SC_BARRIER() do { asm volatile("s_waitcnt lgkmcnt(0)" ::: "memory"); __builtin_amdgcn_s_barrier(); asm volatile("" ::: "memory"); } while (0)
        auto scan_run = [&](const int sc0, const int sc1) {
            if (wave < 4) {
                SC_BARRIER();
                if (pblk) { for (int it = sc0 - 1; it <= sc1; ++it) { SC_ROW(it, true); SC_BARRIER(); } }
                else { for (int it = sc0 - 1; it <= sc1; ++it) { SC_ROW(it, false); SC_BARRIER(); } }
            } else if (wave == 7) {
                SC_DMA(sc0); SC_DMA(sc0 + 1); SC_DMA(sc0 + 2); SC_DMA(sc0 + 3); SC_DMA(sc0 + 4);
                asm volatile("s_waitcnt vmcnt(48)" ::: "memory");
                SC_BARRIER();
                for (int it = sc0 - 1; it <= sc1; ++it) {
                    SC_DMA(it + 6);
                    if (it + 6 < sc1) asm volatile("s_waitcnt vmcnt(48)" ::: "memory");
                    else asm volatile("s_waitcnt vmcnt(0)" ::: "memory");
                    SC_BARRIER();
                }
            } else {
                SC_BARRIER();
                for (int it = sc0 - 1; it <= sc1; ++it) { SC_C(it + 1); SC_YOUT(it - 1); SC_BARRIER(); }
            }
        };
        if (pblk) scan_run(0, PREP_CA);
        else prep_run((vcu - 64) * NWAVES + wave, (G - 64) * NWAVES, 2 * (256 - PREP_CA) * 32, true);
        xcd_barrier(xbar);
        scan_run(pblk ? PREP_CA : 0, pblk ? 256 : NCHB);
        if (!pblk) { __syncthreads(); merge_run(vcu - 64, G - 64, 2 * PREP_CA, true); }
        if (!pblk) {
            __syncthreads();
            LAS float* scr = (LAS float*)(lds + wave * 16384);
            constexpr int I1 = (D / 64) * (2 * FF / 32), I2 = (FF / 64) * (D / 32);
            const int gw = (vcu - 64) * NWAVES + wave, NGW = (G - 64) * NWAVES;
#define PICK2(it, out) do { int r_ = (it); if (r_ < I1) out = cvt_decode(1, a.in[25], a.in[26], FF, D, W2GU, 2 * FF / 32, r_, lane); else out = cvt_decode(0, a.in[27], a.in[27], D, FF, W2D, D / 32, r_ - I1, lane); } while (0)
            CVT_RUN(I1 + I2, PICK2);
#undef PICK2
        }
#undef SC_DESC
#undef SC_DMA
#undef MF
#undef CAT8
#undef SC_C
#undef CVT4
#undef TRR
#undef SC_ROW
#undef SC_BARRIER
#undef SC_YOUT
    }
    SEAM(PH_SCAN);
    if (IN(PH_MERGE)) merge_run(bx, G, MT / 16 - 2 * PREP_CA, false);
    SEAM(PH_MERGE);
    if (IN(PH_WOUT)) {
        { pg8::Gemm g{A16, WOUT, MT, D, D}; pg8::Order S; S.init(MT, D, D, G, bx, 0, MP / 256); pg8::EpiRes<true, true> E{XH, XH, SLAB, 1.0f, 0}; pg8::gemm_phase(lds, g, S, E); }
    }
    SEAM(PH_WOUT);
    if (IN(PH_RMS2)) { for (int m = gw; m < MT; m += NGW) { if (m < MP) rms_row_h(XH + (size_t)m * D, a.in[24], A16 + (size_t)m * D, nullptr, lane);
            else rms_row_f16(Y + (size_t)m * D, a.in[24], A16 + (size_t)m * D, nullptr, lane, (const h16*)SLAB + (size_t)(m - MP) * D, 1.0f, Y + (size_t)m * D); } }
    SEAM(PH_RMS2);
    if (IN(PH_FFN2_GU)) { pg8::Gemm g{A16, W2GU, MT, 2 * FF, D}; pg8::Order S; S.init(MT, 2 * FF, D, G, bx, 0, -1); pg8::EpiSwiGLU E{HM, FF}; pg8::gemm_phase(lds, g, S, E); }
    SEAM(PH_FFN2_GU);
    if (IN(PH_FFN2_D)) { pg8::Gemm g{HM, W2D, MT, D, FF}; pg8::Order S; S.init(MT, D, FF, G, bx, 0, MP / 256); pg8::EpiRes<true, true> E{XH, A16, SLAB, 0.5f, 0}; pg8::gemm_phase(lds, g, S, E); }
    SEAM(PH_FFN2_D);
    if (IN(PH_FINAL)) { for (int m = gw; m < MT; m += NGW) { if (m < MP) rms_row_h(A16 + (size_t)m * D, a.in[28], nullptr, Y + (size_t)m * D, lane);
            else rms_row_f16(Y + (size_t)m * D, a.in[28], nullptr, Y + (size_t)m * D, lane, (const h16*)SLAB + (size_t)(m - MP) * D, 0.5f, nullptr); } }
    if (PROBE_MASK) {
        pr_t[PH_N] = __builtin_amdgcn_s_memrealtime();
        if (bx == 0 && tid == 0) { unsigned long long tot = 0;
#pragma unroll
            for (int k = 0; k < PH_N; ++k) if ((PROBE_MASK >> k) & 1u) tot += pr_t[k + 1] - pr_t[k];
            const unsigned long long t0 = __builtin_amdgcn_s_memrealtime();
            while (__builtin_amdgcn_s_memrealtime() - t0 < tot * PROBE_MUL) __builtin_amdgcn_s_sleep(8);
        }
    }
#undef IN
#undef SEAM
}

extern "C" void kernel_launch(void* const* d_in, const int* in_sizes, int n_in, void* d_out, int out_size, void* d_ws, size_t ws_size, hipStream_t stream) {
    static int grid = 0;
    if (grid == 0) {
        if (n_in != 29 || (size_t)out_size != O_END || ws_size < WS_END) { fprintf(stderr, "kernel_launch: unexpected shapes (n_in %d out %d ws %zu need %zu)\n", n_in, out_size, ws_size, (size_t)WS_END); grid = -1; return; }
        int dev = 0, cus = 0, per_cu = 0;
        if (hipGetDevice(&dev) != hipSuccess || hipDeviceGetAttribute(&cus, hipDeviceAttributeMultiprocessorCount, dev) != hipSuccess) { grid = -1; return; }
        if (hipFuncSetAttribute((const void*)fwd_kernel, hipFuncAttributeMaxDynamicSharedMemorySize, LDS_BYTES) != hipSuccess) { grid = -1; return; }
        if (hipOccupancyMaxActiveBlocksPerMultiprocessor(&per_cu, (const void*)fwd_kernel, NTHR, LDS_BYTES) != hipSuccess || per_cu < 1) { fprintf(stderr, "kernel_launch: occupancy query failed (%d)\n", per_cu); grid = -1; return; }
        grid = cus;
    }
    if (grid < 0) return;
    Args a{};
    for (int i = 0; i < 29; ++i) a.in[i] = (const float*)d_in[i];
    a.out = (float*)d_out; a.ws = (unsigned char*)d_ws; a.ph_lo = 0; a.ph_hi = PH_N;
    void* kargs[] = {&a};
    hipError_t e = hipLaunchCooperativeKernel((const void*)fwd_kernel, dim3(grid), dim3(NTHR), kargs, LDS_BYTES, stream);
    if (e != hipSuccess) fprintf(stderr, "kernel_launch: cooperative launch failed: %s (grid %d)\n", hipGetErrorString(e), grid);
}
```

```cpp
#include <hip/hip_runtime.h>
#include <hip/hip_cooperative_groups.h>
#include <cstdio>
namespace cg = cooperative_groups;

#define LAS __attribute__((address_space(3)))
typedef _Float16 h16;
typedef _Float16 h16x2 __attribute__((ext_vector_type(2)));
typedef _Float16 h16x4 __attribute__((ext_vector_type(4)));
typedef _Float16 h16x8 __attribute__((ext_vector_type(8)));
typedef short s16x4 __attribute__((ext_vector_type(4)));
typedef float f32x4 __attribute__((ext_vector_type(4)));
typedef float f32x2 __attribute__((ext_vector_type(2)));
typedef unsigned u32x4 __attribute__((ext_vector_type(4)));
typedef unsigned u32x2 __attribute__((ext_vector_type(2)));

constexpr int D = 2048, FF = 5632, NA = 6592, NIN = 16832;
constexpr int MP = 8192, MS = 2048, MT = MP + MS;
constexpr int MA = MT + 256;
constexpr int PP = 12800;
constexpr int NW = 16896;
constexpr int PFW = 6656;
constexpr int C_U = 6656, C_Q = 8704, C_SA = 10752;
constexpr int LK = 512;
constexpr int NCHUNK = MT / 64;
constexpr size_t O_Y = 0, O_SHP = 20971520, O_CVP = 20975616, O_WKP = 20983808, O_SHS = 21245952, O_CVS = 21311488, O_WKS = 21442560, O_END = 25636864;
constexpr size_t WS_CTL = 0;
constexpr size_t WS_W1GU = 1u << 20;
constexpr size_t WS_W1D = WS_W1GU + (size_t)2 * FF * D * 2;
constexpr size_t WS_WIN = WS_W1D + (size_t)D * FF * 2;
constexpr size_t WS_WOUT = WS_WIN + (size_t)NW * D * 2;
constexpr size_t WS_A16 = WS_WOUT + (size_t)D * D * 2;
constexpr size_t WS_P16 = WS_A16 + (size_t)MA * D * 2;
constexpr size_t WS_W2GU = WS_P16 + (size_t)MT * PP * 2;
constexpr size_t WS_W2D = WS_W2GU + (size_t)2 * FF * D * 2;
constexpr size_t WS_PF = WS_W2D + (size_t)D * FF * 2;
constexpr size_t WS_END = WS_PF + (size_t)256 * PFW * 2;
constexpr size_t WS_EAG = WS_W1GU;
constexpr size_t WS_HM = WS_P16;
constexpr size_t WS_SLAB = WS_HM + (size_t)MT * FF * 2;
static_assert((size_t)MT * 6144 * 2 <= WS_WOUT - WS_W1GU, "EAG overlay");
static_assert(WS_SLAB + (size_t)4 * MS * D * 4 <= WS_W2GU, "HM + slab overlay of P16");
constexpr size_t OB_WL = O_WKS * 4;
constexpr size_t OB_SIDE = OB_WL + (size_t)6144 * LK * 2;
static_assert(OB_SIDE + (size_t)(MT / 16) * 6144 * 2 <= O_END * 4, "d_out scratch");

constexpr size_t WS_RK = WS_EAG + (size_t)MT * 6144 * 2;
constexpr size_t WS_LM = WS_RK + (size_t)MT * 32 * 4;
static_assert(WS_LM + (size_t)(MT / 16) * 32 * 128 * 4 <= WS_WOUT, "RK + LM");
constexpr int SC_SLOT = 6 * 64, SC_BUF = 16 * SC_SLOT;
constexpr int NWAVES = 8, NTHR = 512;
constexpr int LDS_BYTES = 147456;

__device__ __forceinline__ unsigned pk2h(float a, float b) { h16x2 v = {(h16)a, (h16)b}; return __builtin_bit_cast(unsigned, v); }
__device__ __forceinline__ float wave_sum(float v) {
#pragma unroll
    for (int o = 1; o < 64; o <<= 1) v += __shfl_xor(v, o);
    return v;
}
template <int CTRL> __device__ __forceinline__ float dpp_f(float x) { return __builtin_bit_cast(float, __builtin_amdgcn_update_dpp(0, __builtin_bit_cast(int, x), CTRL, 0xF, 0xF, false)); }
__device__ __forceinline__ float row_allreduce8(float x) { x += dpp_f<0xB1>(x); x += dpp_f<0x4E>(x); x += dpp_f<0x141>(x); return x; }
__device__ __forceinline__ float row_allreduce16(float x) { x = row_allreduce8(x); x += dpp_f<0x140>(x); return x; }
__device__ __forceinline__ float rl_f(float x, int l) { return __builtin_bit_cast(float, __builtin_amdgcn_readlane(__builtin_bit_cast(int, x), l)); }
__device__ __forceinline__ float wave_sum_dpp(float x) { x = row_allreduce16(x); return (rl_f(x, 0) + rl_f(x, 16)) + (rl_f(x, 32) + rl_f(x, 48)); }
__device__ __forceinline__ float wave_sum_bc(float x) {
    x = row_allreduce16(x);
    x += __builtin_bit_cast(float, __builtin_amdgcn_update_dpp(0, __builtin_bit_cast(int, x), 0x142, 0xA, 0xF, false));
    x += __builtin_bit_cast(float, __builtin_amdgcn_update_dpp(0, __builtin_bit_cast(int, x), 0x143, 0xC, 0xF, false));
    return rl_f(x, 63); }
__device__ __forceinline__ float sigmoidf_(float x) { return __builtin_amdgcn_rcpf(1.0f + __expf(-x)); }
__device__ __forceinline__ float tanhf_(float x) { return 1.0f - 2.0f * __builtin_amdgcn_rcpf(1.0f + __expf(2.0f * x)); }

namespace pg8 {
constexpr int BM = 256, BK = 64, HALF = 128, HTB = HALF * BK * 2, STAGE_BYTES = 8 * HTB, NXCD = 8, WGM = 8;
__host__ __device__ __forceinline__ int lds_byte(int r, int c) { const int st = (r >> 4) * 2 + (c >> 5), rr = r & 15, cc = c & 31, ob = rr * 64 + cc * 2; return st * 1024 + (ob ^ (((ob >> 9) & 1) << 5)); }
__host__ __device__ __forceinline__ void stage_rc(int b, int& R, int& C) { const int st = b / 1024, sb = b % 1024, swz = sb ^ (((sb >> 9) & 1) << 5); R = (st >> 1) * 16 + swz / 64; C = (st & 1) * 32 + (swz % 64) / 2; }
__host__ __device__ __forceinline__ int perm32(int rho) { const int n = rho >> 4, i = rho & 15; return 8 * (i >> 2) + 4 * n + (i & 3); }
struct Unit { int pm, pn, kt0, nkt, sp; };
struct Gemm { const h16* A; const h16* Bt; int M, N, K; };
struct Order {
    int nM, nN, nwg, G, c, extra, nkt, nsplit;
    __device__ void init(int M, int N, int K, int G_, int c_, int extra_, int nMw) { nM = M / BM; nN = N / BM; nwg = (nMw < 0 ? nM : nMw) * nN; G = G_; c = c_; extra = extra_; nkt = K / BK; nsplit = nMw < 0 ? 0 : (nM - nMw) * nN * 4; }
    __device__ bool next(int i, Unit& u) const {
        const int ii = (nsplit > 0 && 2 * c >= G && nwg + extra + nsplit >= 2 * G && i < 2) ? 1 - i : i;
        const long L = (long)ii * G + c; if (L >= nwg + extra + nsplit) return false;
        u.kt0 = 0; u.nkt = nkt; u.sp = -1;
        if (L >= nwg + extra) { const int j = (int)(L - nwg - extra), rows = nM - nwg / nN; u.nkt = nkt >> 2;
            if (rows == 8 && nN == 8) {
                const int xcd = j & 7, idx = j >> 3; u.sp = xcd >> 1; u.pn = 4 * (xcd & 1) + (idx >> 3); u.pm = nwg / nN + (idx & 7); }
            else { const int tile = j >> 2; u.sp = j & 3; u.pm = nwg / nN + tile % rows; u.pn = tile / rows; }
            u.kt0 = u.sp * u.nkt; return true; }
        if (L >= nwg) { u.pm = nM; u.pn = (int)(L - nwg); return true; }
        const int nMe = nwg / nN;
        int wgid = (int)L; { const int q = nwg / NXCD, r = nwg % NXCD, xcd = wgid % NXCD, off = wgid / NXCD; wgid = (xcd < r ? xcd * (q + 1) : r * (q + 1) + (xcd - r) * q) + off; }
        const int nig = WGM * nN, gid = wgid / nig, fm = gid * WGM, gsz = (nMe % WGM == 0) ? WGM : ((nMe - fm) < WGM ? (nMe - fm) : WGM);
        u.pm = fm + ((wgid % nig) % gsz); u.pn = (wgid % nig) / gsz; return true;
    }
};

__device__ __forceinline__ void lora_k(Unit& u) { const int typ = u.pn >> 3; u.kt0 = typ == 0 ? 0 : typ == 1 ? 1 : 3; u.nkt = typ == 2 ? 4 : 2; }
template <class Epi, bool LORAK = false, bool SP2 = true, bool ALIGN_EPI = true>
__device__ __forceinline__ void gemm_phase(LAS unsigned char* lds, const Gemm g, const Order& S, const Epi& E) {
    const int tid = threadIdx.x, wid = __builtin_amdgcn_readfirstlane(tid >> 6), lane = tid & 63, wr = wid >> 2, wc = wid & 3, fr = lane & 15, fq = lane >> 4;
    const int K = g.K;
    unsigned voffA[2], voffB[2];
#pragma unroll
    for (int i = 0; i < 2; ++i) { int R, C; stage_rc(tid * 16 + i * 8192, R, C); const int Rb = Epi::PERM ? ((R & ~31) + perm32(R & 31)) : R;
        voffA[i] = (unsigned)(R * K + C) * 2u; voffB[i] = (unsigned)(Rb * K + C) * 2u; }
    const size_t kstep = (size_t)(BK * 2);
    const size_t hstep = (size_t)HALF * K * 2;
    const size_t tstep = 2 * hstep;
    const unsigned ldsw = (unsigned)wid * 1024u;
    const int aoff = lds_byte(wr * 64 + fr, fq * 8), boff = lds_byte(wc * 32 + fr, fq * 8);
#define PG8_SA(b, h) (((b) * 2 + (h)) * HTB)
#define PG8_SB(b, h) ((4 + (b) * 2 + (h)) * HTB)
#define PG8_STAGE(bufoff, gbase, voff) do { _Pragma("unroll") for (int _i = 0; _i < 2; ++_i) \
        __builtin_amdgcn_global_load_lds((const unsigned*)((const char*)(gbase) + (voff)[_i]), (LAS unsigned*)(lds + (bufoff) + ldsw + _i * 8192), 16, 0, 0); } while (0)
#define PG8_LDA(dst, b, h) do { _Pragma("unroll") for (int m = 0; m < 4; ++m) _Pragma("unroll") for (int k = 0; k < 2; ++k) dst[m][k] = *(const LAS h16x8*)(lds + PG8_SA(b, h) + aoff + m * 2048 + k * 1024); } while (0)
#define PG8_LDB(dst, b, h) do { _Pragma("unroll") for (int n = 0; n < 2; ++n) _Pragma("unroll") for (int k = 0; k < 2; ++k) dst[n][k] = *(const LAS h16x8*)(lds + PG8_SB(b, h) + boff + n * 2048 + k * 1024); } while (0)
#define PG8_MMA(ai, bj, At, Bt) do { __builtin_amdgcn_s_setprio(1); _Pragma("unroll") for (int m = 0; m < 4; ++m) _Pragma("unroll") for (int n = 0; n < 2; ++n) _Pragma("unroll") for (int k = 0; k < 2; ++k) \
        acc[ai][bj][m][n] = __builtin_amdgcn_mfma_f32_16x16x32_f16(Bt[n][k], At[m][k], acc[ai][bj][m][n], 0, 0, 0); __builtin_amdgcn_s_setprio(0); } while (0)
#define PG8_WAIT_V(n) asm volatile("s_waitcnt vmcnt(" #n ")" ::: "memory")
#define PG8_WAIT_L(n) asm volatile("s_waitcnt lgkmcnt(" #n ")" ::: "memory")
#define PG8_BAR __builtin_amdgcn_s_barrier()
#define PG8_SCHED __builtin_amdgcn_sched_barrier(0)
    Unit cur, nxt; int ui = 0;
    if (!S.next(0, cur)) return;
    if constexpr (LORAK) lora_k(cur);
    f32x4 acc[2][2][4][2];
#pragma unroll
    for (int a = 0; a < 2; ++a)
#pragma unroll
        for (int b = 0; b < 2; ++b)
#pragma unroll
            for (int m = 0; m < 4; ++m)
#pragma unroll
                for (int n = 0; n < 2; ++n) acc[a][b][m][n] = (f32x4){0.f, 0.f, 0.f, 0.f};
    h16x8 At[4][2], B0[2][2], B1[2][2];
    const char* cA = (const char*)g.A + (size_t)cur.pm * tstep + (size_t)cur.kt0 * kstep; const char* cB = (const char*)g.Bt + (size_t)cur.pn * tstep + (size_t)cur.kt0 * kstep;
    if constexpr (SP2) {
        PG8_STAGE(PG8_SB(0, 0), cB, voffB); PG8_STAGE(PG8_SB(0, 1), cB + hstep, voffB); PG8_STAGE(PG8_SA(0, 0), cA, voffA); PG8_STAGE(PG8_SA(0, 1), cA + hstep, voffA);
        if (wr == 1) PG8_BAR;
        PG8_WAIT_V(2); PG8_BAR;
        PG8_STAGE(PG8_SB(1, 0), cB + kstep, voffB); PG8_STAGE(PG8_SA(1, 0), cA + kstep, voffA); PG8_STAGE(PG8_SB(1, 1), cB + hstep + kstep, voffB);
        PG8_WAIT_V(6); PG8_BAR;
    } else {
        PG8_STAGE(PG8_SB(0, 0), cB, voffB); PG8_STAGE(PG8_SA(0, 0), cA, voffA); PG8_STAGE(PG8_SB(0, 1), cB + hstep, voffB); PG8_STAGE(PG8_SA(0, 1), cA + hstep, voffA);
        if (wr == 1) PG8_BAR;
        PG8_WAIT_V(4); PG8_BAR;
        PG8_STAGE(PG8_SB(1, 0), cB + kstep, voffB); PG8_STAGE(PG8_SA(1, 0), cA + kstep, voffA); PG8_STAGE(PG8_SB(1, 1), cB + hstep + kstep, voffB);
        PG8_WAIT_V(6); PG8_BAR;
    }
    for (;;) {
        const bool has_next = S.next(ui + 1, nxt);
        if constexpr (LORAK) { if (has_next) lora_k(nxt); }
        const char* nA = has_next ? (const char*)g.A + (size_t)nxt.pm * tstep + (size_t)nxt.kt0 * kstep : cA; const char* nB = has_next ? (const char*)g.Bt + (size_t)nxt.pn * tstep + (size_t)nxt.kt0 * kstep : cB;
        const int nt = cur.nkt;
        for (int t = 0; t < nt; t += 2) {
            const bool last = (t == nt - 2);
            const char* a1 = cA + (size_t)(t + 1) * kstep;
            const char* a2 = last ? nA : cA + (size_t)(t + 2) * kstep; const char* b2 = last ? nB : cB + (size_t)(t + 2) * kstep;
            const char* a3 = a2 + kstep; const char* b3 = b2 + kstep;
            if constexpr (SP2) {
            PG8_LDB(B0, 0, 0); PG8_LDB(B1, 0, 1); PG8_SCHED; PG8_LDA(At, 0, 0); PG8_STAGE(PG8_SA(1, 1), a1 + hstep, voffA);
            PG8_WAIT_V(8); PG8_WAIT_L(0); PG8_BAR; PG8_MMA(0, 0, At, B0); PG8_MMA(0, 1, At, B1); PG8_BAR; PG8_SCHED;
            PG8_LDA(At, 0, 1); PG8_STAGE(PG8_SB(0, 0), b2, voffB); PG8_STAGE(PG8_SB(0, 1), b2 + hstep, voffB); PG8_STAGE(PG8_SA(0, 0), a2, voffA);
            PG8_WAIT_V(8); PG8_WAIT_L(0); PG8_BAR; PG8_MMA(1, 0, At, B0); PG8_MMA(1, 1, At, B1); PG8_BAR; PG8_SCHED;
            PG8_LDB(B0, 1, 0); PG8_LDB(B1, 1, 1); PG8_SCHED; PG8_LDA(At, 1, 0); PG8_STAGE(PG8_SA(0, 1), a2 + hstep, voffA);
            PG8_WAIT_V(8); PG8_WAIT_L(0); PG8_BAR; PG8_MMA(0, 0, At, B0); PG8_MMA(0, 1, At, B1); PG8_BAR; PG8_SCHED;
            PG8_LDA(At, 1, 1); PG8_STAGE(PG8_SB(1, 0), b3, voffB); PG8_STAGE(PG8_SB(1, 1), b3 + hstep, voffB); PG8_STAGE(PG8_SA(1, 0), a3, voffA);
            PG8_WAIT_V(8); PG8_WAIT_L(0); PG8_BAR; PG8_MMA(1, 0, At, B0); PG8_MMA(1, 1, At, B1); PG8_BAR; PG8_SCHED;
            } else {
            PG8_LDB(B0, 0, 0); PG8_SCHED; PG8_LDA(At, 0, 0); PG8_STAGE(PG8_SA(1, 1), a1 + hstep, voffA);
            PG8_WAIT_L(8); PG8_BAR; PG8_WAIT_L(0); PG8_MMA(0, 0, At, B0); PG8_BAR; PG8_SCHED;
            PG8_LDB(B1, 0, 1); PG8_STAGE(PG8_SB(0, 0), b2, voffB);
            PG8_BAR; PG8_WAIT_L(0); PG8_MMA(0, 1, At, B1); PG8_BAR;
            PG8_LDA(At, 0, 1); PG8_STAGE(PG8_SA(0, 0), a2, voffA);
            PG8_BAR; PG8_WAIT_L(0); PG8_MMA(1, 0, At, B0); PG8_BAR; PG8_SCHED;
            PG8_STAGE(PG8_SB(0, 1), b2 + hstep, voffB);
            PG8_WAIT_V(6); PG8_BAR; PG8_MMA(1, 1, At, B1); PG8_BAR;
            PG8_LDB(B0, 1, 0); PG8_SCHED; PG8_LDA(At, 1, 0); PG8_STAGE(PG8_SA(0, 1), a2 + hstep, voffA);
            PG8_WAIT_L(8); PG8_BAR; PG8_WAIT_L(0); PG8_MMA(0, 0, At, B0); PG8_BAR; PG8_SCHED;
            PG8_LDB(B1, 1, 1); PG8_STAGE(PG8_SB(1, 0), b3, voffB);
            PG8_BAR; PG8_WAIT_L(0); PG8_MMA(0, 1, At, B1); PG8_BAR;
            PG8_LDA(At, 1, 1); PG8_STAGE(PG8_SA(1, 0), a3, voffA);
            PG8_BAR; PG8_WAIT_L(0); PG8_MMA(1, 0, At, B0); PG8_BAR; PG8_SCHED;
            PG8_STAGE(PG8_SB(1, 1), b3 + hstep, voffB);
            PG8_WAIT_V(6); PG8_BAR; PG8_MMA(1, 1, At, B1); PG8_BAR;
                    }
        }
        if constexpr (ALIGN_EPI) { if (wr == 0) PG8_BAR; }
        E(acc, cur, wr, wc, fr, fq);
        if (!has_next) break;
#pragma unroll
        for (int a = 0; a < 2; ++a)
#pragma unroll
            for (int b = 0; b < 2; ++b)
#pragma unroll
                for (int m = 0; m < 4; ++m)
#pragma unroll
                    for (int n = 0; n < 2; ++n) { unsigned long long z0, z1;
                        asm volatile("v_mov_b64 %0, 0\n\tv_mov_b64 %1, 0" : "=v"(z0), "=v"(z1));
                        typedef unsigned long long u64x2_ __attribute__((ext_vector_type(2)));
                        acc[a][b][m][n] = __builtin_bit_cast(f32x4, (u64x2_){z0, z1}); }
        cur = nxt; cA = nA; cB = nB; ++ui;
        if constexpr (ALIGN_EPI) { if (wr == 1) PG8_BAR; }
    }
    PG8_WAIT_V(0);
    if constexpr (!ALIGN_EPI) { if (wr == 0) PG8_BAR; }
    PG8_BAR;
#undef PG8_SA
#undef PG8_SB
#undef PG8_STAGE
#undef PG8_LDA
#undef PG8_LDB
#undef PG8_MMA
#undef PG8_WAIT_V
#undef PG8_WAIT_L
#undef PG8_BAR
#undef PG8_SCHED
}

struct EpiSwiGLU {
    static constexpr bool PERM = true;
    h16* O; int ldo;
    __device__ __forceinline__ void operator()(const f32x4 (&acc)[2][2][4][2], const Unit& u, int wr, int wc, int fr, int fq) const {
        const int row0 = u.pm * BM + wr * 64 + fr, oc = u.pn * HALF + wc * 32 + 8 * fq;
#pragma unroll
        for (int ai = 0; ai < 2; ++ai)
#pragma unroll
            for (int m = 0; m < 4; ++m) { h16* rowp = O + (size_t)(row0 + ai * HALF + m * 16) * ldo; float o[8];
#pragma unroll
                for (int n = 0; n < 2; ++n) { const f32x4 gt = acc[ai][0][m][n], up = acc[ai][1][m][n];
#pragma unroll
                    for (int j = 0; j < 4; ++j) o[4 * n + j] = gt[j] * sigmoidf_(gt[j]) * up[j]; }
                *(u32x4*)(rowp + oc) = (u32x4){pk2h(o[0], o[1]), pk2h(o[2], o[3]), pk2h(o[4], o[5]), pk2h(o[6], o[7])}; }
    }
};
template <bool RES16, bool OUT16> struct EpiRes {
    static constexpr bool PERM = true;
    const void* res; void* out; float* slab; float scale; int pad;
    __device__ __forceinline__ void operator()(const f32x4 (&acc)[2][2][4][2], const Unit& u, int wr, int wc, int fr, int fq) const {
        const int row0 = u.pm * BM + wr * 64 + fr, col0 = u.pn * BM + wc * 32 + 8 * fq;
        if (u.sp >= 0) {
            h16* sb = (h16*)slab + ((size_t)u.sp * MS - MP) * D;
#pragma unroll
            for (int ai = 0; ai < 2; ++ai)
#pragma unroll
                for (int m = 0; m < 4; ++m) { const size_t off = (size_t)(row0 + ai * HALF + m * 16) * D + col0;
#pragma unroll
                    for (int bj = 0; bj < 2; ++bj) { const f32x4 v0 = acc[ai][bj][m][0], v1 = acc[ai][bj][m][1];
                        *(u32x4*)(sb + off + bj * HALF) = (u32x4){pk2h(v0[0], v0[1]), pk2h(v0[2], v0[3]), pk2h(v1[0], v1[1]), pk2h(v1[2], v1[3])}; } }
            return;
        }
        constexpr int NB = RES16 ? 8 : 4;
#pragma unroll
        for (int b0 = 0; b0 < 16; b0 += NB) {
            f32x4 rf[RES16 ? 1 : 2 * NB]; h16x8 rh[RES16 ? NB : 1];
#pragma unroll
            for (int q = 0; q < NB; ++q) { const int qq = b0 + q, ai = qq >> 3, m = (qq >> 1) & 3, bj = qq & 1; const size_t o_ = (size_t)(row0 + ai * HALF + m * 16) * D + col0 + bj * HALF;
                if constexpr (RES16) rh[q] = *(const h16x8*)((const h16*)res + o_);
                else { rf[2 * q] = *(const f32x4*)((const float*)res + o_); rf[2 * q + 1] = *(const f32x4*)((const float*)res + o_ + 4); } }
            __builtin_amdgcn_sched_barrier(0);
#pragma unroll
            for (int q = 0; q < NB; ++q) { const int qq = b0 + q, ai = qq >> 3, m = (qq >> 1) & 3, bj = qq & 1; const size_t o_ = (size_t)(row0 + ai * HALF + m * 16) * D + col0 + bj * HALF;
                f32x4 r0, r1;
                if constexpr (RES16) { r0 = (f32x4){(float)rh[q][0], (float)rh[q][1], (float)rh[q][2], (float)rh[q][3]}; r1 = (f32x4){(float)rh[q][4], (float)rh[q][5], (float)rh[q][6], (float)rh[q][7]}; }
                else { r0 = rf[2 * q]; r1 = rf[2 * q + 1]; }
                const f32x4 o0 = r0 + scale * acc[ai][bj][m][0], o1 = r1 + scale * acc[ai][bj][m][1];
                if constexpr (OUT16) *(u32x4*)((h16*)out + o_) = (u32x4){pk2h(o0[0], o0[1]), pk2h(o0[2], o0[3]), pk2h(o1[0], o1[1]), pk2h(o1[2], o1[3])};
                else { *(f32x4*)((float*)out + o_) = o0; *(f32x4*)((float*)out + o_ + 4) = o1; } }
            __builtin_amdgcn_sched_barrier(0); }
    }
};
struct EpiP16 {
    static constexpr bool PERM = true;
    h16* P; h16* PF;
    __device__ __forceinline__ void operator()(const f32x4 (&acc)[2][2][4][2], const Unit& u, int wr, int wc, int fr, int fq) const {
        const int row0 = u.pm * BM + wr * 64 + fr; const int kind = u.pn < 26 ? 0 : u.pn < 42 ? 1 : u.pn < 58 ? 2 : 3;
        if (kind == 1 || kind == 2) {
            const int oc = (kind == 1 ? C_U + (u.pn - 26) * HALF : C_Q + (u.pn - 42) * HALF) + wc * 32 + 8 * fq;
#pragma unroll
            for (int ai = 0; ai < 2; ++ai)
#pragma unroll
                for (int m = 0; m < 4; ++m) { const int row = row0 + ai * HALF + m * 16; float o[8];
#pragma unroll
                    for (int bj = 0; bj < 2; ++bj) { const f32x4 v0 = acc[ai][bj][m][0], v1 = acc[ai][bj][m][1];
#pragma unroll
                        for (int j = 0; j < 4; ++j) o[4 * bj + j] = kind == 1 ? v0[j] * v1[j] : sigmoidf_(v1[j]) * v0[j]; }
                    *(u32x4*)(P + (size_t)row * PP + oc) = (u32x4){pk2h(o[0], o[1]), pk2h(o[2], o[3]), pk2h(o[4], o[5]), pk2h(o[6], o[7])}; }
            return;
        }
#pragma unroll
        for (int ai = 0; ai < 2; ++ai)
#pragma unroll
            for (int m = 0; m < 4; ++m) { const int row = row0 + ai * HALF + m * 16;
#pragma unroll
                for (int bj = 0; bj < 2; ++bj) { const int gcol = u.pn * BM + bj * HALF + wc * 32;
                    const f32x4 v0 = acc[ai][bj][m][0], v1 = acc[ai][bj][m][1];
                    if (kind == 0) { u32x4 w; w.x = pk2h(v0[0], v0[1]); w.y = pk2h(v0[2], v0[3]); w.z = pk2h(v1[0], v1[1]); w.w = pk2h(v1[2], v1[3]);
                        if (u.pm < MT / BM) *(u32x4*)(P + (size_t)row * PP + gcol + 8 * fq) = w;
                        else *(u32x4*)(PF + (size_t)(row - MT) * PFW + gcol + 8 * fq) = w; }
                    else { u32x4 w; w.x = pk2h(v0[0], v0[1]); w.y = pk2h(v0[2], v0[3]); w.z = pk2h(v1[0], v1[1]); w.w = pk2h(v1[2], v1[3]);
                        *(u32x4*)(P + (size_t)row * PP + C_SA + (gcol - (PFW + 8192)) + 8 * fq) = w; } } }
    }
};
struct EpiEAG {
    static constexpr bool PERM = true;
    h16* O; const float* w0; const float* a0;
    __device__ __forceinline__ void operator()(const f32x4 (&acc)[2][2][4][2], const Unit& u, int wr, int wc, int fr, int fq) const {
        const int row0 = u.pm * BM + wr * 64 + fr; const int typ = u.pn >> 3;
#pragma unroll
        for (int bj = 0; bj < 2; ++bj) { const int col = u.pn * BM + bj * HALF + wc * 32 + 8 * fq;
            f32x4 b0 = (f32x4){0.f, 0.f, 0.f, 0.f}, b1 = b0;
            if (typ == 0) { b0 = *(const f32x4*)(w0 + col); b1 = *(const f32x4*)(w0 + col + 4); }
            if (typ == 1) { b0 = *(const f32x4*)(a0 + col - D); b1 = *(const f32x4*)(a0 + col - D + 4); }
#pragma unroll
            for (int ai = 0; ai < 2; ++ai)
#pragma unroll
                for (int m = 0; m < 4; ++m) { const int row = row0 + ai * HALF + m * 16;
                    f32x4 v0 = acc[ai][bj][m][0] + b0, v1 = acc[ai][bj][m][1] + b1;
                    if (typ < 2) { const float sc = typ == 0 ? 0.60653065971f : 1.0f;
#pragma unroll
                        for (int j = 0; j < 4; ++j) { v0[j] = sigmoidf_(v0[j]) * sc; v1[j] = sigmoidf_(v1[j]) * sc; } }
                    u32x4 w; w.x = pk2h(v0[0], v0[1]); w.y = pk2h(v0[2], v0[3]); w.z = pk2h(v1[0], v1[1]); w.w = pk2h(v1[2], v1[3]);
                    *(u32x4*)(O + (size_t)row * 6144 + col) = w; } }
    }
};
}


#define XB_TMO      128
#define XB_XCNT(j)  (256  + 64 * (j))
#define XB_XSUB(j)  (1280 + 64 * (j))
#define XB_XGEN(j)  (2304 + 64 * (j))
#define XB_TOP      3328
#define XB_TOPGEN   3392
#define XCD_BAR_WORDS 3456
#define XB_SPIN_CAP (1u << 22)
__device__ __forceinline__ unsigned xb_ld(unsigned* p)              { return __hip_atomic_load(p, __ATOMIC_RELAXED, __HIP_MEMORY_SCOPE_AGENT); }
__device__ __forceinline__ unsigned xb_add(unsigned* p, unsigned v) { return __hip_atomic_fetch_add(p, v, __ATOMIC_RELAXED, __HIP_MEMORY_SCOPE_AGENT); }
__device__ __forceinline__ unsigned xb_xcc_id() { return (unsigned)__builtin_amdgcn_s_getreg((3 << 11) | 20) & 0xFu; }
#define XB_SPIN(cond, bar) do { unsigned _sp = 0; while (cond) { __builtin_amdgcn_s_sleep(1); \
    if ((++_sp & 255u) == 0u) { if (xb_ld(&(bar)[XB_TMO])) break; if (_sp > XB_SPIN_CAP) { atomicAdd(&(bar)[XB_TMO], 1u); break; } } } } while (0)
struct XcdBarrier { unsigned* bar; unsigned x; volatile LAS unsigned* st; };
__device__ __forceinline__ XcdBarrier xcd_barrier_post(unsigned* bar, volatile LAS unsigned* st) {
    XcdBarrier b; b.bar = bar; b.x = xb_xcc_id(); b.st = st;
    if (threadIdx.x == 0) (void)xb_add(&bar[XB_XCNT(b.x)], 1u);
    return b;
}
__device__ __forceinline__ void xcd_barrier_complete(unsigned* bar, unsigned x, unsigned& nloc, unsigned& nx) {
    const unsigned G = gridDim.x * gridDim.y * gridDim.z;
    unsigned sum, cnt, mine, sp = 0u;
    for (;;) {
        sum = 0u; cnt = 0u; mine = 0u;
#pragma unroll
        for (unsigned j = 0; j < 16; ++j) { const unsigned c = xb_ld(&bar[XB_XCNT(j)]); sum += c; cnt += (c > 0u) ? 1u : 0u; mine = (j == x) ? c : mine; }
        if (sum == G) break;
        __builtin_amdgcn_s_sleep(1);
        if ((++sp & 255u) == 0u) { if (xb_ld(&bar[XB_TMO])) break; if (sp > XB_SPIN_CAP) { atomicAdd(&bar[XB_TMO], 1u); break; } }
    }
    nloc = mine > 0u ? mine : 1u; nx = cnt > 0u ? cnt : 1u;
}
__device__ __forceinline__ void xcd_barrier(const XcdBarrier& b) {
    asm volatile("s_waitcnt vmcnt(0)" ::: "memory");
    __syncthreads();
    if (threadIdx.x == 0) {
        unsigned* bar = b.bar;
        __builtin_amdgcn_s_waitcnt(0);
        unsigned nloc = b.st[0], nx = b.st[1];
        if (nloc == 0u) { xcd_barrier_complete(bar, b.x, nloc, nx); b.st[0] = nloc; b.st[1] = nx; }
        const unsigned old = xb_add(&bar[XB_XSUB(b.x)], 1u);
        const unsigned gen = old / nloc;
        if (old + 1u == (gen + 1u) * nloc) {
            __builtin_amdgcn_fence(__ATOMIC_RELEASE, "agent");
            asm volatile("s_waitcnt vmcnt(0)" ::: "memory");
            const unsigned og = xb_add(&bar[XB_TOP], 1u);
            const unsigned tg = og / nx;
            if (og + 1u == (tg + 1u) * nx) xb_add(&bar[XB_TOPGEN], 1u);
            else XB_SPIN(xb_ld(&bar[XB_TOPGEN]) == tg, bar);
            __builtin_amdgcn_fence(__ATOMIC_ACQUIRE, "agent");
            xb_add(&bar[XB_XGEN(b.x)], 1u);
            asm volatile("s_waitcnt vmcnt(0)" ::: "memory");
        } else {
            XB_SPIN(xb_ld(&bar[XB_XGEN(b.x)]) == gen, bar);
            __builtin_amdgcn_fence(__ATOMIC_ACQUIRE, "agent");
            asm volatile("s_waitcnt vmcnt(0)" ::: "memory");
        }
    }
    __syncthreads();
}

struct Args { const float* in[29]; float* out; unsigned char* ws; int ph_lo, ph_hi; };

__device__ __forceinline__ void cvt_item(int mode, const float* s0, const float* s1, int Nsrc, int K, h16* WT, LAS float* scr, int item, int nblk, int lane) {
    const int kb = item / nblk, nb = item % nblk, k0 = 64 * kb, n0 = 32 * nb;
    const int nn = lane & 31; const float* src = s0; int col = n0 + nn; bool zero = false;
    if (mode == 1) { src = (nn < 16) ? s0 : s1; col = (n0 >> 1) + (nn & 15); }
    if (mode == 2) { if (n0 >= NA && n0 < PFW) zero = true; else if (n0 >= PFW) col -= 64; }
#pragma unroll 8
    for (int i = 0; i < 32; ++i) { const int kk = 2 * i + (lane >> 5); scr[kk * 33 + nn] = zero ? 0.f : src[(size_t)(k0 + kk) * Nsrc + col]; }
    asm volatile("s_waitcnt lgkmcnt(0)" ::: "memory");
    const int c = lane & 7;
#pragma unroll
    for (int j = 0; j < 4; ++j) { const int n = (lane >> 3) + 8 * j; const LAS float* s = scr + (8 * c) * 33 + n;
        u32x4 o; o.x = pk2h(s[0 * 33], s[1 * 33]); o.y = pk2h(s[2 * 33], s[3 * 33]); o.z = pk2h(s[4 * 33], s[5 * 33]); o.w = pk2h(s[6 * 33], s[7 * 33]);
        *(u32x4*)(WT + (size_t)(n0 + n) * K + k0 + 8 * c) = o; }
    asm volatile("s_waitcnt lgkmcnt(0)" ::: "memory");
}
struct CvtIt { const float* p; h16* q; int Nsrc, K, vlo, vhi; bool zero; };
__device__ __forceinline__ CvtIt cvt_decode(int mode, const float* s0, const float* s1, int Nsrc, int K, h16* WT, int nblk, int item, int lane) {
    const int kb = item / nblk, nb = item % nblk, k0 = 64 * kb, n0 = 32 * nb, nn = 4 * (lane & 7);
    const float* src = s0; int col = n0 + nn; bool zero = false;
    if (mode == 1) { src = ((n0 >> 7) & 1) ? s1 : s0; col = (n0 >> 8) * 128 + (n0 & 127) + nn; }
    if (mode == 2) {
        const int q = nn >> 3, sp = (nn >> 2) & 1;
        if (n0 >= NA && n0 < PFW) { zero = true; col = 0; }
        else if (n0 >= PFW && n0 < PFW + 4096) { const int rel = n0 - PFW; col = (sp ? NA + 2 * D : NA + D) + ((rel >> 8) << 7) + ((rel >> 5) & 3) * 32 + 8 * q + 4 * ((rel >> 7) & 1); }
        else if (n0 >= PFW + 4096 && n0 < PFW + 8192) { const int rel = n0 - PFW - 4096; col = (sp ? NA + 4 * D : NA) + ((rel >> 8) << 7) + ((rel >> 5) & 3) * 32 + 8 * q + 4 * ((rel >> 7) & 1); }
        else if (n0 >= PFW + 8192) col = NA + 3 * D + (n0 - PFW - 8192) + nn; }
    CvtIt r; r.p = src + (size_t)k0 * Nsrc + col; r.q = WT + (size_t)(n0 + (lane >> 3)) * K + k0 + 8 * (lane & 7); r.Nsrc = Nsrc; r.K = K; r.vlo = 0; r.vhi = 64; r.zero = zero; return r;
}
__device__ __forceinline__ CvtIt cvt_decode_lora(const float* wl, const float* al, const float* gl, h16* WT, int item, int lane) {
    const int typ = item < 128 ? 0 : item < 256 ? 1 : 2, rel = item - (typ == 0 ? 0 : typ == 1 ? 128 : 256), kbi = rel >> 6, nb = rel & 63, n0 = 32 * nb;
    const float* src = typ == 0 ? wl : typ == 1 ? al : gl;
    const int kd0 = typ == 0 ? 64 * kbi : typ == 1 ? 64 * (1 + kbi) : 64 * (3 + kbi);
    const int ks0 = typ == 0 ? 64 * kbi : typ == 1 ? 64 * kbi - 32 : 64 * kbi, kn = typ == 2 ? 256 : 96;
    CvtIt r; r.p = src + (long)ks0 * D + n0 + 4 * (lane & 7); r.q = WT + (size_t)(typ * 2048 + n0 + (lane >> 3)) * LK + kd0 + 8 * (lane & 7); r.Nsrc = D; r.K = LK;
    r.vlo = ks0 < 0 ? -ks0 : 0; r.vhi = kn - ks0 < 64 ? kn - ks0 : 64; r.zero = false; return r;
}
__device__ __forceinline__ void cvt_load(const CvtIt& t, f32x4 (&v)[8], int lane) {
    const int r = lane >> 3;
#pragma unroll
    for (int i = 0; i < 8; ++i) { const int row = 8 * i + r, rc = row < t.vlo ? t.vlo : (row >= t.vhi ? t.vhi - 1 : row);
        const f32x4 x = __builtin_nontemporal_load((const f32x4*)(t.p + (long)rc * t.Nsrc)); v[i] = (row == rc) ? x : (f32x4){0.f, 0.f, 0.f, 0.f}; }
}
__device__ __forceinline__ void cvt_finish(const CvtIt& t, const f32x4 (&v)[8], LAS float* scr, int lane) {
    const int r = lane >> 3, c4 = lane & 7;
#pragma unroll
    for (int i = 0; i < 8; ++i) *(LAS f32x4*)(scr + (8 * i + r) * 32 + 4 * (c4 ^ i)) = t.zero ? (f32x4){0.f, 0.f, 0.f, 0.f} : v[i];
    asm volatile("s_waitcnt lgkmcnt(0)" ::: "memory");
    const int c = lane & 7;
#pragma unroll
    for (int j = 0; j < 4; ++j) { const int n = (lane >> 3) + 8 * j; const LAS float* s = scr + (8 * c) * 32 + (n ^ (4 * c));
        u32x4 o; o.x = pk2h(s[0 * 32], s[1 * 32]); o.y = pk2h(s[2 * 32], s[3 * 32]); o.z = pk2h(s[4 * 32], s[5 * 32]); o.w = pk2h(s[6 * 32], s[7 * 32]);
        *(u32x4*)(t.q + (size_t)(8 * j) * t.K) = o; }
    asm volatile("s_waitcnt lgkmcnt(0)" ::: "memory");
}
#define CVT_RUN(total_, PICK) do { f32x4 va[8], vb[8]; CvtIt A_, B_; int it_ = gw; if (it_ < (total_)) { PICK(it_, A_); cvt_load(A_, va, lane); \
        for (;;) { const int itb_ = it_ + NGW; const bool hb_ = itb_ < (total_); if (hb_) { PICK(itb_, B_); cvt_load(B_, vb, lane); } cvt_finish(A_, va, scr, lane); if (!hb_) break; \
            it_ = itb_ + NGW; const bool ha_ = it_ < (total_); if (ha_) { PICK(it_, A_); cvt_load(A_, va, lane); } cvt_finish(B_, vb, scr, lane); if (!ha_) break; } } } while (0)
__device__ __forceinline__ void cvt_lora_item(const float* wl, const float* al, const float* gl, h16* WT, int item, int lane) {
    const int nb = item >> 6, ko = item & 63, n = nb * 64 + lane, typ = nb >> 5, col = n & 2047;
    const float* src = typ == 0 ? wl : typ == 1 ? al : gl; const int klo = typ == 0 ? 0 : typ == 1 ? 96 : 192, kn = typ == 2 ? 256 : 96;
    float v[8];
#pragma unroll
    for (int e = 0; e < 8; ++e) { const int kr = ko * 8 + e - klo, kc = kr < 0 ? 0 : (kr >= kn ? kn - 1 : kr); v[e] = src[(size_t)kc * D + col]; }
#pragma unroll
    for (int e = 0; e < 8; ++e) { const int kr = ko * 8 + e - klo; if (kr < 0 || kr >= kn) v[e] = 0.f; }
    *(u32x4*)(WT + (size_t)n * LK + ko * 8) = (u32x4){pk2h(v[0], v[1]), pk2h(v[2], v[3]), pk2h(v[4], v[5]), pk2h(v[6], v[7])};
}

__device__ __forceinline__ f32x4 h8lo(const h16x8 h) { return (f32x4){(float)h[0], (float)h[1], (float)h[2], (float)h[3]}; }
__device__ __forceinline__ f32x4 h8hi(const h16x8 h) { return (f32x4){(float)h[4], (float)h[5], (float)h[6], (float)h[7]}; }
__device__ __forceinline__ u32x4 pk8h(const f32x4 a, const f32x4 b) { return (u32x4){pk2h(a.x, a.y), pk2h(a.z, a.w), pk2h(b.x, b.y), pk2h(b.z, b.w)}; }
__device__ __forceinline__ float sq4(const f32x4 v) { return (v.x * v.x + v.y * v.y) + (v.z * v.z + v.w * v.w); }
__device__ __forceinline__ void rms_finish8(const f32x4 (&v)[8], float s, const float* g, h16* orow, float* f32row, float* xout, int lane) {
    const float rs = rsqrtf(wave_sum(s) * (1.f / D) + 1e-6f);
#pragma unroll
    for (int jj = 0; jj < 4; ++jj) { const int e = 8 * lane + 512 * jj; const f32x4 g0 = *(const f32x4*)(g + e), g1 = *(const f32x4*)(g + e + 4); const f32x4 o0 = v[2 * jj] * rs * g0, o1 = v[2 * jj + 1] * rs * g1;
        if (xout) { *(f32x4*)(xout + e) = v[2 * jj]; *(f32x4*)(xout + e + 4) = v[2 * jj + 1]; }
        if (orow) *(u32x4*)(orow + e) = pk8h(o0, o1);
        if (f32row) { *(f32x4*)(f32row + e) = o0; *(f32x4*)(f32row + e + 4) = o1; } }
}
__device__ __forceinline__ void rms_row_f16(const float* xrow, const float* g, h16* orow, float* f32row, int lane, const h16* part = nullptr, float pscale = 0.f, float* xout = nullptr) {
    f32x4 v[8]; float s = 0.f;
#pragma unroll
    for (int jj = 0; jj < 4; ++jj) { const int e = 8 * lane + 512 * jj; v[2 * jj] = *(const f32x4*)(xrow + e); v[2 * jj + 1] = *(const f32x4*)(xrow + e + 4);
        if (part) { const h16* pp = part + e; const size_t st = (size_t)MS * D;
            const h16x8 p0 = *(const h16x8*)pp, p1 = *(const h16x8*)(pp + st), p2 = *(const h16x8*)(pp + 2 * st), p3 = *(const h16x8*)(pp + 3 * st);
            v[2 * jj] += pscale * ((h8lo(p0) + h8lo(p1)) + (h8lo(p2) + h8lo(p3))); v[2 * jj + 1] += pscale * ((h8hi(p0) + h8hi(p1)) + (h8hi(p2) + h8hi(p3))); }
        s += sq4(v[2 * jj]) + sq4(v[2 * jj + 1]); }
    rms_finish8(v, s, g, orow, f32row, xout, lane);
}

__device__ __forceinline__ void rms_row_h(const h16* xrow, const float* g, h16* orow, float* f32row, int lane) {
    f32x4 v[8]; float s = 0.f;
#pragma unroll
    for (int jj = 0; jj < 4; ++jj) { const h16x8 hv = *(const h16x8*)(xrow + 8 * lane + 512 * jj); v[2 * jj] = h8lo(hv); v[2 * jj + 1] = h8hi(hv); s += sq4(v[2 * jj]) + sq4(v[2 * jj + 1]); }
    rms_finish8(v, s, g, orow, f32row, nullptr, lane);
}

constexpr int PREP_CA = 128;
constexpr int MERGE_CA = 96;
__device__ __forceinline__ int prep_map(int j, bool segB) {
    const int h = j & 31, q = j >> 5; int c;
    if (!segB) c = (q / PREP_CA) * 256 + q % PREP_CA;
    else { constexpr int nb = 256 - PREP_CA; c = q < 2 * nb ? (q / nb) * 256 + PREP_CA + q % nb : 512 + (q - 2 * nb); }
    return c * 32 + h;
}

__device__ __forceinline__ void rms_load_s(const float* xrow, const h16* part, f32x4 (&sx)[8], h16x8 (&sp)[16], int lane) {
    const size_t st = (size_t)MS * D;
#pragma unroll
    for (int jj = 0; jj < 4; ++jj) { const int e = 8 * lane + 512 * jj; sx[2 * jj] = *(const f32x4*)(xrow + e); sx[2 * jj + 1] = *(const f32x4*)(xrow + e + 4);
#pragma unroll
        for (int q = 0; q < 4; ++q) sp[4 * jj + q] = *(const h16x8*)(part + e + q * st); }
}
__device__ __forceinline__ void rms_fin_s(const f32x4 (&sx)[8], const h16x8 (&sp)[16], float pscale, const float* g, h16* orow, float* f32row, float* xout, int lane) {
    f32x4 v[8]; float s = 0.f;
#pragma unroll
    for (int jj = 0; jj < 4; ++jj) { const h16x8 p0 = sp[4 * jj], p1 = sp[4 * jj + 1], p2 = sp[4 * jj + 2], p3 = sp[4 * jj + 3];
        v[2 * jj] = sx[2 * jj] + pscale * ((h8lo(p0) + h8lo(p1)) + (h8lo(p2) + h8lo(p3))); v[2 * jj + 1] = sx[2 * jj + 1] + pscale * ((h8hi(p0) + h8hi(p1)) + (h8hi(p2) + h8hi(p3)));
        s += sq4(v[2 * jj]) + sq4(v[2 * jj + 1]); }
    rms_finish8(v, s, g, orow, f32row, xout, lane);
}

__device__ __forceinline__ void rms_load_h(const h16* xrow, h16x8 (&r)[4], int lane) {
#pragma unroll
    for (int jj = 0; jj < 4; ++jj) r[jj] = *(const h16x8*)(xrow + 8 * lane + 512 * jj);
}
__device__ __forceinline__ void rms_fin_h(const h16x8 (&r)[4], const float* g, h16* orow, float* f32row, int lane) {
    f32x4 v[8]; float s = 0.f;
#pragma unroll
    for (int jj = 0; jj < 4; ++jj) { v[2 * jj] = h8lo(r[jj]); v[2 * jj + 1] = h8hi(r[jj]); s += sq4(v[2 * jj]) + sq4(v[2 * jj + 1]); }
    rms_finish8(v, s, g, orow, f32row, nullptr, lane);
}
#define RMS_PIPE_H(m_end, XROW, GW, OROW, FROW) do { h16x8 ra_[4], rb_[4]; int m_ = gw; \
        if (m_ < (m_end)) { rms_load_h(XROW(m_), ra_, lane); for (;;) { const int mb_ = m_ + NGW; const bool hb_ = mb_ < (m_end); if (hb_) rms_load_h(XROW(mb_), rb_, lane); rms_fin_h(ra_, GW, OROW(m_), FROW(m_), lane); if (!hb_) break; \
            m_ = mb_ + NGW; const bool ha_ = m_ < (m_end); if (ha_) rms_load_h(XROW(m_), ra_, lane); rms_fin_h(rb_, GW, OROW(mb_), FROW(mb_), lane); if (!ha_) break; } } } while (0)

__device__ __forceinline__ void rms_load_f(const float* xrow, f32x4 (&r)[8], int lane) {
#pragma unroll
    for (int jj = 0; jj < 4; ++jj) { r[2 * jj] = *(const f32x4*)(xrow + 8 * lane + 512 * jj); r[2 * jj + 1] = *(const f32x4*)(xrow + 8 * lane + 512 * jj + 4); }
}
__device__ __forceinline__ void rms_fin_f(const f32x4 (&v)[8], const float* g, h16* orow, int lane) {
    float s = 0.f;
#pragma unroll
    for (int j = 0; j < 8; ++j) s += sq4(v[j]);
    rms_finish8(v, s, g, orow, nullptr, nullptr, lane);
}
#define RMS_PIPE_F(m_end, XROW, GW, OROW) do { f32x4 ra_[8], rb_[8]; int m_ = gw; \
        if (m_ < (m_end)) { rms_load_f(XROW(m_), ra_, lane); for (;;) { const int mb_ = m_ + NGW; const bool hb_ = mb_ < (m_end); if (hb_) rms_load_f(XROW(mb_), rb_, lane); rms_fin_f(ra_, GW, OROW(m_), lane); if (!hb_) break; \
            m_ = mb_ + NGW; const bool ha_ = m_ < (m_end); if (ha_) rms_load_f(XROW(m_), ra_, lane); rms_fin_f(rb_, GW, OROW(mb_), lane); if (!ha_) break; } } } while (0)

enum { PH_CVT1 = 0, PH_FFN1_GU, PH_FFN1_D, PH_RMS_MIX, PH_WIN, PH_SHIFT, PH_LORA, PH_PREP, PH_SCAN, PH_MERGE, PH_WOUT, PH_RMS2, PH_FFN2_GU, PH_FFN2_D, PH_FINAL, PH_N };

__global__ void __launch_bounds__(NTHR, 2) fwd_kernel(Args a) {
    extern __shared__ __attribute__((aligned(16))) unsigned char lds_raw[];
    LAS unsigned char* lds = (LAS unsigned char*)lds_raw;
    const int tid = threadIdx.x, lane = tid & 63, wave = __builtin_amdgcn_readfirstlane(tid >> 6);
    const int G = gridDim.x, bx = blockIdx.x;
    const int gw = bx * NWAVES + wave, NGW = G * NWAVES;
    unsigned char* ws = a.ws; unsigned char* ob = (unsigned char*)a.out;
    h16* W1GU = (h16*)(ws + WS_W1GU); h16* W1D = (h16*)(ws + WS_W1D); h16* WIN = (h16*)(ws + WS_WIN); h16* WOUT = (h16*)(ws + WS_WOUT);
    h16* A16 = (h16*)(ws + WS_A16); h16* P16 = (h16*)(ws + WS_P16); h16* EAG = (h16*)(ws + WS_EAG); h16* HM = (h16*)(ws + WS_HM);
    h16* W2GU = (h16*)(ws + WS_W2GU); h16* W2D = (h16*)(ws + WS_W2D);
    h16* WL = (h16*)(ob + OB_WL); h16* PF = (h16*)(ws + WS_PF);
    float* Y = a.out + O_Y; float* SLAB = (float*)(ws + WS_SLAB);
    h16* XH = (h16*)(a.out + O_Y);
    const int lo = a.ph_lo, hi = a.ph_hi;
#define IN(k) (lo <= (k) && (k) < hi)
    cg::grid_group grid = cg::this_grid();
    volatile LAS unsigned* xst = (volatile LAS unsigned*)(lds + LDS_BYTES - 16);
    if (tid < 2) xst[tid] = 0u;
    __syncthreads();
    const XcdBarrier xbar = xcd_barrier_post((unsigned*)(ws + WS_CTL), xst);
#ifndef PROBE_MASK
#define PROBE_MASK 0u
#endif
#ifndef PROBE_MUL
#define PROBE_MUL 1u
#endif
    unsigned long long pr_t[PH_N + 1]; (void)pr_t;
    if (PROBE_MASK) pr_t[0] = __builtin_amdgcn_s_memrealtime();
#define SEAM(k) do { if (IN(k) && IN((k) + 1)) { if ((k) == PH_CVT1 && lo > 0) grid.sync(); else xcd_barrier(xbar); } if (PROBE_MASK) pr_t[(k) + 1] = __builtin_amdgcn_s_memrealtime(); } while (0)

    constexpr int LI0 = (D / 64) * (D / 32), LI1 = (D / 64) * (2 * FF / 32), LI2 = (FF / 64) * (D / 32), LATE_N = LI0 + LI1 + LI2;
#define PICKL(it, out) do { int r_ = (it); if (r_ < LI0) out = cvt_decode(0, a.in[23], a.in[23], D, D, WOUT, D / 32, r_, lane); else if ((r_ -= LI0) < LI1) out = cvt_decode(1, a.in[25], a.in[26], FF, D, W2GU, 2 * FF / 32, r_, lane); \
        else out = cvt_decode(0, a.in[27], a.in[27], D, FF, W2D, D / 32, r_ - LI1, lane); } while (0)
    const int win_units = (MT / 256) * (NW / 256) + PFW / 256, win_left = win_units % G;
    const int gu_left = ((MT / 256) * (2 * FF / 256)) % G, gu_tail = gu_left > 0 ? ((G - gu_left) * NWAVES * 10 < (FF / 64) * (D / 32) ? (G - gu_left) * NWAVES * 10 : (FF / 64) * (D / 32)) : 0;
    const int late_tail = win_left > 0 ? ((G - win_left) * NWAVES * 6 < LATE_N ? (G - win_left) * NWAVES * 6 : LATE_N) : 0;
    if (IN(PH_CVT1)) {
        LAS float* scr = (LAS float*)(lds + wave * 16384);
        constexpr int I1 = (D / 64) * (2 * FF / 32), I2 = (FF / 64) * (D / 32), I3 = (D / 64) * (NW / 32);
#define PICK1(it, out) do { int r_ = (it); if (r_ < I1) out = cvt_decode(1, a.in[6], a.in[7], FF, D, W1GU, 2 * FF / 32, r_, lane); else if ((r_ -= I1) < I2 - gu_tail) out = cvt_decode(0, a.in[8], a.in[8], D, FF, W1D, D / 32, r_ + gu_tail, lane); \
            else if ((r_ -= I2 - gu_tail) < I3) out = cvt_decode(2, a.in[10], a.in[10], NIN, D, WIN, NW / 32, r_, lane); else out = cvt_decode_lora(a.in[13], a.in[15], a.in[16], WL, r_ - I3, lane); } while (0)
        CVT_RUN(I1 + I2 - gu_tail + I3 + (win_left > 0 ? 0 : 512), PICK1);
#undef PICK1
        for (int r = gw; r < 256; r += NGW) { h16* orow = A16 + (size_t)(MT + r) * D;
#pragma unroll
            for (int j = 0; j < 8; ++j) { u32x2 w = (u32x2){0u, 0u};
                if (r < 32) { const f32x4 v = *((const f32x4*)(a.in[2] + (size_t)r * D) + lane + 64 * j); w.x = pk2h(v.x, v.y); w.y = pk2h(v.z, v.w); }
                *((u32x2*)orow + lane + 64 * j) = w; } }
#define XF_(m) ((m) < MP ? a.in[0] + (size_t)(m) * D : a.in[1] + (size_t)((m) - MP) * D)
#define OF_(m) (A16 + (size_t)(m) * D)
        RMS_PIPE_F(MT, XF_, a.in[5], OF_);
#undef XF_
#undef OF_
    }
    SEAM(PH_CVT1);
    if (IN(PH_FFN1_GU)) { pg8::Gemm g{A16, W1GU, MT, 2 * FF, D}; pg8::Order S; S.init(MT, 2 * FF, D, G, bx, 0, -1); pg8::EpiSwiGLU E{HM, FF}; pg8::gemm_phase(lds, g, S, E);
        if (gu_left > 0 && bx >= gu_left) {
            LAS float* scr = (LAS float*)(lds + wave * 16384);
            const int gw = (bx - gu_left) * NWAVES + wave, NGW = (G - gu_left) * NWAVES;
#define PICKD(it, out) out = cvt_decode(0, a.in[8], a.in[8], D, FF, W1D, D / 32, (it), lane)
            CVT_RUN(gu_tail, PICKD);
#undef PICKD
        } }
    SEAM(PH_FFN1_GU);
    if (IN(PH_FFN1_D)) { pg8::Gemm g{HM, W1D, MT, D, FF}; pg8::Order S; S.init(MT, D, FF, G, bx, 0, MP / 256); pg8::EpiRes<false, true> E{a.in[0], XH, SLAB, 0.5f, 0}; pg8::gemm_phase(lds, g, S, E); }
    SEAM(PH_FFN1_D);
    if (IN(PH_RMS_MIX)) {
#define XR_(m) (XH + (size_t)(m) * D)
#define OR_(m) (A16 + (size_t)(m) * D)
#define FR_(m) ((((m) & 4095) == 4095) ? a.out + O_SHP + (size_t)((m) >> 12) * D : (float*)nullptr)
        f32x4 sx[8]; h16x8 sp[16]; const int ms = MP + gw; const bool hs_ = ms < MT;
        if (hs_) rms_load_s(a.in[1] + (size_t)(ms - MP) * D, (const h16*)SLAB + (size_t)(ms - MP) * D, sx, sp, lane);
        RMS_PIPE_H(MP, XR_, a.in[9], OR_, FR_);
#undef FR_
        if (hs_) rms_fin_s(sx, sp, 0.5f, a.in[9], A16 + (size_t)ms * D, (((ms - MP) & 63) == 63) ? a.out + O_SHS + (size_t)((ms - MP) >> 6) * D : nullptr, Y + (size_t)ms * D, lane);
        for (int m = ms + NGW; m < MT; m += NGW) { float* so = (((m - MP) & 63) == 63) ? a.out + O_SHS + (size_t)((m - MP) >> 6) * D : nullptr;
            rms_row_f16(a.in[1] + (size_t)(m - MP) * D, a.in[9], A16 + (size_t)m * D, so, lane, (const h16*)SLAB + (size_t)(m - MP) * D, 0.5f, Y + (size_t)m * D); }
    }
    SEAM(PH_RMS_MIX);
    if (IN(PH_WIN)) { pg8::Gemm g{A16, WIN, MT, NW, D}; pg8::Order S; S.init(MT, NW, D, G, bx, PFW / 256, -1); pg8::EpiP16 E{P16, PF}; pg8::gemm_phase(lds, g, S, E);
        if (win_left > 0 && bx >= win_left) {
            LAS float* scr = (LAS float*)(lds + wave * 16384);
            const int gw = (bx - win_left) * NWAVES + wave, NGW = (G - win_left) * NWAVES;
#define PICKT(it, out) do { if ((it) < 512) out = cvt_decode_lora(a.in[13], a.in[15], a.in[16], WL, (it), lane); else PICKL((it) - 512, out); } while (0)
            CVT_RUN(512 + late_tail, PICKT);
#undef PICKT
        } }
    SEAM(PH_WIN);
    if (IN(PH_SHIFT)) {
        const int t0 = bx * NTHR + tid, stp = G * NTHR, NS = (MT / 16) * 768; u32x4 v4[4];
#pragma unroll
        for (int k = 0; k < 4; ++k) { const int item = t0 + k * stp; if (item < NS) { const int c = item / 768, o = item % 768; v4[k] = *(const u32x4*)(P16 + (size_t)(16 * c + 15) * PP + o * 8); } }
#pragma unroll
        for (int k = 0; k < 4; ++k) { const int item = t0 + k * stp; if (item < NS) { const int c = item / 768, o = item % 768; *(u32x4*)((h16*)(ob + OB_SIDE) + (size_t)c * 6144 + o * 8) = v4[k]; } }
        for (int item = t0 + 4 * stp; item < NS; item += stp) { const int c = item / 768, o = item % 768;
            *(u32x4*)((h16*)(ob + OB_SIDE) + (size_t)c * 6144 + o * 8) = *(const u32x4*)(P16 + (size_t)(16 * c + 15) * PP + o * 8); }
    }
    if (IN(PH_SHIFT)) {
        h16* AIN = A16; const float* mu = a.in[11];
        const int t0 = bx * NTHR + tid, o = t0 & 63, rstep = (G * NTHR) >> 6;
        if (o < 56) {
            const int c0 = 6144 + o * 8;
            const f32x4 m0 = *(const f32x4*)(mu + c0), m1 = *(const f32x4*)(mu + c0 + 4);
            const float mu8[8] = {m0.x, m0.y, m0.z, m0.w, m1.x, m1.y, m1.z, m1.w};
#define SH_LD(row_, CV, PV) do { const int r_ = (row_); const bool st_ = r_ < MP ? ((r_ & 4095) == 0) : (((r_ - MP) & 63) == 0); \
                const h16* pp_ = st_ ? (r_ < MP ? PF + (size_t)32 * PFW : PF + (size_t)((r_ - MP) >> 6) * PFW) + c0 : P16 + (size_t)(r_ - 1) * PP + c0; \
                CV = *(const h16x8*)(P16 + (size_t)r_ * PP + c0); PV = *(const h16x8*)pp_; } while (0)
#define SH_FIN(row_, CV, PV) do { float s_[8]; \
                _Pragma("unroll") for (int j = 0; j < 8; ++j) { const float cu = (float)CV[j]; s_[j] = cu + mu8[j] * ((float)PV[j] - cu); } \
                if (o < 12) { _Pragma("unroll") for (int j = 0; j < 8; ++j) s_[j] = tanhf_(s_[j]); } \
                else if (o >= 24) { _Pragma("unroll") for (int j = 0; j < 8; ++j) s_[j] = sigmoidf_(s_[j]); } \
                *(u32x4*)(AIN + (size_t)(row_) * LK + o * 8) = (u32x4){pk2h(s_[0], s_[1]), pk2h(s_[2], s_[3]), pk2h(s_[4], s_[5]), pk2h(s_[6], s_[7])}; } while (0)
            h16x8 cvA, pvA, cvB, pvB; int row = t0 >> 6;
            if (row < MT) { SH_LD(row, cvA, pvA);
                for (;;) { const int rb = row + rstep; const bool hb = rb < MT; if (hb) SH_LD(rb, cvB, pvB); SH_FIN(row, cvA, pvA); if (!hb) break;
                    row = rb + rstep; const bool ha = row < MT; if (ha) SH_LD(row, cvA, pvA); SH_FIN(rb, cvB, pvB); if (!ha) break; } }
#undef SH_LD
#undef SH_FIN
        }
    }
    SEAM(PH_SHIFT);
    if (IN(PH_LORA)) { pg8::Gemm g{A16, WL, MT, 6144, LK}; pg8::Order S; S.init(MT, 6144, LK, G, bx, 0, -1); pg8::EpiEAG E{EAG, a.in[12], a.in[14]}; pg8::gemm_phase<pg8::EpiEAG, true>(lds, g, S, E); }
    SEAM(PH_LORA);
    auto prep_run = [&](const int gw0, const int ngw, const int nitems, const bool segB) {
        LAS unsigned char* sc = lds + wave * 5120;
        float* RK = (float*)(ws + WS_RK); float* LM = (float*)(ws + WS_LM);
        const int cp = lane & 31, hs = lane >> 5;
#define H2LO(x) ((float)__builtin_bit_cast(h16, (unsigned short)((x) & 0xffffu)))
#define H2HI(x) ((float)__builtin_bit_cast(h16, (unsigned short)((x) >> 16)))
#define HSUM(x_, out_) do { float y_ = row_allreduce16(x_); y_ += __builtin_bit_cast(float, __builtin_amdgcn_update_dpp(0, __builtin_bit_cast(int, y_), 0x142, 0xA, 0xF, false)); \
            const float s31_ = rl_f(y_, 31), s63_ = rl_f(y_, 63); out_ = hs ? s63_ : s31_; } while (0)
#define PREP_LOAD(item_, RR, KK, VV, EE, AA) do { const int c_ = (item_) >> 5, h_ = (item_) & 31, r0_ = 16 * c_, j2_ = h_ * 64 + 2 * cp; \
            const bool pr_ = r0_ < MP; const bool st_ = pr_ ? ((r0_ & 4095) == 0) : (((r0_ - MP) & 63) == 0); \
            const h16* pq_ = hs ? P16 + (size_t)(r0_ + 7) * PP + j2_ : (st_ ? PF + (size_t)(pr_ ? 32 : ((r0_ - MP) >> 6)) * PFW + j2_ : (const h16*)(ob + OB_SIDE) + (size_t)(c_ - 1) * 6144 + j2_); \
            const h16* pp_ = P16 + (size_t)(r0_ + 8 * hs) * PP + j2_; const h16* pe_ = EAG + (size_t)(r0_ + 8 * hs) * 6144 + j2_; \
            RR[0] = *(const unsigned*)pq_; KK[0] = *(const unsigned*)(pq_ + D); VV[0] = *(const unsigned*)(pq_ + 2 * D); \
            _Pragma("unroll") for (int s_ = 0; s_ < 8; ++s_) { RR[s_ + 1] = *(const unsigned*)(pp_ + (size_t)s_ * PP); KK[s_ + 1] = *(const unsigned*)(pp_ + (size_t)s_ * PP + D); VV[s_ + 1] = *(const unsigned*)(pp_ + (size_t)s_ * PP + 2 * D); \
                EE[s_] = *(const unsigned*)(pe_ + (size_t)s_ * 6144); AA[s_] = *(const unsigned*)(pe_ + (size_t)s_ * 6144 + D); } } while (0)
        unsigned rr[9], kk[9], vv[9], ee[8], aa[8], rrn[9], kkn[9], vvn[9], een[8], aan[8];
        if (gw0 < nitems) { const int i0_ = prep_map(gw0, segB); PREP_LOAD(i0_, rr, kk, vv, ee, aa); }
        f32x2 c_kk, c_ka, c_rk, c_mr, c_mk, c_mv;
#define PREP_CONST(h_) do { const int q_ = (h_) * 64 + 2 * cp; c_kk = *(const f32x2*)(a.in[17] + q_); c_ka = *(const f32x2*)(a.in[18] + q_); c_rk = *(const f32x2*)(a.in[19] + q_); c_mr = *(const f32x2*)(a.in[11] + q_); c_mk = *(const f32x2*)(a.in[11] + D + q_); c_mv = *(const f32x2*)(a.in[11] + 2 * D + q_); } while (0)
        PREP_CONST(gw0 & 31);
        for (int j = gw0; j < nitems; j += ngw) { const int item = prep_map(j, segB);
            const int c = item >> 5, h = item & 31, row0 = 16 * c, hj2 = h * 64 + 2 * cp;
            if ((ngw & 31) != 0) PREP_CONST(h);
            if (j + ngw < nitems) { const int in_ = prep_map(j + ngw, segB); PREP_LOAD(in_, rrn, kkn, vvn, een, aan); }
            f32x2 Ll[8]; { f32x2 acc = (f32x2){0.f, 0.f};
#pragma unroll
                for (int s_ = 0; s_ < 8; ++s_) { acc -= (f32x2){H2LO(ee[s_]), H2HI(ee[s_])}; Ll[s_] = acc; } }
            const f32x2 oth = (f32x2){__shfl_xor(Ll[7].x, 32), __shfl_xor(Ll[7].y, 32)};
            const f32x2 M_ = hs ? oth : Ll[7]; const f32x2 L15 = M_ + (hs ? Ll[7] : oth);
            *(f32x2*)(LM + (size_t)item * 128 + 64 * hs + 2 * cp) = hs ? L15 : M_;
            const f32x2 off = hs ? (f32x2){0.f, 0.f} : M_;
            unsigned vpk[8]; float rkv[8];
            h16* eo = EAG + (size_t)(row0 + 8 * hs) * 6144 + hj2; h16* po = P16 + (size_t)(row0 + 8 * hs) * PP + hj2;
            f32x2 E3p = (f32x2){__expf(-off.x), __expf(-off.y)};
#pragma unroll
            for (int s_ = 0; s_ < 8; ++s_) { const int t = 8 * hs + s_;
                f32x2 r = (f32x2){H2LO(rr[s_ + 1]), H2HI(rr[s_ + 1])}, k = (f32x2){H2LO(kk[s_ + 1]), H2HI(kk[s_ + 1])}, v = (f32x2){H2LO(vv[s_ + 1]), H2HI(vv[s_ + 1])};
                r += c_mr * ((f32x2){H2LO(rr[s_]), H2HI(rr[s_])} - r); k += c_mk * ((f32x2){H2LO(kk[s_]), H2HI(kk[s_])} - k); v += c_mv * ((f32x2){H2LO(vv[s_]), H2HI(vv[s_])} - v);
                const f32x2 av = (f32x2){H2LO(aa[s_]), H2HI(aa[s_])};
                const f32x2 kkr = k * c_kk; float ss; HSUM(kkr.x * kkr.x + kkr.y * kkr.y, ss);
                const float rn = rsqrtf(fmaxf(ss, 1e-24f)); const f32x2 kap = kkr * rn;
                const f32x2 kmod = k * (1.f + (av - 1.f) * c_ka);
                const f32x2 Dm = Ll[s_] - off; const f32x2 E1 = E3p, E2 = (f32x2){__expf(-Dm.x), __expf(-Dm.y)}, E3 = (f32x2){__expf(Dm.x), __expf(Dm.y)}; E3p = E3;
                const f32x2 fat = kap * E1, frt = r * E3, fbb = kap * av * E2, fkb = kmod * E2;
                const unsigned hat = pk2h(fat.x, fat.y), hrt = pk2h(frt.x, frt.y), hbb = pk2h(fbb.x, fbb.y), hkb = pk2h(fkb.x, fkb.y);
                const f32x2 rkm = r * kmod * c_rk; float rk; HSUM(rkm.x + rkm.y, rk); rkv[s_] = rk;
                *(unsigned*)(eo + (size_t)s_ * 6144) = hat; *(unsigned*)(eo + (size_t)s_ * 6144 + D) = hbb; *(unsigned*)(po + (size_t)s_ * PP) = hrt; *(unsigned*)(po + (size_t)s_ * PP + D) = hkb;
                ((LAS unsigned*)sc)[t * 32 + cp] = hat; ((LAS unsigned*)(sc + 2048))[t * 32 + cp] = hbb;
                vpk[s_] = pk2h(v.x, v.y);
            }
            if (cp == 0) {
#pragma unroll
                for (int s_ = 0; s_ < 8; ++s_) RK[(size_t)(row0 + 8 * hs + s_) * 32 + h] = rkv[s_]; }
            { u32x4 lo, hi;
              lo.x = (vpk[0] & 0xffffu) | (vpk[1] << 16); lo.y = (vpk[2] & 0xffffu) | (vpk[3] << 16); lo.z = (vpk[4] & 0xffffu) | (vpk[5] << 16); lo.w = (vpk[6] & 0xffffu) | (vpk[7] << 16);
              hi.x = (vpk[0] >> 16) | (vpk[1] & 0xffff0000u); hi.y = (vpk[2] >> 16) | (vpk[3] & 0xffff0000u); hi.z = (vpk[4] >> 16) | (vpk[5] & 0xffff0000u); hi.w = (vpk[6] >> 16) | (vpk[7] & 0xffff0000u);
              const int i0 = 2 * cp;
              *(u32x4*)(P16 + (size_t)(row0 + (i0 >> 2)) * PP + 2 * D + h * 64 + (i0 & 3) * 16 + 8 * hs) = lo;
              *(u32x4*)(P16 + (size_t)(row0 + ((i0 + 1) >> 2)) * PP + 2 * D + h * 64 + ((i0 + 1) & 3) * 16 + 8 * hs) = hi; }
            asm volatile("s_waitcnt lgkmcnt(0)" ::: "memory");
            const int fr = lane & 15, fq = lane >> 4;
            f32x4 acc = (f32x4){0.f, 0.f, 0.f, 0.f};
#pragma unroll
            for (int kt = 0; kt < 4; ++kt) acc = __builtin_amdgcn_mfma_f32_16x16x16f16(*(const LAS h16x4*)(sc + (fr * 64 + 16 * kt + 4 * fq) * 2), *(const LAS h16x4*)(sc + 2048 + (fr * 64 + 16 * kt + 4 * fq) * 2), acc, 0, 0, 0);
            LAS float* Pm = (LAS float*)(sc + 4096);
#pragma unroll
            for (int g_ = 0; g_ < 4; ++g_) Pm[(4 * fq + g_) * 16 + fr] = (fr < 4 * fq + g_) ? acc[g_] : 0.f;
            asm volatile("s_waitcnt lgkmcnt(0)" ::: "memory");
            float Tc[16];
#pragma unroll
            for (int t = 0; t < 16; ++t) { float x = (t == fr) ? 1.f : 0.f;
#pragma unroll
                for (int j4 = 0; j4 < (t + 3) / 4; ++j4) { const f32x4 p4 = *(const LAS f32x4*)(Pm + t * 16 + 4 * j4);
                    if (4 * j4 + 0 < t) x -= p4.x * Tc[4 * j4 + 0]; if (4 * j4 + 1 < t) x -= p4.y * Tc[4 * j4 + 1]; if (4 * j4 + 2 < t) x -= p4.z * Tc[4 * j4 + 2]; if (4 * j4 + 3 < t) x -= p4.w * Tc[4 * j4 + 3]; }
                Tc[t] = x; }
            if (lane < 16) {
#pragma unroll
                for (int t = 0; t < 16; ++t) ((LAS h16*)sc)[t * 16 + fr] = (h16)Tc[t]; }
            asm volatile("" ::: "memory");
            if (lane < 32) { const int t = lane >> 1, hf_ = lane & 1;
                *(u32x4*)(P16 + (size_t)(row0 + t) * PP + 6144 + h * 16 + 8 * hf_) = *(const LAS u32x4*)(sc + t * 32 + hf_ * 16); }
            asm volatile("s_waitcnt lgkmcnt(0)" ::: "memory");
#pragma unroll
            for (int q_ = 0; q_ < 9; ++q_) { rr[q_] = rrn[q_]; kk[q_] = kkn[q_]; vv[q_] = vvn[q_]; }
#pragma unroll
            for (int q_ = 0; q_ < 8; ++q_) { ee[q_] = een[q_]; aa[q_] = aan[q_]; }
        }
#undef PREP_LOAD
#undef PREP_CONST
#undef H2LO
#undef H2HI
#undef HSUM
        };
    if (IN(PH_PREP)) prep_run(gw, NGW, 2 * PREP_CA * 32, false);
    SEAM(PH_PREP);
    auto merge_run = [&](const int q0, const int qs, const int nq, const bool early) {
        const float* RK = (const float*)(ws + WS_RK);
        const int o8 = tid & 255, c0 = o8 * 8, hd = o8 >> 3, rg = tid >> 8;
        float w0[8], w1[8], w2[8], lg[8], lb[8];
#pragma unroll
        for (int j = 0; j < 8; ++j) { w0[j] = a.in[22][c0 + j]; w1[j] = a.in[22][D + c0 + j]; w2[j] = a.in[22][2 * D + c0 + j]; lg[j] = a.in[20][c0 + j]; lb[j] = a.in[21][c0 + j]; }
        for (int q = q0; q < nq; q += qs) { const int c = early ? (q / MERGE_CA) * 256 + q % MERGE_CA : (q < 2 * (256 - MERGE_CA) ? (q / (256 - MERGE_CA)) * 256 + MERGE_CA + q % (256 - MERGE_CA) : 512 + (q - 2 * (256 - MERGE_CA)));
            const int row0 = 16 * c + 8 * rg;
            const bool pr = row0 < MP; const int tt0 = pr ? (row0 & 4095) : ((row0 - MP) & 63), sq = pr ? (row0 >> 12) : ((row0 - MP) >> 6), T = pr ? 4096 : 64;
            h16x8 vt[8];
            { const h16* vb = P16 + (size_t)(16 * c + ((c0 & 63) >> 2)) * PP + 2 * D + (c0 & ~63) + 8 * rg;
#pragma unroll
              for (int j = 0; j < 8; ++j) vt[j] = *(const h16x8*)(vb + (size_t)(j >> 2) * PP + (j & 3) * 16); }
            float u1[8], u2[8];
            { const h16* prow = P16 + (size_t)row0 * PP;
              if (tt0 >= 2) { const h16x8 p1 = *(const h16x8*)(prow - PP + C_U + c0), p2 = *(const h16x8*)(prow - 2 * PP + C_U + c0);
#pragma unroll
                  for (int j = 0; j < 8; ++j) { u1[j] = (float)p1[j]; u2[j] = (float)p2[j]; }
              } else {
#pragma unroll
                  for (int j = 0; j < 8; ++j) { u2[j] = pr ? 0.f : a.in[3][(size_t)sq * 2 * D + c0 + j]; u1[j] = pr ? 0.f : a.in[3][(size_t)sq * 2 * D + D + c0 + j]; } } }
#pragma unroll
            for (int hf = 0; hf < 4; ++hf) {
                h16x8 ov[2], gv[2], uu[2], qq[2], sa[2]; float rk[2];
#pragma unroll
                for (int r = 0; r < 2; ++r) { const int row = row0 + 2 * hf + r; const h16* prow = P16 + (size_t)row * PP;
                    ov[r] = __builtin_nontemporal_load((const h16x8*)(A16 + (size_t)row * D + c0)); gv[r] = __builtin_nontemporal_load((const h16x8*)(EAG + (size_t)row * 6144 + 2 * D + c0));
                    uu[r] = *(const h16x8*)(prow + C_U + c0); qq[r] = __builtin_nontemporal_load((const h16x8*)(prow + C_Q + c0)); sa[r] = __builtin_nontemporal_load((const h16x8*)(prow + C_SA + c0));
                    rk[r] = RK[(size_t)row * 32 + hd]; }
#pragma unroll
                for (int r = 0; r < 2; ++r) { const int row = row0 + 2 * hf + r, tt = tt0 + 2 * hf + r;
                    float of[8], s1 = 0.f;
#pragma unroll
                    for (int j = 0; j < 8; ++j) { of[j] = (float)ov[r][j]; s1 += of[j]; }
                    const float mean = row_allreduce8(s1) * (1.f / 64.f); float s2 = 0.f;
#pragma unroll
                    for (int j = 0; j < 8; ++j) { of[j] -= mean; s2 += of[j] * of[j]; }
                    const float rstd = rsqrtf(row_allreduce8(s2) * (1.f / 64.f) + 64e-5f);
                    float mg[8], u0[8];
#pragma unroll
                    for (int j = 0; j < 8; ++j) {
                        const float vs = (float)vt[j][2 * hf + r];
                        const float ya = (of[j] * rstd * lg[j] + lb[j] + rk[r] * vs) * (float)gv[r][j];
                        u0[j] = (float)uu[r][j];
                        const float cv = w0[j] * u2[j] + w1[j] * u1[j] + w2[j] * u0[j];
                        mg[j] = sigmoidf_((float)sa[r][j]) * ya + (float)qq[r][j] * cv; u2[j] = u1[j]; u1[j] = u0[j]; }
                    *(u32x4*)(A16 + (size_t)row * D + c0) = (u32x4){pk2h(mg[0], mg[1]), pk2h(mg[2], mg[3]), pk2h(mg[4], mg[5]), pk2h(mg[6], mg[7])};
                    if (tt >= T - 2) { float* q = a.out + (pr ? O_CVP : O_CVS) + (size_t)sq * 2 * D + (size_t)(tt - (T - 2)) * D + c0;
                        *(f32x4*)q = (f32x4){u0[0], u0[1], u0[2], u0[3]}; *(f32x4*)(q + 4) = (f32x4){u0[4], u0[5], u0[6], u0[7]}; }
                }
            }
        }
        };
    if (IN(PH_SCAN)) {
        const int vcu = (G % 8 == 0) ? (bx % 8) * (G / 8) + bx / 8 : bx;
        constexpr int RAWB = 12288, NSL = 7, CSET = 2560, O_RAW = 0, O_CO = NSL * RAWB, O_YB = O_CO + 2 * CSET;
        static_assert(O_YB + 2 * 2048 <= LDS_BYTES - 16, "scan LDS map");
        h16* OUT16 = A16; const float* LM = (const float*)(ws + WS_LM);
        const bool pblk = vcu < 64;
        const int nitem = pblk ? 1 : (1024 - (vcu - 64) + 191) / 192;
        const int NCHB = pblk ? 256 : 4 * nitem;
#define SC_DESC(cc, prompt, sq, h, t0, first, last) \
        const bool prompt = pblk; bool first, last; int sq, h, t0; \
        if (prompt) { sq = vcu >> 5; h = vcu & 31; t0 = 16 * (cc); first = (cc) == 0; last = (cc) == 255; } \
        else { const int pair = (vcu - 64) + 192 * ((cc) >> 2); sq = pair >> 5; h = pair & 31; t0 = 16 * ((cc) & 3); first = ((cc) & 3) == 0; last = ((cc) & 3) == 3; }
#define SC_DMA(cc) do { if ((cc) < sc1) { SC_DESC(cc, prompt_, sq_, h_, t0_, first_, last_); (void)last_; (void)first_; \
            const size_t rowb_ = (size_t)(prompt_ ? sq_ * 4096 : MP + sq_ * 64) + t0_; \
            LAS unsigned char* dst_ = lds + O_RAW + ((cc) % NSL) * RAWB; \
            const int sw_ = ((lane & 7) ^ (lane >> 3)) * 8;     \
            const h16* e0_ = EAG + (rowb_ + (lane >> 3)) * 6144 + h_ * 64 + sw_; const h16* p0_ = P16 + (rowb_ + (lane >> 3)) * PP + h_ * 64 + sw_; \
            __builtin_amdgcn_global_load_lds((const unsigned*)(e0_), (LAS unsigned*)(dst_), 16, 0, 0); \
            __builtin_amdgcn_global_load_lds((const unsigned*)(e0_ + 8 * 6144), (LAS unsigned*)(dst_ + 1024), 16, 0, 0); \
            __builtin_amdgcn_global_load_lds((const unsigned*)(p0_), (LAS unsigned*)(dst_ + 2048), 16, 0, 0); \
            __builtin_amdgcn_global_load_lds((const unsigned*)(p0_ + 8 * PP), (LAS unsigned*)(dst_ + 3072), 16, 0, 0); \
            __builtin_amdgcn_global_load_lds((const unsigned*)(e0_ + D), (LAS unsigned*)(dst_ + 4096), 16, 0, 0); \
            __builtin_amdgcn_global_load_lds((const unsigned*)(e0_ + D + 8 * 6144), (LAS unsigned*)(dst_ + 5120), 16, 0, 0); \
            __builtin_amdgcn_global_load_lds((const unsigned*)(p0_ + D), (LAS unsigned*)(dst_ + 6144), 16, 0, 0); \
            __builtin_amdgcn_global_load_lds((const unsigned*)(p0_ + D + 8 * PP), (LAS unsigned*)(dst_ + 7168), 16, 0, 0); \
            __builtin_amdgcn_global_load_lds((const unsigned*)(p0_ - sw_ + (lane & 7) * 8 + 2 * D), (LAS unsigned*)(dst_ + 8192), 16, 0, 0); \
            __builtin_amdgcn_global_load_lds((const unsigned*)(p0_ - sw_ + (lane & 7) * 8 + 2 * D + 8 * PP), (LAS unsigned*)(dst_ + 9216), 16, 0, 0); \
            __builtin_amdgcn_global_load_lds((const unsigned*)(P16 + (rowb_ + ((lane & 31) >> 1)) * PP + 6144 + h_ * 16 + (lane & 1) * 8), (LAS unsigned*)(dst_ + 10240), 16, 0, 0); \
            __builtin_amdgcn_global_load_lds((const unsigned*)(LM + ((rowb_ >> 4) * 32 + h_) * 128 + (lane & 31) * 4), (LAS unsigned*)(dst_ + 11264), 16, 0, 0); } } while (0)
#define MF(a_, b_, c_) __builtin_amdgcn_mfma_f32_16x16x32_f16(a_, b_, c_, 0, 0, 0)
#define CAT8(lo_, hi_) ((h16x8){(lo_)[0], (lo_)[1], (lo_)[2], (lo_)[3], (hi_)[0], (hi_)[1], (hi_)[2], (hi_)[3]})
#define SC_C(cc) do { if ((cc) >= sc0 && (cc) < sc1) { \
            const LAS unsigned char* rs = lds + O_RAW + ((cc) % NSL) * RAWB; LAS unsigned char* co = lds + O_CO + ((cc) & 1) * CSET; \
            const int fr = lane & 15, fq = lane >> 4; const int oa = wave == 4 ? 0 : 2048, ob_ = wave == 6 ? 4096 : 6144; \
            f32x4 acc = (f32x4){0.f, 0.f, 0.f, 0.f}; \
            _Pragma("unroll") for (int kb = 0; kb < 2; ++kb) { const int o_ = fr * 128 + (((4 * kb + fq) ^ (fr & 7)) << 4); acc = MF(*(const LAS h16x8*)(rs + oa + o_), *(const LAS h16x8*)(rs + ob_ + o_), acc); } \
            _Pragma("unroll") for (int g_ = 0; g_ < 4; ++g_) { const int t = 4 * fq + g_; const bool keep = wave == 4 ? (fr < t) : (fr <= t); ((LAS h16*)(co + (wave - 4) * 512))[t * 16 + fr] = (h16)(keep ? acc[g_] : 0.f); } \
            if (wave == 4) { const float M_ = ((const LAS float*)(rs + 11264))[lane], L15 = ((const LAS float*)(rs + 11264 + 256))[lane]; \
                ((LAS float*)(co + 1536))[lane] = __expf(M_); ((LAS float*)(co + 1792))[lane] = __expf(L15 - M_); ((LAS float*)(co + 2048))[lane] = __expf(L15); } } } while (0)
        f32x4 St[4];
#pragma unroll
        for (int n = 0; n < 4; ++n) St[n] = (f32x4){0.f, 0.f, 0.f, 0.f};
#define CVT4(x_) ((h16x4){(h16)(x_)[0], (h16)(x_)[1], (h16)(x_)[2], (h16)(x_)[3]})
#define TRR(p_) __builtin_bit_cast(h16x4, __builtin_amdgcn_ds_read_tr16_b64_v4i16((LAS s16x4*)(p_)))
#define SC_ROW(cc, PROMPT) do { if ((cc) >= sc0 && (cc) < sc1) { SC_DESC(cc, prompt, sq, h, t0, first, last); \
            const int fr = lane & 15, fq = lane >> 4; \
            float* sp = a.out + (prompt ? O_WKP : O_WKS) + ((size_t)(sq * 32 + h) * 64 + 16 * wave + fr) * 64 + 4 * fq; \
            if (first) { _Pragma("unroll") for (int n = 0; n < 4; ++n) { St[n] = (f32x4){0.f, 0.f, 0.f, 0.f}; if (!(PROMPT)) St[n] = *(const f32x4*)(a.in[4] + ((size_t)(sq * 32 + h) * 64 + 16 * wave + fr) * 64 + 16 * n + 4 * fq); } } \
            LAS unsigned char* rs = lds + O_RAW + ((cc) % NSL) * RAWB; const LAS unsigned char* co = lds + O_CO + ((cc) & 1) * CSET; \
              \
            f32x4 em[4], gm[4], e4[4]; h16x4 atl[2][2], rtl[2][2], kbt[4], bbt[4]; \
              \
            _Pragma("unroll") for (int n = 0; n < 4; ++n) em[n] = *(const LAS f32x4*)(co + 1536 + (16 * n + 4 * fq) * 4); \
            _Pragma("unroll") for (int b = 0; b < 2; ++b) { \
                const int o0_ = fr * 128 + (((4 * b + (fq >> 1)) ^ (fr & 7)) << 4) + 8 * (fq & 1), o1_ = fr * 128 + (((4 * b + 2 + (fq >> 1)) ^ (fr & 7)) << 4) + 8 * (fq & 1); \
                atl[b][0] = *(const LAS h16x4*)(rs + o0_); atl[b][1] = *(const LAS h16x4*)(rs + o1_); rtl[b][0] = *(const LAS h16x4*)(rs + 2048 + o0_); rtl[b][1] = *(const LAS h16x4*)(rs + 2048 + o1_); } \
            const h16x4 aak = *(const LAS h16x4*)(co + (fr * 16 + 4 * fq) * 2), vm = *(const LAS h16x4*)(rs + 8192 + ((16 * wave + fr) * 16 + 4 * fq) * 2), tA = *(const LAS h16x4*)(rs + 10240 + (fr * 16 + 4 * fq) * 2), \
                        ark = *(const LAS h16x4*)(co + 512 + (fr * 16 + 4 * fq) * 2), arb = *(const LAS h16x4*)(co + 1024 + (fr * 16 + 4 * fq) * 2); \
            _Pragma("unroll") for (int n = 0; n < 4; ++n) { const int tr_ = 4 * fq + (fr >> 2); const int o_ = tr_ * 128 + (((2 * n + ((fr & 3) >> 1)) ^ (tr_ & 7)) << 4) + 8 * (fr & 1); kbt[n] = TRR(rs + 6144 + o_); bbt[n] = TRR(rs + 4096 + o_); } \
            _Pragma("unroll") for (int n = 0; n < 4; ++n) { gm[n] = *(const LAS f32x4*)(co + 2048 + (16 * n + 4 * fq) * 4); e4[n] = *(const LAS f32x4*)(co + 1792 + (16 * n + 4 * fq) * 4); } \
            __builtin_amdgcn_sched_barrier(0); \
            const h16x4 z4 = (h16x4){(h16)0.f, (h16)0.f, (h16)0.f, (h16)0.f}; \
            h16x4 sh[4]; \
            _Pragma("unroll") for (int n = 0; n < 4; ++n) { const f32x4 x = St[n] * em[n]; sh[n] = CVT4(x); } \
            f32x4 W1 = (f32x4){0.f, 0.f, 0.f, 0.f}, Yt = W1; \
              \
            _Pragma("unroll") for (int b = 0; b < 2; ++b) { const h16x8 sb = CAT8(sh[2 * b], sh[2 * b + 1]); \
                W1 = MF(CAT8(atl[b][0], atl[b][1]), sb, W1); Yt = MF(CAT8(rtl[b][0], rtl[b][1]), sb, Yt); } \
            W1 = MF(CAT8(aak, z4), CAT8(vm, z4), W1); \
            const h16x4 w1h = CVT4(W1); \
            f32x4 U = MF(CAT8(tA, z4), CAT8(w1h, z4), ((f32x4){0.f, 0.f, 0.f, 0.f})); \
            const f32x4 nU = -U; const h16x4 uh = CVT4(nU); const h16x8 vu = CAT8(vm, uh);     \
            Yt = MF(CAT8(ark, arb), vu, Yt); \
            _Pragma("unroll") for (int n = 0; n < 4; ++n) { const f32x4 tmp = MF(CAT8(kbt[n], bbt[n]), vu, ((f32x4){0.f, 0.f, 0.f, 0.f})); St[n] = gm[n] * St[n] + e4[n] * tmp; } \
            { LAS h16* yb = (LAS h16*)(lds + O_YB + ((cc) & 1) * 2048) + (4 * fq) * 64 + 16 * wave + fr; (void)t0; \
              yb[0] = (h16)Yt[0]; yb[64] = (h16)Yt[1]; yb[128] = (h16)Yt[2]; yb[192] = (h16)Yt[3]; } \
            if (last) { _Pragma("unroll") for (int n = 0; n < 4; ++n) *(f32x4*)(sp + 16 * n) = St[n]; } } } while (0)
#define SC_YOUT(cc) do { if ((cc) >= sc0 && (cc) < sc1 && wave >= 5) { SC_DESC(cc, prompt, sq, h, t0, first, last); (void)first; (void)last; \
            const int L_ = (wave - 5) * 64 + lane, t_ = L_ >> 3, part_ = L_ & 7; \
            *(u32x4*)(OUT16 + ((size_t)(prompt ? sq * 4096 : MP + sq * 64) + t0 + t_) * D + h * 64 + part_ * 8) = *(const LAS u32x4*)(lds + O_YB + ((cc) & 1) * 2048 + t_ * 128 + part_ * 16); } } while (0)
#define SC_BARRIER() do { asm volatile("s_waitcnt lgkmcnt(0)" ::: "memory"); __builtin_amdgcn_s_barrier(); asm volatile("" ::: "memory"); } while (0)
        auto scan_run = [&](const int sc0, const int sc1) {
            if (wave < 4) {
                SC_BARRIER();
                if (pblk) { for (int it = sc0 - 1; it <= sc1; ++it) { SC_ROW(it, true); SC_BARRIER(); } }
                else { for (int it = sc0 - 1; it <= sc1; ++it) { SC_ROW(it, false); SC_BARRIER(); } }
            } else if (wave == 7) {
                SC_DMA(sc0); SC_DMA(sc0 + 1); SC_DMA(sc0 + 2); SC_DMA(sc0 + 3); SC_DMA(sc0 + 4);
                asm volatile("s_waitcnt vmcnt(48)" ::: "memory");
                SC_BARRIER();
                for (int it = sc0 - 1; it <= sc1; ++it) {
                    SC_DMA(it + 6);
                    if (it + 6 < sc1) asm volatile("s_waitcnt vmcnt(48)" ::: "memory");
                    else asm volatile("s_waitcnt vmcnt(0)" ::: "memory");
                    SC_BARRIER();
                }
            } else {
                SC_BARRIER();
                for (int it = sc0 - 1; it <= sc1; ++it) { SC_C(it + 1); SC_YOUT(it - 1); SC_BARRIER(); }
            }
        };
        if (pblk) scan_run(0, PREP_CA);
        else prep_run((vcu - 64) * NWAVES + wave, (G - 64) * NWAVES, (2 * (256 - PREP_CA) + MS / 16) * 32, true);
        xcd_barrier(xbar);
        scan_run(pblk ? PREP_CA : 0, pblk ? 256 : NCHB);
        if (!pblk) { __syncthreads(); merge_run(vcu - 64, G - 64, 2 * MERGE_CA, true); }
        if (!pblk) {
            __syncthreads();
            LAS float* scr = (LAS float*)(lds + wave * 16384);
            const int gw = (vcu - 64) * NWAVES + wave, NGW = (G - 64) * NWAVES;
#define PICKL2(it, out) PICKL((it) + late_tail, out)
            CVT_RUN(LATE_N - gu_tail - late_tail, PICKL2);
#undef PICKL2
        }
#undef SC_DESC
#undef SC_DMA
#undef MF
#undef CAT8
#undef SC_C
#undef CVT4
#undef TRR
#undef SC_ROW
#undef SC_BARRIER
#undef SC_YOUT
    }
    SEAM(PH_SCAN);
    if (IN(PH_MERGE)) merge_run(bx, G, MT / 16 - 2 * MERGE_CA, false);
    SEAM(PH_MERGE);
    if (IN(PH_WOUT)) {
        { pg8::Gemm g{A16, WOUT, MT, D, D}; pg8::Order S; S.init(MT, D, D, G, bx, 0, MP / 256); pg8::EpiRes<true, true> E{XH, XH, SLAB, 1.0f, 0}; pg8::gemm_phase(lds, g, S, E); }
    }
    SEAM(PH_WOUT);
    if (IN(PH_RMS2)) {
#define FR_(m) ((float*)nullptr)
        f32x4 sx[8]; h16x8 sp[16]; const int ms = MP + gw; const bool hs_ = ms < MT;
        if (hs_) rms_load_s(Y + (size_t)ms * D, (const h16*)SLAB + (size_t)(ms - MP) * D, sx, sp, lane);
        RMS_PIPE_H(MP, XR_, a.in[24], OR_, FR_);
#undef FR_
        if (hs_) rms_fin_s(sx, sp, 1.0f, a.in[24], A16 + (size_t)ms * D, nullptr, Y + (size_t)ms * D, lane);
        for (int m = ms + NGW; m < MT; m += NGW) rms_row_f16(Y + (size_t)m * D, a.in[24], A16 + (size_t)m * D, nullptr, lane, (const h16*)SLAB + (size_t)(m - MP) * D, 1.0f, Y + (size_t)m * D);
    }
    SEAM(PH_RMS2);
    if (IN(PH_FFN2_GU)) { pg8::Gemm g{A16, W2GU, MT, 2 * FF, D}; pg8::Order S; S.init(MT, 2 * FF, D, G, bx, 0, -1); pg8::EpiSwiGLU E{HM, FF}; pg8::gemm_phase(lds, g, S, E);
        if (gu_left > 0 && bx >= gu_left) {
            LAS float* scr = (LAS float*)(lds + wave * 16384);
            const int gw = (bx - gu_left) * NWAVES + wave, NGW = (G - gu_left) * NWAVES;
#define PICKL3(it, out) PICKL((it) + LATE_N - gu_tail, out)
            CVT_RUN(gu_tail, PICKL3);
#undef PICKL3
        } }
    SEAM(PH_FFN2_GU);
    if (IN(PH_FFN2_D)) { pg8::Gemm g{HM, W2D, MT, D, FF}; pg8::Order S; S.init(MT, D, FF, G, bx, 0, MP / 256); pg8::EpiRes<true, true> E{XH, A16, SLAB, 0.5f, 0}; pg8::gemm_phase(lds, g, S, E); }
    SEAM(PH_FFN2_D);
    if (IN(PH_FINAL)) {
#define XA_(m) (A16 + (size_t)(m) * D)
#define ON_(m) ((h16*)nullptr)
#define FY_(m) (Y + (size_t)(m) * D)
        f32x4 sx[8]; h16x8 sp[16]; const int ms = MP + gw; const bool hs_ = ms < MT;
        if (hs_) rms_load_s(Y + (size_t)ms * D, (const h16*)SLAB + (size_t)(ms - MP) * D, sx, sp, lane);
        RMS_PIPE_H(MP, XA_, a.in[28], ON_, FY_);
        if (hs_) rms_fin_s(sx, sp, 0.5f, a.in[28], nullptr, Y + (size_t)ms * D, nullptr, lane);
#undef XA_
#undef ON_
#undef FY_
#undef XR_
#undef OR_
        for (int m = ms + NGW; m < MT; m += NGW) rms_row_f16(Y + (size_t)m * D, a.in[28], nullptr, Y + (size_t)m * D, lane, (const h16*)SLAB + (size_t)(m - MP) * D, 0.5f, nullptr);
    }
    if (PROBE_MASK) {
        pr_t[PH_N] = __builtin_amdgcn_s_memrealtime();
        if (bx == 0 && tid == 0) { unsigned long long tot = 0;
#pragma unroll
            for (int k = 0; k < PH_N; ++k) if ((PROBE_MASK >> k) & 1u) tot += pr_t[k + 1] - pr_t[k];
            const unsigned long long t0 = __builtin_amdgcn_s_memrealtime();
            while (__builtin_amdgcn_s_memrealtime() - t0 < tot * PROBE_MUL) __builtin_amdgcn_s_sleep(8);
        }
    }
#undef IN
#undef SEAM
}

extern "C" void kernel_launch(void* const* d_in, const int* in_sizes, int n_in, void* d_out, int out_size, void* d_ws, size_t ws_size, hipStream_t stream) {
    static int grid = 0;
    if (grid == 0) {
        if (n_in != 29 || (size_t)out_size != O_END || ws_size < WS_END) { fprintf(stderr, "kernel_launch: unexpected shapes (n_in %d out %d ws %zu need %zu)\n", n_in, out_size, ws_size, (size_t)WS_END); grid = -1; return; }
        int dev = 0, cus = 0, per_cu = 0;
        if (hipGetDevice(&dev) != hipSuccess || hipDeviceGetAttribute(&cus, hipDeviceAttributeMultiprocessorCount, dev) != hipSuccess) { grid = -1; return; }
        if (hipFuncSetAttribute((const void*)fwd_kernel, hipFuncAttributeMaxDynamicSharedMemorySize, LDS_BYTES) != hipSuccess) { grid = -1; return; }
        if (hipOccupancyMaxActiveBlocksPerMultiprocessor(&per_cu, (const void*)fwd_kernel, NTHR, LDS_BYTES) != hipSuccess || per_cu < 1) { fprintf(stderr, "kernel_launch: occupancy query failed (%d)\n", per_cu); grid = -1; return; }
        grid = cus;
    }
    if (grid < 0) return;
    if (hipMemsetAsync((char*)d_ws + WS_CTL, 0, XCD_BAR_WORDS * 4, stream) != hipSuccess) return;
    Args a{};
    for (int i = 0; i < 29; ++i) a.in[i] = (const float*)d_in[i];
    a.out = (float*)d_out; a.ws = (unsigned char*)d_ws; a.ph_lo = 0; a.ph_hi = PH_N;
    void* kargs[] = {&a};
    hipError_t e = hipLaunchCooperativeKernel((const void*)fwd_kernel, dim3(grid), dim3(NTHR), kargs, LDS_BYTES, stream);
    if (e != hipSuccess) fprintf(stderr, "kernel_launch: cooperative launch failed: %s (grid %d)\n", hipGetErrorString(e), grid);
}
```
